# Optimizing an MI355X kernel written in HIP

```python
import jax, jax.numpy as jnp
from jax import lax
import numpy as np


D_MODEL = 1024
BATCH = 2
SEQ = 16384
DEPTH = 2

D_MIX = D_MODEL
D_POOL = D_MIX // 2
POOL_WINDOWS = (2, 4, 8, 16)
N_POOL_GROUPS = len(POOL_WINDOWS)
POOL_GROUP_DIM = D_POOL // N_POOL_GROUPS
D_ATTN = D_MIX - D_POOL
NA_HEAD_DIM = 32
NA_HEADS = D_ATTN // NA_HEAD_DIM
D_IN = D_POOL + 3 * D_ATTN
GRID_W = 64
NA_KH_MAX = 8
NA_KW = 16
D_FF = 4 * D_MODEL
N_EXPERTS = 8
TOP_K = 2
D_FF_EXPERT = (7 * D_MODEL) // 2
MOE_BLOCK = 256
RMS_EPS = 1e-6
N_DENSE = (DEPTH + 1) // 2
N_MOE = DEPTH // 2

kernel_name = 'hybrid_pool_natten_moe_encoder'


def rmsnorm(x, g):
    xf = x.astype(jnp.float32)
    y = xf * lax.rsqrt(jnp.mean(xf * xf, axis=-1, keepdims=True) + RMS_EPS)
    return (y * g.astype(jnp.float32)).astype(x.dtype)


def pool_mixer(u, pool_w, pool_scale):
    S = u.shape[1]
    uf = u.astype(jnp.float32)
    cs = jnp.concatenate([jnp.zeros_like(uf[:, :1]), jnp.cumsum(uf, axis=1)], axis=1)
    t = np.arange(S)
    outs = []
    for g, w in enumerate(POOL_WINDOWS):
        c_lo, c_hi = g * POOL_GROUP_DIM, (g + 1) * POOL_GROUP_DIM
        lo = np.clip(t - w // 2, 0, S)
        hi = np.clip(t + w - w // 2, 0, S)
        csg = cs[:, :, c_lo:c_hi]
        win_mean = (csg[:, hi] - csg[:, lo]) / (hi - lo).astype(np.float32)[None, :, None]
        delta = (win_mean - uf[:, :, c_lo:c_hi]).astype(u.dtype)
        outs.append(jnp.einsum('bsc,cd->bsd', delta, pool_w[g]))
    return jnp.concatenate(outs, axis=-1) * pool_scale


def neighbourhood_attention(q, k, v, rpb):
    B, S = q.shape[0], q.shape[1]
    rows = S // GRID_W
    kh = min(NA_KH_MAX, rows)
    qg = (q * (NA_HEAD_DIM ** -0.5)).reshape(B, rows, GRID_W, NA_HEADS, NA_HEAD_DIM)
    kg = k.reshape(B, rows, GRID_W, NA_HEADS, NA_HEAD_DIM)
    vg = v.reshape(B, rows, GRID_W, NA_HEADS, NA_HEAD_DIM)
    cols = np.arange(GRID_W)
    c0 = np.clip(cols - NA_KW // 2, 0, GRID_W - NA_KW)
    col_idx = c0[:, None] + np.arange(NA_KW)[None, :]
    dc = col_idx - cols[:, None] + (NA_KW - 1)

    def one_row(r):
        r0 = jnp.clip(r - kh // 2, 0, rows - kh)
        k_rows = lax.dynamic_slice_in_dim(kg, r0, kh, axis=1)
        v_rows = lax.dynamic_slice_in_dim(vg, r0, kh, axis=1)
        k_nb = k_rows[:, :, col_idx]
        v_nb = v_rows[:, :, col_idx]
        q_row = lax.dynamic_index_in_dim(qg, r, axis=1, keepdims=False)
        s = jnp.einsum('bchd,bicjhd->bhcij', q_row, k_nb, preferred_element_type=jnp.float32)
        dr = r0 + jnp.arange(kh) - r + (NA_KH_MAX - 1)
        bias = rpb[:, dr[:, None, None], dc[None, :, :]]
        s = s + jnp.transpose(bias, (0, 2, 1, 3)).astype(jnp.float32)[None]
        p = jax.nn.softmax(s.reshape(B, NA_HEADS, GRID_W, kh * NA_KW), axis=-1)
        p = p.reshape(B, NA_HEADS, GRID_W, kh, NA_KW).astype(v.dtype)
        return jnp.einsum('bhcij,bicjhd->bchd', p, v_nb)

    out = lax.map(one_row, jnp.arange(rows))
    return jnp.transpose(out, (1, 0, 2, 3, 4)).reshape(B, S, D_ATTN)


def swiglu(x, wg, wu, wd):
    a = jnp.einsum('bsd,df->bsf', x, wg)
    b = jnp.einsum('bsd,df->bsf', x, wu)
    return jnp.einsum('bsf,fd->bsd', jax.nn.silu(a) * b, wd)


def moe_swiglu(h, w_router, w_gate, w_up, w_down):
    B, S, D = h.shape
    T = B * S
    xt = h.reshape(T, D)
    logits = jnp.einsum('td,de->te', xt, w_router, preferred_element_type=jnp.float32)
    top_logit, top_idx = lax.top_k(logits, TOP_K)
    gates = jax.nn.softmax(top_logit, axis=-1)
    A = T * TOP_K
    e_flat = top_idx.reshape(A)
    g_flat = gates.reshape(A)
    tok_flat = jnp.repeat(jnp.arange(T, dtype=jnp.int32), TOP_K)
    order = jnp.argsort(e_flat)
    e_sorted = e_flat[order]
    counts = jnp.bincount(e_flat, length=N_EXPERTS)
    padded = (counts + MOE_BLOCK - 1) // MOE_BLOCK * MOE_BLOCK
    start = jnp.cumsum(counts) - counts
    pad_end = jnp.cumsum(padded)
    pad_start = pad_end - padded
    dest = pad_start[e_sorted] + (jnp.arange(A) - start[e_sorted])
    n_blocks = (A + MOE_BLOCK - 1) // MOE_BLOCK + N_EXPERTS
    n_rows = n_blocks * MOE_BLOCK
    row_tok = jnp.zeros((n_rows,), jnp.int32).at[dest].set(tok_flat[order])
    row_gate = jnp.zeros((n_rows,), jnp.float32).at[dest].set(g_flat[order])
    block_expert = jnp.minimum(
        jnp.searchsorted(pad_end, jnp.arange(n_blocks) * MOE_BLOCK, side='right'), N_EXPERTS - 1)

    def run_block(args):
        tok, gate, e = args
        xb = xt[tok]
        a = xb @ w_gate[e]
        b = xb @ w_up[e]
        y = (jax.nn.silu(a) * b) @ w_down[e]
        return y * gate[:, None].astype(y.dtype)

    ys = lax.map(run_block, (row_tok.reshape(n_blocks, MOE_BLOCK),
                             row_gate.reshape(n_blocks, MOE_BLOCK), block_expert))
    out = jnp.zeros((T, D), h.dtype).at[row_tok].add(ys.reshape(n_rows, D).astype(h.dtype))
    return out.reshape(B, S, D)


def setup_inputs(seed: int = 0) -> dict:
    key = jax.random.key(seed)
    ks = jax.random.split(key, 17)
    f32 = jnp.float32

    def nrm(k, shape, scale):
        return jax.random.normal(k, shape, f32) * scale

    def gain(k, shape):
        return 1.0 + 0.05 * jax.random.normal(k, shape, f32)

    return {
        'x': nrm(ks[0], (BATCH, SEQ, D_MODEL), 1.0),
        'mix_norm_pre': gain(ks[1], (DEPTH, D_MODEL)),
        'mix_norm_post': gain(ks[2], (DEPTH, D_MODEL)),
        'ffn_norm_pre': gain(ks[3], (DEPTH, D_MODEL)),
        'ffn_norm_post': gain(ks[4], (DEPTH, D_MODEL)),
        'w_in': nrm(ks[5], (DEPTH, D_MODEL, D_IN), D_MODEL ** -0.5),
        'pool_w': nrm(ks[6], (DEPTH, N_POOL_GROUPS, POOL_GROUP_DIM, POOL_GROUP_DIM), POOL_GROUP_DIM ** -0.5),
        'pool_scale': gain(ks[7], (DEPTH, D_POOL)),
        'na_rpb': nrm(ks[8], (DEPTH, NA_HEADS, 2 * NA_KH_MAX - 1, 2 * NA_KW - 1), 0.1),
        'w_out': nrm(ks[9], (DEPTH, D_MIX, D_MODEL), D_MIX ** -0.5),
        'dense_w_gate': nrm(ks[10], (N_DENSE, D_MODEL, D_FF), D_MODEL ** -0.5),
        'dense_w_up': nrm(ks[11], (N_DENSE, D_MODEL, D_FF), D_MODEL ** -0.5),
        'dense_w_down': nrm(ks[12], (N_DENSE, D_FF, D_MODEL), D_FF ** -0.5),
        'moe_router': nrm(ks[13], (N_MOE, D_MODEL, N_EXPERTS), D_MODEL ** -0.5),
        'moe_w_gate': nrm(ks[14], (N_MOE, N_EXPERTS, D_MODEL, D_FF_EXPERT), D_MODEL ** -0.5),
        'moe_w_up': nrm(ks[15], (N_MOE, N_EXPERTS, D_MODEL, D_FF_EXPERT), D_MODEL ** -0.5),
        'moe_w_down': nrm(ks[16], (N_MOE, N_EXPERTS, D_FF_EXPERT, D_MODEL), D_FF_EXPERT ** -0.5),
    }


def reference(x, mix_norm_pre, mix_norm_post, ffn_norm_pre, ffn_norm_post, w_in, pool_w,
              pool_scale, na_rpb, w_out, dense_w_gate, dense_w_up, dense_w_down,
              moe_router, moe_w_gate, moe_w_up, moe_w_down):
    B, S, _ = x.shape
    h = x
    for layer in range(DEPTH):
        hn = rmsnorm(h, mix_norm_pre[layer])
        proj = jnp.einsum('bsd,de->bse', hn, w_in[layer])
        u = proj[..., :D_POOL]
        q = proj[..., D_POOL:D_POOL + D_ATTN].reshape(B, S, NA_HEADS, NA_HEAD_DIM)
        k = proj[..., D_POOL + D_ATTN:D_POOL + 2 * D_ATTN].reshape(B, S, NA_HEADS, NA_HEAD_DIM)
        v = proj[..., D_POOL + 2 * D_ATTN:].reshape(B, S, NA_HEADS, NA_HEAD_DIM)
        y_pool = pool_mixer(u, pool_w[layer], pool_scale[layer])
        y_na = neighbourhood_attention(q, k, v, na_rpb[layer])
        mix = jnp.einsum('bse,ed->bsd', jnp.concatenate([y_pool, y_na], axis=-1), w_out[layer])
        h = h + rmsnorm(mix, mix_norm_post[layer])
        hn = rmsnorm(h, ffn_norm_pre[layer])
        j = layer // 2
        if layer % 2 == 0:
            f = swiglu(hn, dense_w_gate[j], dense_w_up[j], dense_w_down[j])
        else:
            f = moe_swiglu(hn, moe_router[j], moe_w_gate[j], moe_w_up[j], moe_w_down[j])
        h = h + rmsnorm(f, ffn_norm_post[layer])
    return h
```

```cpp
#include <hip/hip_runtime.h>
#include <cstdio>
#include <cstdint>

#ifndef MODE
#define MODE 0
#endif

#define GAS __attribute__((address_space(1)))
#define LAS __attribute__((address_space(3)))
typedef unsigned short bf16;
typedef unsigned v4u __attribute__((ext_vector_type(4)));
typedef unsigned v2u __attribute__((ext_vector_type(2)));
typedef float f32x4 __attribute__((ext_vector_type(4)));
typedef float f32x2 __attribute__((ext_vector_type(2)));
typedef short bf16x8 __attribute__((ext_vector_type(8)));

constexpr int BATCH = 2, SEQ = 16384, T = BATCH * SEQ, D = 1024, DIN = 2048, DPOOL = 512, DATT = 512, NH = 16, HD = 32;
constexpr int GRIDW = 64, GROWS = SEQ / GRIDW, KH = 8, KW = 16;
constexpr int DFF = 4096, NE = 8, DFFE = 3584, DEPTH = 2;
constexpr int NPROJ = 1536;
constexpr float RMS_EPS = 1e-6f;
constexpr float LOG2E = 1.4426950408889634f;
constexpr float QSCALE = 0.17677669529663687f * LOG2E;
constexpr int CHUNK_BLK = 64;
constexpr int MAXCHUNK = 5;
constexpr int MAXBLK = 264;

constexpr size_t MiB = 1u << 20;
constexpr size_t WS_CTL = 0, CTL_ZERO_BYTES = 1 * MiB;
constexpr size_t WS_LIST = 1 * MiB;
constexpr size_t WS_INFO = 2 * MiB;
constexpr size_t WS_LISTID = 2 * MiB + 512 * 1024;
constexpr size_t WS_BTAB = 2 * MiB + 768 * 1024;
constexpr size_t WS_WP = 3 * MiB;
constexpr size_t WS_WIN = 4 * MiB;
constexpr size_t WS_WOUT = 12 * MiB;
constexpr size_t WS_WGU0 = 16 * MiB;
constexpr size_t WS_WD0 = 32 * MiB;
constexpr size_t WS_WGUM = 40 * MiB;
constexpr size_t WS_WDM = 152 * MiB;
constexpr size_t WS_HN = 208 * MiB;
constexpr size_t WS_R = 272 * MiB;
constexpr size_t WS_HFF = WS_R;
constexpr size_t WS_Y = WS_R + 128 * MiB;
constexpr size_t WS_PROJ = WS_R;
constexpr size_t WS_VT = WS_R + 96 * MiB;
constexpr size_t WS_MIXO = WS_R + 128 * MiB;
constexpr size_t WS_MIX = WS_R + 192 * MiB;
constexpr size_t WS_END = 532 * MiB;
constexpr int CW_TMO = 0, CW_CODE = 1;
constexpr int CW_BAR = 4096;
constexpr int CW_CNT = 8192;
constexpr int CW_DBG = 12288;

constexpr int RING_BYTES = 131072;
constexpr int TOKBUF_OFF = RING_BYTES;
constexpr int BLK_OFF = TOKBUF_OFF + 1024;
constexpr int BST_OFF = BLK_OFF + 272 * 4;
constexpr int LCNT_OFF = BST_OFF + 64;
constexpr int MISC_OFF = LCNT_OFF + 64;
constexpr int LDS_BYTES = 147456;
static_assert(MISC_OFF + 64 <= LDS_BYTES, "LDS map");

#define RLX_AGENT __ATOMIC_RELAXED, __HIP_MEMORY_SCOPE_AGENT
#define LDS_WAIT() asm volatile("s_waitcnt lgkmcnt(0)" ::: "memory")
#define VM_WAIT() asm volatile("s_waitcnt vmcnt(0)" ::: "memory")
__device__ __forceinline__ unsigned f2bf(float f) { unsigned u = __builtin_bit_cast(unsigned, f); return (u + 0x7fffu + ((u >> 16) & 1u)) >> 16; }
__device__ __forceinline__ unsigned pk2(float lo, float hi) { return f2bf(lo) | (f2bf(hi) << 16); }
__device__ __forceinline__ float bflo(unsigned w) { return __builtin_bit_cast(float, w << 16); }
__device__ __forceinline__ float bfhi(unsigned w) { return __builtin_bit_cast(float, w & 0xffff0000u); }
__device__ __forceinline__ float bf2f(bf16 v) { return __builtin_bit_cast(float, (unsigned)v << 16); }
__device__ __forceinline__ unsigned cvt_pk_bf16(float lo, float hi) { unsigned r; asm volatile("v_cvt_pk_bf16_f32 %0, %1, %2" : "=v"(r) : "v"(lo), "v"(hi)); return r; }
__device__ __forceinline__ float wave_sum(float v) {
#pragma unroll
    for (int o = 1; o < 64; o <<= 1) v += __shfl_xor(v, o);
    return v;
}

#define XB_TMO      128
#define XB_XCNT(j)  (256  + 64 * (j))
#define XB_XSUB(j)  (1280 + 64 * (j))
#define XB_XGEN(j)  (2304 + 64 * (j))
#define XB_TOP      3328
#define XB_TOPGEN   3392
#define XCD_BAR_WORDS 3456
#define XB_SPIN_CAP (1u << 18)
__device__ __forceinline__ unsigned xb_ld(unsigned* p)              { return __hip_atomic_load(p, __ATOMIC_RELAXED, __HIP_MEMORY_SCOPE_AGENT); }
__device__ __forceinline__ unsigned xb_add(unsigned* p, unsigned v) { return __hip_atomic_fetch_add(p, v, __ATOMIC_RELAXED, __HIP_MEMORY_SCOPE_AGENT); }
__device__ __forceinline__ unsigned xb_xcc_id() { return (unsigned)__builtin_amdgcn_s_getreg((3 << 11) | 20) & 0xFu; }
#define XB_SPIN(cond, bar) do { unsigned _sp = 0; while (cond) { __builtin_amdgcn_s_sleep(1); \
    if ((++_sp & 255u) == 0u) { if (xb_ld(&(bar)[XB_TMO])) break; if (_sp > XB_SPIN_CAP) { atomicAdd(&(bar)[XB_TMO], 1u); break; } } } } while (0)
struct XcdBarrier { unsigned* bar; unsigned x; volatile LAS unsigned* st; };
__device__ __forceinline__ XcdBarrier xcd_barrier_post(unsigned* bar, volatile LAS unsigned* st) {
    XcdBarrier b; b.bar = bar; b.x = xb_xcc_id(); b.st = st;
    if (threadIdx.x == 0) (void)xb_add(&bar[XB_XCNT(b.x)], 1u);
    return b;
}
__device__ __forceinline__ void xcd_barrier_complete(unsigned* bar, unsigned x, unsigned& nloc, unsigned& nx) {
    const unsigned G = gridDim.x * gridDim.y * gridDim.z;
    unsigned sum, cnt, mine, sp = 0u;
    for (;;) {
        sum = 0u; cnt = 0u; mine = 0u;
#pragma unroll
        for (unsigned j = 0; j < 16; ++j) { const unsigned c = xb_ld(&bar[XB_XCNT(j)]); sum += c; cnt += (c > 0u) ? 1u : 0u; mine = (j == x) ? c : mine; }
        if (sum == G) break;
        __builtin_amdgcn_s_sleep(1);
        if ((++sp & 255u) == 0u) { if (xb_ld(&bar[XB_TMO])) break; if (sp > XB_SPIN_CAP) { atomicAdd(&bar[XB_TMO], 1u); break; } }
    }
    nloc = mine > 0u ? mine : 1u; nx = cnt > 0u ? cnt : 1u;
}
__device__ __forceinline__ void xcd_barrier(const XcdBarrier& b) {
    asm volatile("s_waitcnt vmcnt(0)" ::: "memory");
    __syncthreads();
    if (threadIdx.x == 0) {
        unsigned* bar = b.bar;
        __builtin_amdgcn_s_waitcnt(0);
        unsigned nloc = b.st[0], nx = b.st[1];
        if (nloc == 0u) { xcd_barrier_complete(bar, b.x, nloc, nx); b.st[0] = nloc; b.st[1] = nx; }
        const unsigned old = xb_add(&bar[XB_XSUB(b.x)], 1u);
        const unsigned gen = old / nloc;
        if (old + 1u == (gen + 1u) * nloc) {
            __builtin_amdgcn_fence(__ATOMIC_RELEASE, "agent");
            asm volatile("s_waitcnt vmcnt(0)" ::: "memory");
            const unsigned og = xb_add(&bar[XB_TOP], 1u);
            const unsigned tg = og / nx;
            if (og + 1u == (tg + 1u) * nx) xb_add(&bar[XB_TOPGEN], 1u);
            else XB_SPIN(xb_ld(&bar[XB_TOPGEN]) == tg, bar);
            __builtin_amdgcn_fence(__ATOMIC_ACQUIRE, "agent");
            xb_add(&bar[XB_XGEN(b.x)], 1u);
            asm volatile("s_waitcnt vmcnt(0)" ::: "memory");
        } else {
            XB_SPIN(xb_ld(&bar[XB_XGEN(b.x)]) == gen, bar);
            __builtin_amdgcn_fence(__ATOMIC_ACQUIRE, "agent");
            asm volatile("s_waitcnt vmcnt(0)" ::: "memory");
        }
    }
    __syncthreads();
}

namespace pg8 {
constexpr int BM = 256, BK = 64, HALF = 128, HTB = HALF * BK * 2, STAGE_BYTES = 8 * HTB, NXCD = 8, WGM = 8;
__host__ __device__ __forceinline__ int lds_byte(int r, int c) { const int st = (r >> 4) * 2 + (c >> 5), rr = r & 15, cc = c & 31, ob = rr * 64 + cc * 2; return st * 1024 + (ob ^ (((ob >> 9) & 1) << 5)); }
__host__ __device__ __forceinline__ void stage_rc(int b, int& R, int& C) { const int st = b / 1024, sb = b % 1024, swz = sb ^ (((sb >> 9) & 1) << 5); R = (st >> 1) * 16 + swz / 64; C = (st & 1) * 32 + (swz % 64) / 2; }
__host__ __device__ __forceinline__ int perm32(int rho) { const int n = rho >> 4, i = rho & 15; return 8 * (i >> 2) + 4 * n + (i & 3); }

struct Unit { const char* A; const char* B; const int* list; bf16* obase; int orow, ocol, ldc; float scale; };

__device__ __forceinline__ bool tile_order(int i, int G, int c, int nM, int nN, int& pm, int& pn) {
    const int nwg = nM * nN; const long L = (long)i * G + c; if (L >= nwg) return false;
    int wgid = (int)L; { const int q = nwg / NXCD, r = nwg % NXCD, xcd = wgid % NXCD, off = wgid / NXCD; wgid = (xcd < r ? xcd * (q + 1) : r * (q + 1) + (xcd - r) * q) + off; }
    const int nig = WGM * nN, gid = wgid / nig, fm = gid * WGM, gsz = (nM - fm) < WGM ? (nM - fm) : WGM;
    pm = fm + ((wgid % nig) % gsz); pn = (wgid % nig) / gsz; return true;
}

struct EpiBf16 {
    __device__ __forceinline__ void operator()(const f32x4 (&acc)[2][2][4][2], const Unit& u, int wr, int wc, int fr, int fq) const {
        const int row0 = u.orow + wr * 64 + fr, col0 = u.ocol + wc * 32 + 8 * fq; const float sc = u.scale;
#pragma unroll
        for (int ai = 0; ai < 2; ++ai)
#pragma unroll
            for (int m = 0; m < 4; ++m) { bf16* rowp = u.obase + (size_t)(row0 + ai * HALF + m * 16) * u.ldc + col0;
#pragma unroll
                for (int bj = 0; bj < 2; ++bj) { const f32x4 v0 = acc[ai][bj][m][0] * sc, v1 = acc[ai][bj][m][1] * sc;
                    v4u w; w.x = cvt_pk_bf16(v0[0], v0[1]); w.y = cvt_pk_bf16(v0[2], v0[3]); w.z = cvt_pk_bf16(v1[0], v1[1]); w.w = cvt_pk_bf16(v1[2], v1[3]);
                    *(v4u*)(rowp + bj * HALF) = w; } }
    }
};
__device__ __forceinline__ float silu_mul(float g, float u) { return g * u * __builtin_amdgcn_rcpf(1.0f + __builtin_amdgcn_exp2f(-LOG2E * g)); }
struct EpiSwiGLU {
    __device__ __forceinline__ void operator()(const f32x4 (&acc)[2][2][4][2], const Unit& u, int wr, int wc, int fr, int fq) const {
        const int row0 = u.orow + wr * 64 + fr, col0 = u.ocol + wc * 32 + 8 * fq;
#pragma unroll
        for (int ai = 0; ai < 2; ++ai)
#pragma unroll
            for (int m = 0; m < 4; ++m) { bf16* rowp = u.obase + (size_t)(row0 + ai * HALF + m * 16) * u.ldc + col0;
                const f32x4 g0 = acc[ai][0][m][0], g1 = acc[ai][0][m][1], u0 = acc[ai][1][m][0], u1 = acc[ai][1][m][1];
                v4u w; w.x = cvt_pk_bf16(silu_mul(g0[0], u0[0]), silu_mul(g0[1], u0[1])); w.y = cvt_pk_bf16(silu_mul(g0[2], u0[2]), silu_mul(g0[3], u0[3]));
                w.z = cvt_pk_bf16(silu_mul(g1[0], u1[0]), silu_mul(g1[1], u1[1])); w.w = cvt_pk_bf16(silu_mul(g1[2], u1[2]), silu_mul(g1[3], u1[3]));
                *(v4u*)rowp = w; }
    }
};

template <class Epi, class Sched, bool GATHER>
__device__ __forceinline__ void gemm_phase(LAS unsigned char* lds, LAS int* tokbuf, const int K, const Sched& S, const Epi& E) {
    int tid_ = threadIdx.x; asm volatile("" : "+v"(tid_));
    const int tid = tid_, wid = __builtin_amdgcn_readfirstlane(tid >> 6), lane = tid & 63, wr = wid >> 2, wc = wid & 3, fr = lane & 15, fq = lane >> 4;
    const int nt = K / BK;
    unsigned voffA[2][2], voffB[2]; int rowA[2], colA[2];
#pragma unroll
    for (int i = 0; i < 2; ++i) { int R, C; stage_rc(tid * 16 + i * 8192, R, C); const int Rb = (R & ~31) + perm32(R & 31);
        voffA[0][i] = (unsigned)(R * K + C) * 2u; voffA[1][i] = (unsigned)((R + HALF) * K + C) * 2u; voffB[i] = (unsigned)(Rb * K + C) * 2u; rowA[i] = R; colA[i] = C; }
    const size_t kstep = (size_t)(BK * 2);
    const size_t hstep = (size_t)HALF * K * 2;
    const unsigned ldsw = (unsigned)wid * 1024u;
    const int aoff = lds_byte(wr * 64 + fr, fq * 8), boff = lds_byte(wc * 32 + fr, fq * 8);
#define PG8_SA(b, h) (((b) * 2 + (h)) * HTB)
#define PG8_SB(b, h) ((4 + (b) * 2 + (h)) * HTB)
#define PG8_STAGE(bufoff, gbase, voff) do { _Pragma("unroll") for (int _i = 0; _i < 2; ++_i) \
        __builtin_amdgcn_global_load_lds((const unsigned*)((const char*)(gbase) + (voff)[_i]), (LAS unsigned*)(lds + (bufoff) + ldsw + _i * 8192), 16, 0, 0); } while (0)
#define PG8_LDA(dst, b, h) do { _Pragma("unroll") for (int m = 0; m < 4; ++m) _Pragma("unroll") for (int k = 0; k < 2; ++k) dst[m][k] = *(const LAS bf16x8*)(lds + PG8_SA(b, h) + aoff + m * 2048 + k * 1024); } while (0)
#define PG8_LDB(dst, b, h) do { _Pragma("unroll") for (int n = 0; n < 2; ++n) _Pragma("unroll") for (int k = 0; k < 2; ++k) dst[n][k] = *(const LAS bf16x8*)(lds + PG8_SB(b, h) + boff + n * 2048 + k * 1024); } while (0)
#define PG8_MMA(ai, bj, At, Bt) do { __builtin_amdgcn_s_setprio(1); _Pragma("unroll") for (int m = 0; m < 4; ++m) _Pragma("unroll") for (int n = 0; n < 2; ++n) _Pragma("unroll") for (int k = 0; k < 2; ++k) \
        acc[ai][bj][m][n] = __builtin_amdgcn_mfma_f32_16x16x32_bf16(Bt[n][k], At[m][k], acc[ai][bj][m][n], 0, 0, 0); __builtin_amdgcn_s_setprio(0); } while (0)
#define PG8_WAIT_V(n) asm volatile("s_waitcnt vmcnt(" #n ")" ::: "memory")
#define PG8_WAIT_L(n) asm volatile("s_waitcnt lgkmcnt(" #n ")" ::: "memory")
#define PG8_BAR __builtin_amdgcn_s_barrier()
#define PG8_SCHED __builtin_amdgcn_sched_barrier(0)
#define PG8_TOKOFF(dst) do { _Pragma("unroll") for (int _h = 0; _h < 2; ++_h) _Pragma("unroll") for (int _i = 0; _i < 2; ++_i) \
        dst[_h][_i] = (unsigned)tokbuf[_h * HALF + rowA[_i]] * (unsigned)(K * 2) + (unsigned)(colA[_i] * 2); } while (0)
#define PG8_TOKDMA(listp) do { if (wid < 4) __builtin_amdgcn_global_load_lds((const unsigned*)((listp) + tid), (LAS unsigned*)(tokbuf + wid * 64), 4, 0, 0); } while (0)
    Unit cur, nxt; int ui = 0;
    if (!S.next(0, cur)) return;
    f32x4 acc[2][2][4][2];
#pragma unroll
    for (int a = 0; a < 2; ++a)
#pragma unroll
        for (int b = 0; b < 2; ++b)
#pragma unroll
            for (int m = 0; m < 4; ++m)
#pragma unroll
                for (int n = 0; n < 2; ++n) acc[a][b][m][n] = (f32x4){0.f, 0.f, 0.f, 0.f};
    bf16x8 At[4][2], B0[2][2], B1[2][2];
    const char* cA = cur.A; const char* cB = cur.B;
    if constexpr (GATHER) {
        PG8_TOKDMA(cur.list); PG8_WAIT_V(0); PG8_BAR; asm volatile("" ::: "memory");
        PG8_TOKOFF(voffA); PG8_WAIT_L(0); asm volatile("" ::: "memory");
    }
    PG8_STAGE(PG8_SB(0, 0), cB, voffB); PG8_STAGE(PG8_SB(0, 1), cB + hstep, voffB); PG8_STAGE(PG8_SA(0, 0), cA, voffA[0]); PG8_STAGE(PG8_SA(0, 1), cA, voffA[1]);
    if (wr == 1) PG8_BAR;
    PG8_WAIT_V(2); PG8_BAR;
    PG8_STAGE(PG8_SB(1, 0), cB + kstep, voffB); PG8_STAGE(PG8_SA(1, 0), cA + kstep, voffA[0]); PG8_STAGE(PG8_SB(1, 1), cB + hstep + kstep, voffB);
    PG8_WAIT_V(6); PG8_BAR;
    for (;;) {
        const bool has_next = S.next(ui + 1, nxt);
        if constexpr (GATHER) { if (has_next) PG8_TOKDMA(nxt.list); }
        const char* nA = has_next ? nxt.A : cA; const char* nB = has_next ? nxt.B : cB;
        for (int t = 0; t < nt; t += 2) {
            const bool last = (t == nt - 2);
            const char* a1 = cA + (size_t)(t + 1) * kstep;
            const char* a2 = last ? nA : cA + (size_t)(t + 2) * kstep; const char* b2 = last ? nB : cB + (size_t)(t + 2) * kstep;
            const char* a3 = a2 + kstep; const char* b3 = b2 + kstep;
            PG8_LDB(B0, 0, 0); PG8_LDB(B1, 0, 1); PG8_SCHED; PG8_LDA(At, 0, 0); PG8_STAGE(PG8_SA(1, 1), a1, voffA[1]);
            if constexpr (GATHER) { if (last && has_next) { PG8_TOKOFF(voffA); } }
            PG8_WAIT_V(8); PG8_WAIT_L(0); PG8_BAR; PG8_MMA(0, 0, At, B0); PG8_MMA(0, 1, At, B1); PG8_BAR; PG8_SCHED;
            PG8_LDA(At, 0, 1); PG8_STAGE(PG8_SB(0, 0), b2, voffB); PG8_STAGE(PG8_SB(0, 1), b2 + hstep, voffB); PG8_STAGE(PG8_SA(0, 0), a2, voffA[0]);
            PG8_WAIT_V(8); PG8_WAIT_L(0); PG8_BAR; PG8_MMA(1, 0, At, B0); PG8_MMA(1, 1, At, B1); PG8_BAR; PG8_SCHED;
            PG8_LDB(B0, 1, 0); PG8_LDB(B1, 1, 1); PG8_SCHED; PG8_LDA(At, 1, 0); PG8_STAGE(PG8_SA(0, 1), a2, voffA[1]);
            PG8_WAIT_V(8); PG8_WAIT_L(0); PG8_BAR; PG8_MMA(0, 0, At, B0); PG8_MMA(0, 1, At, B1); PG8_BAR; PG8_SCHED;
            PG8_LDA(At, 1, 1); PG8_STAGE(PG8_SB(1, 0), b3, voffB); PG8_STAGE(PG8_SB(1, 1), b3 + hstep, voffB); PG8_STAGE(PG8_SA(1, 0), a3, voffA[0]);
            PG8_WAIT_V(8); PG8_WAIT_L(0); PG8_BAR; PG8_MMA(1, 0, At, B0); PG8_MMA(1, 1, At, B1); PG8_BAR; PG8_SCHED;
        }
        if (wr == 0) PG8_BAR;
        E(acc, cur, wr, wc, fr, fq);
        if (!has_next) break;
#pragma unroll
        for (int a = 0; a < 2; ++a)
#pragma unroll
            for (int b = 0; b < 2; ++b)
#pragma unroll
                for (int m = 0; m < 4; ++m)
#pragma unroll
                    for (int n = 0; n < 2; ++n) acc[a][b][m][n] = (f32x4){0.f, 0.f, 0.f, 0.f};
        cur = nxt; cA = nA; cB = nB; ++ui;
        if (wr == 1) PG8_BAR;
    }
    PG8_WAIT_V(0);
    PG8_BAR;
#undef PG8_SA
#undef PG8_SB
#undef PG8_STAGE
#undef PG8_LDA
#undef PG8_LDB
#undef PG8_MMA
#undef PG8_WAIT_V
#undef PG8_WAIT_L
#undef PG8_BAR
#undef PG8_SCHED
#undef PG8_TOKOFF
#undef PG8_TOKDMA
}
}

struct Args { const float* in[17]; float* out; unsigned char* ws; int lo, hi; };
struct Frame {
    LAS unsigned char* lds; volatile LAS unsigned* MISC; unsigned* ctl; int tid, lane, wave, G, bid;
    const float *x, *g_mpre, *g_mpost, *g_fpre, *g_fpost, *w_in, *pool_w, *pool_scale, *rpb, *w_out, *dwg, *dwu, *dwd, *router, *mwg, *mwu, *mwd;
    float* out; unsigned char* ws;
};

__device__ __forceinline__ void p0_transpose_item(const float* W, int K, int N, bf16* WT, int kb, int n0, int row_base, LAS float* scr, int lane) {
    const int k0 = 64 * kb;
#pragma unroll 8
    for (int i = 0; i < 32; ++i) { const int kk = 2 * i + (lane >> 5); scr[kk * 33 + (lane & 31)] = W[(size_t)(k0 + kk) * N + n0 + (lane & 31)]; }
    LDS_WAIT(); asm volatile("" ::: "memory");
    const int c = lane & 7;
#pragma unroll
    for (int j = 0; j < 4; ++j) { const int n = (lane >> 3) + 8 * j; const LAS float* s = scr + (8 * c) * 33 + n;
        v4u o; o.x = pk2(s[0 * 33], s[1 * 33]); o.y = pk2(s[2 * 33], s[3 * 33]); o.z = pk2(s[4 * 33], s[5 * 33]); o.w = pk2(s[6 * 33], s[7 * 33]);
        *(v4u*)(WT + (size_t)(row_base + n) * K + k0 + 8 * c) = o; }
    LDS_WAIT(); asm volatile("" ::: "memory");
}
__device__ __forceinline__ void p0_matrix(const float* W, int K, int N, bf16* WT, int ilv_half, LAS float* scr, int lane, int gw, int NGW, int& base) {
    const int nblk = N / 32, nitems = (K / 64) * nblk;
    int it = gw - (base % NGW); if (it < 0) it += NGW;
    for (; it < nitems; it += NGW) { const int kb = it / nblk, n0 = 32 * (it % nblk);
        const int rb = ilv_half < 0 ? n0 : (n0 / 128) * 256 + (n0 % 128) + 128 * ilv_half;
        p0_transpose_item(W, K, N, WT, kb, n0, rb, scr, lane); }
    base += nitems;
}
__device__ __forceinline__ void rms_row_to_bf16(const float* xrow, const float* g, bf16* orow, int lane) {
    const f32x4* xr = (const f32x4*)xrow + lane; const f32x4* gr = (const f32x4*)g + lane;
    f32x4 v[4]; float s = 0.f;
#pragma unroll
    for (int j = 0; j < 4; ++j) { v[j] = xr[64 * j]; s += (v[j].x * v[j].x + v[j].y * v[j].y) + (v[j].z * v[j].z + v[j].w * v[j].w); }
    const float rstd = 1.0f / sqrtf(wave_sum(s) * (1.f / D) + RMS_EPS);
    v2u* o8 = (v2u*)orow + lane;
#pragma unroll
    for (int j = 0; j < 4; ++j) { const f32x4 gg = gr[64 * j]; v2u w; w.x = pk2(v[j].x * rstd * gg.x, v[j].y * rstd * gg.y); w.y = pk2(v[j].z * rstd * gg.z, v[j].w * rstd * gg.w); o8[64 * j] = w; }
}
__device__ __forceinline__ void p0_prologue(Frame& F0) {
    Frame F = F0; { int t_ = threadIdx.x; asm volatile("" : "+v"(t_)); F.tid = t_; F.lane = t_ & 63; F.wave = __builtin_amdgcn_readfirstlane(t_ >> 6); }
    LAS float* scr = (LAS float*)(F.lds + F.wave * 16384);
    const int gw = F.bid * 8 + F.wave, NGW = F.G * 8, gt = F.bid * 512 + F.tid, NGT = F.G * 512;
    { v4u z = (v4u){0u, 0u, 0u, 0u}; v4u* L = (v4u*)(F.ws + WS_LIST); for (int i = gt; i < (int)(NE * T / 4); i += NGT) L[i] = z;
      int* id = (int*)(F.ws + WS_LISTID); for (int i = gt; i < T; i += NGT) id[i] = i; }
    int base = 0;
    for (int l = 0; l < DEPTH; ++l) {
        p0_matrix(F.w_in + (size_t)l * D * DIN, D, DIN, (bf16*)(F.ws + WS_WIN) + (size_t)l * DIN * D, -1, scr, F.lane, gw, NGW, base);
        p0_matrix(F.w_out + (size_t)l * D * D, D, D, (bf16*)(F.ws + WS_WOUT) + (size_t)l * D * D, -1, scr, F.lane, gw, NGW, base);
        for (int g = 0; g < 4; ++g) p0_matrix(F.pool_w + (size_t)(l * 4 + g) * 128 * 128, 128, 128, (bf16*)(F.ws + WS_WP) + (size_t)(l * 4 + g) * 128 * 128, -1, scr, F.lane, gw, NGW, base);
    }
    p0_matrix(F.dwg, D, DFF, (bf16*)(F.ws + WS_WGU0), 0, scr, F.lane, gw, NGW, base);
    p0_matrix(F.dwu, D, DFF, (bf16*)(F.ws + WS_WGU0), 1, scr, F.lane, gw, NGW, base);
    p0_matrix(F.dwd, DFF, D, (bf16*)(F.ws + WS_WD0), -1, scr, F.lane, gw, NGW, base);
    for (int e = 0; e < NE; ++e) {
        p0_matrix(F.mwg + (size_t)e * D * DFFE, D, DFFE, (bf16*)(F.ws + WS_WGUM) + (size_t)e * 2 * DFFE * D, 0, scr, F.lane, gw, NGW, base);
        p0_matrix(F.mwu + (size_t)e * D * DFFE, D, DFFE, (bf16*)(F.ws + WS_WGUM) + (size_t)e * 2 * DFFE * D, 1, scr, F.lane, gw, NGW, base);
        p0_matrix(F.mwd + (size_t)e * DFFE * D, DFFE, D, (bf16*)(F.ws + WS_WDM) + (size_t)e * D * DFFE, -1, scr, F.lane, gw, NGW, base);
    }
    bf16* HN = (bf16*)(F.ws + WS_HN);
    for (int m = gw; m < T; m += NGW) rms_row_to_bf16(F.x + (size_t)m * D, F.g_mpre, HN + (size_t)m * D, F.lane);
}

__device__ __forceinline__ unsigned ld_cnt(const unsigned* ctl, int e) { return __hip_atomic_load(ctl + CW_CNT + 64 * e, RLX_AGENT); }

__device__ __forceinline__ void ld_bf16_row(const bf16* row, int lane, f32x4 (&v)[4]) {
    const v2u* p = (const v2u*)row + lane;
#pragma unroll
    for (int j = 0; j < 4; ++j) { const v2u w = p[64 * j]; v[j] = (f32x4){bflo(w.x), bfhi(w.x), bflo(w.y), bfhi(w.y)}; }
}
__device__ __forceinline__ float sumsq16(const f32x4 (&v)[4]) {
    float s = 0.f;
#pragma unroll
    for (int j = 0; j < 4; ++j) s += (v[j].x * v[j].x + v[j].y * v[j].y) + (v[j].z * v[j].z + v[j].w * v[j].w);
    return s;
}
template <bool FFN>
__device__ __forceinline__ void norm_phase(Frame& F0, int l) {
    Frame F = F0; { int t_ = threadIdx.x; asm volatile("" : "+v"(t_)); F.tid = t_; F.lane = t_ & 63; F.wave = __builtin_amdgcn_readfirstlane(t_ >> 6); }
    const int lane = F.lane, gw = F.bid * 8 + F.wave, NGW = F.G * 8;
    const bool moe = (l & 1) != 0;
    LAS float* WR = (LAS float*)F.lds;
    LAS unsigned* lcnt = (LAS unsigned*)(F.lds + LCNT_OFF); LAS unsigned* lbase = lcnt + 8;
    LAS int* bst = (LAS int*)(F.lds + BST_OFF);
    if (!FFN && moe) {
        for (int i = F.tid; i < D * NE; i += 512) { const int d = i >> 3, e = i & 7; WR[e * D + d] = F.router[i]; }
        if (F.tid < 8) lcnt[F.tid] = 0u;
        __syncthreads();
    }
    if (FFN && moe) {
        if (F.tid == 0) { int s = 0; for (int e = 0; e < NE; ++e) { bst[e] = s; s += (int)((ld_cnt(F.ctl, e) + 255u) >> 8); } }
        __syncthreads();
    }
    const float* gA = FFN ? F.g_fpost + l * D : F.g_mpost + l * D;
    const float* gB = FFN ? F.g_mpre + (l + 1) * D : F.g_fpre + l * D;
    const bool haveB = FFN ? (l + 1 < DEPTH) : true;
    const bf16* addsrc = FFN ? (const bf16*)(F.ws + WS_Y) : (const bf16*)(F.ws + WS_MIX);
    const float* hold_base = (!FFN && l == 0) ? F.x : F.out;
    bf16* HN = (bf16*)(F.ws + WS_HN);
    const v2u* info = (const v2u*)(F.ws + WS_INFO); const f32x2* ginfo = (const f32x2*)(F.ws + WS_INFO + 256 * 1024);
    int sTok = 0, sE0 = 0, sE1 = 0; float sG0 = 0.f, sG1 = 0.f; int it = 0;
    for (int m = gw; m < T; m += NGW, ++it) {
        f32x4 a[4];
        if (FFN && moe) {
            const v2u nf = info[m]; const int e0 = (int)(nf.x >> 16), p0 = (int)(nf.x & 0xffffu), e1 = (int)(nf.y >> 16), p1 = (int)(nf.y & 0xffffu);
            const f32x2 gg = ginfo[m]; const float g0 = gg.x, g1 = gg.y;
            const int r0 = 256 * bst[e0] + p0, r1 = 256 * bst[e1] + p1;
            f32x4 b[4]; ld_bf16_row(addsrc + (size_t)r0 * D, lane, a); ld_bf16_row(addsrc + (size_t)r1 * D, lane, b);
#pragma unroll
            for (int j = 0; j < 4; ++j) a[j] = a[j] * g0 + b[j] * g1;
        } else ld_bf16_row(addsrc + (size_t)m * D, lane, a);
        const float r1 = 1.0f / sqrtf(wave_sum(sumsq16(a)) * (1.f / D) + RMS_EPS);
        const f32x4* hp = (const f32x4*)(hold_base + (size_t)m * D) + lane; const f32x4* gAp = (const f32x4*)gA + lane;
        f32x4 h[4];
#pragma unroll
        for (int j = 0; j < 4; ++j) h[j] = hp[64 * j] + a[j] * r1 * gAp[64 * j];
        f32x4* op = (f32x4*)(F.out + (size_t)m * D) + lane;
#pragma unroll
        for (int j = 0; j < 4; ++j) op[64 * j] = h[j];
        if (haveB) {
            const float r2 = 1.0f / sqrtf(wave_sum(sumsq16(h)) * (1.f / D) + RMS_EPS);
            const f32x4* gBp = (const f32x4*)gB + lane; v2u* o8 = (v2u*)(HN + (size_t)m * D) + lane;
#pragma unroll
            for (int j = 0; j < 4; ++j) { h[j] = h[j] * r2 * gBp[64 * j]; v2u w; w.x = pk2(h[j].x, h[j].y); w.y = pk2(h[j].z, h[j].w); o8[64 * j] = w; }
            if (!FFN && moe) {
                float lg[NE];
#pragma unroll
                for (int e = 0; e < NE; ++e) { float s = 0.f;
#pragma unroll
                    for (int j = 0; j < 4; ++j) { const f32x4 w = *(const LAS f32x4*)(WR + e * D + 256 * j + 4 * lane); s += (h[j].x * w.x + h[j].y * w.y) + (h[j].z * w.z + h[j].w * w.w); }
                    lg[e] = wave_sum(s); }
                int e0 = 0; float l0 = lg[0];
#pragma unroll
                for (int e = 1; e < NE; ++e) if (lg[e] > l0) { l0 = lg[e]; e0 = e; }
                int e1 = -1; float l1 = -INFINITY;
#pragma unroll
                for (int e = 0; e < NE; ++e) if (e != e0 && lg[e] > l1) { l1 = lg[e]; e1 = e; }
                const float g0 = 1.0f / (1.0f + __expf(l1 - l0)), g1 = 1.0f - g0;
                if (lane == it) { sTok = m; sE0 = e0; sE1 = e1; sG0 = g0; sG1 = g1; }
            }
        }
    }
    if (!FFN && moe) {
        unsigned loc0 = 0u, loc1 = 0u;
        if (lane < it) { loc0 = __hip_atomic_fetch_add(lcnt + sE0, 1u, __ATOMIC_RELAXED, __HIP_MEMORY_SCOPE_WORKGROUP); loc1 = __hip_atomic_fetch_add(lcnt + sE1, 1u, __ATOMIC_RELAXED, __HIP_MEMORY_SCOPE_WORKGROUP); }
        __syncthreads();
        if (F.tid < 8) lbase[F.tid] = __hip_atomic_fetch_add(F.ctl + CW_CNT + 64 * F.tid, lcnt[F.tid], RLX_AGENT);
        __syncthreads();
        if (lane < it) {
            const unsigned p0 = lbase[sE0] + loc0, p1 = lbase[sE1] + loc1;
            int* list = (int*)(F.ws + WS_LIST);
            list[(size_t)sE0 * T + p0] = sTok; list[(size_t)sE1 * T + p1] = sTok;
            v2u nf; nf.x = ((unsigned)sE0 << 16) | p0; nf.y = ((unsigned)sE1 << 16) | p1;
            ((v2u*)(F.ws + WS_INFO))[sTok] = nf; ((f32x2*)(F.ws + WS_INFO + 256 * 1024))[sTok] = (f32x2){sG0, sG1};
        }
    }
}

constexpr int U_PITCH = 1040, U_ROWS = 80, BIAS_OFF = U_PITCH * U_ROWS;
__device__ __forceinline__ void mixer_phase(Frame& F0, int l) {
    Frame F = F0; { int t_ = threadIdx.x; asm volatile("" : "+v"(t_)); F.tid = t_; F.lane = t_ & 63; F.wave = __builtin_amdgcn_readfirstlane(t_ >> 6); }
    const int tid = F.tid, lane = F.lane, wid = F.wave, fr = lane & 15, fq = lane >> 4;
    const bf16* proj = (const bf16*)(F.ws + WS_PROJ); const bf16* Vt = (const bf16*)(F.ws + WS_VT); bf16* mixo = (bf16*)(F.ws + WS_MIXO);
    const bf16* Wp = (const bf16*)(F.ws + WS_WP) + (size_t)l * 4 * 128 * 128; const float* pscale = F.pool_scale + l * DPOOL; const float* rpb = F.rpb + (size_t)l * NH * 15 * 31;
    LAS float* BIAS = (LAS float*)(F.lds + BIAS_OFF);
    for (int i = tid; i < NH * 15 * 31; i += 512) BIAS[i] = rpb[i] * LOG2E;
    for (int unit = F.bid; unit < BATCH * GROWS; unit += F.G) {
        const int b = unit / GROWS, r = unit % GROWS, tb0 = b * SEQ, trow0 = 64 * r - 8;
        __syncthreads();
        for (int idx = tid; idx < U_ROWS * 64; idx += 512) { const int row = idx >> 6, pc = idx & 63, t = trow0 + row;
            if (t >= 0 && t < SEQ) { const v4u v = *(const v4u*)(proj + (size_t)(tb0 + t) * NPROJ + pc * 8); *(LAS v4u*)(F.lds + row * U_PITCH + pc * 16) = v; } }
        __syncthreads();
        {
            const int g = wid >> 1, half = wid & 1, hw = 1 << g;
            bf16x8 dfr[2][4];
#pragma unroll
            for (int mt = 0; mt < 2; ++mt)
#pragma unroll
                for (int ks = 0; ks < 4; ++ks) {
                    const int t = 64 * r + 32 * half + 16 * mt + fr, ch = 128 * g + 32 * ks + 8 * fq;
                    const int lo = max(t - hw, 0), hi = min(t + hw, SEQ);
                    float s0 = 0.f, s1 = 0.f, s2 = 0.f, s3 = 0.f, s4 = 0.f, s5 = 0.f, s6 = 0.f, s7 = 0.f;
                    for (int tt = lo; tt < hi; ++tt) { const v4u v = *(const LAS v4u*)(F.lds + (tt - trow0) * U_PITCH + ch * 2);
                        s0 += bflo(v.x); s1 += bfhi(v.x); s2 += bflo(v.y); s3 += bfhi(v.y); s4 += bflo(v.z); s5 += bfhi(v.z); s6 += bflo(v.w); s7 += bfhi(v.w); }
                    const v4u c = *(const LAS v4u*)(F.lds + (t - trow0) * U_PITCH + ch * 2);
                    const float inv = 1.0f / (float)(hi - lo);
                    v4u p; p.x = pk2(s0 * inv - bflo(c.x), s1 * inv - bfhi(c.x)); p.y = pk2(s2 * inv - bflo(c.y), s3 * inv - bfhi(c.y));
                    p.z = pk2(s4 * inv - bflo(c.z), s5 * inv - bfhi(c.z)); p.w = pk2(s6 * inv - bflo(c.w), s7 * inv - bfhi(c.w));
                    dfr[mt][ks] = __builtin_bit_cast(bf16x8, p);
                }
            const bf16* Wg = Wp + (size_t)g * 128 * 128;
#pragma unroll 2
            for (int nt = 0; nt < 8; ++nt) {
                bf16x8 wf[4];
#pragma unroll
                for (int ks = 0; ks < 4; ++ks) wf[ks] = *(const bf16x8*)(Wg + (size_t)(16 * nt + fr) * 128 + 32 * ks + 8 * fq);
                const f32x4 sc = *(const f32x4*)(pscale + 128 * g + 16 * nt + 4 * fq);
#pragma unroll
                for (int mt = 0; mt < 2; ++mt) {
                    f32x4 acc = (f32x4){0.f, 0.f, 0.f, 0.f};
#pragma unroll
                    for (int ks = 0; ks < 4; ++ks) acc = __builtin_amdgcn_mfma_f32_16x16x32_bf16(wf[ks], dfr[mt][ks], acc, 0, 0, 0);
                    acc = acc * sc;
                    v2u w; w.x = pk2(acc[0], acc[1]); w.y = pk2(acc[2], acc[3]);
                    *(v2u*)(mixo + (size_t)(tb0 + 64 * r + 32 * half + 16 * mt + fr) * D + 128 * g + 16 * nt + 4 * fq) = w;
                }
            }
        }
        {
            const int r0 = min(max(r - KH / 2, 0), GROWS - KH);
            for (int hh = 0; hh < 2; ++hh) {
                const int h = 2 * wid + hh;
                for (int qb = 0; qb < 4; ++qb) {
                    const int cs = qb == 0 ? 0 : (qb == 1 ? 8 : (qb == 2 ? 24 : 32));
                    const bf16x8 qf = *(const bf16x8*)(proj + (size_t)(tb0 + 64 * r + 16 * qb + fr) * NPROJ + 512 + 32 * h + 8 * fq);
                    f32x4 s[KH][2];
#pragma unroll
                    for (int kr = 0; kr < KH; ++kr)
#pragma unroll
                        for (int tau = 0; tau < 2; ++tau) {
                            const int keycol = cs + 8 * (fr >> 2) + 4 * tau + (fr & 3);
                            const bf16x8 kf = *(const bf16x8*)(proj + (size_t)(tb0 + 64 * (r0 + kr) + keycol) * NPROJ + 1024 + 32 * h + 8 * fq);
                            s[kr][tau] = __builtin_amdgcn_mfma_f32_16x16x32_bf16(kf, qf, (f32x4){0.f, 0.f, 0.f, 0.f}, 0, 0, 0);
                        }
                    const int c = 16 * qb + fr, c0 = min(max(c - KW / 2, 0), GRIDW - KW);
                    float mx = -INFINITY;
#pragma unroll
                    for (int kr = 0; kr < KH; ++kr) {
                        const LAS float* brow = BIAS + (h * 15 + (r0 + kr - r + KH - 1)) * 31;
#pragma unroll
                        for (int tau = 0; tau < 2; ++tau)
#pragma unroll
                            for (int q = 0; q < 4; ++q) {
                                const int kc = cs + 8 * fq + 4 * tau + q; const bool valid = (kc >= c0) && (kc < c0 + KW);
                                const int dc = min(max(kc - c + KW - 1, 0), 2 * KW - 2);
                                const float v = valid ? s[kr][tau][q] + brow[dc] : -INFINITY;
                                s[kr][tau][q] = v; mx = fmaxf(mx, v);
                            }
                    }
                    mx = fmaxf(mx, __shfl_xor(mx, 16)); mx = fmaxf(mx, __shfl_xor(mx, 32));
                    float sum = 0.f;
#pragma unroll
                    for (int kr = 0; kr < KH; ++kr)
#pragma unroll
                        for (int tau = 0; tau < 2; ++tau)
#pragma unroll
                            for (int q = 0; q < 4; ++q) { const float p = __builtin_amdgcn_exp2f(s[kr][tau][q] - mx); s[kr][tau][q] = p; sum += p; }
                    sum += __shfl_xor(sum, 16); sum += __shfl_xor(sum, 32);
                    f32x4 o[2] = {(f32x4){0.f, 0.f, 0.f, 0.f}, (f32x4){0.f, 0.f, 0.f, 0.f}};
#pragma unroll
                    for (int kr = 0; kr < KH; ++kr) {
                        v4u pw; pw.x = pk2(s[kr][0][0], s[kr][0][1]); pw.y = pk2(s[kr][0][2], s[kr][0][3]); pw.z = pk2(s[kr][1][0], s[kr][1][1]); pw.w = pk2(s[kr][1][2], s[kr][1][3]);
                        const bf16x8 pf = __builtin_bit_cast(bf16x8, pw);
#pragma unroll
                        for (int dt = 0; dt < 2; ++dt) {
                            const bf16x8 vf = *(const bf16x8*)(Vt + (size_t)(32 * h + 16 * dt + fr) * T + tb0 + 64 * (r0 + kr) + cs + 8 * fq);
                            o[dt] = __builtin_amdgcn_mfma_f32_16x16x32_bf16(vf, pf, o[dt], 0, 0, 0);
                        }
                    }
                    const float inv = 1.0f / sum;
#pragma unroll
                    for (int dt = 0; dt < 2; ++dt) { v2u w; w.x = pk2(o[dt][0] * inv, o[dt][1] * inv); w.y = pk2(o[dt][2] * inv, o[dt][3] * inv);
                        *(v2u*)(mixo + (size_t)(tb0 + 64 * r + 16 * qb + fr) * D + DPOOL + 32 * h + 16 * dt + 4 * fq) = w; }
                }
            }
        }
    }
    __syncthreads();
}

struct SchedProj {
    const char* hn; const char* win; bf16* proj; bf16* vt; int G, c;
    __device__ __forceinline__ bool next(int i, pg8::Unit& u) const {
        int pm, pn; if (!pg8::tile_order(i, G, c, T / 256, 8, pm, pn)) return false;
        const size_t tstep = (size_t)256 * D * 2; u.list = nullptr;
        if (pn < 6) { u.A = hn + pm * tstep; u.B = win + pn * tstep; u.obase = proj; u.orow = 256 * pm; u.ocol = 256 * pn; u.ldc = NPROJ; u.scale = (pn == 2 || pn == 3) ? QSCALE : 1.0f; }
        else { u.A = win + pn * tstep; u.B = hn + pm * tstep; u.obase = vt; u.orow = 256 * (pn - 6); u.ocol = 256 * pm; u.ldc = T; u.scale = 1.0f; }
        return true;
    }
};
struct SchedOut {
    const char* a; const char* w; bf16* o; int G, c;
    __device__ __forceinline__ bool next(int i, pg8::Unit& u) const {
        int pm, pn; if (!pg8::tile_order(i, G, c, T / 256, 4, pm, pn)) return false;
        const size_t tstep = (size_t)256 * D * 2; u.list = nullptr;
        u.A = a + pm * tstep; u.B = w + pn * tstep; u.obase = o; u.orow = 256 * pm; u.ocol = 256 * pn; u.ldc = D; u.scale = 1.0f; return true;
    }
};
__device__ __forceinline__ void ffn_table(Frame& F0, bool moe) {
    Frame F = F0; { int t_ = threadIdx.x; asm volatile("" : "+v"(t_)); F.tid = t_; F.lane = t_ & 63; F.wave = __builtin_amdgcn_readfirstlane(t_ >> 6); }
    LAS int* blk = (LAS int*)(F.lds + BLK_OFF); LAS int* bst = (LAS int*)(F.lds + BST_OFF);
    __syncthreads();
    if (F.tid == 0) { int s = 0; for (int e = 0; e < NE; ++e) { bst[e] = s; s += moe ? (int)((ld_cnt(F.ctl, e) + 255u) >> 8) : (e == 0 ? T / 256 : 0); } bst[8] = s; }
    __syncthreads();
    for (int b = F.tid; b < MAXBLK + 8; b += 512) { int e = 0; for (int k = 1; k < NE; ++k) if (b >= bst[k]) e = k; blk[b] = e; }
    __syncthreads();
}
struct SchedUp {
    const char* hn; const char* wgu; const int* lists; bf16* hff; LAS int* blk; LAS int* bst; int G, c, cstart, nblk, nN, F_, moe;
    __device__ __forceinline__ bool next(int i, pg8::Unit& u) const {
        int pm, pn; if (!pg8::tile_order(i, G, c, nblk, nN, pm, pn)) return false;
        const int b = cstart + pm, e = __builtin_amdgcn_readfirstlane(blk[b]), lb = b - __builtin_amdgcn_readfirstlane(bst[e]);
        u.A = hn; u.list = lists + (moe ? (size_t)e * T + 256 * lb : (size_t)256 * b);
        u.B = wgu + ((size_t)e * 2 * F_ + 256 * pn) * D * 2; u.obase = hff; u.orow = 256 * pm; u.ocol = 128 * pn; u.ldc = F_; u.scale = 1.0f; return true;
    }
};
struct SchedDown {
    const char* hff; const char* wd; bf16* y; LAS int* blk; int G, c, cstart, nblk, F_;
    __device__ __forceinline__ bool next(int i, pg8::Unit& u) const {
        int pm, pn; if (!pg8::tile_order(i, G, c, nblk, 4, pm, pn)) return false;
        const int b = cstart + pm, e = __builtin_amdgcn_readfirstlane(blk[b]); u.list = nullptr;
        u.A = hff + (size_t)pm * 256 * F_ * 2; u.B = wd + ((size_t)e * D + 256 * pn) * F_ * 2; u.obase = y; u.orow = 256 * b; u.ocol = 256 * pn; u.ldc = D; u.scale = 1.0f; return true;
    }
};

constexpr int STEPS_PER_LAYER = 16, NSTEPS = 1 + DEPTH * STEPS_PER_LAYER;
__global__ void __launch_bounds__(512, 2) mk_fwd(Args args) {
    extern __shared__ __attribute__((aligned(16))) unsigned char lds_raw[];
    Frame F;
    F.lds = (LAS unsigned char*)lds_raw; F.MISC = (volatile LAS unsigned*)(F.lds + MISC_OFF);
    F.tid = threadIdx.x; F.lane = F.tid & 63; F.wave = __builtin_amdgcn_readfirstlane(F.tid >> 6); F.G = gridDim.x; F.bid = blockIdx.x;
    F.ws = args.ws; F.ctl = (unsigned*)(args.ws + WS_CTL); F.out = args.out;
    F.x = args.in[0]; F.g_mpre = args.in[1]; F.g_mpost = args.in[2]; F.g_fpre = args.in[3]; F.g_fpost = args.in[4]; F.w_in = args.in[5]; F.pool_w = args.in[6]; F.pool_scale = args.in[7];
    F.rpb = args.in[8]; F.w_out = args.in[9]; F.dwg = args.in[10]; F.dwu = args.in[11]; F.dwd = args.in[12]; F.router = args.in[13]; F.mwg = args.in[14]; F.mwu = args.in[15]; F.mwd = args.in[16];
    if (F.tid < 16) F.MISC[F.tid] = 0u;
    __syncthreads();
    const int lo = args.lo, hi = args.hi;
    XcdBarrier bar; bar.bar = F.ctl + CW_BAR; bar.x = 0; bar.st = F.MISC;
    if (hi - lo > 1) bar = xcd_barrier_post(F.ctl + CW_BAR, F.MISC);
#define RUN(s) (lo <= (s) && (s) < hi)
#define SEAM(s) do { if (RUN(s) && RUN((s) + 1)) xcd_barrier(bar); } while (0)
    LAS int* tokbuf = (LAS int*)(F.lds + TOKBUF_OFF); LAS int* blk = (LAS int*)(F.lds + BLK_OFF); LAS int* bst = (LAS int*)(F.lds + BST_OFF);
    const char* HN = (const char*)(F.ws + WS_HN);

    #ifndef NO_P0
    if (RUN(0)) { p0_prologue(F); } SEAM(0);
#endif
    for (int l = 0; l < DEPTH; ++l) {
        const int base = 1 + STEPS_PER_LAYER * l; const bool moe = (l & 1) != 0;
#ifndef NO_P1
        if (RUN(base + 0)) {
            SchedProj S{HN, (const char*)(F.ws + WS_WIN) + (size_t)l * DIN * D * 2, (bf16*)(F.ws + WS_PROJ), (bf16*)(F.ws + WS_VT), F.G, F.bid};
            pg8::gemm_phase<pg8::EpiBf16, SchedProj, false>(F.lds, tokbuf, D, S, pg8::EpiBf16{});
        } SEAM(base + 0);
#endif
#ifndef NO_P2
        if (RUN(base + 1)) { mixer_phase(F, l); } SEAM(base + 1);
#endif
#ifndef NO_P3
        if (RUN(base + 2)) {
            SchedOut S{(const char*)(F.ws + WS_MIXO), (const char*)(F.ws + WS_WOUT) + (size_t)l * D * D * 2, (bf16*)(F.ws + WS_MIX), F.G, F.bid};
            pg8::gemm_phase<pg8::EpiBf16, SchedOut, false>(F.lds, tokbuf, D, S, pg8::EpiBf16{});
        } SEAM(base + 2);
#endif
#ifndef NO_P4
        if (RUN(base + 3)) { norm_phase<false>(F, l); } SEAM(base + 3);
#endif
        const int F_ = moe ? DFFE : DFF;
        bool table = false; int NB = 0;
        for (int c = 0; c < MAXCHUNK; ++c) {
            const int s5 = base + 4 + 2 * c, s6 = s5 + 1;
            if (!(RUN(s5) || RUN(s6))) continue;
            if (!table) { ffn_table(F, moe); NB = __builtin_amdgcn_readfirstlane(bst[8]); table = true; }
            const int cstart = c * CHUNK_BLK, nblk = min(NB - cstart, CHUNK_BLK);
            if (nblk <= 0) continue;
#ifndef NO_P5
            if (RUN(s5)) {
                SchedUp S{HN, moe ? (const char*)(F.ws + WS_WGUM) : (const char*)(F.ws + WS_WGU0), moe ? (const int*)(F.ws + WS_LIST) : (const int*)(F.ws + WS_LISTID), (bf16*)(F.ws + WS_HFF), blk, bst, F.G, F.bid, cstart, nblk, F_ / 128, F_, moe ? 1 : 0};
                pg8::gemm_phase<pg8::EpiSwiGLU, SchedUp, true>(F.lds, tokbuf, D, S, pg8::EpiSwiGLU{});
            } SEAM(s5);
#endif
#ifndef NO_P6
            if (RUN(s6)) {
                SchedDown S{(const char*)(F.ws + WS_HFF), moe ? (const char*)(F.ws + WS_WDM) : (const char*)(F.ws + WS_WD0), (bf16*)(F.ws + WS_Y), blk, F.G, F.bid, cstart, nblk, F_};
                pg8::gemm_phase<pg8::EpiBf16, SchedDown, false>(F.lds, tokbuf, F_, S, pg8::EpiBf16{});
            } SEAM(s6);
#endif
        }
#ifndef NO_P7
        if (RUN(base + 14)) { norm_phase<true>(F, l); }
#endif
        if (l + 1 < DEPTH) { if (RUN(base + 14) && RUN(base + 16)) xcd_barrier(bar); }
    }
#undef RUN
#undef SEAM
}

__global__ void __launch_bounds__(64) nk_gemm(const bf16* A, int lda, const bf16* Bt, int ldb, int K, bf16* O, int ldo, float scale, int sc_lo, int sc_hi) {
    const int m0 = 32 * blockIdx.y, n0 = 32 * blockIdx.x, lane = threadIdx.x, fr = lane & 15, fq = lane >> 4;
    f32x4 acc[2][2];
#pragma unroll
    for (int a = 0; a < 2; ++a)
#pragma unroll
        for (int b = 0; b < 2; ++b) acc[a][b] = (f32x4){0.f, 0.f, 0.f, 0.f};
    for (int k0 = 0; k0 < K; k0 += 32) {
        bf16x8 a[2], b[2];
#pragma unroll
        for (int i = 0; i < 2; ++i) { a[i] = *(const bf16x8*)(A + (size_t)(m0 + 16 * i + fr) * lda + k0 + 8 * fq); b[i] = *(const bf16x8*)(Bt + (size_t)(n0 + 16 * i + fr) * ldb + k0 + 8 * fq); }
#pragma unroll
        for (int mt = 0; mt < 2; ++mt)
#pragma unroll
            for (int nt = 0; nt < 2; ++nt) acc[mt][nt] = __builtin_amdgcn_mfma_f32_16x16x32_bf16(a[mt], b[nt], acc[mt][nt], 0, 0, 0);
    }
#pragma unroll
    for (int mt = 0; mt < 2; ++mt)
#pragma unroll
        for (int nt = 0; nt < 2; ++nt)
#pragma unroll
            for (int q = 0; q < 4; ++q) { const int m = m0 + 16 * mt + 4 * fq + q, n = n0 + 16 * nt + fr; const float sc = (n >= sc_lo && n < sc_hi) ? scale : 1.0f;
                O[(size_t)m * ldo + n] = (bf16)f2bf(acc[mt][nt][q] * sc); }
}
__global__ void nk_blocktab(const unsigned* ctl, int* btab, int moe) {
    if (threadIdx.x != 0 || blockIdx.x != 0) return;
    int b = 0;
    for (int e = 0; e < NE; ++e) { const int nb = moe ? (int)((ctl[CW_CNT + 64 * e] + 255u) >> 8) : (e == 0 ? T / 256 : 0); for (int k = 0; k < nb; ++k) btab[b++] = e | (k << 8); }
    btab[MAXBLK] = b;
}
__global__ void __launch_bounds__(64) nk_ffn_up(const bf16* hn, const bf16* wgu, const int* lists, const int* btab, bf16* hff, int cstart, int F_, int moe) {
    const int m0 = 32 * blockIdx.y, f0 = 32 * blockIdx.x, lane = threadIdx.x, fr = lane & 15, fq = lane >> 4;
    const int b = cstart + m0 / 256; if (b >= btab[MAXBLK]) return;
    const int e = btab[b] & 0xff, lb = btab[b] >> 8;
    const int* list = lists + (moe ? (size_t)e * T + 256 * lb : (size_t)256 * b) + (m0 % 256);
    const bf16* W = wgu + (size_t)e * 2 * F_ * D; const int rg = (f0 / 128) * 256 + (f0 % 128);
    const bf16* arow[2]; arow[0] = hn + (size_t)list[fr] * D; arow[1] = hn + (size_t)list[16 + fr] * D;
    f32x4 ag[2][2], au[2][2];
#pragma unroll
    for (int a = 0; a < 2; ++a)
#pragma unroll
        for (int c = 0; c < 2; ++c) { ag[a][c] = (f32x4){0.f, 0.f, 0.f, 0.f}; au[a][c] = (f32x4){0.f, 0.f, 0.f, 0.f}; }
    for (int k0 = 0; k0 < D; k0 += 32) {
        bf16x8 a[2], bg[2], bu[2];
#pragma unroll
        for (int i = 0; i < 2; ++i) { a[i] = *(const bf16x8*)(arow[i] + k0 + 8 * fq); bg[i] = *(const bf16x8*)(W + (size_t)(rg + 16 * i + fr) * D + k0 + 8 * fq); bu[i] = *(const bf16x8*)(W + (size_t)(rg + 128 + 16 * i + fr) * D + k0 + 8 * fq); }
#pragma unroll
        for (int mt = 0; mt < 2; ++mt)
#pragma unroll
            for (int nt = 0; nt < 2; ++nt) { ag[mt][nt] = __builtin_amdgcn_mfma_f32_16x16x32_bf16(a[mt], bg[nt], ag[mt][nt], 0, 0, 0); au[mt][nt] = __builtin_amdgcn_mfma_f32_16x16x32_bf16(a[mt], bu[nt], au[mt][nt], 0, 0, 0); }
    }
#pragma unroll
    for (int mt = 0; mt < 2; ++mt)
#pragma unroll
        for (int nt = 0; nt < 2; ++nt)
#pragma unroll
            for (int q = 0; q < 4; ++q) { const float g = ag[mt][nt][q], u = au[mt][nt][q]; const float v = g * u / (1.0f + __expf(-g));
                hff[(size_t)(m0 + 16 * mt + 4 * fq + q) * F_ + f0 + 16 * nt + fr] = (bf16)f2bf(v); }
}
__global__ void __launch_bounds__(64) nk_ffn_down(const bf16* hff, const bf16* wd, const int* btab, bf16* y, int cstart, int F_) {
    const int m0 = 32 * blockIdx.y, n0 = 32 * blockIdx.x, lane = threadIdx.x, fr = lane & 15, fq = lane >> 4;
    const int b = cstart + m0 / 256; if (b >= btab[MAXBLK]) return;
    const int e = btab[b] & 0xff; const bf16* W = wd + (size_t)e * D * F_;
    f32x4 acc[2][2];
#pragma unroll
    for (int a = 0; a < 2; ++a)
#pragma unroll
        for (int c = 0; c < 2; ++c) acc[a][c] = (f32x4){0.f, 0.f, 0.f, 0.f};
    for (int k0 = 0; k0 < F_; k0 += 32) {
        bf16x8 a[2], bb[2];
#pragma unroll
        for (int i = 0; i < 2; ++i) { a[i] = *(const bf16x8*)(hff + (size_t)(m0 + 16 * i + fr) * F_ + k0 + 8 * fq); bb[i] = *(const bf16x8*)(W + (size_t)(n0 + 16 * i + fr) * F_ + k0 + 8 * fq); }
#pragma unroll
        for (int mt = 0; mt < 2; ++mt)
#pragma unroll
            for (int nt = 0; nt < 2; ++nt) acc[mt][nt] = __builtin_amdgcn_mfma_f32_16x16x32_bf16(a[mt], bb[nt], acc[mt][nt], 0, 0, 0);
    }
#pragma unroll
    for (int mt = 0; mt < 2; ++mt)
#pragma unroll
        for (int nt = 0; nt < 2; ++nt)
#pragma unroll
            for (int q = 0; q < 4; ++q) y[(size_t)(256 * cstart + m0 + 16 * mt + 4 * fq + q) * D + n0 + 16 * nt + fr] = (bf16)f2bf(acc[mt][nt][q]);
}
__global__ void nk_pool_delta(const bf16* proj, bf16* delta) {
    const int idx = blockIdx.x * 256 + threadIdx.x, tok = idx / DPOOL, ch = idx % DPOOL, b = tok / SEQ, t = tok % SEQ, g = ch / 128, hw = 1 << g;
    const int lo = max(t - hw, 0), hi = min(t + hw, SEQ); float s = 0.f;
    for (int tt = lo; tt < hi; ++tt) s += bf2f(proj[(size_t)(b * SEQ + tt) * NPROJ + ch]);
    delta[(size_t)tok * DPOOL + ch] = (bf16)f2bf(s / (float)(hi - lo) - bf2f(proj[(size_t)tok * NPROJ + ch]));
}
__global__ void nk_pool_mm(const bf16* delta, const bf16* Wp, const float* pscale, bf16* mixo) {
    const int idx = blockIdx.x * 256 + threadIdx.x, tok = idx / DPOOL, dd = idx % DPOOL, g = dd / 128, d = dd % 128; float s = 0.f;
    for (int c = 0; c < 128; ++c) s += bf2f(delta[(size_t)tok * DPOOL + 128 * g + c]) * bf2f(Wp[(size_t)(g * 128 + d) * 128 + c]);
    mixo[(size_t)tok * D + dd] = (bf16)f2bf(s * pscale[dd]);
}
__global__ void nk_na(const bf16* proj, const bf16* Vt, const float* rpb, bf16* mixo) {
    const int idx = blockIdx.x * 256 + threadIdx.x, tok = idx / NH, h = idx % NH, b = tok / SEQ, t = tok % SEQ, r = t / GRIDW, c = t % GRIDW;
    const int r0 = min(max(r - KH / 2, 0), GROWS - KH), c0 = min(max(c - KW / 2, 0), GRIDW - KW);
    float q[HD];
#pragma unroll
    for (int d = 0; d < HD; ++d) q[d] = bf2f(proj[(size_t)tok * NPROJ + 512 + HD * h + d]);
    float mx = -INFINITY;
    for (int i = 0; i < KH; ++i) for (int j = 0; j < KW; ++j) {
        const size_t kt = (size_t)(b * SEQ + (r0 + i) * GRIDW + c0 + j); float s = 0.f;
#pragma unroll
        for (int d = 0; d < HD; ++d) s += q[d] * bf2f(proj[kt * NPROJ + 1024 + HD * h + d]);
        s += rpb[(h * 15 + (r0 + i - r + KH - 1)) * 31 + (c0 + j - c + KW - 1)] * LOG2E; mx = fmaxf(mx, s);
    }
    float o[HD], sum = 0.f;
#pragma unroll
    for (int d = 0; d < HD; ++d) o[d] = 0.f;
    for (int i = 0; i < KH; ++i) for (int j = 0; j < KW; ++j) {
        const size_t kt = (size_t)(b * SEQ + (r0 + i) * GRIDW + c0 + j); float s = 0.f;
#pragma unroll
        for (int d = 0; d < HD; ++d) s += q[d] * bf2f(proj[kt * NPROJ + 1024 + HD * h + d]);
        s += rpb[(h * 15 + (r0 + i - r + KH - 1)) * 31 + (c0 + j - c + KW - 1)] * LOG2E;
        const float p = exp2f(s - mx); sum += p; const float pb = __builtin_bit_cast(float, f2bf(p) << 16);
#pragma unroll
        for (int d = 0; d < HD; ++d) o[d] += pb * bf2f(Vt[(size_t)(HD * h + d) * T + kt]);
    }
#pragma unroll
    for (int d = 0; d < HD; ++d) mixo[(size_t)tok * D + DPOOL + HD * h + d] = (bf16)f2bf(o[d] / sum);
}

static void launch_mk(const Args& a0, int lo, int hi, int grid, hipStream_t stream) {
    Args a = a0; a.lo = lo; a.hi = hi;
    hipLaunchKernelGGL(mk_fwd, dim3(grid), dim3(512), LDS_BYTES, stream, a);
}
extern "C" void kernel_launch(void* const* d_in, const int* in_sizes, int n_in, void* d_out, int out_size, void* d_ws, size_t ws_size, hipStream_t stream) {
    static int grid = 0;
    if (grid == 0) {
        if (n_in != 17 || out_size != T * D || ws_size < WS_END) { fprintf(stderr, "kernel_launch: unexpected problem (n_in %d, out %d, ws %zu)\n", n_in, out_size, ws_size); grid = -1; return; }
        int dev = 0, cus = 0;
        if (hipGetDevice(&dev) != hipSuccess || hipDeviceGetAttribute(&cus, hipDeviceAttributeMultiprocessorCount, dev) != hipSuccess) { grid = -1; return; }
        if (hipFuncSetAttribute((const void*)mk_fwd, hipFuncAttributeMaxDynamicSharedMemorySize, LDS_BYTES) != hipSuccess) { grid = -1; return; }
        int per_cu = 0;
        if (hipOccupancyMaxActiveBlocksPerMultiprocessor(&per_cu, (const void*)mk_fwd, 512, LDS_BYTES) != hipSuccess || per_cu < 1) { fprintf(stderr, "kernel_launch: occupancy query says %d\n", per_cu); }
        (void)hipGetLastError();
        grid = cus;
    }
    if (grid < 0) return;
    hipMemsetAsync((char*)d_ws + WS_CTL, 0, CTL_ZERO_BYTES, stream);
    Args a{};
    for (int i = 0; i < 17; ++i) a.in[i] = (const float*)d_in[i];
    a.out = (float*)d_out; a.ws = (unsigned char*)d_ws; a.lo = 0; a.hi = 0;
    unsigned char* ws = (unsigned char*)d_ws;
#if MODE == 3
    launch_mk(a, 0, NSTEPS, grid, stream);
#elif MODE == 2
    for (int s = 0; s < NSTEPS; ++s) {
        const int r = (s - 1) % STEPS_PER_LAYER;
        if (s > 0 && (r == 15 || (((s - 1) / STEPS_PER_LAYER) == 0 && r >= 8 && r < 14))) continue;
        launch_mk(a, s, s + 1, grid, stream);
    }
#else
    launch_mk(a, 0, 1, grid, stream);
    const bf16* HN = (const bf16*)(ws + WS_HN);
    for (int l = 0; l < DEPTH; ++l) {
        const int base = 1 + STEPS_PER_LAYER * l; const int moe = l & 1;
        const bf16* win = (const bf16*)(ws + WS_WIN) + (size_t)l * DIN * D;
        hipLaunchKernelGGL(nk_gemm, dim3(NPROJ / 32, T / 32), dim3(64), 0, stream, HN, D, win, D, D, (bf16*)(ws + WS_PROJ), NPROJ, QSCALE, 512, 1024);
        hipLaunchKernelGGL(nk_gemm, dim3(T / 32, DATT / 32), dim3(64), 0, stream, win + (size_t)NPROJ * D, D, HN, D, D, (bf16*)(ws + WS_VT), T, 1.0f, 0, 0);
        hipLaunchKernelGGL(nk_pool_delta, dim3(T * DPOOL / 256), dim3(256), 0, stream, (const bf16*)(ws + WS_PROJ), (bf16*)(ws + WS_MIX));
        hipLaunchKernelGGL(nk_pool_mm, dim3(T * DPOOL / 256), dim3(256), 0, stream, (const bf16*)(ws + WS_MIX), (const bf16*)(ws + WS_WP) + (size_t)l * 4 * 128 * 128, (const float*)d_in[7] + l * DPOOL, (bf16*)(ws + WS_MIXO));
        hipLaunchKernelGGL(nk_na, dim3(T * NH / 256), dim3(256), 0, stream, (const bf16*)(ws + WS_PROJ), (const bf16*)(ws + WS_VT), (const float*)d_in[8] + (size_t)l * NH * 15 * 31, (bf16*)(ws + WS_MIXO));
        hipLaunchKernelGGL(nk_gemm, dim3(D / 32, T / 32), dim3(64), 0, stream, (const bf16*)(ws + WS_MIXO), D, (const bf16*)(ws + WS_WOUT) + (size_t)l * D * D, D, D, (bf16*)(ws + WS_MIX), D, 1.0f, 0, 0);
        launch_mk(a, base + 3, base + 4, grid, stream);
#if defined(TRUNC)
        if (TRUNC == 2 * l + 1) return;
#endif
        hipLaunchKernelGGL(nk_blocktab, dim3(1), dim3(64), 0, stream, (const unsigned*)(ws + WS_CTL), (int*)(ws + WS_BTAB), moe);
        const int F_ = moe ? DFFE : DFF, nchunk = moe ? MAXCHUNK : 2;
        for (int c = 0; c < nchunk; ++c) {
            hipLaunchKernelGGL(nk_ffn_up, dim3(F_ / 32, CHUNK_BLK * 256 / 32), dim3(64), 0, stream, HN, moe ? (const bf16*)(ws + WS_WGUM) : (const bf16*)(ws + WS_WGU0), moe ? (const int*)(ws + WS_LIST) : (const int*)(ws + WS_LISTID), (const int*)(ws + WS_BTAB), (bf16*)(ws + WS_HFF), c * CHUNK_BLK, F_, moe);
            hipLaunchKernelGGL(nk_ffn_down, dim3(D / 32, CHUNK_BLK * 256 / 32), dim3(64), 0, stream, (const bf16*)(ws + WS_HFF), moe ? (const bf16*)(ws + WS_WDM) : (const bf16*)(ws + WS_WD0), (const int*)(ws + WS_BTAB), (bf16*)(ws + WS_Y), c * CHUNK_BLK, F_);
        }
        launch_mk(a, base + 14, base + 15, grid, stream);
#if defined(TRUNC)
        if (TRUNC == 2 * l + 2) return;
#endif
    }
#endif
}
```

```cpp
#include <hip/hip_runtime.h>
#include <cstdio>
#include <cstdint>

#ifndef MODE
#define MODE 3
#endif
#ifndef NAIVE
#define NAIVE 0
#endif

#define GAS __attribute__((address_space(1)))
#define LAS __attribute__((address_space(3)))
typedef unsigned short bf16;
typedef unsigned v4u __attribute__((ext_vector_type(4)));
typedef unsigned v2u __attribute__((ext_vector_type(2)));
typedef float f32x4 __attribute__((ext_vector_type(4)));
typedef float f32x2 __attribute__((ext_vector_type(2)));
typedef short bf16x8 __attribute__((ext_vector_type(8)));

constexpr int BATCH = 2, SEQ = 16384, T = BATCH * SEQ, D = 1024, DIN = 2048, DPOOL = 512, DATT = 512, NH = 16, HD = 32;
constexpr int GRIDW = 64, GROWS = SEQ / GRIDW, KH = 8, KW = 16;
constexpr int DFF = 4096, NE = 8, DFFE = 3584, DEPTH = 2;
constexpr int NPROJ = 1536;
constexpr float RMS_EPS = 1e-6f;
constexpr float LOG2E = 1.4426950408889634f;
constexpr float QSCALE = 0.17677669529663687f * LOG2E;
constexpr int CHUNK_BLK = 64;
constexpr int MAXCHUNK = 5;
constexpr int MAXBLK = 264;

constexpr size_t MiB = 1u << 20;
constexpr size_t WS_CTL = 0, CTL_ZERO_BYTES = 1 * MiB;
constexpr size_t WS_LIST = 1 * MiB;
constexpr size_t WS_INFO = 2 * MiB;
constexpr size_t WS_LISTID = 2 * MiB + 512 * 1024;
constexpr size_t WS_BTAB = 2 * MiB + 768 * 1024;
constexpr size_t WS_WP = 3 * MiB;
constexpr size_t WS_WIN = 4 * MiB;
constexpr size_t WS_WOUT = 12 * MiB;
constexpr size_t WS_WGU0 = 16 * MiB;
constexpr size_t WS_WD0 = 32 * MiB;
constexpr size_t WS_WGUM = 40 * MiB;
constexpr size_t WS_WDM = 152 * MiB;
constexpr size_t WS_HN = 208 * MiB;
constexpr size_t WS_R = 272 * MiB;
constexpr size_t WS_HFF = WS_R;
constexpr size_t WS_Y = WS_R + 128 * MiB;
constexpr size_t WS_PROJ = WS_R;
constexpr size_t WS_VT = WS_R + 96 * MiB;
constexpr size_t WS_MIXO = WS_R + 128 * MiB;
constexpr size_t WS_MIX = WS_R + 192 * MiB;
constexpr size_t WS_END = 532 * MiB;
constexpr int CW_TMO = 0, CW_CODE = 1;
constexpr int CW_BAR = 4096;
constexpr int CW_CNT = 8192;
constexpr int CW_DBG = 12288;

constexpr int RING_BYTES = 131072;
constexpr int TOKBUF_OFF = RING_BYTES;
constexpr int BLK_OFF = TOKBUF_OFF + 1024;
constexpr int BST_OFF = BLK_OFF + 272 * 4;
constexpr int LCNT_OFF = BST_OFF + 64;
constexpr int MISC_OFF = LCNT_OFF + 64;
constexpr int LDS_BYTES = 147456;
static_assert(MISC_OFF + 64 <= LDS_BYTES, "LDS map");

#define RLX_AGENT __ATOMIC_RELAXED, __HIP_MEMORY_SCOPE_AGENT
#define LDS_WAIT() asm volatile("s_waitcnt lgkmcnt(0)" ::: "memory")
#define VM_WAIT() asm volatile("s_waitcnt vmcnt(0)" ::: "memory")
__device__ __forceinline__ unsigned f2bf(float f) { unsigned u = __builtin_bit_cast(unsigned, f); return (u + 0x7fffu + ((u >> 16) & 1u)) >> 16; }
__device__ __forceinline__ unsigned pk2(float lo, float hi) { return f2bf(lo) | (f2bf(hi) << 16); }
__device__ __forceinline__ float bflo(unsigned w) { return __builtin_bit_cast(float, w << 16); }
__device__ __forceinline__ float bfhi(unsigned w) { return __builtin_bit_cast(float, w & 0xffff0000u); }
__device__ __forceinline__ float bf2f(bf16 v) { return __builtin_bit_cast(float, (unsigned)v << 16); }
__device__ __forceinline__ unsigned cvt_pk_bf16(float lo, float hi) { unsigned r; asm volatile("v_cvt_pk_bf16_f32 %0, %1, %2" : "=v"(r) : "v"(lo), "v"(hi)); return r; }
__device__ __forceinline__ float wave_sum(float v) {
#pragma unroll
    for (int o = 1; o < 64; o <<= 1) v += __shfl_xor(v, o);
    return v;
}

#define XB_TMO      128
#define XB_XCNT(j)  (256  + 64 * (j))
#define XB_XSUB(j)  (1280 + 64 * (j))
#define XB_XGEN(j)  (2304 + 64 * (j))
#define XB_TOP      3328
#define XB_TOPGEN   3392
#define XCD_BAR_WORDS 3456
#define XB_SPIN_CAP (1u << 18)
__device__ __forceinline__ unsigned xb_ld(unsigned* p)              { return __hip_atomic_load(p, __ATOMIC_RELAXED, __HIP_MEMORY_SCOPE_AGENT); }
__device__ __forceinline__ unsigned xb_add(unsigned* p, unsigned v) { return __hip_atomic_fetch_add(p, v, __ATOMIC_RELAXED, __HIP_MEMORY_SCOPE_AGENT); }
__device__ __forceinline__ unsigned xb_xcc_id() { return (unsigned)__builtin_amdgcn_s_getreg((3 << 11) | 20) & 0xFu; }
#define XB_SPIN(cond, bar) do { unsigned _sp = 0; while (cond) { __builtin_amdgcn_s_sleep(1); \
    if ((++_sp & 255u) == 0u) { if (xb_ld(&(bar)[XB_TMO])) break; if (_sp > XB_SPIN_CAP) { atomicAdd(&(bar)[XB_TMO], 1u); break; } } } } while (0)
struct XcdBarrier { unsigned* bar; unsigned x; volatile LAS unsigned* st; };
__device__ __forceinline__ XcdBarrier xcd_barrier_post(unsigned* bar, volatile LAS unsigned* st) {
    XcdBarrier b; b.bar = bar; b.x = xb_xcc_id(); b.st = st;
    if (threadIdx.x == 0) (void)xb_add(&bar[XB_XCNT(b.x)], 1u);
    return b;
}
__device__ __forceinline__ void xcd_barrier_complete(unsigned* bar, unsigned x, unsigned& nloc, unsigned& nx) {
    const unsigned G = gridDim.x * gridDim.y * gridDim.z;
    unsigned sum, cnt, mine, sp = 0u;
    for (;;) {
        sum = 0u; cnt = 0u; mine = 0u;
#pragma unroll
        for (unsigned j = 0; j < 16; ++j) { const unsigned c = xb_ld(&bar[XB_XCNT(j)]); sum += c; cnt += (c > 0u) ? 1u : 0u; mine = (j == x) ? c : mine; }
        if (sum == G) break;
        __builtin_amdgcn_s_sleep(1);
        if ((++sp & 255u) == 0u) { if (xb_ld(&bar[XB_TMO])) break; if (sp > XB_SPIN_CAP) { atomicAdd(&bar[XB_TMO], 1u); break; } }
    }
    nloc = mine > 0u ? mine : 1u; nx = cnt > 0u ? cnt : 1u;
}
__device__ __forceinline__ void xcd_barrier(const XcdBarrier& b) {
    asm volatile("s_waitcnt vmcnt(0)" ::: "memory");
    __syncthreads();
    if (threadIdx.x == 0) {
        unsigned* bar = b.bar;
        __builtin_amdgcn_s_waitcnt(0);
        unsigned nloc = b.st[0], nx = b.st[1];
        if (nloc == 0u) { xcd_barrier_complete(bar, b.x, nloc, nx); b.st[0] = nloc; b.st[1] = nx; }
        const unsigned old = xb_add(&bar[XB_XSUB(b.x)], 1u);
        const unsigned gen = old / nloc;
        if (old + 1u == (gen + 1u) * nloc) {
            __builtin_amdgcn_fence(__ATOMIC_RELEASE, "agent");
            asm volatile("s_waitcnt vmcnt(0)" ::: "memory");
            const unsigned og = xb_add(&bar[XB_TOP], 1u);
            const unsigned tg = og / nx;
            if (og + 1u == (tg + 1u) * nx) xb_add(&bar[XB_TOPGEN], 1u);
            else XB_SPIN(xb_ld(&bar[XB_TOPGEN]) == tg, bar);
            __builtin_amdgcn_fence(__ATOMIC_ACQUIRE, "agent");
            xb_add(&bar[XB_XGEN(b.x)], 1u);
            asm volatile("s_waitcnt vmcnt(0)" ::: "memory");
        } else {
            XB_SPIN(xb_ld(&bar[XB_XGEN(b.x)]) == gen, bar);
            __builtin_amdgcn_fence(__ATOMIC_ACQUIRE, "agent");
            asm volatile("s_waitcnt vmcnt(0)" ::: "memory");
        }
    }
    __syncthreads();
}

namespace pg8 {
constexpr int BM = 256, BK = 64, HALF = 128, HTB = HALF * BK * 2, STAGE_BYTES = 8 * HTB, NXCD = 8, WGM = 8;
__host__ __device__ __forceinline__ int lds_byte(int r, int c) { const int st = (r >> 4) * 2 + (c >> 5), rr = r & 15, cc = c & 31, ob = rr * 64 + cc * 2; return st * 1024 + (ob ^ (((ob >> 9) & 1) << 5)); }
__host__ __device__ __forceinline__ void stage_rc(int b, int& R, int& C) { const int st = b / 1024, sb = b % 1024, swz = sb ^ (((sb >> 9) & 1) << 5); R = (st >> 1) * 16 + swz / 64; C = (st & 1) * 32 + (swz % 64) / 2; }
__host__ __device__ __forceinline__ int perm32(int rho) { const int n = rho >> 4, i = rho & 15; return 8 * (i >> 2) + 4 * n + (i & 3); }

struct Unit { const char* A; const char* B; const int* list; bf16* obase; int orow, ocol, ldc; float scale; };

__device__ __forceinline__ bool tile_order(int i, int G, int c, int nM, int nN, int& pm, int& pn) {
    const int nwg = nM * nN; const long L = (long)i * G + c; if (L >= nwg) return false;
    int wgid = (int)L; { const int q = nwg / NXCD, r = nwg % NXCD, xcd = wgid % NXCD, off = wgid / NXCD; wgid = (xcd < r ? xcd * (q + 1) : r * (q + 1) + (xcd - r) * q) + off; }
    const int nig = WGM * nN, gid = wgid / nig, fm = gid * WGM, gsz = (nM - fm) < WGM ? (nM - fm) : WGM;
    pm = fm + ((wgid % nig) % gsz); pn = (wgid % nig) / gsz; return true;
}

struct EpiBf16 {
    __device__ __forceinline__ void operator()(const f32x4 (&acc)[2][2][4][2], const Unit& u, int wr, int wc, int fr, int fq) const {
        const int row0 = u.orow + wr * 64 + fr, col0 = u.ocol + wc * 32 + 8 * fq; const float sc = u.scale;
#pragma unroll
        for (int ai = 0; ai < 2; ++ai)
#pragma unroll
            for (int m = 0; m < 4; ++m) { bf16* rowp = u.obase + (size_t)(row0 + ai * HALF + m * 16) * u.ldc + col0;
#pragma unroll
                for (int bj = 0; bj < 2; ++bj) { const f32x4 v0 = acc[ai][bj][m][0] * sc, v1 = acc[ai][bj][m][1] * sc;
                    v4u w; w.x = cvt_pk_bf16(v0[0], v0[1]); w.y = cvt_pk_bf16(v0[2], v0[3]); w.z = cvt_pk_bf16(v1[0], v1[1]); w.w = cvt_pk_bf16(v1[2], v1[3]);
                    *(v4u*)(rowp + bj * HALF) = w; } }
    }
};
__device__ __forceinline__ float silu_mul(float g, float u) { return g * u * __builtin_amdgcn_rcpf(1.0f + __builtin_amdgcn_exp2f(-LOG2E * g)); }
struct EpiSwiGLU {
    __device__ __forceinline__ void operator()(const f32x4 (&acc)[2][2][4][2], const Unit& u, int wr, int wc, int fr, int fq) const {
        const int row0 = u.orow + wr * 64 + fr, col0 = u.ocol + wc * 32 + 8 * fq;
#pragma unroll
        for (int ai = 0; ai < 2; ++ai)
#pragma unroll
            for (int m = 0; m < 4; ++m) { bf16* rowp = u.obase + (size_t)(row0 + ai * HALF + m * 16) * u.ldc + col0;
                const f32x4 g0 = acc[ai][0][m][0], g1 = acc[ai][0][m][1], u0 = acc[ai][1][m][0], u1 = acc[ai][1][m][1];
                v4u w; w.x = cvt_pk_bf16(silu_mul(g0[0], u0[0]), silu_mul(g0[1], u0[1])); w.y = cvt_pk_bf16(silu_mul(g0[2], u0[2]), silu_mul(g0[3], u0[3]));
                w.z = cvt_pk_bf16(silu_mul(g1[0], u1[0]), silu_mul(g1[1], u1[1])); w.w = cvt_pk_bf16(silu_mul(g1[2], u1[2]), silu_mul(g1[3], u1[3]));
                *(v4u*)rowp = w; }
    }
};

template <class Epi, class Sched, bool GATHER>
__device__ __forceinline__ void gemm_phase(LAS unsigned char* lds, LAS int* tokbuf, const int K, const Sched& S, const Epi& E) {
    int tid_ = threadIdx.x; asm volatile("" : "+v"(tid_));
    const int tid = tid_, wid = __builtin_amdgcn_readfirstlane(tid >> 6), lane = tid & 63, wr = wid >> 2, wc = wid & 3, fr = lane & 15, fq = lane >> 4;
    const int nt = K / BK;
    unsigned voffA[2][2], voffB[2]; int rowA[2], colA[2];
#pragma unroll
    for (int i = 0; i < 2; ++i) { int R, C; stage_rc(tid * 16 + i * 8192, R, C); const int Rb = (R & ~31) + perm32(R & 31);
        voffA[0][i] = (unsigned)(R * K + C) * 2u; voffA[1][i] = (unsigned)((R + HALF) * K + C) * 2u; voffB[i] = (unsigned)(Rb * K + C) * 2u; rowA[i] = R; colA[i] = C; }
    const size_t kstep = (size_t)(BK * 2);
    const size_t hstep = (size_t)HALF * K * 2;
    const unsigned ldsw = (unsigned)wid * 1024u;
    const int aoff = lds_byte(wr * 64 + fr, fq * 8), boff = lds_byte(wc * 32 + fr, fq * 8);
#define PG8_SA(b, h) (((b) * 2 + (h)) * HTB)
#define PG8_SB(b, h) ((4 + (b) * 2 + (h)) * HTB)
#define PG8_STAGE(bufoff, gbase, voff) do { _Pragma("unroll") for (int _i = 0; _i < 2; ++_i) \
        __builtin_amdgcn_global_load_lds((const unsigned*)((const char*)(gbase) + (voff)[_i]), (LAS unsigned*)(lds + (bufoff) + ldsw + _i * 8192), 16, 0, 0); } while (0)
#define PG8_LDA(dst, b, h) do { _Pragma("unroll") for (int m = 0; m < 4; ++m) _Pragma("unroll") for (int k = 0; k < 2; ++k) dst[m][k] = *(const LAS bf16x8*)(lds + PG8_SA(b, h) + aoff + m * 2048 + k * 1024); } while (0)
#define PG8_LDB(dst, b, h) do { _Pragma("unroll") for (int n = 0; n < 2; ++n) _Pragma("unroll") for (int k = 0; k < 2; ++k) dst[n][k] = *(const LAS bf16x8*)(lds + PG8_SB(b, h) + boff + n * 2048 + k * 1024); } while (0)
#define PG8_MMA(ai, bj, At, Bt) do { __builtin_amdgcn_s_setprio(1); _Pragma("unroll") for (int m = 0; m < 4; ++m) _Pragma("unroll") for (int n = 0; n < 2; ++n) _Pragma("unroll") for (int k = 0; k < 2; ++k) \
        acc[ai][bj][m][n] = __builtin_amdgcn_mfma_f32_16x16x32_bf16(Bt[n][k], At[m][k], acc[ai][bj][m][n], 0, 0, 0); __builtin_amdgcn_s_setprio(0); } while (0)
#define PG8_WAIT_V(n) asm volatile("s_waitcnt vmcnt(" #n ")" ::: "memory")
#define PG8_WAIT_L(n) asm volatile("s_waitcnt lgkmcnt(" #n ")" ::: "memory")
#define PG8_BAR __builtin_amdgcn_s_barrier()
#define PG8_SCHED __builtin_amdgcn_sched_barrier(0)
#define PG8_TOKOFF(dst) do { _Pragma("unroll") for (int _h = 0; _h < 2; ++_h) _Pragma("unroll") for (int _i = 0; _i < 2; ++_i) \
        dst[_h][_i] = (unsigned)tokbuf[_h * HALF + rowA[_i]] * (unsigned)(K * 2) + (unsigned)(colA[_i] * 2); } while (0)
#define PG8_TOKDMA(listp) do { if (wid < 4) __builtin_amdgcn_global_load_lds((const unsigned*)((listp) + tid), (LAS unsigned*)(tokbuf + wid * 64), 4, 0, 0); } while (0)
    Unit cur, nxt; int ui = 0;
    if (!S.next(0, cur)) return;
    f32x4 acc[2][2][4][2];
#pragma unroll
    for (int a = 0; a < 2; ++a)
#pragma unroll
        for (int b = 0; b < 2; ++b)
#pragma unroll
            for (int m = 0; m < 4; ++m)
#pragma unroll
                for (int n = 0; n < 2; ++n) acc[a][b][m][n] = (f32x4){0.f, 0.f, 0.f, 0.f};
    bf16x8 At[4][2], B0[2][2], B1[2][2];
    const char* cA = cur.A; const char* cB = cur.B;
    if constexpr (GATHER) {
        PG8_TOKDMA(cur.list); PG8_WAIT_V(0); PG8_BAR; asm volatile("" ::: "memory");
        PG8_TOKOFF(voffA); PG8_WAIT_L(0); asm volatile("" ::: "memory");
    }
    PG8_STAGE(PG8_SB(0, 0), cB, voffB); PG8_STAGE(PG8_SB(0, 1), cB + hstep, voffB); PG8_STAGE(PG8_SA(0, 0), cA, voffA[0]); PG8_STAGE(PG8_SA(0, 1), cA, voffA[1]);
    if (wr == 1) PG8_BAR;
    PG8_WAIT_V(2); PG8_BAR;
    PG8_STAGE(PG8_SB(1, 0), cB + kstep, voffB); PG8_STAGE(PG8_SA(1, 0), cA + kstep, voffA[0]); PG8_STAGE(PG8_SB(1, 1), cB + hstep + kstep, voffB);
    PG8_WAIT_V(6); PG8_BAR;
    for (;;) {
        const bool has_next = S.next(ui + 1, nxt);
        if constexpr (GATHER) { if (has_next) PG8_TOKDMA(nxt.list); }
        const char* nA = has_next ? nxt.A : cA; const char* nB = has_next ? nxt.B : cB;
        for (int t = 0; t < nt; t += 2) {
            const bool last = (t == nt - 2);
            const char* a1 = cA + (size_t)(t + 1) * kstep;
            const char* a2 = last ? nA : cA + (size_t)(t + 2) * kstep; const char* b2 = last ? nB : cB + (size_t)(t + 2) * kstep;
            const char* a3 = a2 + kstep; const char* b3 = b2 + kstep;
            PG8_LDB(B0, 0, 0); PG8_LDB(B1, 0, 1); PG8_SCHED; PG8_LDA(At, 0, 0); PG8_STAGE(PG8_SA(1, 1), a1, voffA[1]);
            if constexpr (GATHER) { if (last && has_next) { PG8_TOKOFF(voffA); } }
            PG8_WAIT_V(8); PG8_WAIT_L(0); PG8_BAR; PG8_MMA(0, 0, At, B0); PG8_MMA(0, 1, At, B1); PG8_BAR; PG8_SCHED;
            PG8_LDA(At, 0, 1); PG8_STAGE(PG8_SB(0, 0), b2, voffB); PG8_STAGE(PG8_SB(0, 1), b2 + hstep, voffB); PG8_STAGE(PG8_SA(0, 0), a2, voffA[0]);
            PG8_WAIT_V(8); PG8_WAIT_L(0); PG8_BAR; PG8_MMA(1, 0, At, B0); PG8_MMA(1, 1, At, B1); PG8_BAR; PG8_SCHED;
            PG8_LDB(B0, 1, 0); PG8_LDB(B1, 1, 1); PG8_SCHED; PG8_LDA(At, 1, 0); PG8_STAGE(PG8_SA(0, 1), a2, voffA[1]);
            PG8_WAIT_V(8); PG8_WAIT_L(0); PG8_BAR; PG8_MMA(0, 0, At, B0); PG8_MMA(0, 1, At, B1); PG8_BAR; PG8_SCHED;
            PG8_LDA(At, 1, 1); PG8_STAGE(PG8_SB(1, 0), b3, voffB); PG8_STAGE(PG8_SB(1, 1), b3 + hstep, voffB); PG8_STAGE(PG8_SA(1, 0), a3, voffA[0]);
            PG8_WAIT_V(8); PG8_WAIT_L(0); PG8_BAR; PG8_MMA(1, 0, At, B0); PG8_MMA(1, 1, At, B1); PG8_BAR; PG8_SCHED;
        }
        if (wr == 0) PG8_BAR;
        E(acc, cur, wr, wc, fr, fq);
        if (!has_next) break;
#pragma unroll
        for (int a = 0; a < 2; ++a)
#pragma unroll
            for (int b = 0; b < 2; ++b)
#pragma unroll
                for (int m = 0; m < 4; ++m)
#pragma unroll
                    for (int n = 0; n < 2; ++n) acc[a][b][m][n] = (f32x4){0.f, 0.f, 0.f, 0.f};
        cur = nxt; cA = nA; cB = nB; ++ui;
        if (wr == 1) PG8_BAR;
    }
    PG8_WAIT_V(0);
    PG8_BAR;
#undef PG8_SA
#undef PG8_SB
#undef PG8_STAGE
#undef PG8_LDA
#undef PG8_LDB
#undef PG8_MMA
#undef PG8_WAIT_V
#undef PG8_WAIT_L
#undef PG8_BAR
#undef PG8_SCHED
#undef PG8_TOKOFF
#undef PG8_TOKDMA
}
}

struct Args { const float* in[17]; float* out; unsigned char* ws; int lo, hi; };
struct Frame {
    LAS unsigned char* lds; volatile LAS unsigned* MISC; unsigned* ctl; int tid, lane, wave, G, bid;
    const float *x, *g_mpre, *g_mpost, *g_fpre, *g_fpost, *w_in, *pool_w, *pool_scale, *rpb, *w_out, *dwg, *dwu, *dwd, *router, *mwg, *mwu, *mwd;
    float* out; unsigned char* ws;
};

__device__ __forceinline__ void p0_transpose_item(const float* W, int K, int N, bf16* WT, int kb, int n0, int row_base, LAS float* scr, int lane) {
    const int k0 = 64 * kb;
#pragma unroll 8
    for (int i = 0; i < 32; ++i) { const int kk = 2 * i + (lane >> 5); scr[kk * 33 + (lane & 31)] = W[(size_t)(k0 + kk) * N + n0 + (lane & 31)]; }
    LDS_WAIT(); asm volatile("" ::: "memory");
    const int c = lane & 7;
#pragma unroll
    for (int j = 0; j < 4; ++j) { const int n = (lane >> 3) + 8 * j; const LAS float* s = scr + (8 * c) * 33 + n;
        v4u o; o.x = pk2(s[0 * 33], s[1 * 33]); o.y = pk2(s[2 * 33], s[3 * 33]); o.z = pk2(s[4 * 33], s[5 * 33]); o.w = pk2(s[6 * 33], s[7 * 33]);
        *(v4u*)(WT + (size_t)(row_base + n) * K + k0 + 8 * c) = o; }
    LDS_WAIT(); asm volatile("" ::: "memory");
}
__device__ __forceinline__ void p0_matrix(const float* W, int K, int N, bf16* WT, int ilv_half, LAS float* scr, int lane, int gw, int NGW, int& base) {
    const int nblk = N / 32, nitems = (K / 64) * nblk;
    int it = gw - (base % NGW); if (it < 0) it += NGW;
    for (; it < nitems; it += NGW) { const int kb = it / nblk, n0 = 32 * (it % nblk);
        const int rb = ilv_half < 0 ? n0 : (n0 / 128) * 256 + (n0 % 128) + 128 * ilv_half;
        p0_transpose_item(W, K, N, WT, kb, n0, rb, scr, lane); }
    base += nitems;
}
__device__ __forceinline__ void rms_row_to_bf16(const float* xrow, const float* g, bf16* orow, int lane) {
    const f32x4* xr = (const f32x4*)xrow + lane; const f32x4* gr = (const f32x4*)g + lane;
    f32x4 v[4]; float s = 0.f;
#pragma unroll
    for (int j = 0; j < 4; ++j) { v[j] = xr[64 * j]; s += (v[j].x * v[j].x + v[j].y * v[j].y) + (v[j].z * v[j].z + v[j].w * v[j].w); }
    const float rstd = 1.0f / sqrtf(wave_sum(s) * (1.f / D) + RMS_EPS);
    v2u* o8 = (v2u*)orow + lane;
#pragma unroll
    for (int j = 0; j < 4; ++j) { const f32x4 gg = gr[64 * j]; v2u w; w.x = pk2(v[j].x * rstd * gg.x, v[j].y * rstd * gg.y); w.y = pk2(v[j].z * rstd * gg.z, v[j].w * rstd * gg.w); o8[64 * j] = w; }
}
__device__ __forceinline__ void p0_prologue(Frame& F0) {
    Frame F = F0; { int t_ = threadIdx.x; asm volatile("" : "+v"(t_)); F.tid = t_; F.lane = t_ & 63; F.wave = __builtin_amdgcn_readfirstlane(t_ >> 6); }
    LAS float* scr = (LAS float*)(F.lds + F.wave * 16384);
    const int gw = F.bid * 8 + F.wave, NGW = F.G * 8, gt = F.bid * 512 + F.tid, NGT = F.G * 512;
    { v4u z = (v4u){0u, 0u, 0u, 0u}; v4u* L = (v4u*)(F.ws + WS_LIST); for (int i = gt; i < (int)(NE * T / 4); i += NGT) L[i] = z;
      int* id = (int*)(F.ws + WS_LISTID); for (int i = gt; i < T; i += NGT) id[i] = i; }
    int base = 0;
    for (int l = 0; l < DEPTH; ++l) {
        p0_matrix(F.w_in + (size_t)l * D * DIN, D, DIN, (bf16*)(F.ws + WS_WIN) + (size_t)l * DIN * D, -1, scr, F.lane, gw, NGW, base);
        p0_matrix(F.w_out + (size_t)l * D * D, D, D, (bf16*)(F.ws + WS_WOUT) + (size_t)l * D * D, -1, scr, F.lane, gw, NGW, base);
        for (int g = 0; g < 4; ++g) p0_matrix(F.pool_w + (size_t)(l * 4 + g) * 128 * 128, 128, 128, (bf16*)(F.ws + WS_WP) + (size_t)(l * 4 + g) * 128 * 128, -1, scr, F.lane, gw, NGW, base);
    }
    p0_matrix(F.dwg, D, DFF, (bf16*)(F.ws + WS_WGU0), 0, scr, F.lane, gw, NGW, base);
    p0_matrix(F.dwu, D, DFF, (bf16*)(F.ws + WS_WGU0), 1, scr, F.lane, gw, NGW, base);
    p0_matrix(F.dwd, DFF, D, (bf16*)(F.ws + WS_WD0), -1, scr, F.lane, gw, NGW, base);
    for (int e = 0; e < NE; ++e) {
        p0_matrix(F.mwg + (size_t)e * D * DFFE, D, DFFE, (bf16*)(F.ws + WS_WGUM) + (size_t)e * 2 * DFFE * D, 0, scr, F.lane, gw, NGW, base);
        p0_matrix(F.mwu + (size_t)e * D * DFFE, D, DFFE, (bf16*)(F.ws + WS_WGUM) + (size_t)e * 2 * DFFE * D, 1, scr, F.lane, gw, NGW, base);
        p0_matrix(F.mwd + (size_t)e * DFFE * D, DFFE, D, (bf16*)(F.ws + WS_WDM) + (size_t)e * D * DFFE, -1, scr, F.lane, gw, NGW, base);
    }
    bf16* HN = (bf16*)(F.ws + WS_HN);
    for (int m = gw; m < T; m += NGW) rms_row_to_bf16(F.x + (size_t)m * D, F.g_mpre, HN + (size_t)m * D, F.lane);
}

__device__ __forceinline__ unsigned ld_cnt(const unsigned* ctl, int e) { return __hip_atomic_load(ctl + CW_CNT + 64 * e, RLX_AGENT); }

__device__ __forceinline__ void ld_bf16_row(const bf16* row, int lane, f32x4 (&v)[4]) {
    const v2u* p = (const v2u*)row + lane;
#pragma unroll
    for (int j = 0; j < 4; ++j) { const v2u w = p[64 * j]; v[j] = (f32x4){bflo(w.x), bfhi(w.x), bflo(w.y), bfhi(w.y)}; }
}
__device__ __forceinline__ float sumsq16(const f32x4 (&v)[4]) {
    float s = 0.f;
#pragma unroll
    for (int j = 0; j < 4; ++j) s += (v[j].x * v[j].x + v[j].y * v[j].y) + (v[j].z * v[j].z + v[j].w * v[j].w);
    return s;
}
template <bool FFN>
__device__ __forceinline__ void norm_phase(Frame& F0, int l) {
    Frame F = F0; { int t_ = threadIdx.x; asm volatile("" : "+v"(t_)); F.tid = t_; F.lane = t_ & 63; F.wave = __builtin_amdgcn_readfirstlane(t_ >> 6); }
    const int lane = F.lane, gw = F.bid * 8 + F.wave, NGW = F.G * 8;
    const bool moe = (l & 1) != 0;
    LAS float* WR = (LAS float*)F.lds;
    LAS unsigned* lcnt = (LAS unsigned*)(F.lds + LCNT_OFF); LAS unsigned* lbase = lcnt + 8;
    LAS int* bst = (LAS int*)(F.lds + BST_OFF);
    if (!FFN && moe) {
        for (int i = F.tid; i < D * NE; i += 512) { const int d = i >> 3, e = i & 7; WR[e * D + d] = F.router[i]; }
        if (F.tid < 8) lcnt[F.tid] = 0u;
        __syncthreads();
    }
    if (FFN && moe) {
        if (F.tid == 0) { int s = 0; for (int e = 0; e < NE; ++e) { bst[e] = s; s += (int)((ld_cnt(F.ctl, e) + 255u) >> 8); } }
        __syncthreads();
    }
    const float* gA = FFN ? F.g_fpost + l * D : F.g_mpost + l * D;
    const float* gB = FFN ? F.g_mpre + (l + 1) * D : F.g_fpre + l * D;
    const bool haveB = FFN ? (l + 1 < DEPTH) : true;
    const bf16* addsrc = FFN ? (const bf16*)(F.ws + WS_Y) : (const bf16*)(F.ws + WS_MIX);
    const float* hold_base = (!FFN && l == 0) ? F.x : F.out;
    bf16* HN = (bf16*)(F.ws + WS_HN);
    const v2u* info = (const v2u*)(F.ws + WS_INFO); const f32x2* ginfo = (const f32x2*)(F.ws + WS_INFO + 256 * 1024);
    int sTok = 0, sE0 = 0, sE1 = 0; float sG0 = 0.f, sG1 = 0.f; int it = 0;
    for (int m = gw; m < T; m += NGW, ++it) {
        f32x4 a[4];
        if (FFN && moe) {
            const v2u nf = info[m]; const int e0 = (int)(nf.x >> 16), p0 = (int)(nf.x & 0xffffu), e1 = (int)(nf.y >> 16), p1 = (int)(nf.y & 0xffffu);
            const f32x2 gg = ginfo[m]; const float g0 = gg.x, g1 = gg.y;
            const int r0 = 256 * bst[e0] + p0, r1 = 256 * bst[e1] + p1;
            f32x4 b[4]; ld_bf16_row(addsrc + (size_t)r0 * D, lane, a); ld_bf16_row(addsrc + (size_t)r1 * D, lane, b);
#pragma unroll
            for (int j = 0; j < 4; ++j) a[j] = a[j] * g0 + b[j] * g1;
        } else ld_bf16_row(addsrc + (size_t)m * D, lane, a);
        const float r1 = 1.0f / sqrtf(wave_sum(sumsq16(a)) * (1.f / D) + RMS_EPS);
        const f32x4* hp = (const f32x4*)(hold_base + (size_t)m * D) + lane; const f32x4* gAp = (const f32x4*)gA + lane;
        f32x4 h[4];
#pragma unroll
        for (int j = 0; j < 4; ++j) h[j] = hp[64 * j] + a[j] * r1 * gAp[64 * j];
        f32x4* op = (f32x4*)(F.out + (size_t)m * D) + lane;
#pragma unroll
        for (int j = 0; j < 4; ++j) op[64 * j] = h[j];
        if (haveB) {
            const float r2 = 1.0f / sqrtf(wave_sum(sumsq16(h)) * (1.f / D) + RMS_EPS);
            const f32x4* gBp = (const f32x4*)gB + lane; v2u* o8 = (v2u*)(HN + (size_t)m * D) + lane;
#pragma unroll
            for (int j = 0; j < 4; ++j) { h[j] = h[j] * r2 * gBp[64 * j]; v2u w; w.x = pk2(h[j].x, h[j].y); w.y = pk2(h[j].z, h[j].w); o8[64 * j] = w; }
            if (!FFN && moe) {
                float lg[NE];
#pragma unroll
                for (int e = 0; e < NE; ++e) { float s = 0.f;
#pragma unroll
                    for (int j = 0; j < 4; ++j) { const f32x4 w = *(const LAS f32x4*)(WR + e * D + 256 * j + 4 * lane); s += (h[j].x * w.x + h[j].y * w.y) + (h[j].z * w.z + h[j].w * w.w); }
                    lg[e] = wave_sum(s); }
                int e0 = 0; float l0 = lg[0];
#pragma unroll
                for (int e = 1; e < NE; ++e) if (lg[e] > l0) { l0 = lg[e]; e0 = e; }
                int e1 = -1; float l1 = -INFINITY;
#pragma unroll
                for (int e = 0; e < NE; ++e) if (e != e0 && lg[e] > l1) { l1 = lg[e]; e1 = e; }
                const float g0 = 1.0f / (1.0f + __expf(l1 - l0)), g1 = 1.0f - g0;
                if (lane == it) { sTok = m; sE0 = e0; sE1 = e1; sG0 = g0; sG1 = g1; }
            }
        }
    }
    if (!FFN && moe) {
        unsigned loc0 = 0u, loc1 = 0u;
        if (lane < it) { loc0 = __hip_atomic_fetch_add(lcnt + sE0, 1u, __ATOMIC_RELAXED, __HIP_MEMORY_SCOPE_WORKGROUP); loc1 = __hip_atomic_fetch_add(lcnt + sE1, 1u, __ATOMIC_RELAXED, __HIP_MEMORY_SCOPE_WORKGROUP); }
        __syncthreads();
        if (F.tid < 8) lbase[F.tid] = __hip_atomic_fetch_add(F.ctl + CW_CNT + 64 * F.tid, lcnt[F.tid], RLX_AGENT);
        __syncthreads();
        if (lane < it) {
            const unsigned p0 = lbase[sE0] + loc0, p1 = lbase[sE1] + loc1;
            int* list = (int*)(F.ws + WS_LIST);
            list[(size_t)sE0 * T + p0] = sTok; list[(size_t)sE1 * T + p1] = sTok;
            v2u nf; nf.x = ((unsigned)sE0 << 16) | p0; nf.y = ((unsigned)sE1 << 16) | p1;
            ((v2u*)(F.ws + WS_INFO))[sTok] = nf; ((f32x2*)(F.ws + WS_INFO + 256 * 1024))[sTok] = (f32x2){sG0, sG1};
        }
    }
}

constexpr int U_PITCH = 1040, U_ROWS = 80, BIAS_OFF = U_PITCH * U_ROWS;
__device__ __forceinline__ void mixer_phase(Frame& F0, int l) {
    Frame F = F0; { int t_ = threadIdx.x; asm volatile("" : "+v"(t_)); F.tid = t_; F.lane = t_ & 63; F.wave = __builtin_amdgcn_readfirstlane(t_ >> 6); }
    const int tid = F.tid, lane = F.lane, wid = F.wave, fr = lane & 15, fq = lane >> 4;
    const bf16* proj = (const bf16*)(F.ws + WS_PROJ); const bf16* Vt = (const bf16*)(F.ws + WS_VT); bf16* mixo = (bf16*)(F.ws + WS_MIXO);
    const bf16* Wp = (const bf16*)(F.ws + WS_WP) + (size_t)l * 4 * 128 * 128; const float* pscale = F.pool_scale + l * DPOOL; const float* rpb = F.rpb + (size_t)l * NH * 15 * 31;
    LAS float* BIAS = (LAS float*)(F.lds + BIAS_OFF);
    for (int i = tid; i < NH * 15 * 31; i += 512) BIAS[i] = rpb[i] * LOG2E;
    for (int unit = F.bid; unit < BATCH * GROWS; unit += F.G) {
        const int b = unit / GROWS, r = unit % GROWS, tb0 = b * SEQ, trow0 = 64 * r - 8;
        __syncthreads();
        for (int idx = tid; idx < U_ROWS * 64; idx += 512) { const int row = idx >> 6, pc = idx & 63, t = trow0 + row;
            if (t >= 0 && t < SEQ) { const v4u v = *(const v4u*)(proj + (size_t)(tb0 + t) * NPROJ + pc * 8); *(LAS v4u*)(F.lds + row * U_PITCH + pc * 16) = v; } }
        __syncthreads();
        {
            const int g = wid >> 1, half = wid & 1, hw = 1 << g;
            bf16x8 dfr[2][4];
#pragma unroll
            for (int mt = 0; mt < 2; ++mt)
#pragma unroll
                for (int ks = 0; ks < 4; ++ks) {
                    const int t = 64 * r + 32 * half + 16 * mt + fr, ch = 128 * g + 32 * ks + 8 * fq;
                    const int lo = max(t - hw, 0), hi = min(t + hw, SEQ);
                    float s0 = 0.f, s1 = 0.f, s2 = 0.f, s3 = 0.f, s4 = 0.f, s5 = 0.f, s6 = 0.f, s7 = 0.f;
                    for (int tt = lo; tt < hi; ++tt) { const v4u v = *(const LAS v4u*)(F.lds + (tt - trow0) * U_PITCH + ch * 2);
                        s0 += bflo(v.x); s1 += bfhi(v.x); s2 += bflo(v.y); s3 += bfhi(v.y); s4 += bflo(v.z); s5 += bfhi(v.z); s6 += bflo(v.w); s7 += bfhi(v.w); }
                    const v4u c = *(const LAS v4u*)(F.lds + (t - trow0) * U_PITCH + ch * 2);
                    const float inv = 1.0f / (float)(hi - lo);
                    v4u p; p.x = pk2(s0 * inv - bflo(c.x), s1 * inv - bfhi(c.x)); p.y = pk2(s2 * inv - bflo(c.y), s3 * inv - bfhi(c.y));
                    p.z = pk2(s4 * inv - bflo(c.z), s5 * inv - bfhi(c.z)); p.w = pk2(s6 * inv - bflo(c.w), s7 * inv - bfhi(c.w));
                    dfr[mt][ks] = __builtin_bit_cast(bf16x8, p);
                }
            const bf16* Wg = Wp + (size_t)g * 128 * 128;
#pragma unroll 2
            for (int nt = 0; nt < 8; ++nt) {
                bf16x8 wf[4];
#pragma unroll
                for (int ks = 0; ks < 4; ++ks) wf[ks] = *(const bf16x8*)(Wg + (size_t)(16 * nt + fr) * 128 + 32 * ks + 8 * fq);
                const f32x4 sc = *(const f32x4*)(pscale + 128 * g + 16 * nt + 4 * fq);
#pragma unroll
                for (int mt = 0; mt < 2; ++mt) {
                    f32x4 acc = (f32x4){0.f, 0.f, 0.f, 0.f};
#pragma unroll
                    for (int ks = 0; ks < 4; ++ks) acc = __builtin_amdgcn_mfma_f32_16x16x32_bf16(wf[ks], dfr[mt][ks], acc, 0, 0, 0);
                    acc = acc * sc;
                    v2u w; w.x = pk2(acc[0], acc[1]); w.y = pk2(acc[2], acc[3]);
                    *(v2u*)(mixo + (size_t)(tb0 + 64 * r + 32 * half + 16 * mt + fr) * D + 128 * g + 16 * nt + 4 * fq) = w;
                }
            }
        }
        {
            const int r0 = min(max(r - KH / 2, 0), GROWS - KH);
            for (int hh = 0; hh < 2; ++hh) {
                const int h = 2 * wid + hh;
                for (int qb = 0; qb < 4; ++qb) {
                    const int cs = qb == 0 ? 0 : (qb == 1 ? 8 : (qb == 2 ? 24 : 32));
                    const bf16x8 qf = *(const bf16x8*)(proj + (size_t)(tb0 + 64 * r + 16 * qb + fr) * NPROJ + 512 + 32 * h + 8 * fq);
                    f32x4 s[KH][2];
#pragma unroll
                    for (int kr = 0; kr < KH; ++kr)
#pragma unroll
                        for (int tau = 0; tau < 2; ++tau) {
                            const int keycol = cs + 8 * (fr >> 2) + 4 * tau + (fr & 3);
                            const bf16x8 kf = *(const bf16x8*)(proj + (size_t)(tb0 + 64 * (r0 + kr) + keycol) * NPROJ + 1024 + 32 * h + 8 * fq);
                            s[kr][tau] = __builtin_amdgcn_mfma_f32_16x16x32_bf16(kf, qf, (f32x4){0.f, 0.f, 0.f, 0.f}, 0, 0, 0);
                        }
                    const int c = 16 * qb + fr, c0 = min(max(c - KW / 2, 0), GRIDW - KW);
                    float mx = -INFINITY;
#pragma unroll
                    for (int kr = 0; kr < KH; ++kr) {
                        const LAS float* brow = BIAS + (h * 15 + (r0 + kr - r + KH - 1)) * 31;
#pragma unroll
                        for (int tau = 0; tau < 2; ++tau)
#pragma unroll
                            for (int q = 0; q < 4; ++q) {
                                const int kc = cs + 8 * fq + 4 * tau + q; const bool valid = (kc >= c0) && (kc < c0 + KW);
                                const int dc = min(max(kc - c + KW - 1, 0), 2 * KW - 2);
                                const float v = valid ? s[kr][tau][q] + brow[dc] : -INFINITY;
                                s[kr][tau][q] = v; mx = fmaxf(mx, v);
                            }
                    }
                    mx = fmaxf(mx, __shfl_xor(mx, 16)); mx = fmaxf(mx, __shfl_xor(mx, 32));
                    float sum = 0.f;
#pragma unroll
                    for (int kr = 0; kr < KH; ++kr)
#pragma unroll
                        for (int tau = 0; tau < 2; ++tau)
#pragma unroll
                            for (int q = 0; q < 4; ++q) { const float p = __builtin_amdgcn_exp2f(s[kr][tau][q] - mx); s[kr][tau][q] = p; sum += p; }
                    sum += __shfl_xor(sum, 16); sum += __shfl_xor(sum, 32);
                    f32x4 o[2] = {(f32x4){0.f, 0.f, 0.f, 0.f}, (f32x4){0.f, 0.f, 0.f, 0.f}};
#pragma unroll
                    for (int kr = 0; kr < KH; ++kr) {
                        v4u pw; pw.x = pk2(s[kr][0][0], s[kr][0][1]); pw.y = pk2(s[kr][0][2], s[kr][0][3]); pw.z = pk2(s[kr][1][0], s[kr][1][1]); pw.w = pk2(s[kr][1][2], s[kr][1][3]);
                        const bf16x8 pf = __builtin_bit_cast(bf16x8, pw);
#pragma unroll
                        for (int dt = 0; dt < 2; ++dt) {
                            const bf16x8 vf = *(const bf16x8*)(Vt + (size_t)(32 * h + 16 * dt + fr) * T + tb0 + 64 * (r0 + kr) + cs + 8 * fq);
                            o[dt] = __builtin_amdgcn_mfma_f32_16x16x32_bf16(vf, pf, o[dt], 0, 0, 0);
                        }
                    }
                    const float inv = 1.0f / sum;
#pragma unroll
                    for (int dt = 0; dt < 2; ++dt) { v2u w; w.x = pk2(o[dt][0] * inv, o[dt][1] * inv); w.y = pk2(o[dt][2] * inv, o[dt][3] * inv);
                        *(v2u*)(mixo + (size_t)(tb0 + 64 * r + 16 * qb + fr) * D + DPOOL + 32 * h + 16 * dt + 4 * fq) = w; }
                }
            }
        }
    }
    __syncthreads();
}

struct SchedProj {
    const char* hn; const char* win; bf16* proj; bf16* vt; int G, c;
    __device__ __forceinline__ bool next(int i, pg8::Unit& u) const {
        int pm, pn; if (!pg8::tile_order(i, G, c, T / 256, 8, pm, pn)) return false;
        const size_t tstep = (size_t)256 * D * 2; u.list = nullptr;
        if (pn < 6) { u.A = hn + pm * tstep; u.B = win + pn * tstep; u.obase = proj; u.orow = 256 * pm; u.ocol = 256 * pn; u.ldc = NPROJ; u.scale = (pn == 2 || pn == 3) ? QSCALE : 1.0f; }
        else { u.A = win + pn * tstep; u.B = hn + pm * tstep; u.obase = vt; u.orow = 256 * (pn - 6); u.ocol = 256 * pm; u.ldc = T; u.scale = 1.0f; }
        return true;
    }
};
struct SchedOut {
    const char* a; const char* w; bf16* o; int G, c;
    __device__ __forceinline__ bool next(int i, pg8::Unit& u) const {
        int pm, pn; if (!pg8::tile_order(i, G, c, T / 256, 4, pm, pn)) return false;
        const size_t tstep = (size_t)256 * D * 2; u.list = nullptr;
        u.A = a + pm * tstep; u.B = w + pn * tstep; u.obase = o; u.orow = 256 * pm; u.ocol = 256 * pn; u.ldc = D; u.scale = 1.0f; return true;
    }
};
__device__ __forceinline__ void ffn_table(Frame& F0, bool moe) {
    Frame F = F0; { int t_ = threadIdx.x; asm volatile("" : "+v"(t_)); F.tid = t_; F.lane = t_ & 63; F.wave = __builtin_amdgcn_readfirstlane(t_ >> 6); }
    LAS int* blk = (LAS int*)(F.lds + BLK_OFF); LAS int* bst = (LAS int*)(F.lds + BST_OFF);
    __syncthreads();
    if (F.tid == 0) { int s = 0; for (int e = 0; e < NE; ++e) { bst[e] = s; s += moe ? (int)((ld_cnt(F.ctl, e) + 255u) >> 8) : (e == 0 ? T / 256 : 0); } bst[8] = s; }
    __syncthreads();
    for (int b = F.tid; b < MAXBLK + 8; b += 512) { int e = 0; for (int k = 1; k < NE; ++k) if (b >= bst[k]) e = k; blk[b] = e; }
    __syncthreads();
}
struct SchedUp {
    const char* hn; const char* wgu; const int* lists; bf16* hff; LAS int* blk; LAS int* bst; int G, c, cstart, nblk, nN, F_, moe;
    __device__ __forceinline__ bool next(int i, pg8::Unit& u) const {
        int pm, pn; if (!pg8::tile_order(i, G, c, nblk, nN, pm, pn)) return false;
        const int b = cstart + pm, e = __builtin_amdgcn_readfirstlane(blk[b]), lb = b - __builtin_amdgcn_readfirstlane(bst[e]);
        u.A = hn; u.list = lists + (moe ? (size_t)e * T + 256 * lb : (size_t)256 * b);
        u.B = wgu + ((size_t)e * 2 * F_ + 256 * pn) * D * 2; u.obase = hff; u.orow = 256 * pm; u.ocol = 128 * pn; u.ldc = F_; u.scale = 1.0f; return true;
    }
};
struct SchedDown {
    const char* hff; const char* wd; bf16* y; LAS int* blk; int G, c, cstart, nblk, F_;
    __device__ __forceinline__ bool next(int i, pg8::Unit& u) const {
        int pm, pn; if (!pg8::tile_order(i, G, c, nblk, 4, pm, pn)) return false;
        const int b = cstart + pm, e = __builtin_amdgcn_readfirstlane(blk[b]); u.list = nullptr;
        u.A = hff + (size_t)pm * 256 * F_ * 2; u.B = wd + ((size_t)e * D + 256 * pn) * F_ * 2; u.obase = y; u.orow = 256 * b; u.ocol = 256 * pn; u.ldc = D; u.scale = 1.0f; return true;
    }
};

constexpr int STEPS_PER_LAYER = 16, NSTEPS = 1 + DEPTH * STEPS_PER_LAYER;
__global__ void __launch_bounds__(512, 2) mk_fwd(Args args) {
    extern __shared__ __attribute__((aligned(16))) unsigned char lds_raw[];
    Frame F;
    F.lds = (LAS unsigned char*)lds_raw; F.MISC = (volatile LAS unsigned*)(F.lds + MISC_OFF);
    F.tid = threadIdx.x; F.lane = F.tid & 63; F.wave = __builtin_amdgcn_readfirstlane(F.tid >> 6); F.G = gridDim.x; F.bid = blockIdx.x;
    F.ws = args.ws; F.ctl = (unsigned*)(args.ws + WS_CTL); F.out = args.out;
    F.x = args.in[0]; F.g_mpre = args.in[1]; F.g_mpost = args.in[2]; F.g_fpre = args.in[3]; F.g_fpost = args.in[4]; F.w_in = args.in[5]; F.pool_w = args.in[6]; F.pool_scale = args.in[7];
    F.rpb = args.in[8]; F.w_out = args.in[9]; F.dwg = args.in[10]; F.dwu = args.in[11]; F.dwd = args.in[12]; F.router = args.in[13]; F.mwg = args.in[14]; F.mwu = args.in[15]; F.mwd = args.in[16];
    if (F.tid < 16) F.MISC[F.tid] = 0u;
    __syncthreads();
    const int lo = args.lo, hi = args.hi;
    XcdBarrier bar; bar.bar = F.ctl + CW_BAR; bar.x = 0; bar.st = F.MISC;
    if (hi - lo > 1) bar = xcd_barrier_post(F.ctl + CW_BAR, F.MISC);
#define RUN(s) (lo <= (s) && (s) < hi)
#define SEAM(s) do { if (RUN(s) && RUN((s) + 1)) xcd_barrier(bar); } while (0)
    LAS int* tokbuf = (LAS int*)(F.lds + TOKBUF_OFF); LAS int* blk = (LAS int*)(F.lds + BLK_OFF); LAS int* bst = (LAS int*)(F.lds + BST_OFF);
    const char* HN = (const char*)(F.ws + WS_HN);

    #ifndef NO_P0
    if (RUN(0)) { p0_prologue(F); } SEAM(0);
#endif
    for (int l = 0; l < DEPTH; ++l) {
        const int base = 1 + STEPS_PER_LAYER * l; const bool moe = (l & 1) != 0;
#ifndef NO_P1
        if (RUN(base + 0)) {
            SchedProj S{HN, (const char*)(F.ws + WS_WIN) + (size_t)l * DIN * D * 2, (bf16*)(F.ws + WS_PROJ), (bf16*)(F.ws + WS_VT), F.G, F.bid};
            pg8::gemm_phase<pg8::EpiBf16, SchedProj, false>(F.lds, tokbuf, D, S, pg8::EpiBf16{});
        } SEAM(base + 0);
#endif
#ifndef NO_P2
        if (RUN(base + 1)) { mixer_phase(F, l); } SEAM(base + 1);
#endif
#ifndef NO_P3
        if (RUN(base + 2)) {
            SchedOut S{(const char*)(F.ws + WS_MIXO), (const char*)(F.ws + WS_WOUT) + (size_t)l * D * D * 2, (bf16*)(F.ws + WS_MIX), F.G, F.bid};
            pg8::gemm_phase<pg8::EpiBf16, SchedOut, false>(F.lds, tokbuf, D, S, pg8::EpiBf16{});
        } SEAM(base + 2);
#endif
#ifndef NO_P4
        if (RUN(base + 3)) { norm_phase<false>(F, l); } SEAM(base + 3);
#endif
        const int F_ = moe ? DFFE : DFF;
        bool table = false; int NB = 0;
        for (int c = 0; c < MAXCHUNK; ++c) {
            const int s5 = base + 4 + 2 * c, s6 = s5 + 1;
            if (!(RUN(s5) || RUN(s6))) continue;
            if (!table) { ffn_table(F, moe); NB = __builtin_amdgcn_readfirstlane(bst[8]); table = true; }
            const int cstart = c * CHUNK_BLK, nblk = min(NB - cstart, CHUNK_BLK);
            if (nblk <= 0) continue;
#ifndef NO_P5
            if (RUN(s5)) {
                SchedUp S{HN, moe ? (const char*)(F.ws + WS_WGUM) : (const char*)(F.ws + WS_WGU0), moe ? (const int*)(F.ws + WS_LIST) : (const int*)(F.ws + WS_LISTID), (bf16*)(F.ws + WS_HFF), blk, bst, F.G, F.bid, cstart, nblk, F_ / 128, F_, moe ? 1 : 0};
                pg8::gemm_phase<pg8::EpiSwiGLU, SchedUp, true>(F.lds, tokbuf, D, S, pg8::EpiSwiGLU{});
            } SEAM(s5);
#endif
#ifndef NO_P6
            if (RUN(s6)) {
                SchedDown S{(const char*)(F.ws + WS_HFF), moe ? (const char*)(F.ws + WS_WDM) : (const char*)(F.ws + WS_WD0), (bf16*)(F.ws + WS_Y), blk, F.G, F.bid, cstart, nblk, F_};
                pg8::gemm_phase<pg8::EpiBf16, SchedDown, false>(F.lds, tokbuf, F_, S, pg8::EpiBf16{});
            } SEAM(s6);
#endif
        }
#ifndef NO_P7
        if (RUN(base + 14)) { norm_phase<true>(F, l); }
#endif
        if (l + 1 < DEPTH) { if (RUN(base + 14) && RUN(base + 16)) xcd_barrier(bar); }
    }
#undef RUN
#undef SEAM
}

__global__ void __launch_bounds__(64) nk_gemm(const bf16* A, int lda, const bf16* Bt, int ldb, int K, bf16* O, int ldo, float scale, int sc_lo, int sc_hi) {
    const int m0 = 32 * blockIdx.y, n0 = 32 * blockIdx.x, lane = threadIdx.x, fr = lane & 15, fq = lane >> 4;
    f32x4 acc[2][2];
#pragma unroll
    for (int a = 0; a < 2; ++a)
#pragma unroll
        for (int b = 0; b < 2; ++b) acc[a][b] = (f32x4){0.f, 0.f, 0.f, 0.f};
    for (int k0 = 0; k0 < K; k0 += 32) {
        bf16x8 a[2], b[2];
#pragma unroll
        for (int i = 0; i < 2; ++i) { a[i] = *(const bf16x8*)(A + (size_t)(m0 + 16 * i + fr) * lda + k0 + 8 * fq); b[i] = *(const bf16x8*)(Bt + (size_t)(n0 + 16 * i + fr) * ldb + k0 + 8 * fq); }
#pragma unroll
        for (int mt = 0; mt < 2; ++mt)
#pragma unroll
            for (int nt = 0; nt < 2; ++nt) acc[mt][nt] = __builtin_amdgcn_mfma_f32_16x16x32_bf16(a[mt], b[nt], acc[mt][nt], 0, 0, 0);
    }
#pragma unroll
    for (int mt = 0; mt < 2; ++mt)
#pragma unroll
        for (int nt = 0; nt < 2; ++nt)
#pragma unroll
            for (int q = 0; q < 4; ++q) { const int m = m0 + 16 * mt + 4 * fq + q, n = n0 + 16 * nt + fr; const float sc = (n >= sc_lo && n < sc_hi) ? scale : 1.0f;
                O[(size_t)m * ldo + n] = (bf16)f2bf(acc[mt][nt][q] * sc); }
}
__global__ void nk_blocktab(const unsigned* ctl, int* btab, int moe) {
    if (threadIdx.x != 0 || blockIdx.x != 0) return;
    int b = 0;
    for (int e = 0; e < NE; ++e) { const int nb = moe ? (int)((ctl[CW_CNT + 64 * e] + 255u) >> 8) : (e == 0 ? T / 256 : 0); for (int k = 0; k < nb; ++k) btab[b++] = e | (k << 8); }
    btab[MAXBLK] = b;
}
__global__ void __launch_bounds__(64) nk_ffn_up(const bf16* hn, const bf16* wgu, const int* lists, const int* btab, bf16* hff, int cstart, int F_, int moe) {
    const int m0 = 32 * blockIdx.y, f0 = 32 * blockIdx.x, lane = threadIdx.x, fr = lane & 15, fq = lane >> 4;
    const int b = cstart + m0 / 256; if (b >= btab[MAXBLK]) return;
    const int e = btab[b] & 0xff, lb = btab[b] >> 8;
    const int* list = lists + (moe ? (size_t)e * T + 256 * lb : (size_t)256 * b) + (m0 % 256);
    const bf16* W = wgu + (size_t)e * 2 * F_ * D; const int rg = (f0 / 128) * 256 + (f0 % 128);
    const bf16* arow[2]; arow[0] = hn + (size_t)list[fr] * D; arow[1] = hn + (size_t)list[16 + fr] * D;
    f32x4 ag[2][2], au[2][2];
#pragma unroll
    for (int a = 0; a < 2; ++a)
#pragma unroll
        for (int c = 0; c < 2; ++c) { ag[a][c] = (f32x4){0.f, 0.f, 0.f, 0.f}; au[a][c] = (f32x4){0.f, 0.f, 0.f, 0.f}; }
    for (int k0 = 0; k0 < D; k0 += 32) {
        bf16x8 a[2], bg[2], bu[2];
#pragma unroll
        for (int i = 0; i < 2; ++i) { a[i] = *(const bf16x8*)(arow[i] + k0 + 8 * fq); bg[i] = *(const bf16x8*)(W + (size_t)(rg + 16 * i + fr) * D + k0 + 8 * fq); bu[i] = *(const bf16x8*)(W + (size_t)(rg + 128 + 16 * i + fr) * D + k0 + 8 * fq); }
#pragma unroll
        for (int mt = 0; mt < 2; ++mt)
#pragma unroll
            for (int nt = 0; nt < 2; ++nt) { ag[mt][nt] = __builtin_amdgcn_mfma_f32_16x16x32_bf16(a[mt], bg[nt], ag[mt][nt], 0, 0, 0); au[mt][nt] = __builtin_amdgcn_mfma_f32_16x16x32_bf16(a[mt], bu[nt], au[mt][nt], 0, 0, 0); }
    }
#pragma unroll
    for (int mt = 0; mt < 2; ++mt)
#pragma unroll
        for (int nt = 0; nt < 2; ++nt)
#pragma unroll
            for (int q = 0; q < 4; ++q) { const float g = ag[mt][nt][q], u = au[mt][nt][q]; const float v = g * u / (1.0f + __expf(-g));
                hff[(size_t)(m0 + 16 * mt + 4 * fq + q) * F_ + f0 + 16 * nt + fr] = (bf16)f2bf(v); }
}
__global__ void __launch_bounds__(64) nk_ffn_down(const bf16* hff, const bf16* wd, const int* btab, bf16* y, int cstart, int F_) {
    const int m0 = 32 * blockIdx.y, n0 = 32 * blockIdx.x, lane = threadIdx.x, fr = lane & 15, fq = lane >> 4;
    const int b = cstart + m0 / 256; if (b >= btab[MAXBLK]) return;
    const int e = btab[b] & 0xff; const bf16* W = wd + (size_t)e * D * F_;
    f32x4 acc[2][2];
#pragma unroll
    for (int a = 0; a < 2; ++a)
#pragma unroll
        for (int c = 0; c < 2; ++c) acc[a][c] = (f32x4){0.f, 0.f, 0.f, 0.f};
    for (int k0 = 0; k0 < F_; k0 += 32) {
        bf16x8 a[2], bb[2];
#pragma unroll
        for (int i = 0; i < 2; ++i) { a[i] = *(const bf16x8*)(hff + (size_t)(m0 + 16 * i + fr) * F_ + k0 + 8 * fq); bb[i] = *(const bf16x8*)(W + (size_t)(n0 + 16 * i + fr) * F_ + k0 + 8 * fq); }
#pragma unroll
        for (int mt = 0; mt < 2; ++mt)
#pragma unroll
            for (int nt = 0; nt < 2; ++nt) acc[mt][nt] = __builtin_amdgcn_mfma_f32_16x16x32_bf16(a[mt], bb[nt], acc[mt][nt], 0, 0, 0);
    }
#pragma unroll
    for (int mt = 0; mt < 2; ++mt)
#pragma unroll
        for (int nt = 0; nt < 2; ++nt)
#pragma unroll
            for (int q = 0; q < 4; ++q) y[(size_t)(256 * cstart + m0 + 16 * mt + 4 * fq + q) * D + n0 + 16 * nt + fr] = (bf16)f2bf(acc[mt][nt][q]);
}
__global__ void nk_pool_delta(const bf16* proj, bf16* delta) {
    const int idx = blockIdx.x * 256 + threadIdx.x, tok = idx / DPOOL, ch = idx % DPOOL, b = tok / SEQ, t = tok % SEQ, g = ch / 128, hw = 1 << g;
    const int lo = max(t - hw, 0), hi = min(t + hw, SEQ); float s = 0.f;
    for (int tt = lo; tt < hi; ++tt) s += bf2f(proj[(size_t)(b * SEQ + tt) * NPROJ + ch]);
    delta[(size_t)tok * DPOOL + ch] = (bf16)f2bf(s / (float)(hi - lo) - bf2f(proj[(size_t)tok * NPROJ + ch]));
}
__global__ void nk_pool_mm(const bf16* delta, const bf16* Wp, const float* pscale, bf16* mixo) {
    const int idx = blockIdx.x * 256 + threadIdx.x, tok = idx / DPOOL, dd = idx % DPOOL, g = dd / 128, d = dd % 128; float s = 0.f;
    for (int c = 0; c < 128; ++c) s += bf2f(delta[(size_t)tok * DPOOL + 128 * g + c]) * bf2f(Wp[(size_t)(g * 128 + d) * 128 + c]);
    mixo[(size_t)tok * D + dd] = (bf16)f2bf(s * pscale[dd]);
}
__global__ void nk_na(const bf16* proj, const bf16* Vt, const float* rpb, bf16* mixo) {
    const int idx = blockIdx.x * 256 + threadIdx.x, tok = idx / NH, h = idx % NH, b = tok / SEQ, t = tok % SEQ, r = t / GRIDW, c = t % GRIDW;
    const int r0 = min(max(r - KH / 2, 0), GROWS - KH), c0 = min(max(c - KW / 2, 0), GRIDW - KW);
    float q[HD];
#pragma unroll
    for (int d = 0; d < HD; ++d) q[d] = bf2f(proj[(size_t)tok * NPROJ + 512 + HD * h + d]);
    float mx = -INFINITY;
    for (int i = 0; i < KH; ++i) for (int j = 0; j < KW; ++j) {
        const size_t kt = (size_t)(b * SEQ + (r0 + i) * GRIDW + c0 + j); float s = 0.f;
#pragma unroll
        for (int d = 0; d < HD; ++d) s += q[d] * bf2f(proj[kt * NPROJ + 1024 + HD * h + d]);
        s += rpb[(h * 15 + (r0 + i - r + KH - 1)) * 31 + (c0 + j - c + KW - 1)] * LOG2E; mx = fmaxf(mx, s);
    }
    float o[HD], sum = 0.f;
#pragma unroll
    for (int d = 0; d < HD; ++d) o[d] = 0.f;
    for (int i = 0; i < KH; ++i) for (int j = 0; j < KW; ++j) {
        const size_t kt = (size_t)(b * SEQ + (r0 + i) * GRIDW + c0 + j); float s = 0.f;
#pragma unroll
        for (int d = 0; d < HD; ++d) s += q[d] * bf2f(proj[kt * NPROJ + 1024 + HD * h + d]);
        s += rpb[(h * 15 + (r0 + i - r + KH - 1)) * 31 + (c0 + j - c + KW - 1)] * LOG2E;
        const float p = exp2f(s - mx); sum += p; const float pb = __builtin_bit_cast(float, f2bf(p) << 16);
#pragma unroll
        for (int d = 0; d < HD; ++d) o[d] += pb * bf2f(Vt[(size_t)(HD * h + d) * T + kt]);
    }
#pragma unroll
    for (int d = 0; d < HD; ++d) mixo[(size_t)tok * D + DPOOL + HD * h + d] = (bf16)f2bf(o[d] / sum);
}

static void launch_mk(const Args& a0, int lo, int hi, int grid, hipStream_t stream) {
    Args a = a0; a.lo = lo; a.hi = hi;
    hipLaunchKernelGGL(mk_fwd, dim3(grid), dim3(512), LDS_BYTES, stream, a);
}
extern "C" void kernel_launch(void* const* d_in, const int* in_sizes, int n_in, void* d_out, int out_size, void* d_ws, size_t ws_size, hipStream_t stream) {
    static int grid = 0;
    if (grid == 0) {
        if (n_in != 17 || out_size != T * D || ws_size < WS_END) { fprintf(stderr, "kernel_launch: unexpected problem (n_in %d, out %d, ws %zu)\n", n_in, out_size, ws_size); grid = -1; return; }
        int dev = 0, cus = 0;
        if (hipGetDevice(&dev) != hipSuccess || hipDeviceGetAttribute(&cus, hipDeviceAttributeMultiprocessorCount, dev) != hipSuccess) { grid = -1; return; }
        if (hipFuncSetAttribute((const void*)mk_fwd, hipFuncAttributeMaxDynamicSharedMemorySize, LDS_BYTES) != hipSuccess) { grid = -1; return; }
        int per_cu = 0;
        if (hipOccupancyMaxActiveBlocksPerMultiprocessor(&per_cu, (const void*)mk_fwd, 512, LDS_BYTES) != hipSuccess || per_cu < 1) { fprintf(stderr, "kernel_launch: occupancy query says %d\n", per_cu); }
        (void)hipGetLastError();
        grid = cus;
    }
    if (grid < 0) return;
    hipMemsetAsync((char*)d_ws + WS_CTL, 0, CTL_ZERO_BYTES, stream);
    Args a{};
    for (int i = 0; i < 17; ++i) a.in[i] = (const float*)d_in[i];
    a.out = (float*)d_out; a.ws = (unsigned char*)d_ws; a.lo = 0; a.hi = 0;
    unsigned char* ws = (unsigned char*)d_ws;
#if MODE == 3
    launch_mk(a, 0, NSTEPS, grid, stream);
#else
    launch_mk(a, 0, 1, grid, stream);
    const bf16* HN = (const bf16*)(ws + WS_HN);
    for (int l = 0; l < DEPTH; ++l) {
        const int base = 1 + STEPS_PER_LAYER * l; const int moe = l & 1;
        const bf16* win = (const bf16*)(ws + WS_WIN) + (size_t)l * DIN * D;
        if (NAIVE & 1) {
            hipLaunchKernelGGL(nk_gemm, dim3(NPROJ / 32, T / 32), dim3(64), 0, stream, HN, D, win, D, D, (bf16*)(ws + WS_PROJ), NPROJ, QSCALE, 512, 1024);
            hipLaunchKernelGGL(nk_gemm, dim3(T / 32, DATT / 32), dim3(64), 0, stream, win + (size_t)NPROJ * D, D, HN, D, D, (bf16*)(ws + WS_VT), T, 1.0f, 0, 0);
        } else launch_mk(a, base + 0, base + 1, grid, stream);
        if (NAIVE & 2) {
            hipLaunchKernelGGL(nk_pool_delta, dim3(T * DPOOL / 256), dim3(256), 0, stream, (const bf16*)(ws + WS_PROJ), (bf16*)(ws + WS_MIX));
            hipLaunchKernelGGL(nk_pool_mm, dim3(T * DPOOL / 256), dim3(256), 0, stream, (const bf16*)(ws + WS_MIX), (const bf16*)(ws + WS_WP) + (size_t)l * 4 * 128 * 128, (const float*)d_in[7] + l * DPOOL, (bf16*)(ws + WS_MIXO));
            hipLaunchKernelGGL(nk_na, dim3(T * NH / 256), dim3(256), 0, stream, (const bf16*)(ws + WS_PROJ), (const bf16*)(ws + WS_VT), (const float*)d_in[8] + (size_t)l * NH * 15 * 31, (bf16*)(ws + WS_MIXO));
        } else launch_mk(a, base + 1, base + 2, grid, stream);
        if (NAIVE & 4) hipLaunchKernelGGL(nk_gemm, dim3(D / 32, T / 32), dim3(64), 0, stream, (const bf16*)(ws + WS_MIXO), D, (const bf16*)(ws + WS_WOUT) + (size_t)l * D * D, D, D, (bf16*)(ws + WS_MIX), D, 1.0f, 0, 0);
        else launch_mk(a, base + 2, base + 3, grid, stream);
        launch_mk(a, base + 3, base + 4, grid, stream);
        if (NAIVE & 24) hipLaunchKernelGGL(nk_blocktab, dim3(1), dim3(64), 0, stream, (const unsigned*)(ws + WS_CTL), (int*)(ws + WS_BTAB), moe);
        const int F_ = moe ? DFFE : DFF, nchunk = moe ? MAXCHUNK : 2;
        for (int c = 0; c < nchunk; ++c) {
            if (NAIVE & 8) hipLaunchKernelGGL(nk_ffn_up, dim3(F_ / 32, CHUNK_BLK * 256 / 32), dim3(64), 0, stream, HN, moe ? (const bf16*)(ws + WS_WGUM) : (const bf16*)(ws + WS_WGU0), moe ? (const int*)(ws + WS_LIST) : (const int*)(ws + WS_LISTID), (const int*)(ws + WS_BTAB), (bf16*)(ws + WS_HFF), c * CHUNK_BLK, F_, moe);
            else launch_mk(a, base + 4 + 2 * c, base + 5 + 2 * c, grid, stream);
            if (NAIVE & 16) hipLaunchKernelGGL(nk_ffn_down, dim3(D / 32, CHUNK_BLK * 256 / 32), dim3(64), 0, stream, (const bf16*)(ws + WS_HFF), moe ? (const bf16*)(ws + WS_WDM) : (const bf16*)(ws + WS_WD0), (const int*)(ws + WS_BTAB), (bf16*)(ws + WS_Y), c * CHUNK_BLK, F_);
            else launch_mk(a, base + 5 + 2 * c, base + 6 + 2 * c, grid, stream);
        }
        launch_mk(a, base + 14, base + 15, grid, stream);
    }
#endif
}
```

```cpp
#include <hip/hip_runtime.h>
#include <cstdio>
#include <cstdint>

#ifndef MODE
#define MODE 3
#endif
#ifndef NAIVE
#define NAIVE 0
#endif
#ifndef I8_DENSE
#define I8_DENSE 1
#endif
#ifndef I8_PROJ
#define I8_PROJ 1
#endif
#ifndef FP6_UP
#define FP6_UP 1
#endif
#ifndef FP8_DDOWN
#define FP8_DDOWN 1
#endif
#ifndef FP8_MOE
#define FP8_MOE 1
#endif
#if ((FP8_MOE || I8_DENSE) && (NAIVE & 24) || I8_PROJ && (NAIVE & 1)) && MODE != 3
#error the simple reference FFN kernels are bf16 only: build with -DFP8_MOE=0 to use them
#endif

#define GAS __attribute__((address_space(1)))
#define LAS __attribute__((address_space(3)))
typedef unsigned short bf16;
typedef unsigned v4u __attribute__((ext_vector_type(4)));
typedef unsigned v2u __attribute__((ext_vector_type(2)));
typedef float f32x4 __attribute__((ext_vector_type(4)));
typedef float f32x2 __attribute__((ext_vector_type(2)));
typedef short bf16x8 __attribute__((ext_vector_type(8)));

constexpr int BATCH = 2, SEQ = 16384, T = BATCH * SEQ, D = 1024, DIN = 2048, DPOOL = 512, DATT = 512, NH = 16, HD = 32;
constexpr int GRIDW = 64, GROWS = SEQ / GRIDW, KH = 8, KW = 16;
constexpr int DFF = 4096, NE = 8, DFFE = 3584, DEPTH = 2;
constexpr int UPITCH = 512;
constexpr int NPROJ = 1536;
constexpr float RMS_EPS = 1e-6f;
constexpr float LOG2E = 1.4426950408889634f;
constexpr float QSCALE = 0.17677669529663687f * LOG2E;
__host__ __device__ __forceinline__ size_t vt_index(int ch, int tok) { return (size_t)(tok >> 6) * (DATT * 64) + (size_t)ch * 64 + (tok & 63); }
constexpr float S6A = 1.25f, S6W = 40.0f;
typedef float f32x16 __attribute__((ext_vector_type(16)));
typedef int i32x6 __attribute__((ext_vector_type(6)));
constexpr float W8_UP = 32.0f, W8_DN = 64.0f;
typedef int i32x8 __attribute__((ext_vector_type(8)));
typedef int i32x4 __attribute__((ext_vector_type(4)));
constexpr int CHUNK_BLK = 64;
constexpr int MAXCHUNK = 5;
constexpr int MAXBLK = 264;

constexpr size_t MiB = 1u << 20;
constexpr size_t WS_CTL = 0, CTL_ZERO_BYTES = 1 * MiB;
constexpr size_t WS_LIST = 1 * MiB;
constexpr size_t WS_INFO = 2 * MiB;
constexpr size_t WS_LISTID = 2 * MiB + 512 * 1024;
constexpr size_t WS_SA = 2 * MiB + 640 * 1024;
constexpr size_t WS_SWIN = 2 * MiB + 896 * 1024;
constexpr size_t WS_SW0 = 2 * MiB + 832 * 1024;
constexpr size_t WS_BTAB = 2 * MiB + 768 * 1024;
constexpr size_t WS_WP = 3 * MiB;
constexpr size_t WS_WIN = 4 * MiB;
constexpr size_t WS_WOUT = 12 * MiB;
constexpr size_t WS_WGU0 = 16 * MiB;
constexpr size_t WS_WD0 = 32 * MiB;
constexpr size_t WS_WGUM = 40 * MiB;
constexpr size_t WS_WDM = (FP8_MOE ? 160 : 152) * MiB;
constexpr size_t WS_H16 = 96 * MiB;
constexpr size_t WS_HN = 208 * MiB;
constexpr size_t WS_R = 272 * MiB;
constexpr size_t WS_HFF = WS_R;
constexpr size_t WS_Y = WS_R + 128 * MiB;
constexpr size_t WS_PQ = WS_R + 32 * MiB, WS_PK = WS_R + 64 * MiB;
constexpr size_t WS_PROJ = WS_R;
constexpr size_t WS_VT = WS_R + 96 * MiB;
constexpr size_t WS_MIXO = WS_R + 128 * MiB;
constexpr size_t WS_MIX = WS_R + 192 * MiB;
constexpr size_t WS_END = 532 * MiB;
constexpr int HFF_TILE = 256 * 128;
constexpr int TAILSPLIT = 7, TAILPART_ROWS = 8 * 256;
constexpr size_t WS_TAILPART = WS_WGU0;
static_assert(WS_TAILPART + (size_t)(TAILSPLIT - 1) * TAILPART_ROWS * D * 2 <= WS_WGUM, "tail partials");
static_assert(!FP8_MOE || (WS_WGUM + (size_t)NE * 2 * DFFE * D <= WS_H16 && WS_H16 + (size_t)T * D * 2 <= WS_WDM), "H16 sits in the gap the fp8 expert weights leave");

constexpr int CW_TMO = 0, CW_CODE = 1;
constexpr int CW_BAR = 4096;
constexpr int CW_CNT = 16384;
constexpr int CW_DBG = 20480;

constexpr int RING_BYTES = 131072;
constexpr int TOKBUF_OFF = RING_BYTES;
constexpr int BLK_OFF = TOKBUF_OFF + 9 * 1024;
constexpr int BST_OFF = BLK_OFF + 272 * 4;
constexpr int LCNT_OFF = BST_OFF + 64;
constexpr int MISC_OFF = LCNT_OFF + 64;
constexpr int LDS_BYTES = 147456;
static_assert(MISC_OFF + 64 <= LDS_BYTES, "LDS map");

#define RLX_AGENT __ATOMIC_RELAXED, __HIP_MEMORY_SCOPE_AGENT
#define LDS_WAIT() asm volatile("s_waitcnt lgkmcnt(0)" ::: "memory")
#define VM_WAIT() asm volatile("s_waitcnt vmcnt(0)" ::: "memory")
__device__ __forceinline__ unsigned f2bf(float f) { unsigned u = __builtin_bit_cast(unsigned, f); return (u + 0x7fffu + ((u >> 16) & 1u)) >> 16; }
__device__ __forceinline__ unsigned pk2(float lo, float hi) { return f2bf(lo) | (f2bf(hi) << 16); }
__device__ __forceinline__ float bflo(unsigned w) { return __builtin_bit_cast(float, w << 16); }
__device__ __forceinline__ float bfhi(unsigned w) { return __builtin_bit_cast(float, w & 0xffff0000u); }
__device__ __forceinline__ float bf2f(bf16 v) { return __builtin_bit_cast(float, (unsigned)v << 16); }
__device__ __forceinline__ unsigned cvt_pk_bf16(float lo, float hi) { unsigned r; asm volatile("v_cvt_pk_bf16_f32 %0, %1, %2" : "=v"(r) : "v"(lo), "v"(hi)); return r; }
__device__ __forceinline__ float wave_sum(float v) {
#pragma unroll
    for (int o = 1; o < 64; o <<= 1) v += __shfl_xor(v, o);
    return v;
}

#define XB_TMO      128
#define XB_XCNT(j)  (256  + 64 * (j))
#define XB_XSUB(j)  (1280 + 64 * (j))
#define XB_XGEN(j)  (2304 + 64 * (j))
#define XB_TOP      3328
#define XB_TOPGEN   3392
#define XCD_BAR_WORDS 3456
#define XB_SPIN_CAP (1u << 18)
__device__ __forceinline__ unsigned xb_ld(unsigned* p)              { return __hip_atomic_load(p, __ATOMIC_RELAXED, __HIP_MEMORY_SCOPE_AGENT); }
__device__ __forceinline__ unsigned xb_add(unsigned* p, unsigned v) { return __hip_atomic_fetch_add(p, v, __ATOMIC_RELAXED, __HIP_MEMORY_SCOPE_AGENT); }
__device__ __forceinline__ unsigned xb_xcc_id() { return (unsigned)__builtin_amdgcn_s_getreg((3 << 11) | 20) & 0xFu; }
#define XB_SPIN(cond, bar) do { unsigned _sp = 0; while (cond) { __builtin_amdgcn_s_sleep(1); \
    if ((++_sp & 255u) == 0u) { if (xb_ld(&(bar)[XB_TMO])) break; if (_sp > XB_SPIN_CAP) { atomicAdd(&(bar)[XB_TMO], 1u); break; } } } } while (0)
struct XcdBarrier { unsigned* bar; unsigned x; volatile LAS unsigned* st; };
__device__ __forceinline__ XcdBarrier xcd_barrier_post(unsigned* bar, volatile LAS unsigned* st) {
    XcdBarrier b; b.bar = bar; b.x = xb_xcc_id(); b.st = st;
    if (threadIdx.x == 0) (void)xb_add(&bar[XB_XCNT(b.x)], 1u);
    return b;
}
__device__ __forceinline__ void xcd_barrier_complete(unsigned* bar, unsigned x, unsigned& nloc, unsigned& nx) {
    const unsigned G = gridDim.x * gridDim.y * gridDim.z;
    unsigned sum, cnt, mine, sp = 0u;
    for (;;) {
        sum = 0u; cnt = 0u; mine = 0u;
#pragma unroll
        for (unsigned j = 0; j < 16; ++j) { const unsigned c = xb_ld(&bar[XB_XCNT(j)]); sum += c; cnt += (c > 0u) ? 1u : 0u; mine = (j == x) ? c : mine; }
        if (sum == G) break;
        __builtin_amdgcn_s_sleep(1);
        if ((++sp & 255u) == 0u) { if (xb_ld(&bar[XB_TMO])) break; if (sp > XB_SPIN_CAP) { atomicAdd(&bar[XB_TMO], 1u); break; } }
    }
    nloc = mine > 0u ? mine : 1u; nx = cnt > 0u ? cnt : 1u;
}
__device__ __forceinline__ void xcd_barrier(const XcdBarrier& b) {
    asm volatile("s_waitcnt vmcnt(0)" ::: "memory");
    __syncthreads();
    if (threadIdx.x == 0) {
        unsigned* bar = b.bar;
        __builtin_amdgcn_s_waitcnt(0);
        unsigned nloc = b.st[0], nx = b.st[1];
        if (nloc == 0u) { xcd_barrier_complete(bar, b.x, nloc, nx); b.st[0] = nloc; b.st[1] = nx; }
        const unsigned old = xb_add(&bar[XB_XSUB(b.x)], 1u);
        const unsigned gen = old / nloc;
        if (old + 1u == (gen + 1u) * nloc) {
            __builtin_amdgcn_fence(__ATOMIC_RELEASE, "agent");
            asm volatile("s_waitcnt vmcnt(0)" ::: "memory");
            const unsigned og = xb_add(&bar[XB_TOP], 1u);
            const unsigned tg = og / nx;
            if (og + 1u == (tg + 1u) * nx) xb_add(&bar[XB_TOPGEN], 1u);
            else XB_SPIN(xb_ld(&bar[XB_TOPGEN]) == tg, bar);
            __builtin_amdgcn_fence(__ATOMIC_ACQUIRE, "agent");
            xb_add(&bar[XB_XGEN(b.x)], 1u);
            asm volatile("s_waitcnt vmcnt(0)" ::: "memory");
        } else {
            XB_SPIN(xb_ld(&bar[XB_XGEN(b.x)]) == gen, bar);
            __builtin_amdgcn_fence(__ATOMIC_ACQUIRE, "agent");
            asm volatile("s_waitcnt vmcnt(0)" ::: "memory");
        }
    }
    __syncthreads();
}

namespace pg8 {
constexpr int BM = 256, BK = 64, HALF = 128, HTB = HALF * BK * 2, STAGE_BYTES = 8 * HTB, NXCD = 8, WGM = 8;
__host__ __device__ __forceinline__ int lds_byte(int r, int c) { const int st = (r >> 4) * 2 + (c >> 5), rr = r & 15, cc = c & 31, ob = rr * 64 + cc * 2; return st * 1024 + (ob ^ (((ob >> 9) & 1) << 5)); }
__host__ __device__ __forceinline__ void stage_rc(int b, int& R, int& C) { const int st = b / 1024, sb = b % 1024, swz = sb ^ (((sb >> 9) & 1) << 5); R = (st >> 1) * 16 + swz / 64; C = (st & 1) * 32 + (swz % 64) / 2; }
__host__ __device__ __forceinline__ int perm32(int rho) { const int n = rho >> 4, i = rho & 15; return 8 * (i >> 2) + 4 * n + (i & 3); }

struct Unit { const char* A; const char* B; const void* p0; const float* cs; bf16* obase; int orow, ocol, ldc; float scale; };

__device__ __forceinline__ bool tile_order(int i, int G, int c, int nM, int nN, int& pm, int& pn) {
    const int nwg = nM * nN; const long L = (long)i * G + c; if (L >= nwg) return false;
    int wgid = (int)L; { const int q = nwg / NXCD, r = nwg % NXCD, xcd = wgid % NXCD, off = wgid / NXCD; wgid = (xcd < r ? xcd * (q + 1) : r * (q + 1) + (xcd - r) * q) + off; }
    const int nig = WGM * nN, gid = wgid / nig, fm = gid * WGM, gsz = (nM - fm) < WGM ? (nM - fm) : WGM;
    pm = fm + ((wgid % nig) % gsz); pn = (wgid % nig) / gsz; return true;
}

template <bool VT> struct EpiBf16T {
    static constexpr bool SCL = false;
    __device__ __forceinline__ void operator()(const f32x4 (&acc)[2][2][4][2], const Unit& u, int wr, int wc, int fr, int fq, const LAS int* tok, const LAS float* scl) const {
        const int row0 = u.orow + wr * 64 + fr, col0 = u.ocol + wc * 32 + 8 * fq; const float sc = u.scale;
#pragma unroll
        for (int ai = 0; ai < 2; ++ai)
#pragma unroll
            for (int m = 0; m < 4; ++m) { const int row = row0 + ai * HALF + m * 16; bf16* rowp = u.obase + (size_t)row * u.ldc + col0;
#pragma unroll
                for (int bj = 0; bj < 2; ++bj) { const f32x4 v0 = acc[ai][bj][m][0] * sc, v1 = acc[ai][bj][m][1] * sc;
                    v4u w; w.x = cvt_pk_bf16(v0[0], v0[1]); w.y = cvt_pk_bf16(v0[2], v0[3]); w.z = cvt_pk_bf16(v1[0], v1[1]); w.w = cvt_pk_bf16(v1[2], v1[3]);
                    bf16* p = (VT && u.ldc < 0) ? u.obase + vt_index(row, col0 + bj * HALF) : rowp + bj * HALF;
                    *(v4u*)p = w; } }
    }
};
typedef EpiBf16T<false> EpiBf16;
typedef EpiBf16T<true> EpiProj;
__device__ __forceinline__ float silu_mul(float g, float u) { return g * u * __builtin_amdgcn_rcpf(1.0f + __builtin_amdgcn_exp2f(-LOG2E * g)); }
struct EpiSwiGLU {
    static constexpr bool SCL = false;
    __device__ __forceinline__ void operator()(const f32x4 (&acc)[2][2][4][2], const Unit& u, int wr, int wc, int fr, int fq, const LAS int* tok, const LAS float* scl) const {
        const int row0 = u.orow + wr * 64 + fr, col0 = u.ocol + wc * 32 + 8 * fq;
#pragma unroll
        for (int ai = 0; ai < 2; ++ai)
#pragma unroll
            for (int m = 0; m < 4; ++m) { bf16* rowp = u.obase + (size_t)(row0 + ai * HALF + m * 16) * u.ldc + col0;
                const f32x4 g0 = acc[ai][0][m][0], g1 = acc[ai][0][m][1], u0 = acc[ai][1][m][0], u1 = acc[ai][1][m][1];
                v4u w; w.x = cvt_pk_bf16(silu_mul(g0[0], u0[0]), silu_mul(g0[1], u0[1])); w.y = cvt_pk_bf16(silu_mul(g0[2], u0[2]), silu_mul(g0[3], u0[3]));
                w.z = cvt_pk_bf16(silu_mul(g1[0], u1[0]), silu_mul(g1[1], u1[1])); w.w = cvt_pk_bf16(silu_mul(g1[2], u1[2]), silu_mul(g1[3], u1[3]));
                *(v4u*)rowp = w; }
    }
};

template <bool F6> struct EpiSwiGLU8T {
    static constexpr bool SCL = false;
    static __device__ __forceinline__ f32x2 pair(f32x2 gr, f32x2 ur) {
        const float sc = F6 ? 1.0f / (S6A * S6W) : 1.0f / W8_UP; const f32x2 a = gr * (-LOG2E * sc);
        f32x2 t; t.x = __builtin_amdgcn_exp2f(a.x); t.y = __builtin_amdgcn_exp2f(a.y);
        const f32x2 d = t + 1.0f; f32x2 r; r.x = __builtin_amdgcn_rcpf(d.x); r.y = __builtin_amdgcn_rcpf(d.y);
        return (gr * ur) * (r * (sc * sc));
    }
    __device__ __forceinline__ void operator()(const f32x4 (&acc)[2][2][4][2], const Unit& u, int wr, int wc, int fr, int fq, const LAS int* tok, const LAS float* scl) const {
        const int row0 = u.orow + wr * 64 + fr, col0 = u.ocol + wc * 32 + 8 * fq;
#pragma unroll
        for (int ai = 0; ai < 2; ++ai)
#pragma unroll
            for (int m = 0; m < 4; ++m) { unsigned char* rowp = (unsigned char*)u.obase + (size_t)(row0 + ai * HALF + m * 16) * 128 + col0;
                const f32x4 g0 = acc[ai][0][m][0], g1 = acc[ai][0][m][1], u0 = acc[ai][1][m][0], u1 = acc[ai][1][m][1];
                const f32x2 o0 = pair((f32x2){g0[0], g0[1]}, (f32x2){u0[0], u0[1]}), o1 = pair((f32x2){g0[2], g0[3]}, (f32x2){u0[2], u0[3]});
                const f32x2 o2 = pair((f32x2){g1[0], g1[1]}, (f32x2){u1[0], u1[1]}), o3 = pair((f32x2){g1[2], g1[3]}, (f32x2){u1[2], u1[3]});
                int w0 = 0, w1 = 0;
                w0 = __builtin_amdgcn_cvt_pk_fp8_f32(o0.x, o0.y, w0, false); w0 = __builtin_amdgcn_cvt_pk_fp8_f32(o1.x, o1.y, w0, true);
                w1 = __builtin_amdgcn_cvt_pk_fp8_f32(o2.x, o2.y, w1, false); w1 = __builtin_amdgcn_cvt_pk_fp8_f32(o3.x, o3.y, w1, true);
                v2u w; w.x = (unsigned)w0; w.y = (unsigned)w1; *(v2u*)rowp = w; }
    }
};

typedef EpiSwiGLU8T<false> EpiSwiGLU8;
typedef EpiSwiGLU8T<true> EpiSwiGLU6;
struct EpiProj_I8 {
    static constexpr bool SCL = true;
    __device__ __forceinline__ const float* rs_ptr(const Unit& u) const { return (const float*)u.p0; }
    __device__ __forceinline__ const float* cs_ptr(const Unit& u) const { return u.cs; }
    __device__ __forceinline__ void operator()(const f32x4 (&acc)[2][2][4][2], const Unit& u, int wr, int wc, int fr, int fq, const LAS int* tok, const LAS float* scl) const {
        const int rl0 = wr * 64 + fr, cl0 = wc * 32 + 8 * fq, row0 = u.orow + rl0, col0 = u.ocol + cl0; const float sc = u.scale;
        const bool hm = u.ldc == 0; const size_t rstride = hm ? 32 : (size_t)u.ldc, bstride = hm ? (size_t)4 * T * 32 : (size_t)HALF;
        bf16* lbase = hm ? u.obase + (size_t)((u.ocol >> 5) + wc) * T * 32 + 8 * fq : u.obase + col0;
        f32x4 cv[2][2];
#pragma unroll
        for (int bj = 0; bj < 2; ++bj) { cv[bj][0] = *(const LAS f32x4*)(scl + 256 + cl0 + bj * HALF) * sc; cv[bj][1] = *(const LAS f32x4*)(scl + 256 + cl0 + bj * HALF + 4) * sc; }
#pragma unroll
        for (int ai = 0; ai < 2; ++ai)
#pragma unroll
            for (int m = 0; m < 4; ++m) { const int row = row0 + ai * HALF + m * 16; const float sr = scl[rl0 + ai * HALF + m * 16]; bf16* rowp = lbase + (size_t)row * rstride;
#pragma unroll
                for (int bj = 0; bj < 2; ++bj) { const f32x4 v0 = __builtin_convertvector(__builtin_bit_cast(i32x4, acc[ai][bj][m][0]), f32x4) * cv[bj][0] * sr, v1 = __builtin_convertvector(__builtin_bit_cast(i32x4, acc[ai][bj][m][1]), f32x4) * cv[bj][1] * sr;
                    v4u w; w.x = cvt_pk_bf16(v0[0], v0[1]); w.y = cvt_pk_bf16(v0[2], v0[3]); w.z = cvt_pk_bf16(v1[0], v1[1]); w.w = cvt_pk_bf16(v1[2], v1[3]);
                    bf16* p = (u.ldc < 0) ? u.obase + vt_index(row, col0 + bj * HALF) : rowp + bj * bstride;
                    *(v4u*)p = w; } }
    }
};
template <bool F8OUT> struct EpiSwiGLU_I8T {
    static constexpr bool SCL = true;
    const float* sA; const float* sW; const int* idl;
    __device__ __forceinline__ const float* rs_ptr(const Unit& u) const { return sA + ((const int*)u.p0 - idl); }
    __device__ __forceinline__ const float* cs_ptr(const Unit& u) const { return sW + 2 * u.ocol; }
    static __device__ __forceinline__ f32x2 pair(f32x2 gr, f32x2 ur, f32x2 ka, f32x2 k, float sa) {
        const f32x2 a = (gr * sa) * ka;
        f32x2 t; t.x = __builtin_amdgcn_exp2f(a.x); t.y = __builtin_amdgcn_exp2f(a.y);
        const f32x2 d = t * k + k; f32x2 r; r.x = __builtin_amdgcn_rcpf(d.x); r.y = __builtin_amdgcn_rcpf(d.y);
        return (gr * ur) * r;
    }
    __device__ __forceinline__ void operator()(const f32x4 (&acc)[2][2][4][2], const Unit& u, int wr, int wc, int fr, int fq, const LAS int* tok, const LAS float* scl) const {
        const int rl0 = wr * 64 + fr, row0 = u.orow + rl0, cl0 = wc * 32 + 8 * fq, col0 = u.ocol + cl0;
        f32x2 ka[4], kc[4];
#pragma unroll
        for (int i = 0; i < 4; ++i) { const f32x2 wg = *(const LAS f32x2*)(scl + 256 + cl0 + 2 * i), wu = *(const LAS f32x2*)(scl + 256 + HALF + cl0 + 2 * i); const f32x2 p = wg * wu;
            ka[i] = wg * (-LOG2E); kc[i].x = __builtin_amdgcn_rcpf(p.x); kc[i].y = __builtin_amdgcn_rcpf(p.y); }
#pragma unroll
        for (int ai = 0; ai < 2; ++ai)
#pragma unroll
            for (int m = 0; m < 4; ++m) { const float sa = scl[rl0 + ai * HALF + m * 16], rs2 = __builtin_amdgcn_rcpf(sa * sa);
                bf16* rowp = u.obase + (size_t)(row0 + ai * HALF + m * 16) * u.ldc + col0;
                f32x2 o[4];
#pragma unroll
                for (int i = 0; i < 4; ++i) { const f32x4 ga = acc[ai][0][m][i >> 1], ua = acc[ai][1][m][i >> 1];
                    const float g0 = ga[2 * (i & 1)], g1 = ga[2 * (i & 1) + 1], u0 = ua[2 * (i & 1)], u1 = ua[2 * (i & 1) + 1];
                    const f32x2 gr = (f32x2){(float)__float_as_int(g0), (float)__float_as_int(g1)}, ur = (f32x2){(float)__float_as_int(u0), (float)__float_as_int(u1)};
                    o[i] = pair(gr, ur, ka[i], kc[i] * rs2, sa); }
                if constexpr (F8OUT) { int w0 = 0, w1 = 0;
                    w0 = __builtin_amdgcn_cvt_pk_fp8_f32(o[0].x, o[0].y, w0, false); w0 = __builtin_amdgcn_cvt_pk_fp8_f32(o[1].x, o[1].y, w0, true);
                    w1 = __builtin_amdgcn_cvt_pk_fp8_f32(o[2].x, o[2].y, w1, false); w1 = __builtin_amdgcn_cvt_pk_fp8_f32(o[3].x, o[3].y, w1, true);
                    v2u w; w.x = (unsigned)w0; w.y = (unsigned)w1; *(v2u*)((unsigned char*)u.obase + (size_t)(row0 + ai * HALF + m * 16) * 128 + col0) = w; }
                else { v4u w; w.x = cvt_pk_bf16(o[0].x, o[0].y); w.y = cvt_pk_bf16(o[1].x, o[1].y); w.z = cvt_pk_bf16(o[2].x, o[2].y); w.w = cvt_pk_bf16(o[3].x, o[3].y);
                    *(v4u*)rowp = w; } }
    }
};
typedef EpiSwiGLU_I8T<FP8_DDOWN != 0> EpiSwiGLU_I8;

template <class Epi, class Sched, bool GATHER, int MT = 0  >
__device__ __forceinline__ void gemm_phase(LAS unsigned char* lds, LAS int* tokbuf, const int K, const Sched& S, const Epi& E, const int P_ = 0, const int PA_ = 0, const int KSA_ = 0) {
    const int P = P_ ? P_ : K, PA = PA_ ? PA_ : P;
    const size_t kstepA = KSA_ ? (size_t)KSA_ : (size_t)(BK * 2);
    int tid_ = threadIdx.x; asm volatile("" : "+v"(tid_));
    const int tid = tid_, wid = __builtin_amdgcn_readfirstlane(tid >> 6), lane = tid & 63, wr = wid >> 2, wc = wid & 3, fr = lane & 15, fq = lane >> 4;
    const int nt = K / BK;
    unsigned voffA[2][2], voffB[2]; int rowA[2], colA[2];
#pragma unroll
    for (int i = 0; i < 2; ++i) { int R, C; stage_rc(tid * 16 + i * 8192, R, C); const int Rb = (R & ~31) + perm32(R & 31);
        voffA[0][i] = (unsigned)(R * PA + C) * 2u; voffA[1][i] = (unsigned)((R + HALF) * PA + C) * 2u; voffB[i] = (unsigned)(Rb * P + C) * 2u; rowA[i] = R; colA[i] = C; }
    const size_t kstep = (size_t)(BK * 2);
    const size_t hstep = (size_t)HALF * P * 2, hstepA = (size_t)HALF * PA * 2;
    const unsigned ldsw = (unsigned)wid * 1024u;
    const int aoff = lds_byte(wr * 64 + fr, fq * 8), boff = lds_byte(wc * 32 + fr, fq * 8);
#define PG8_SA(b, h) (((b) * 2 + (h)) * HTB)
#define PG8_SB(b, h) ((4 + (b) * 2 + (h)) * HTB)
#define PG8_STAGE(bufoff, gbase, voff) do { _Pragma("unroll") for (int _i = 0; _i < 2; ++_i) \
        __builtin_amdgcn_global_load_lds((const unsigned*)((const char*)(gbase) + (voff)[_i]), (LAS unsigned*)(lds + (bufoff) + ldsw + _i * 8192), 16, 0, 0); } while (0)
#define PG8_STAGE_A1(bufoff, gbase) do { if constexpr (GATHER) PG8_STAGE(bufoff, gbase, voffA[1]); else PG8_STAGE(bufoff, (gbase) + hstepA, voffA[0]); } while (0)
#define PG8_LDA(dst, b, h) do { _Pragma("unroll") for (int m = 0; m < 4; ++m) _Pragma("unroll") for (int k = 0; k < 2; ++k) dst[m][k] = *(const LAS bf16x8*)(lds + PG8_SA(b, h) + aoff + m * 2048 + k * 1024); } while (0)
#define PG8_LDB(dst, b, h) do { _Pragma("unroll") for (int n = 0; n < 2; ++n) _Pragma("unroll") for (int k = 0; k < 2; ++k) dst[n][k] = *(const LAS bf16x8*)(lds + PG8_SB(b, h) + boff + n * 2048 + k * 1024); } while (0)
#define PG8_CAT8(x) __builtin_shufflevector(__builtin_bit_cast(i32x4, (x)[0]), __builtin_bit_cast(i32x4, (x)[1]), 0, 1, 2, 3, 4, 5, 6, 7)
#define PG8_MMA(ai, bj, At, Bt) do { __builtin_amdgcn_s_setprio(1); _Pragma("unroll") for (int m = 0; m < 4; ++m) _Pragma("unroll") for (int n = 0; n < 2; ++n) { \
        if constexpr (MT == 1) acc[ai][bj][m][n] = __builtin_amdgcn_mfma_scale_f32_16x16x128_f8f6f4(PG8_CAT8(Bt[n]), PG8_CAT8(At[m]), acc[ai][bj][m][n], 0, 0, 0, 0, 0, 0); \
        else if constexpr (MT == 3) acc[ai][bj][m][n] = __builtin_amdgcn_mfma_scale_f32_16x16x128_f8f6f4(PG8_CAT8(Bt[n]), PG8_CAT8(At[m]), acc[ai][bj][m][n], 2, 2, 0, 0, 0, 0); \
        else if constexpr (MT == 2) { _Pragma("unroll") for (int k = 0; k < 2; ++k) acc[ai][bj][m][n] = __builtin_bit_cast(f32x4, __builtin_amdgcn_mfma_i32_16x16x64_i8(__builtin_bit_cast(i32x4, Bt[n][k]), __builtin_bit_cast(i32x4, At[m][k]), __builtin_bit_cast(i32x4, acc[ai][bj][m][n]), 0, 0, 0)); } \
        else { _Pragma("unroll") for (int k = 0; k < 2; ++k) acc[ai][bj][m][n] = __builtin_amdgcn_mfma_f32_16x16x32_bf16(Bt[n][k], At[m][k], acc[ai][bj][m][n], 0, 0, 0); } } \
        __builtin_amdgcn_s_setprio(0); } while (0)
#define PG8_WAIT_V(n) asm volatile("s_waitcnt vmcnt(" #n ")" ::: "memory")
#define PG8_WAIT_L(n) asm volatile("s_waitcnt lgkmcnt(" #n ")" ::: "memory")
#define PG8_BAR __builtin_amdgcn_s_barrier()
#define PG8_SCHED __builtin_amdgcn_sched_barrier(0)
#define PG8_TOKOFF(dst, tb) do { _Pragma("unroll") for (int _h = 0; _h < 2; ++_h) _Pragma("unroll") for (int _i = 0; _i < 2; ++_i) \
        dst[_h][_i] = (unsigned)(tb)[_h * HALF + rowA[_i]] * (unsigned)(PA * 2) + (unsigned)(colA[_i] * 2); } while (0)
#define PG8_TOKDMA(listp, tb) do { if (wid < 4) __builtin_amdgcn_global_load_lds((const unsigned*)((listp) + tid), (LAS unsigned*)((tb) + wid * 64), 4, 0, 0); } while (0)
#define PG8_SCB(u_) ((LAS float*)(tokbuf + 768) + 512 * ((u_) % 3))
#define PG8_SCLDMA(un, u_) do { const float* sp_ = wid < 4 ? E.rs_ptr(un) + tid : E.cs_ptr(un) + (tid - 256); \
        __builtin_amdgcn_global_load_lds((const unsigned*)sp_, (LAS unsigned*)(PG8_SCB(u_) + wid * 64), 4, 0, 0); } while (0)
#define PG8_TB(u_) (tokbuf + 256 * ((u_) % 3))
    Unit cur, nxt; int ui = 0;
    if (!S.next(0, cur)) return;
    f32x4 acc[2][2][4][2];
#pragma unroll
    for (int a = 0; a < 2; ++a)
#pragma unroll
        for (int b = 0; b < 2; ++b)
#pragma unroll
            for (int m = 0; m < 4; ++m)
#pragma unroll
                for (int n = 0; n < 2; ++n) acc[a][b][m][n] = (f32x4){0.f, 0.f, 0.f, 0.f};
    bf16x8 At[4][2], B0[2][2], B1[2][2];
    const char* cA = cur.A; const char* cB = cur.B;
    if constexpr (Epi::SCL) PG8_SCLDMA(cur, 0);
    if constexpr (GATHER) {
        PG8_TOKDMA((const int*)cur.p0, PG8_TB(0)); PG8_WAIT_V(0); PG8_BAR; asm volatile("" ::: "memory");
        PG8_TOKOFF(voffA, PG8_TB(0)); PG8_WAIT_L(0); asm volatile("" ::: "memory");
    } else if constexpr (Epi::SCL) { PG8_WAIT_V(0); PG8_BAR; asm volatile("" ::: "memory"); }
    PG8_STAGE(PG8_SB(0, 0), cB, voffB); PG8_STAGE(PG8_SB(0, 1), cB + hstep, voffB); PG8_STAGE(PG8_SA(0, 0), cA, voffA[0]); PG8_STAGE_A1(PG8_SA(0, 1), cA);
    if (wr == 1) PG8_BAR;
    PG8_WAIT_V(2); PG8_BAR;
    PG8_STAGE(PG8_SB(1, 0), cB + kstep, voffB); PG8_STAGE(PG8_SA(1, 0), cA + kstepA, voffA[0]); PG8_STAGE(PG8_SB(1, 1), cB + hstep + kstep, voffB);
    PG8_WAIT_V(6); PG8_BAR;
    for (;;) {
        const bool has_next = S.next(ui + 1, nxt);
        if constexpr (Epi::SCL) { if (has_next) PG8_SCLDMA(nxt, ui + 1); }
        if constexpr (GATHER) { if (has_next) PG8_TOKDMA((const int*)nxt.p0, PG8_TB(ui + 1)); }
        const char* nA = has_next ? nxt.A : cA; const char* nB = has_next ? nxt.B : cB;
        for (int t = 0; t < nt; t += 2) {
            const bool last = (t == nt - 2);
            const char* a1 = cA + (size_t)(t + 1) * kstepA;
            const char* a2 = last ? nA : cA + (size_t)(t + 2) * kstepA; const char* b2 = last ? nB : cB + (size_t)(t + 2) * kstep;
            const char* a3 = a2 + kstepA; const char* b3 = b2 + kstep;
            PG8_LDB(B0, 0, 0); PG8_LDB(B1, 0, 1); PG8_SCHED; PG8_LDA(At, 0, 0); PG8_STAGE_A1(PG8_SA(1, 1), a1);
            if constexpr (GATHER) { if (last && has_next) { PG8_TOKOFF(voffA, PG8_TB(ui + 1)); } }
            PG8_WAIT_V(8); PG8_WAIT_L(0); PG8_BAR; PG8_MMA(0, 0, At, B0); PG8_MMA(0, 1, At, B1); PG8_BAR; PG8_SCHED;
            PG8_LDA(At, 0, 1); PG8_STAGE(PG8_SB(0, 0), b2, voffB); PG8_STAGE(PG8_SB(0, 1), b2 + hstep, voffB); PG8_STAGE(PG8_SA(0, 0), a2, voffA[0]);
            PG8_WAIT_V(8); PG8_WAIT_L(0); PG8_BAR; PG8_MMA(1, 0, At, B0); PG8_MMA(1, 1, At, B1); PG8_BAR; PG8_SCHED;
            PG8_LDB(B0, 1, 0); PG8_LDB(B1, 1, 1); PG8_SCHED; PG8_LDA(At, 1, 0); PG8_STAGE_A1(PG8_SA(0, 1), a2);
            PG8_WAIT_V(8); PG8_WAIT_L(0); PG8_BAR; PG8_MMA(0, 0, At, B0); PG8_MMA(0, 1, At, B1); PG8_BAR; PG8_SCHED;
            PG8_LDA(At, 1, 1); PG8_STAGE(PG8_SB(1, 0), b3, voffB); PG8_STAGE(PG8_SB(1, 1), b3 + hstep, voffB); PG8_STAGE(PG8_SA(1, 0), a3, voffA[0]);
            PG8_WAIT_V(8); PG8_WAIT_L(0); PG8_BAR; PG8_MMA(1, 0, At, B0); PG8_MMA(1, 1, At, B1); PG8_BAR; PG8_SCHED;
        }
        if (wr == 0) PG8_BAR;
#ifndef EPIX
#define EPIX 1
#endif
        for (int e_ = 0; e_ < EPIX; ++e_) E(acc, cur, wr, wc, fr, fq, PG8_TB(ui), PG8_SCB(ui));
        if (!has_next) break;
#pragma unroll
        for (int a = 0; a < 2; ++a)
#pragma unroll
            for (int b = 0; b < 2; ++b)
#pragma unroll
                for (int m = 0; m < 4; ++m)
#pragma unroll
                    for (int n = 0; n < 2; ++n) acc[a][b][m][n] = (f32x4){0.f, 0.f, 0.f, 0.f};
        cur = nxt; cA = nA; cB = nB; ++ui;
        if (wr == 1) PG8_BAR;
    }
    PG8_WAIT_V(0);
    PG8_BAR;
#undef PG8_SA
#undef PG8_SB
#undef PG8_STAGE
#undef PG8_LDA
#undef PG8_STAGE_A1
#undef PG8_LDB
#undef PG8_MMA
#undef PG8_CAT8
#undef PG8_WAIT_V
#undef PG8_WAIT_L
#undef PG8_BAR
#undef PG8_SCHED
#undef PG8_TOKOFF
#undef PG8_TOKDMA
#undef PG8_TB
#undef PG8_SCB
#undef PG8_SCLDMA
}
}

struct Args { const float* in[17]; float* out; unsigned char* ws; int lo, hi, breg, pad; };
struct Frame {
    LAS unsigned char* lds; volatile LAS unsigned* MISC; unsigned* ctl; int tid, lane, wave, G, bid;
    const float *x, *g_mpre, *g_mpost, *g_fpre, *g_fpost, *w_in, *pool_w, *pool_scale, *rpb, *w_out, *dwg, *dwu, *dwd, *router, *mwg, *mwu, *mwd;
    float* out; unsigned char* ws;
};

__device__ __forceinline__ void p0_transpose_item(const float* W, int K, int N, bf16* WT, int kb, int n0, int row_base, LAS float* scr, int lane) {
    const int k0 = 64 * kb;
#pragma unroll 8
    for (int i = 0; i < 32; ++i) { const int kk = 2 * i + (lane >> 5); scr[kk * 33 + (lane & 31)] = W[(size_t)(k0 + kk) * N + n0 + (lane & 31)]; }
    LDS_WAIT(); asm volatile("" ::: "memory");
    const int c = lane & 7;
#pragma unroll
    for (int j = 0; j < 4; ++j) { const int n = (lane >> 3) + 8 * j; const LAS float* s = scr + (8 * c) * 33 + n;
        v4u o; o.x = pk2(s[0 * 33], s[1 * 33]); o.y = pk2(s[2 * 33], s[3 * 33]); o.z = pk2(s[4 * 33], s[5 * 33]); o.w = pk2(s[6 * 33], s[7 * 33]);
        *(v4u*)(WT + (size_t)(row_base + n) * K + k0 + 8 * c) = o; }
    LDS_WAIT(); asm volatile("" ::: "memory");
}
__device__ __forceinline__ void p0_matrix(const float* W, int K, int N, bf16* WT, int ilv_half, LAS float* scr, int lane, int gw, int NGW, int& base) {
    const int nblk = N / 32, nitems = (K / 64) * nblk;
    int it = gw - (base % NGW); if (it < 0) it += NGW;
    for (; it < nitems; it += NGW) { const int kb = it / nblk, n0 = 32 * (it % nblk);
        const int rb = ilv_half < 0 ? n0 : (n0 / 128) * 256 + (n0 % 128) + 128 * ilv_half;
        p0_transpose_item(W, K, N, WT, kb, n0, rb, scr, lane); }
    base += nitems;
}
__device__ __forceinline__ void p0_transpose_item_fp8(const float* W, int K, int N, unsigned char* WT, int kt, int n0, int row_base, float scale, LAS float* scr, int lane) {
    const int k0 = 128 * kt;
    { float v_[64]; const float* wp_ = W + (size_t)(k0 + (lane >> 5)) * N + n0 + (lane & 31);
#pragma unroll
      for (int i = 0; i < 64; ++i) v_[i] = wp_[(size_t)(2 * i) * N];
#pragma unroll
      for (int i = 0; i < 64; ++i) scr[(2 * i + (lane >> 5)) * 33 + (lane & 31)] = v_[i] * scale; }
    LDS_WAIT(); asm volatile("" ::: "memory");
    const int c = lane & 7;
#pragma unroll 1
    for (int pass = 0; pass < 4; ++pass) { const int n = (lane >> 3) + 8 * pass; const LAS float* sp = scr + (16 * c) * 33 + n;
        v4u o;
#pragma unroll
        for (int d = 0; d < 4; ++d) { int w = 0; w = __builtin_amdgcn_cvt_pk_fp8_f32(sp[(4 * d) * 33], sp[(4 * d + 1) * 33], w, false); w = __builtin_amdgcn_cvt_pk_fp8_f32(sp[(4 * d + 2) * 33], sp[(4 * d + 3) * 33], w, true); o[d] = (unsigned)w; }
        *(v4u*)(WT + (size_t)(row_base + n) * K + k0 + 16 * c) = o; }
    LDS_WAIT(); asm volatile("" ::: "memory");
}
__device__ __forceinline__ void p0_transpose_item_fp6(const float* W, int K, int N, unsigned char* WT, int kt, int n0, int row_base, float scale, LAS float* scr, int lane) {
    const int k0 = 128 * kt;
    { float v_[64]; const float* wp_ = W + (size_t)(k0 + (lane >> 5)) * N + n0 + (lane & 31);
#pragma unroll
      for (int i = 0; i < 64; ++i) v_[i] = wp_[(size_t)(2 * i) * N];
#pragma unroll
      for (int i = 0; i < 64; ++i) scr[(2 * i + (lane >> 5)) * 33 + (lane & 31)] = v_[i] * scale; }
    LDS_WAIT(); asm volatile("" ::: "memory");
    const int n = lane & 31, g = lane >> 5;
    unsigned char* rp = WT + (size_t)(row_base + n) * K + 128 * kt;
#pragma unroll 1
    for (int h = 0; h < 2; ++h) { const int fq = 2 * h + g; const LAS float* sp = scr + (32 * fq) * 33 + n;
        f32x16 x, y;
#pragma unroll
        for (int i = 0; i < 16; ++i) { x[i] = sp[i * 33]; y[i] = sp[(16 + i) * 33]; }
        const i32x6 o = __builtin_amdgcn_cvt_scalef32_2xpk16_fp6_f32(x, y, 1.0f);
        *(v4u*)(rp + 16 * fq) = (v4u){(unsigned)o[0], (unsigned)o[1], (unsigned)o[2], (unsigned)o[3]};
        *(v4u*)(rp + 64 + 16 * fq) = (v4u){(unsigned)o[4], (unsigned)o[5], 0u, 0u}; }
    LDS_WAIT(); asm volatile("" ::: "memory");
}
__device__ __forceinline__ void p0_matrix_fp6(const float* W, int K, int N, unsigned char* WT, int ilv_half, float scale, LAS float* scr, int lane, int gw, int NGW, int& base) {
    const int nblk = N / 32, nitems = (K / 128) * nblk;
    int it = gw - (base % NGW); if (it < 0) it += NGW;
    for (; it < nitems; it += NGW) { const int kt = it / nblk, n0 = 32 * (it % nblk);
        const int rb = (n0 / 128) * 256 + (n0 % 128) + 128 * ilv_half;
        p0_transpose_item_fp6(W, K, N, WT, kt, n0, rb, scale, scr, lane); }
    base += nitems;
}
__device__ __forceinline__ void p0_matrix_fp8(const float* W, int K, int N, unsigned char* WT, int ilv_half, float scale, LAS float* scr, int lane, int gw, int NGW, int& base) {
    const int nblk = N / 32, nitems = (K / 128) * nblk;
    int it = gw - (base % NGW); if (it < 0) it += NGW;
    for (; it < nitems; it += NGW) { const int kt = it / nblk, n0 = 32 * (it % nblk);
        const int rb = ilv_half < 0 ? n0 : (n0 / 128) * 256 + (n0 % 128) + 128 * ilv_half;
        p0_transpose_item_fp8(W, K, N, WT, kt, n0, rb, scale, scr, lane); }
    base += nitems;
}
__device__ __forceinline__ void rms_row_to_bf16(const float* xrow, const float* g, bf16* orow, int lane) {
    const f32x4* xr = (const f32x4*)xrow + lane; const f32x4* gr = (const f32x4*)g + lane;
    f32x4 v[4]; float s = 0.f;
#pragma unroll
    for (int j = 0; j < 4; ++j) { v[j] = xr[64 * j]; s += (v[j].x * v[j].x + v[j].y * v[j].y) + (v[j].z * v[j].z + v[j].w * v[j].w); }
    const float rstd = 1.0f / sqrtf(wave_sum(s) * (1.f / D) + RMS_EPS);
    v2u* o8 = (v2u*)orow + lane;
#pragma unroll
    for (int j = 0; j < 4; ++j) { const f32x4 gg = gr[64 * j]; v2u w; w.x = pk2(v[j].x * rstd * gg.x, v[j].y * rstd * gg.y); w.y = pk2(v[j].z * rstd * gg.z, v[j].w * rstd * gg.w); o8[64 * j] = w; }
}
__device__ __forceinline__ float wave_max(float v) {
#pragma unroll
    for (int o = 1; o < 64; o <<= 1) v = fmaxf(v, __shfl_xor(v, o));
    return v;
}
__device__ __forceinline__ void p0_colblock_i8(Frame& F, const float* W, int N, int n0, unsigned char* W8, float* sW, int dest0) {
    const int tid = F.tid, lane = F.lane, wid = F.wave, n = lane & 31, kh = lane >> 5;
    LAS float* slab = (LAS float*)F.lds; LAS float* cmax = (LAS float*)(F.lds + RING_BYTES);
    __syncthreads();
    float mx = 0.f;
#pragma unroll 1
    for (int i0 = 0; i0 < 64; i0 += 16) {
        float v[16];
#pragma unroll
        for (int i = 0; i < 16; ++i) v[i] = W[(size_t)(128 * wid + 2 * (i0 + i) + kh) * N + n0 + n];
#pragma unroll
        for (int i = 0; i < 16; ++i) { const int k = 128 * wid + 2 * (i0 + i) + kh; slab[k * 32 + (n ^ (k & 31))] = v[i]; mx = fmaxf(mx, fabsf(v[i])); }
    }
    cmax[wid * 64 + lane] = mx;
    __syncthreads();
    float amax = 0.f;
#pragma unroll
    for (int w = 0; w < 8; ++w) amax = fmaxf(amax, fmaxf(cmax[w * 64 + n], cmax[w * 64 + 32 + n]));
    const float sc = amax > 0.f ? amax * (1.0f / 127.0f) : 1.0f, inv = amax > 0.f ? 127.0f / amax : 0.f;
    const int kc = tid >> 5, dest = dest0 + n;
#pragma unroll 1
    for (int q4 = 0; q4 < 4; ++q4) { v4u o;
#pragma unroll
        for (int d = 0; d < 4; ++d) { unsigned w = 0u;
#pragma unroll
            for (int j = 0; j < 4; ++j) { const int k = 64 * kc + 16 * q4 + 4 * d + j; w |= ((unsigned)__float2int_rn(slab[k * 32 + (n ^ (k & 31))] * inv) & 0xffu) << (8 * j); }
            o[d] = w; }
        *(v4u*)(W8 + (size_t)dest * D + 64 * kc + 16 * q4) = o; }
    if (kc == 0) sW[dest] = sc;
}
__device__ __forceinline__ void p0_i8_weights(Frame& F) {
    constexpr int NB_D = I8_DENSE ? 2 * (DFF / 32) : 0, NB_P = I8_PROJ ? DEPTH * (DIN / 32) : 0;
    for (int cb = F.bid; cb < NB_D + NB_P; cb += F.G) {
        if (cb < NB_D) { const int half = cb / (DFF / 32), n0 = 32 * (cb % (DFF / 32));
            p0_colblock_i8(F, half ? F.dwu : F.dwg, DFF, n0, F.ws + WS_WGU0, (float*)(F.ws + WS_SW0), (n0 / 128) * 256 + (n0 % 128) + 128 * half); }
        else { const int c2 = cb - NB_D, l = c2 / (DIN / 32), n0 = 32 * (c2 % (DIN / 32));
            p0_colblock_i8(F, F.w_in + (size_t)l * D * DIN, DIN, n0, F.ws + WS_WIN + (size_t)l * DIN * D, (float*)(F.ws + WS_SWIN) + l * DIN, n0); }
    }
    __syncthreads();
}
__device__ __forceinline__ void rms_row_to_i8(const float* xrow, const float* g, unsigned char* orow, float* sa, int lane) {
    const f32x4* xr = (const f32x4*)xrow + lane; const f32x4* gr = (const f32x4*)g + lane;
    f32x4 v[4]; float s = 0.f;
#pragma unroll
    for (int j = 0; j < 4; ++j) { v[j] = xr[64 * j]; s += (v[j].x * v[j].x + v[j].y * v[j].y) + (v[j].z * v[j].z + v[j].w * v[j].w); }
    const float rstd = 1.0f / sqrtf(wave_sum(s) * (1.f / D) + RMS_EPS); float am = 0.f;
#pragma unroll
    for (int j = 0; j < 4; ++j) { v[j] = v[j] * rstd * gr[64 * j]; am = fmaxf(fmaxf(am, fmaxf(fabsf(v[j].x), fabsf(v[j].y))), fmaxf(fabsf(v[j].z), fabsf(v[j].w))); }
    am = wave_max(am); const float inv = am > 0.f ? 127.0f / am : 0.f;
#pragma unroll
    for (int j = 0; j < 4; ++j) ((unsigned*)orow + lane)[64 * j] = ((unsigned)__float2int_rn(v[j].x * inv) & 0xffu) | (((unsigned)__float2int_rn(v[j].y * inv) & 0xffu) << 8) | (((unsigned)__float2int_rn(v[j].z * inv) & 0xffu) << 16) | (((unsigned)__float2int_rn(v[j].w * inv) & 0xffu) << 24);
    if (lane == 0) *sa = am > 0.f ? am * (1.0f / 127.0f) : 1.0f;
}
__device__ __forceinline__ void p0_prologue(Frame& F0) {
    Frame F = F0; { int t_ = threadIdx.x; asm volatile("" : "+v"(t_)); F.tid = t_; F.lane = t_ & 63; F.wave = __builtin_amdgcn_readfirstlane(t_ >> 6); }
    LAS float* scr = (LAS float*)(F.lds + F.wave * 16896);
    const int gw = F.bid * 8 + F.wave, NGW = F.G * 8, gt = F.bid * 512 + F.tid, NGT = F.G * 512;
    { v4u z = (v4u){0u, 0u, 0u, 0u}; v4u* L = (v4u*)(F.ws + WS_LIST); for (int i = gt; i < (int)(NE * T / 4); i += NGT) L[i] = z;
      int* id = (int*)(F.ws + WS_LISTID); for (int i = gt; i < T; i += NGT) id[i] = i; }
    int base = 0;
    for (int l = 0; l < DEPTH; ++l) {
#if !I8_PROJ
        p0_matrix(F.w_in + (size_t)l * D * DIN, D, DIN, (bf16*)(F.ws + WS_WIN) + (size_t)l * DIN * D, -1, scr, F.lane, gw, NGW, base);
#endif
        p0_matrix(F.w_out + (size_t)l * D * D, D, D, (bf16*)(F.ws + WS_WOUT) + (size_t)l * D * D, -1, scr, F.lane, gw, NGW, base);
        for (int g = 0; g < 4; ++g) p0_matrix(F.pool_w + (size_t)(l * 4 + g) * 128 * 128, 128, 128, (bf16*)(F.ws + WS_WP) + (size_t)(l * 4 + g) * 128 * 128, -1, scr, F.lane, gw, NGW, base);
    }
#if !I8_DENSE
    p0_matrix(F.dwg, D, DFF, (bf16*)(F.ws + WS_WGU0), 0, scr, F.lane, gw, NGW, base);
    p0_matrix(F.dwu, D, DFF, (bf16*)(F.ws + WS_WGU0), 1, scr, F.lane, gw, NGW, base);
#endif
#if FP8_DDOWN
    p0_matrix_fp8(F.dwd, DFF, D, F.ws + WS_WD0, -1, W8_DN, scr, F.lane, gw, NGW, base);
#else
    p0_matrix(F.dwd, DFF, D, (bf16*)(F.ws + WS_WD0), -1, scr, F.lane, gw, NGW, base);
#endif
    for (int e = 0; e < NE; ++e) {
#if FP8_MOE
#if FP6_UP
        p0_matrix_fp6(F.mwg + (size_t)e * D * DFFE, D, DFFE, F.ws + WS_WGUM + (size_t)e * 2 * DFFE * D, 0, S6W, scr, F.lane, gw, NGW, base);
        p0_matrix_fp6(F.mwu + (size_t)e * D * DFFE, D, DFFE, F.ws + WS_WGUM + (size_t)e * 2 * DFFE * D, 1, S6W, scr, F.lane, gw, NGW, base);
#else
        p0_matrix_fp8(F.mwg + (size_t)e * D * DFFE, D, DFFE, F.ws + WS_WGUM + (size_t)e * 2 * DFFE * D, 0, W8_UP, scr, F.lane, gw, NGW, base);
        p0_matrix_fp8(F.mwu + (size_t)e * D * DFFE, D, DFFE, F.ws + WS_WGUM + (size_t)e * 2 * DFFE * D, 1, W8_UP, scr, F.lane, gw, NGW, base);
#endif
        p0_matrix_fp8(F.mwd + (size_t)e * DFFE * D, DFFE, D, F.ws + WS_WDM + (size_t)e * D * DFFE, -1, W8_DN, scr, F.lane, gw, NGW, base);
#else
        p0_matrix(F.mwg + (size_t)e * D * DFFE, D, DFFE, (bf16*)(F.ws + WS_WGUM) + (size_t)e * 2 * DFFE * D, 0, scr, F.lane, gw, NGW, base);
        p0_matrix(F.mwu + (size_t)e * D * DFFE, D, DFFE, (bf16*)(F.ws + WS_WGUM) + (size_t)e * 2 * DFFE * D, 1, scr, F.lane, gw, NGW, base);
        p0_matrix(F.mwd + (size_t)e * DFFE * D, DFFE, D, (bf16*)(F.ws + WS_WDM) + (size_t)e * D * DFFE, -1, scr, F.lane, gw, NGW, base);
#endif
    }
    bf16* HN = (bf16*)(F.ws + WS_HN);
#if I8_PROJ
    for (int m = gw; m < T; m += NGW) rms_row_to_i8(F.x + (size_t)m * D, F.g_mpre, (unsigned char*)HN + (size_t)m * D, (float*)(F.ws + WS_SA) + m, F.lane);
#else
    for (int m = gw; m < T; m += NGW) rms_row_to_bf16(F.x + (size_t)m * D, F.g_mpre, HN + (size_t)m * D, F.lane);
#endif
#if I8_DENSE || I8_PROJ
    p0_i8_weights(F);
#endif
}

__device__ __forceinline__ unsigned ld_cnt(const unsigned* ctl, int e) { return __hip_atomic_load(ctl + CW_CNT + 64 * e, RLX_AGENT); }

__device__ __forceinline__ void ld_bf16_row(const bf16* row, int lane, f32x4 (&v)[4]) {
    const v2u* p = (const v2u*)row + lane;
#pragma unroll
    for (int j = 0; j < 4; ++j) { const v2u w = p[64 * j]; v[j] = (f32x4){bflo(w.x), bfhi(w.x), bflo(w.y), bfhi(w.y)}; }
}
__device__ __forceinline__ float sumsq16(const f32x4 (&v)[4]) {
    float s = 0.f;
#pragma unroll
    for (int j = 0; j < 4; ++j) s += (v[j].x * v[j].x + v[j].y * v[j].y) + (v[j].z * v[j].z + v[j].w * v[j].w);
    return s;
}
#define H16 FP8_MOE
struct NormRow { v2u a[4]; v2u b[4]; f32x4 hf[4]; v2u hb[4]; float g0, g1; };
template <bool FFN>
__device__ __forceinline__ void norm_phase(Frame& F0, int l) {
    Frame F = F0; { int t_ = threadIdx.x; asm volatile("" : "+v"(t_)); F.tid = t_; F.lane = t_ & 63; F.wave = __builtin_amdgcn_readfirstlane(t_ >> 6); }
    const int lane = F.lane, gw = F.bid * 8 + F.wave, NGW = F.G * 8;
    const bool moe = (l & 1) != 0;
    LAS float* WR = (LAS float*)F.lds;
    LAS unsigned* lcnt = (LAS unsigned*)(F.lds + LCNT_OFF); LAS unsigned* lbase = lcnt + 8;
    LAS int* bst = (LAS int*)(F.lds + BST_OFF);
    LAS float* rowbuf = (LAS float*)(F.lds + 32768 + F.wave * 4352);
    if (!FFN && moe) {
        for (int i = F.tid; i < D * NE; i += 512) { const int d = i >> 3, e = i & 7; WR[e * D + d] = F.router[i]; }
        if (F.tid < 8) lcnt[F.tid] = 0u;
        __syncthreads();
    }
    if (FFN && moe) {
        if (F.tid == 0) { int s = 0; for (int e = 0; e < NE; ++e) { bst[e] = s; s += (int)((ld_cnt(F.ctl, e) + 255u) >> 8); } }
        __syncthreads();
    }
    const float* gA = FFN ? F.g_fpost + l * D : F.g_mpost + l * D;
    const float* gB = FFN ? F.g_mpre + (l + 1) * D : F.g_fpre + l * D;
    const bool haveB = FFN ? (l + 1 < DEPTH) : true;
    const bool last = FFN && (l + 1 == DEPTH);
    const bool I8HN = FFN ? (I8_PROJ != 0) : (I8_DENSE && !moe);
    const bool hold_f32 = (!FFN && l == 0) || !H16;
    const bf16* addsrc = FFN ? (const bf16*)(F.ws + WS_Y) : (const bf16*)(F.ws + WS_MIX);
    const float* hold32 = (!FFN && l == 0) ? F.x : F.out;
    bf16* H = (bf16*)(F.ws + WS_H16);
    bf16* HN = (bf16*)(F.ws + WS_HN);
    const v2u* info = (const v2u*)(F.ws + WS_INFO); const f32x2* ginfo = (const f32x2*)(F.ws + WS_INFO + 256 * 1024);
#define NORM_LOAD(R, m_, nf_, gg_) do { \
        if (FFN && moe) { const int e0_ = (int)((nf_).x >> 16), p0_ = (int)((nf_).x & 0xffffu), e1_ = (int)((nf_).y >> 16), p1_ = (int)((nf_).y & 0xffffu); \
            const v2u* pa_ = (const v2u*)(addsrc + (size_t)(256 * bst[e0_] + p0_) * D) + lane; const v2u* pb_ = (const v2u*)(addsrc + (size_t)(256 * bst[e1_] + p1_) * D) + lane; \
            _Pragma("unroll") for (int j = 0; j < 4; ++j) { (R).a[j] = pa_[64 * j]; (R).b[j] = pb_[64 * j]; } (R).g0 = (gg_).x; (R).g1 = (gg_).y; } \
        else { const v2u* pa_ = (const v2u*)(addsrc + (size_t)(m_) * D) + lane; _Pragma("unroll") for (int j = 0; j < 4; ++j) (R).a[j] = pa_[64 * j]; } \
        if (hold_f32) { const f32x4* hp_ = (const f32x4*)(hold32 + (size_t)(m_) * D) + lane; _Pragma("unroll") for (int j = 0; j < 4; ++j) (R).hf[j] = hp_[64 * j]; } \
        else { const v2u* hp_ = (const v2u*)(H + (size_t)(m_) * D) + lane; _Pragma("unroll") for (int j = 0; j < 4; ++j) (R).hb[j] = hp_[64 * j]; } } while (0)
    int sTok = 0, sE0 = 0, sE1 = 0; float sG0 = 0.f, sG1 = 0.f;
    v2u nfL = (v2u){0u, 0u}; f32x2 ggL = (f32x2){0.f, 0.f};
    if (FFN && moe) { const int mi = gw + lane * NGW; if (mi < T) { nfL = info[mi]; ggL = ginfo[mi]; } }
    const int nfLx = (int)nfL.x, nfLy = (int)nfL.y; const float ggLx_ = ggL.x, ggLy_ = ggL.y; const int ggLx = __float_as_int(ggLx_), ggLy = __float_as_int(ggLy_);
#define NORM_INFO(nf_, gg_, it_) do { if (FFN && moe) { const int x_ = __builtin_amdgcn_readlane(nfLx, it_), y_ = __builtin_amdgcn_readlane(nfLy, it_), gx_ = __builtin_amdgcn_readlane(ggLx, it_), gy_ = __builtin_amdgcn_readlane(ggLy, it_); \
        (nf_).x = (unsigned)x_; (nf_).y = (unsigned)y_; (gg_).x = __int_as_float(gx_); (gg_).y = __int_as_float(gy_); } } while (0)
#define NORM_ROW(R, m_, it_) do { \
        f32x4 a[4]; \
        _Pragma("unroll") for (int j = 0; j < 4; ++j) { a[j] = (f32x4){bflo((R).a[j].x), bfhi((R).a[j].x), bflo((R).a[j].y), bfhi((R).a[j].y)}; \
            if (FFN && moe) { const f32x4 b = (f32x4){bflo((R).b[j].x), bfhi((R).b[j].x), bflo((R).b[j].y), bfhi((R).b[j].y)}; a[j] = a[j] * (R).g0 + b * (R).g1; } } \
        const float r1 = 1.0f / sqrtf(wave_sum(sumsq16(a)) * (1.f / D) + RMS_EPS); \
        const f32x4* gAp = (const f32x4*)gA + lane; \
        f32x4 h[4]; \
        _Pragma("unroll") for (int j = 0; j < 4; ++j) { const f32x4 ho = hold_f32 ? (R).hf[j] : (f32x4){bflo((R).hb[j].x), bfhi((R).hb[j].x), bflo((R).hb[j].y), bfhi((R).hb[j].y)}; h[j] = ho + a[j] * r1 * gAp[64 * j]; } \
        if (last || !H16) { f32x4* op = (f32x4*)(F.out + (size_t)(m_) * D) + lane; _Pragma("unroll") for (int j = 0; j < 4; ++j) op[64 * j] = h[j]; } \
        else { v2u* op = (v2u*)(H + (size_t)(m_) * D) + lane; _Pragma("unroll") for (int j = 0; j < 4; ++j) { v2u w; w.x = cvt_pk_bf16(h[j].x, h[j].y); w.y = cvt_pk_bf16(h[j].z, h[j].w); op[64 * j] = w; } } \
        if (haveB) { \
            const float r2 = 1.0f / sqrtf(wave_sum(sumsq16(h)) * (1.f / D) + RMS_EPS); \
            const f32x4* gBp = (const f32x4*)gB + lane; v2u* o8 = (v2u*)(HN + (size_t)(m_) * D) + lane; \
            _Pragma("unroll") for (int j = 0; j < 4; ++j) { h[j] = h[j] * r2 * gBp[64 * j]; \
                if (FP8_MOE && FP6_UP && !FFN && moe) { const int e_ = 256 * j + 4 * lane, ix_ = e_ + (e_ >> 5); rowbuf[ix_] = h[j].x * S6A; rowbuf[ix_ + 1] = h[j].y * S6A; rowbuf[ix_ + 2] = h[j].z * S6A; rowbuf[ix_ + 3] = h[j].w * S6A; } \
                else if (FP8_MOE && !FFN && moe) { int w = 0; w = __builtin_amdgcn_cvt_pk_fp8_f32(h[j].x, h[j].y, w, false); w = __builtin_amdgcn_cvt_pk_fp8_f32(h[j].z, h[j].w, w, true); ((unsigned*)((unsigned char*)HN + (size_t)(m_) * D) + lane)[64 * j] = (unsigned)w; } \
                else if (!I8HN) { v2u w; w.x = cvt_pk_bf16(h[j].x, h[j].y); w.y = cvt_pk_bf16(h[j].z, h[j].w); o8[64 * j] = w; } } \
            if (FP8_MOE && FP6_UP && !FFN && moe) { asm volatile("s_waitcnt lgkmcnt(0)" ::: "memory"); \
                if (lane < 32) { f32x16 x_, y_; _Pragma("unroll") for (int i = 0; i < 16; ++i) { x_[i] = rowbuf[33 * lane + i]; y_[i] = rowbuf[33 * lane + 16 + i]; } \
                    const i32x6 o_ = __builtin_amdgcn_cvt_scalef32_2xpk16_fp6_f32(x_, y_, 1.0f); unsigned char* rp_ = (unsigned char*)HN + (size_t)(m_) * D + 128 * (lane >> 2); \
                    *(v4u*)(rp_ + 16 * (lane & 3)) = (v4u){(unsigned)o_[0], (unsigned)o_[1], (unsigned)o_[2], (unsigned)o_[3]}; *(v4u*)(rp_ + 64 + 16 * (lane & 3)) = (v4u){(unsigned)o_[4], (unsigned)o_[5], 0u, 0u}; } \
                asm volatile("s_waitcnt lgkmcnt(0)" ::: "memory"); } \
            if (I8HN) { float am = 0.f; \
                _Pragma("unroll") for (int j = 0; j < 4; ++j) am = fmaxf(fmaxf(am, fmaxf(fabsf(h[j].x), fabsf(h[j].y))), fmaxf(fabsf(h[j].z), fabsf(h[j].w))); \
                am = wave_max(am); const float sa_ = am > 0.f ? am * (1.0f / 127.0f) : 1.0f, inv_ = am > 0.f ? 127.0f / am : 0.f; \
                _Pragma("unroll") for (int j = 0; j < 4; ++j) { const unsigned w = ((unsigned)__float2int_rn(h[j].x * inv_) & 0xffu) | (((unsigned)__float2int_rn(h[j].y * inv_) & 0xffu) << 8) | (((unsigned)__float2int_rn(h[j].z * inv_) & 0xffu) << 16) | (((unsigned)__float2int_rn(h[j].w * inv_) & 0xffu) << 24); \
                    ((unsigned*)((unsigned char*)HN + (size_t)(m_) * D) + lane)[64 * j] = w; } \
                if (lane == 0) ((float*)(F.ws + WS_SA))[(m_)] = sa_; } \
            if (!FFN && moe) { \
                float lg[NE]; \
                _Pragma("unroll") for (int e = 0; e < NE; ++e) { float s_ = 0.f; \
                    _Pragma("unroll") for (int j = 0; j < 4; ++j) { const f32x4 w = *(const LAS f32x4*)(WR + e * D + 256 * j + 4 * lane); s_ += (h[j].x * w.x + h[j].y * w.y) + (h[j].z * w.z + h[j].w * w.w); } \
                    lg[e] = wave_sum(s_); } \
                int e0 = 0; float l0 = lg[0]; \
                _Pragma("unroll") for (int e = 1; e < NE; ++e) if (lg[e] > l0) { l0 = lg[e]; e0 = e; } \
                int e1 = -1; float l1 = -INFINITY; \
                _Pragma("unroll") for (int e = 0; e < NE; ++e) if (e != e0 && lg[e] > l1) { l1 = lg[e]; e1 = e; } \
                const float g0 = 1.0f / (1.0f + __expf(l1 - l0)), g1 = 1.0f - g0; \
                if (lane == (it_)) { sTok = (m_); sE0 = e0; sE1 = e1; sG0 = g0; sG1 = g1; } \
            } \
        } } while (0)
    int it = 0;
    NormRow c0, c1; v2u nf = (v2u){0u, 0u}; f32x2 gg = (f32x2){0.f, 0.f};
    if (gw < T) { NORM_INFO(nf, gg, 0); NORM_LOAD(c0, gw, nf, gg); }
    if (gw + NGW < T) { NORM_INFO(nf, gg, 1); NORM_LOAD(c1, gw + NGW, nf, gg); }
    for (int m = gw; m < T; m += 2 * NGW, it += 2) {
        const int m1 = m + NGW, m2 = m + 2 * NGW, m3 = m + 3 * NGW;
        NormRow n0, n1;
        if (m2 < T) { NORM_INFO(nf, gg, it + 2); NORM_LOAD(n0, m2, nf, gg); }
        if (m3 < T) { NORM_INFO(nf, gg, it + 3); NORM_LOAD(n1, m3, nf, gg); }
        NORM_ROW(c0, m, it);
        if (m1 < T) NORM_ROW(c1, m1, it + 1);
        c0 = n0; c1 = n1;
    }
    it = (T - gw + NGW - 1) / NGW; if (it < 0) it = 0;
#undef NORM_ROW
#undef NORM_INFO
#undef NORM_LOAD
    if (!FFN && moe) {
        unsigned loc0 = 0u, loc1 = 0u;
        if (lane < it) { loc0 = __hip_atomic_fetch_add(lcnt + sE0, 1u, __ATOMIC_RELAXED, __HIP_MEMORY_SCOPE_WORKGROUP); loc1 = __hip_atomic_fetch_add(lcnt + sE1, 1u, __ATOMIC_RELAXED, __HIP_MEMORY_SCOPE_WORKGROUP); }
        __syncthreads();
        if (F.tid < 8) lbase[F.tid] = __hip_atomic_fetch_add(F.ctl + CW_CNT + 64 * F.tid, lcnt[F.tid], RLX_AGENT);
        __syncthreads();
        if (lane < it) {
            const unsigned p0 = lbase[sE0] + loc0, p1 = lbase[sE1] + loc1;
            int* list = (int*)(F.ws + WS_LIST);
            list[(size_t)sE0 * T + p0] = sTok; list[(size_t)sE1 * T + p1] = sTok;
            v2u nf; nf.x = ((unsigned)sE0 << 16) | p0; nf.y = ((unsigned)sE1 << 16) | p1;
            ((v2u*)(F.ws + WS_INFO))[sTok] = nf; ((f32x2*)(F.ws + WS_INFO + 256 * 1024))[sTok] = (f32x2){sG0, sG1};
        }
    }
}

__device__ __forceinline__ size_t mixo_index(size_t tok, int ch) { return ((tok >> 8) * 16 + (size_t)(ch >> 6)) * (256 * 64) + (tok & 255) * 64 + (ch & 63); }
constexpr int U_PITCH = 1040, U_ROWS = 80, BIAS_OFF = U_PITCH * U_ROWS;
typedef __bf16 bf16x2_t __attribute__((ext_vector_type(2)));
template <int HW>
__device__ __forceinline__ void pool_frags(bf16x8 (&dfr)[2][4], const LAS unsigned char* cb, const float (&inv)[2]) {
    unsigned one_lo_ = 0x00003f80u, one_hi_ = 0x3f800000u; asm volatile("" : "+v"(one_lo_), "+v"(one_hi_));
    const bf16x2_t ONE_LO = __builtin_bit_cast(bf16x2_t, one_lo_), ONE_HI = __builtin_bit_cast(bf16x2_t, one_hi_);
#pragma unroll
    for (int mt = 0; mt < 2; ++mt)
#pragma unroll
        for (int ks = 0; ks < 4; ++ks) {
            const LAS unsigned char* cp = cb + mt * 16 * U_PITCH + ks * 64;
            float s0 = 0.f, s1 = 0.f, s2 = 0.f, s3 = 0.f, s4 = 0.f, s5 = 0.f, s6 = 0.f, s7 = 0.f;
#pragma unroll
            for (int d = -HW; d < HW; ++d) { const v4u v = *(const LAS v4u*)(cp + d * U_PITCH); const unsigned vx = v.x, vy = v.y, vz = v.z, vw = v.w;
                const bf16x2_t px = __builtin_bit_cast(bf16x2_t, vx), py = __builtin_bit_cast(bf16x2_t, vy), pz = __builtin_bit_cast(bf16x2_t, vz), pw = __builtin_bit_cast(bf16x2_t, vw);
                s0 = __builtin_amdgcn_fdot2_f32_bf16(px, ONE_LO, s0, false); s1 = __builtin_amdgcn_fdot2_f32_bf16(px, ONE_HI, s1, false);
                s2 = __builtin_amdgcn_fdot2_f32_bf16(py, ONE_LO, s2, false); s3 = __builtin_amdgcn_fdot2_f32_bf16(py, ONE_HI, s3, false);
                s4 = __builtin_amdgcn_fdot2_f32_bf16(pz, ONE_LO, s4, false); s5 = __builtin_amdgcn_fdot2_f32_bf16(pz, ONE_HI, s5, false);
                s6 = __builtin_amdgcn_fdot2_f32_bf16(pw, ONE_LO, s6, false); s7 = __builtin_amdgcn_fdot2_f32_bf16(pw, ONE_HI, s7, false); }
            const v4u c = *(const LAS v4u*)cp; const float iv = inv[mt];
            v4u p; p.x = cvt_pk_bf16(s0 * iv - bflo(c.x), s1 * iv - bfhi(c.x)); p.y = cvt_pk_bf16(s2 * iv - bflo(c.y), s3 * iv - bfhi(c.y));
            p.z = cvt_pk_bf16(s4 * iv - bflo(c.z), s5 * iv - bfhi(c.z)); p.w = cvt_pk_bf16(s6 * iv - bflo(c.w), s7 * iv - bfhi(c.w));
            dfr[mt][ks] = __builtin_bit_cast(bf16x8, p);
        }
}
__device__ __forceinline__ void mixer_phase(Frame& F0, int l) {
    Frame F = F0; { int t_ = threadIdx.x; asm volatile("" : "+v"(t_)); F.tid = t_; F.lane = t_ & 63; F.wave = __builtin_amdgcn_readfirstlane(t_ >> 6); }
    const int tid = F.tid, lane = F.lane, wid = F.wave, fr = lane & 15, fq = lane >> 4;
    const bf16* proj = (const bf16*)(F.ws + WS_PROJ); bf16* mixo = (bf16*)(F.ws + WS_MIXO);
    const bf16* Wp = (const bf16*)(F.ws + WS_WP) + (size_t)l * 4 * 128 * 128; const float* pscale = F.pool_scale + l * DPOOL;
    const int vcu = (F.G % 8 == 0) ? (F.bid % 8) * (F.G / 8) + F.bid / 8 : F.bid;
    for (int unit = vcu; unit < BATCH * GROWS; unit += F.G) {
        const int b = unit / GROWS, r = unit % GROWS, tb0 = b * SEQ, trow0 = 64 * r - 8;
        __syncthreads();
        { v4u uv[10];
#pragma unroll
          for (int k = 0; k < 10; ++k) { const int idx = tid + 512 * k, row = idx >> 6, pc = idx & 63, t = trow0 + row; uv[k] = (v4u){0u, 0u, 0u, 0u}; if (t >= 0 && t < SEQ) uv[k] = *(const v4u*)(proj + (size_t)(tb0 + t) * UPITCH + pc * 8); }
#pragma unroll
          for (int k = 0; k < 10; ++k) { const int idx = tid + 512 * k, row = idx >> 6, pc = idx & 63; *(LAS v4u*)(F.lds + row * U_PITCH + pc * 16) = uv[k]; } }
        __syncthreads();
#ifndef REP_POOL
#define REP_POOL 1
#endif
        for (int rep_ = 0; rep_ < REP_POOL; ++rep_) {
            const int g = wid >> 1, half = wid & 1, hw = 1 << g;
            const bf16* Wg = Wp + (size_t)g * 128 * 128;
            bf16x8 wnext[4];
#pragma unroll
            for (int ks = 0; ks < 4; ++ks) wnext[ks] = *(const bf16x8*)(Wg + (size_t)fr * 128 + 32 * ks + 8 * fq);
            bf16x8 dfr[2][4];
            { const LAS unsigned char* cb = F.lds + (8 + 32 * half + fr) * U_PITCH + (128 * g + 8 * fq) * 2;
              float inv[2];
#pragma unroll
              for (int mt = 0; mt < 2; ++mt) { const int t = 64 * r + 32 * half + 16 * mt + fr; inv[mt] = 1.0f / (float)(min(t + hw, SEQ) - max(t - hw, 0)); }
              switch (g) { case 0: pool_frags<1>(dfr, cb, inv); break; case 1: pool_frags<2>(dfr, cb, inv); break; case 2: pool_frags<4>(dfr, cb, inv); break; default: pool_frags<8>(dfr, cb, inv); break; } }
#pragma unroll
            for (int nt = 0; nt < 8; ++nt) {
                bf16x8 wf[4];
#pragma unroll
                for (int ks = 0; ks < 4; ++ks) wf[ks] = wnext[ks];
                if (nt + 1 < 8) {
#pragma unroll
                    for (int ks = 0; ks < 4; ++ks) wnext[ks] = *(const bf16x8*)(Wg + (size_t)(16 * (nt + 1) + fr) * 128 + 32 * ks + 8 * fq); }
                const f32x4 sc = *(const f32x4*)(pscale + 128 * g + 16 * nt + 4 * fq);
#pragma unroll
                for (int mt = 0; mt < 2; ++mt) {
                    f32x4 acc = (f32x4){0.f, 0.f, 0.f, 0.f};
#pragma unroll
                    for (int ks = 0; ks < 4; ++ks) acc = __builtin_amdgcn_mfma_f32_16x16x32_bf16(wf[ks], dfr[mt][ks], acc, 0, 0, 0);
                    acc = acc * sc;
                    v2u w; w.x = cvt_pk_bf16(acc[0], acc[1]); w.y = cvt_pk_bf16(acc[2], acc[3]);
                    *(v2u*)(mixo + mixo_index((size_t)(tb0 + 64 * r + 32 * half + 16 * mt + fr), 128 * g + 16 * nt + 4 * fq)) = w;
                }
            }
        }
    }
    __syncthreads();
}

constexpr int NA_KTOK = 80, NA_KROW = 64 * NA_KTOK, NA_VD = 144, NA_VROW = 32 * NA_VD, NA_NKR = 11, NA_NPC = NA_NKR * 256;
constexpr int NA_K_OFF = 0, NA_V_OFF = NA_NKR * NA_KROW, NA_B_OFF = NA_V_OFF + NA_NKR * NA_VROW;
static_assert(NA_B_OFF + 15 * 128 <= RING_BYTES, "NA LDS map");
#ifndef REP_NA
#define REP_NA 1
#endif
__device__ __forceinline__ void na_phase(Frame& F0, int l) {
    Frame F = F0; { int t_ = threadIdx.x; asm volatile("" : "+v"(t_)); F.tid = t_; F.lane = t_ & 63; F.wave = __builtin_amdgcn_readfirstlane(t_ >> 6); }
    const int tid = F.tid, lane = F.lane, wid = F.wave, fr = lane & 15, fq = lane >> 4;
    const bf16* projq = (const bf16*)(F.ws + WS_PQ); const bf16* projk = (const bf16*)(F.ws + WS_PK); const bf16* Vt = (const bf16*)(F.ws + WS_VT); bf16* mixo = (bf16*)(F.ws + WS_MIXO);
    const float* rpb = F.rpb + (size_t)l * NH * 15 * 31;
    const int vcu = (F.G % 8 == 0) ? (F.bid % 8) * (F.G / 8) + F.bid / 8 : F.bid;
    constexpr int NU = BATCH * NH * (GROWS / 4);
    const int upc = (NU + F.G - 1) / F.G, u0 = vcu * upc, u1 = min(u0 + upc, NU);
    v4u kreg[6], vreg[6];
    int w_hi = -1, w_bh = -1;
#define NA_UNIT(u, b, h, sg, krlo, nrows) const int b = (u) / (NH * 64), h = ((u) / 64) % NH, sg = (u) % 64, krlo = min(max(4 * sg - 4, 0), GROWS - KH), nrows = min(NA_NKR, GROWS - krlo)
#define NA_PLAN(u, newlo, nnew) NA_UNIT(u, pb_, ph_, psg_, pkrlo_, pnrows_); const bool keep_ = ((u) / 64 == w_bh) && pkrlo_ <= w_hi && pkrlo_ + NA_NKR > w_hi - 1; \
        const int newlo = keep_ ? max(pkrlo_, w_hi) : pkrlo_, nnew = pkrlo_ + pnrows_ - newlo; (void)psg_
#define NA_LOAD(newlo, nnew, b_, h_) do { const size_t tb_ = (size_t)(b_) * SEQ + 64 * (newlo); \
        _Pragma("unroll") for (int k = 0; k < 6; ++k) { const int p = tid + 512 * k, row = p >> 8, rem = p & 255; \
            if (row < (nnew)) { kreg[k] = *(const v4u*)(projk + ((size_t)(h_) * T + tb_ + 64 * row + (rem >> 2)) * 32 + 8 * (rem & 3)); \
                vreg[k] = *(const v4u*)(Vt + vt_index(32 * (h_) + (rem >> 3), (int)tb_ + 64 * row) + 8 * (rem & 7)); } } } while (0)
    int c_newlo = 0, c_nnew = 0;
    if (u0 < u1) { NA_PLAN(u0, nl_, nn_); c_newlo = nl_; c_nnew = nn_; NA_LOAD(nl_, nn_, pb_, ph_); }
    for (int u = u0; u < u1; ++u) {
        NA_UNIT(u, b, h, sg, krlo, nrows);
        __syncthreads();
#pragma unroll
        for (int k = 0; k < 6; ++k) { const int p = tid + 512 * k, row = p >> 8, rem = p & 255;
            if (row < c_nnew) { const int slot = (c_newlo + row) % NA_NKR;
                *(LAS v4u*)(F.lds + NA_K_OFF + slot * NA_KROW + (rem >> 2) * NA_KTOK + 16 * (rem & 3)) = kreg[k];
                *(LAS v4u*)(F.lds + NA_V_OFF + slot * NA_VROW + (rem >> 3) * NA_VD + 16 * (rem & 7)) = vreg[k]; } }
        if (tid < 15 * 32) { const int col = tid & 31, row = tid >> 5; *(LAS float*)(F.lds + NA_B_OFF + tid * 4) = col < 31 ? rpb[(h * 15 + row) * 31 + col] * LOG2E : -INFINITY; }
        __syncthreads();
        w_hi = krlo + nrows; w_bh = u / 64;
        if (u + 1 < u1) { NA_PLAN(u + 1, nl_, nn_); c_newlo = nl_; c_nnew = nn_; NA_LOAD(nl_, nn_, pb_, ph_); }
        const size_t tb0 = (size_t)b * SEQ;
#pragma unroll 1
        for (int tt = 0; tt < 2; ++tt) {
            const int t = wid + 8 * tt, j = t >> 2, qb = t & 3, r = 4 * sg + j, r0 = min(max(r - KH / 2, 0), GROWS - KH);
            const int cs = qb == 0 ? 0 : (qb == 1 ? 8 : (qb == 2 ? 24 : 32));
            const int c = 16 * qb + fr, c0 = min(max(c - KW / 2, 0), GRIDW - KW);
            const int th = c0 - cs;
            bool vq[4]; int boff[4];
#pragma unroll
            for (int q = 0; q < 4; ++q) { vq[q] = (4 * fq + q) >= th; boff[q] = (cs + 4 * fq + q + (vq[q] ? 0 : 16) - c + KW - 1) * 4; }
            const unsigned M0 = (vq[0] ? 0xffffu : 0u) | (vq[1] ? 0xffff0000u : 0u), M1 = (vq[2] ? 0xffffu : 0u) | (vq[3] ? 0xffff0000u : 0u), N0 = ~M0, N1 = ~M1;
            const size_t qtok = tb0 + 64 * r + 16 * qb + fr;
            const bf16x8 qf = *(const bf16x8*)(projq + ((size_t)h * T + qtok) * 32 + 8 * fq);
            int slot[KH];
#pragma unroll
            for (int kr = 0; kr < KH; ++kr) slot[kr] = (r0 + kr) % NA_NKR;
            const LAS unsigned char* kb = F.lds + NA_K_OFF + (cs + fr) * NA_KTOK + 16 * fq;
            const LAS unsigned char* bb = F.lds + NA_B_OFF + (r0 - r + KH - 1) * 128;
            f32x2 sv[KH][2];
            float mx = -INFINITY;
#pragma unroll
            for (int kr = 0; kr < KH; ++kr) {
                f32x4 bv;
#pragma unroll
                for (int q = 0; q < 4; ++q) bv[q] = *(const LAS float*)(bb + boff[q] + kr * 128);
                const f32x4 s0 = __builtin_amdgcn_mfma_f32_16x16x32_bf16(*(const LAS bf16x8*)(kb + slot[kr] * NA_KROW), qf, bv, 0, 0, 0);
                const f32x4 s1 = __builtin_amdgcn_mfma_f32_16x16x32_bf16(*(const LAS bf16x8*)(kb + slot[kr] * NA_KROW + 16 * NA_KTOK), qf, bv, 0, 0, 0);
                const float e0 = vq[0] ? s0[0] : s1[0], e1 = vq[1] ? s0[1] : s1[1], e2 = vq[2] ? s0[2] : s1[2], e3 = vq[3] ? s0[3] : s1[3];
                sv[kr][0] = (f32x2){e0, e1}; sv[kr][1] = (f32x2){e2, e3};
                mx = fmaxf(fmaxf(mx, e0), e1); mx = fmaxf(fmaxf(mx, e2), e3);
            }
            mx = fmaxf(mx, __shfl_xor(mx, 16)); mx = fmaxf(mx, __shfl_xor(mx, 32));
            const f32x2 mx2 = (f32x2){mx, mx};
            f32x2 sum2 = (f32x2){0.f, 0.f};
#pragma unroll
            for (int kr = 0; kr < KH; ++kr)
#pragma unroll
                for (int hh = 0; hh < 2; ++hh) { const f32x2 dlt = sv[kr][hh] - mx2; f32x2 p; p.x = __builtin_amdgcn_exp2f(dlt.x); p.y = __builtin_amdgcn_exp2f(dlt.y); sv[kr][hh] = p; sum2 += p; }
            float sum = sum2.x + sum2.y;
            sum += __shfl_xor(sum, 16); sum += __shfl_xor(sum, 32);
            const LAS unsigned char* vb = F.lds + NA_V_OFF + fr * NA_VD + (cs + 4 * fq) * 2;
            f32x4 o[2] = {(f32x4){0.f, 0.f, 0.f, 0.f}, (f32x4){0.f, 0.f, 0.f, 0.f}};
#pragma unroll
            for (int kr = 0; kr < KH; ++kr) {
                const unsigned u01 = cvt_pk_bf16(sv[kr][0].x, sv[kr][0].y), u23 = cvt_pk_bf16(sv[kr][1].x, sv[kr][1].y);
                v4u pw; pw.x = u01 & M0; pw.y = u23 & M1; pw.z = u01 & N0; pw.w = u23 & N1;
                const bf16x8 pf = __builtin_bit_cast(bf16x8, pw);
#pragma unroll
                for (int dt = 0; dt < 2; ++dt) {
                    const LAS unsigned char* vp = vb + slot[kr] * NA_VROW + 16 * dt * NA_VD;
                    const v2u lo = *(const LAS v2u*)vp, hi = *(const LAS v2u*)(vp + 32);
                    v4u vw; vw.x = lo.x; vw.y = lo.y; vw.z = hi.x; vw.w = hi.y;
                    o[dt] = __builtin_amdgcn_mfma_f32_16x16x32_bf16(__builtin_bit_cast(bf16x8, vw), pf, o[dt], 0, 0, 0);
                }
            }
            const float inv = __builtin_amdgcn_rcpf(sum);
            bf16* orow = mixo + mixo_index(qtok, DPOOL + 32 * h + 4 * fq);
#pragma unroll
            for (int dt = 0; dt < 2; ++dt) { v2u w; w.x = cvt_pk_bf16(o[dt][0] * inv, o[dt][1] * inv); w.y = cvt_pk_bf16(o[dt][2] * inv, o[dt][3] * inv); *(v2u*)(orow + 16 * dt) = w; }
        }
    }
    __syncthreads();
#undef NA_UNIT
#undef NA_PLAN
#undef NA_LOAD
}

struct SchedProj {
    const char* hn; const char* win; bf16* proj; bf16* vt; int G, c, esz; const float* sa; const float* sw;
    __device__ __forceinline__ bool next(int i, pg8::Unit& u) const {
        int pm, pn; if (!pg8::tile_order(i, G, c, T / 256, 8, pm, pn)) return false;
        const size_t tstep = (size_t)256 * D * esz;
        if (pn < 6) { u.A = hn + pm * tstep; u.B = win + pn * tstep; u.orow = 256 * pm;
            if (pn < 2) { u.obase = proj; u.ocol = 256 * pn; u.ldc = UPITCH; } else { u.obase = proj + (size_t)(pn >> 1) * T * 512; u.ocol = 256 * (pn & 1); u.ldc = 0; }
            u.scale = (pn == 2 || pn == 3) ? QSCALE : 1.0f; u.p0 = sa + 256 * pm; u.cs = sw + 256 * pn; }
        else { u.A = win + pn * tstep; u.B = hn + pm * tstep; u.obase = vt; u.orow = 256 * (pn - 6); u.ocol = 256 * pm; u.ldc = -1; u.scale = 1.0f; u.p0 = sw + 256 * pn; u.cs = sa + 256 * pm; }
        return true;
    }
};
struct SchedOut {
    const char* a; const char* w; bf16* o; int G, c;
    __device__ __forceinline__ bool next(int i, pg8::Unit& u) const {
        int pm, pn; if (!pg8::tile_order(i, G, c, T / 256, 4, pm, pn)) return false;
        const size_t tstep = (size_t)256 * D * 2; u.p0 = nullptr; u.cs = nullptr;
        u.A = a + pm * tstep; u.B = w + pn * tstep; u.obase = o; u.orow = 256 * pm; u.ocol = 256 * pn; u.ldc = D; u.scale = 1.0f; return true;
    }
};
__device__ __forceinline__ void ffn_table(Frame& F0, bool moe) {
    Frame F = F0; { int t_ = threadIdx.x; asm volatile("" : "+v"(t_)); F.tid = t_; F.lane = t_ & 63; F.wave = __builtin_amdgcn_readfirstlane(t_ >> 6); }
    LAS int* blk = (LAS int*)(F.lds + BLK_OFF); LAS int* bst = (LAS int*)(F.lds + BST_OFF);
    __syncthreads();
    if (F.tid == 0) { int s = 0; for (int e = 0; e < NE; ++e) { bst[e] = s; s += moe ? (int)((ld_cnt(F.ctl, e) + 255u) >> 8) : (e == 0 ? T / 256 : 0); } bst[8] = s; }
    __syncthreads();
    for (int b = F.tid; b < MAXBLK + 8; b += 512) { int e = 0; for (int k = 1; k < NE; ++k) if (b >= bst[k]) e = k; blk[b] = e; }
    __syncthreads();
}
__device__ __forceinline__ bool tail_reduce(Frame& F0) {
    int t_ = threadIdx.x; asm volatile("" : "+v"(t_));
    const int lane = t_ & 63, gw = F0.bid * 8 + __builtin_amdgcn_readfirstlane(t_ >> 6), NGW = F0.G * 8;
    int nb = 0;
    for (int e = 0; e < NE; ++e) nb += (int)((ld_cnt(F0.ctl, e) + 255u) >> 8);
    const int nrows = (nb - 256) * 256;
    if (nrows <= 0) return false;
    bf16* y = (bf16*)(F0.ws + WS_Y) + (size_t)256 * 256 * D; const bf16* part = (const bf16*)(F0.ws + WS_TAILPART);
    for (int r = gw; r < nrows; r += NGW) {
        v4u w[TAILSPLIT][2];
#pragma unroll
        for (int h = 0; h < 2; ++h) { w[0][h] = *((const v4u*)(y + (size_t)r * D) + lane + 64 * h);
#pragma unroll
            for (int p = 1; p < TAILSPLIT; ++p) w[p][h] = *((const v4u*)(part + ((size_t)(p - 1) * TAILPART_ROWS + r) * D) + lane + 64 * h); }
#pragma unroll
        for (int h = 0; h < 2; ++h) { v4u o;
#pragma unroll
            for (int j = 0; j < 4; ++j) { float lo = 0.f, hi = 0.f;
#pragma unroll
                for (int p = 0; p < TAILSPLIT; ++p) { lo += bflo(w[p][h][j]); hi += bfhi(w[p][h][j]); }
                o[j] = cvt_pk_bf16(lo, hi); }
            *((v4u*)(y + (size_t)r * D) + lane + 64 * h) = o; }
    }
    return true;
}
template <bool TILED> struct SchedUpT {
    const char* hn; const char* wgu; const int* lists; bf16* hff; LAS int* blk; LAS int* bst; int G, c, cstart, nblk, nN, F_, moe, esz;
    __device__ __forceinline__ bool next(int i, pg8::Unit& u) const {
        int pm, pn; if (!pg8::tile_order(i, G, c, nblk, nN, pm, pn)) return false;
        const int b = cstart + pm, e = __builtin_amdgcn_readfirstlane(blk[b]), lb = b - __builtin_amdgcn_readfirstlane(bst[e]);
        u.A = hn; u.p0 = lists + (moe ? (size_t)e * T + 256 * lb : (size_t)256 * b); u.cs = nullptr;
        u.B = wgu + ((size_t)e * 2 * F_ + 256 * pn) * D * esz; u.obase = hff; u.orow = 256 * pm; u.ocol = 128 * pn; u.ldc = F_; u.scale = 1.0f;
        if constexpr (TILED) { u.obase = (bf16*)((char*)hff + ((size_t)pm * nN + pn) * HFF_TILE - 128 * pn - (size_t)256 * pm * 128); }
        return true;
    }
};
template <bool TILED> struct SchedDownT {
    const char* hff; const char* wd; bf16* y; LAS int* blk; int G, c, cstart, nblk, F_, esz; float scale; const int* idl; int pm0, split;
    __device__ __forceinline__ bool next(int i, pg8::Unit& u) const {
        int pm, pn; if (!pg8::tile_order(i, G, c, nblk, 4 * split, pm, pn)) return false;
        const int p = pn >> 2; pn &= 3;
        const int b = cstart + pm, e = __builtin_amdgcn_readfirstlane(blk[b]); u.p0 = idl; u.cs = nullptr;
        const size_t koff = (size_t)p * (F_ / split) * esz;
        u.A = hff + (size_t)(pm0 + pm) * 256 * F_ * esz + (TILED ? (size_t)p * (F_ / split / 128) * HFF_TILE : koff); u.B = wd + ((size_t)e * D + 256 * pn) * F_ * esz + koff;
        const long long poff = p == 0 ? 0ll : ((long long)WS_TAILPART - (long long)WS_Y) / 2 + (long long)(p - 1) * TAILPART_ROWS * D;
        u.obase = y + poff; u.orow = p == 0 ? 256 * b : 256 * pm; u.ocol = 256 * pn; u.ldc = D; u.scale = scale; return true;
    }
};

constexpr int STEPS_PER_LAYER = 16, NSTEPS = 1 + DEPTH * STEPS_PER_LAYER;
#define RUN(s) (lo <= (s) && (s) < hi)
#ifndef BARX
#define BARX 1
#endif
#define SEAM(s) do { if (RUN(s) && RUN((s) + 1)) { for (int b_ = 0; b_ < BARX; ++b_) xcd_barrier(bar); } } while (0)
template <int L>
__device__ __forceinline__ void run_layer(Frame& F, const XcdBarrier& bar, const int lo, const int hi) {
    constexpr int l = L, base = 1 + STEPS_PER_LAYER * L; constexpr bool moe = (L & 1) != 0, f8 = FP8_MOE && moe, i8 = I8_DENSE && !moe; constexpr bool h8 = f8 || (FP8_DDOWN && !moe);
    LAS int* tokbuf = (LAS int*)(F.lds + TOKBUF_OFF); LAS int* blk = (LAS int*)(F.lds + BLK_OFF); LAS int* bst = (LAS int*)(F.lds + BST_OFF);
    const char* HN = (const char*)(F.ws + WS_HN);
#ifndef NO_P1
    if (RUN(base + 0)) {
        SchedProj S{HN, (const char*)(F.ws + WS_WIN) + (size_t)l * DIN * D * (I8_PROJ ? 1 : 2), (bf16*)(F.ws + WS_PROJ), (bf16*)(F.ws + WS_VT), F.G, F.bid, I8_PROJ ? 1 : 2, (const float*)(F.ws + WS_SA), (const float*)(F.ws + WS_SWIN) + l * DIN};
        if constexpr (I8_PROJ != 0) pg8::gemm_phase<pg8::EpiProj_I8, SchedProj, false, 2>(F.lds, tokbuf, D / 2, S, pg8::EpiProj_I8{});
        else pg8::gemm_phase<pg8::EpiProj, SchedProj, false>(F.lds, tokbuf, D, S, pg8::EpiProj{});
    } SEAM(base + 0);
#endif
#ifndef NO_P2
#ifndef NA_CALLS
#define NA_CALLS 1
#endif
#ifndef POOL_CALLS
#define POOL_CALLS 1
#endif
    if (RUN(base + 1)) { for (int i_ = 0; i_ < POOL_CALLS; ++i_) mixer_phase(F, l); for (int i_ = 0; i_ < NA_CALLS; ++i_) na_phase(F, l); } SEAM(base + 1);
#endif
#ifndef NO_P3
    if (RUN(base + 2)) {
        SchedOut S{(const char*)(F.ws + WS_MIXO), (const char*)(F.ws + WS_WOUT) + (size_t)l * D * D * 2, (bf16*)(F.ws + WS_MIX), F.G, F.bid};
        pg8::gemm_phase<pg8::EpiBf16, SchedOut, false>(F.lds, tokbuf, D, S, pg8::EpiBf16{}, D, 64, 256 * 128);
    } SEAM(base + 2);
#endif
#ifndef NO_P4
    if (RUN(base + 3)) { norm_phase<false>(F, l); } SEAM(base + 3);
#endif
    constexpr int F_ = moe ? DFFE : DFF, cblk = h8 ? 2 * CHUNK_BLK : CHUNK_BLK;
    bool table = false; int NB = 0;
    for (int c = 0; c < MAXCHUNK; ++c) {
        const int s5 = base + 4 + 2 * c, s6 = s5 + 1;
        if (!(RUN(s5) || RUN(s6))) continue;
        if (!table) { ffn_table(F, moe); NB = __builtin_amdgcn_readfirstlane(bst[8]); table = true; }
        const int cstart = c * cblk; int nblk = min(NB - cstart, cblk);
        if constexpr (f8) { if (c == 1) nblk = NB - cstart; else if (c > 1) continue; }
        if (nblk <= 0) continue;
#ifndef NO_P5
        if (RUN(s5)) {
            typedef SchedUpT<h8> SchedUp; SchedUp S{HN, moe ? (const char*)(F.ws + WS_WGUM) : (const char*)(F.ws + WS_WGU0), moe ? (const int*)(F.ws + WS_LIST) : (const int*)(F.ws + WS_LISTID), (bf16*)(F.ws + WS_HFF), blk, bst, F.G, F.bid, cstart, nblk, F_ / 128, F_, moe ? 1 : 0, (f8 || i8) ? 1 : 2};
            if constexpr (f8 && FP6_UP) pg8::gemm_phase<pg8::EpiSwiGLU6, SchedUp, true, 3>(F.lds, tokbuf, D / 2, S, pg8::EpiSwiGLU6{});
            else if constexpr (f8) pg8::gemm_phase<pg8::EpiSwiGLU8, SchedUp, true, 1>(F.lds, tokbuf, D / 2, S, pg8::EpiSwiGLU8{});
            else if constexpr (i8) pg8::gemm_phase<pg8::EpiSwiGLU_I8, SchedUp, true, 2>(F.lds, tokbuf, D / 2, S, pg8::EpiSwiGLU_I8{(const float*)(F.ws + WS_SA), (const float*)(F.ws + WS_SW0), (const int*)(F.ws + WS_LISTID)});
            else pg8::gemm_phase<pg8::EpiSwiGLU, SchedUp, true>(F.lds, tokbuf, D, S, pg8::EpiSwiGLU{});
        } SEAM(s5);
#endif
#ifndef NO_P6
        if (RUN(s6)) {
            const int nfull = h8 ? min(nblk, cblk) : nblk;
            typedef SchedDownT<h8> SchedDown; SchedDown S{(const char*)(F.ws + WS_HFF), moe ? (const char*)(F.ws + WS_WDM) : (const char*)(F.ws + WS_WD0), (bf16*)(F.ws + WS_Y), blk, F.G, F.bid, cstart, nfull, F_, h8 ? 1 : 2, h8 ? 1.0f / W8_DN : 1.0f, (const int*)(F.ws + WS_LISTID), 0, 1};
            if constexpr (h8) {
                const int npass = (f8 && nblk > nfull) ? 2 : 1;
#pragma clang loop unroll(disable)
                for (int pass = 0; pass < npass; ++pass) {
                    if (pass == 1) { S.cstart = cstart + nfull; S.nblk = nblk - nfull; S.pm0 = nfull; S.split = TAILSPLIT; }
                    pg8::gemm_phase<pg8::EpiBf16, SchedDown, true, 1>(F.lds, tokbuf, pass == 0 ? F_ / 2 : F_ / 2 / TAILSPLIT, S, pg8::EpiBf16{}, F_ / 2, 64, HFF_TILE);
                }
            }
            else pg8::gemm_phase<pg8::EpiBf16, SchedDown, false>(F.lds, tokbuf, F_, S, pg8::EpiBf16{});
        } SEAM(s6);
#endif
    }
#ifndef NO_P7
    if (RUN(base + 14)) { if constexpr (f8) { if (tail_reduce(F)) xcd_barrier(bar); } norm_phase<true>(F, l); }
#endif
    if (l + 1 < DEPTH) { if (RUN(base + 14) && RUN(base + 16)) xcd_barrier(bar); }
}
__global__ void __launch_bounds__(512, 2) mk_fwd(Args args) {
    extern __shared__ __attribute__((aligned(16))) unsigned char lds_raw[];
    Frame F;
    F.lds = (LAS unsigned char*)lds_raw; F.MISC = (volatile LAS unsigned*)(F.lds + MISC_OFF);
    F.tid = threadIdx.x; F.lane = F.tid & 63; F.wave = __builtin_amdgcn_readfirstlane(F.tid >> 6); F.G = gridDim.x; F.bid = blockIdx.x;
    F.ws = args.ws; F.ctl = (unsigned*)(args.ws + WS_CTL); F.out = args.out;
    F.x = args.in[0]; F.g_mpre = args.in[1]; F.g_mpost = args.in[2]; F.g_fpre = args.in[3]; F.g_fpost = args.in[4]; F.w_in = args.in[5]; F.pool_w = args.in[6]; F.pool_scale = args.in[7];
    F.rpb = args.in[8]; F.w_out = args.in[9]; F.dwg = args.in[10]; F.dwu = args.in[11]; F.dwd = args.in[12]; F.router = args.in[13]; F.mwg = args.in[14]; F.mwu = args.in[15]; F.mwd = args.in[16];
    if (F.tid < 16) F.MISC[F.tid] = 0u;
    __syncthreads();
    const int lo = args.lo, hi = args.hi;
    XcdBarrier bar; bar.bar = F.ctl + CW_BAR + args.breg * XCD_BAR_WORDS; bar.x = 0; bar.st = F.MISC;
    if (hi - lo > 1) bar = xcd_barrier_post(F.ctl + CW_BAR + args.breg * XCD_BAR_WORDS, F.MISC);
#ifndef NO_P0
#ifndef REP_P0
#define REP_P0 1
#endif
    if (RUN(0)) { for (int r_ = 0; r_ < REP_P0; ++r_) p0_prologue(F); } SEAM(0);
#endif
    run_layer<0>(F, bar, lo, hi);
    run_layer<1>(F, bar, lo, hi);
}
#undef RUN
#undef SEAM

__global__ void __launch_bounds__(64) nk_gemm(const bf16* A, int lda, const bf16* Bt, int ldb, int K, bf16* O, int ldo, float scale, int sc_lo, int sc_hi, int vt) {
    const int m0 = 32 * blockIdx.y, n0 = 32 * blockIdx.x, lane = threadIdx.x, fr = lane & 15, fq = lane >> 4;
    f32x4 acc[2][2];
#pragma unroll
    for (int a = 0; a < 2; ++a)
#pragma unroll
        for (int b = 0; b < 2; ++b) acc[a][b] = (f32x4){0.f, 0.f, 0.f, 0.f};
    for (int k0 = 0; k0 < K; k0 += 32) {
        bf16x8 a[2], b[2];
#pragma unroll
        for (int i = 0; i < 2; ++i) { a[i] = *(const bf16x8*)(A + (size_t)(m0 + 16 * i + fr) * lda + k0 + 8 * fq); b[i] = *(const bf16x8*)(Bt + (size_t)(n0 + 16 * i + fr) * ldb + k0 + 8 * fq); }
#pragma unroll
        for (int mt = 0; mt < 2; ++mt)
#pragma unroll
            for (int nt = 0; nt < 2; ++nt) acc[mt][nt] = __builtin_amdgcn_mfma_f32_16x16x32_bf16(a[mt], b[nt], acc[mt][nt], 0, 0, 0);
    }
#pragma unroll
    for (int mt = 0; mt < 2; ++mt)
#pragma unroll
        for (int nt = 0; nt < 2; ++nt)
#pragma unroll
            for (int q = 0; q < 4; ++q) { const int m = m0 + 16 * mt + 4 * fq + q, n = n0 + 16 * nt + fr; const float sc = (n >= sc_lo && n < sc_hi) ? scale : 1.0f;
                O[vt ? vt_index(m, n) : (size_t)m * ldo + n] = (bf16)f2bf(acc[mt][nt][q] * sc); }
}
__global__ void nk_blocktab(const unsigned* ctl, int* btab, int moe) {
    if (threadIdx.x != 0 || blockIdx.x != 0) return;
    int b = 0;
    for (int e = 0; e < NE; ++e) { const int nb = moe ? (int)((ctl[CW_CNT + 64 * e] + 255u) >> 8) : (e == 0 ? T / 256 : 0); for (int k = 0; k < nb; ++k) btab[b++] = e | (k << 8); }
    btab[MAXBLK] = b;
}
__global__ void __launch_bounds__(64) nk_ffn_up(const bf16* hn, const bf16* wgu, const int* lists, const int* btab, bf16* hff, int cstart, int F_, int moe) {
    const int m0 = 32 * blockIdx.y, f0 = 32 * blockIdx.x, lane = threadIdx.x, fr = lane & 15, fq = lane >> 4;
    const int b = cstart + m0 / 256; if (b >= btab[MAXBLK]) return;
    const int e = btab[b] & 0xff, lb = btab[b] >> 8;
    const int* list = lists + (moe ? (size_t)e * T + 256 * lb : (size_t)256 * b) + (m0 % 256);
    const bf16* W = wgu + (size_t)e * 2 * F_ * D; const int rg = (f0 / 128) * 256 + (f0 % 128);
    const bf16* arow[2]; arow[0] = hn + (size_t)list[fr] * D; arow[1] = hn + (size_t)list[16 + fr] * D;
    f32x4 ag[2][2], au[2][2];
#pragma unroll
    for (int a = 0; a < 2; ++a)
#pragma unroll
        for (int c = 0; c < 2; ++c) { ag[a][c] = (f32x4){0.f, 0.f, 0.f, 0.f}; au[a][c] = (f32x4){0.f, 0.f, 0.f, 0.f}; }
    for (int k0 = 0; k0 < D; k0 += 32) {
        bf16x8 a[2], bg[2], bu[2];
#pragma unroll
        for (int i = 0; i < 2; ++i) { a[i] = *(const bf16x8*)(arow[i] + k0 + 8 * fq); bg[i] = *(const bf16x8*)(W + (size_t)(rg + 16 * i + fr) * D + k0 + 8 * fq); bu[i] = *(const bf16x8*)(W + (size_t)(rg + 128 + 16 * i + fr) * D + k0 + 8 * fq); }
#pragma unroll
        for (int mt = 0; mt < 2; ++mt)
#pragma unroll
            for (int nt = 0; nt < 2; ++nt) { ag[mt][nt] = __builtin_amdgcn_mfma_f32_16x16x32_bf16(a[mt], bg[nt], ag[mt][nt], 0, 0, 0); au[mt][nt] = __builtin_amdgcn_mfma_f32_16x16x32_bf16(a[mt], bu[nt], au[mt][nt], 0, 0, 0); }
    }
#pragma unroll
    for (int mt = 0; mt < 2; ++mt)
#pragma unroll
        for (int nt = 0; nt < 2; ++nt)
#pragma unroll
            for (int q = 0; q < 4; ++q) { const float g = ag[mt][nt][q], u = au[mt][nt][q]; const float v = g * u / (1.0f + __expf(-g));
                hff[(size_t)(m0 + 16 * mt + 4 * fq + q) * F_ + f0 + 16 * nt + fr] = (bf16)f2bf(v); }
}
__global__ void __launch_bounds__(64) nk_ffn_down(const bf16* hff, const bf16* wd, const int* btab, bf16* y, int cstart, int F_) {
    const int m0 = 32 * blockIdx.y, n0 = 32 * blockIdx.x, lane = threadIdx.x, fr = lane & 15, fq = lane >> 4;
    const int b = cstart + m0 / 256; if (b >= btab[MAXBLK]) return;
    const int e = btab[b] & 0xff; const bf16* W = wd + (size_t)e * D * F_;
    f32x4 acc[2][2];
#pragma unroll
    for (int a = 0; a < 2; ++a)
#pragma unroll
        for (int c = 0; c < 2; ++c) acc[a][c] = (f32x4){0.f, 0.f, 0.f, 0.f};
    for (int k0 = 0; k0 < F_; k0 += 32) {
        bf16x8 a[2], bb[2];
#pragma unroll
        for (int i = 0; i < 2; ++i) { a[i] = *(const bf16x8*)(hff + (size_t)(m0 + 16 * i + fr) * F_ + k0 + 8 * fq); bb[i] = *(const bf16x8*)(W + (size_t)(n0 + 16 * i + fr) * F_ + k0 + 8 * fq); }
#pragma unroll
        for (int mt = 0; mt < 2; ++mt)
#pragma unroll
            for (int nt = 0; nt < 2; ++nt) acc[mt][nt] = __builtin_amdgcn_mfma_f32_16x16x32_bf16(a[mt], bb[nt], acc[mt][nt], 0, 0, 0);
    }
#pragma unroll
    for (int mt = 0; mt < 2; ++mt)
#pragma unroll
        for (int nt = 0; nt < 2; ++nt)
#pragma unroll
            for (int q = 0; q < 4; ++q) y[(size_t)(256 * cstart + m0 + 16 * mt + 4 * fq + q) * D + n0 + 16 * nt + fr] = (bf16)f2bf(acc[mt][nt][q]);
}
__global__ void nk_pool_delta(const bf16* proj, bf16* delta) {
    const int idx = blockIdx.x * 256 + threadIdx.x, tok = idx / DPOOL, ch = idx % DPOOL, b = tok / SEQ, t = tok % SEQ, g = ch / 128, hw = 1 << g;
    const int lo = max(t - hw, 0), hi = min(t + hw, SEQ); float s = 0.f;
    for (int tt = lo; tt < hi; ++tt) s += bf2f(proj[(size_t)(b * SEQ + tt) * NPROJ + ch]);
    delta[(size_t)tok * DPOOL + ch] = (bf16)f2bf(s / (float)(hi - lo) - bf2f(proj[(size_t)tok * NPROJ + ch]));
}
__global__ void nk_pool_mm(const bf16* delta, const bf16* Wp, const float* pscale, bf16* mixo) {
    const int idx = blockIdx.x * 256 + threadIdx.x, tok = idx / DPOOL, dd = idx % DPOOL, g = dd / 128, d = dd % 128; float s = 0.f;
    for (int c = 0; c < 128; ++c) s += bf2f(delta[(size_t)tok * DPOOL + 128 * g + c]) * bf2f(Wp[(size_t)(g * 128 + d) * 128 + c]);
    mixo[(size_t)tok * D + dd] = (bf16)f2bf(s * pscale[dd]);
}
__global__ void nk_na(const bf16* proj, const bf16* Vt, const float* rpb, bf16* mixo) {
    const int idx = blockIdx.x * 256 + threadIdx.x, tok = idx / NH, h = idx % NH, b = tok / SEQ, t = tok % SEQ, r = t / GRIDW, c = t % GRIDW;
    const int r0 = min(max(r - KH / 2, 0), GROWS - KH), c0 = min(max(c - KW / 2, 0), GRIDW - KW);
    float q[HD];
#pragma unroll
    for (int d = 0; d < HD; ++d) q[d] = bf2f(proj[(size_t)tok * NPROJ + 512 + HD * h + d]);
    float mx = -INFINITY;
    for (int i = 0; i < KH; ++i) for (int j = 0; j < KW; ++j) {
        const size_t kt = (size_t)(b * SEQ + (r0 + i) * GRIDW + c0 + j); float s = 0.f;
#pragma unroll
        for (int d = 0; d < HD; ++d) s += q[d] * bf2f(proj[kt * NPROJ + 1024 + HD * h + d]);
        s += rpb[(h * 15 + (r0 + i - r + KH - 1)) * 31 + (c0 + j - c + KW - 1)] * LOG2E; mx = fmaxf(mx, s);
    }
    float o[HD], sum = 0.f;
#pragma unroll
    for (int d = 0; d < HD; ++d) o[d] = 0.f;
    for (int i = 0; i < KH; ++i) for (int j = 0; j < KW; ++j) {
        const size_t kt = (size_t)(b * SEQ + (r0 + i) * GRIDW + c0 + j); float s = 0.f;
#pragma unroll
        for (int d = 0; d < HD; ++d) s += q[d] * bf2f(proj[kt * NPROJ + 1024 + HD * h + d]);
        s += rpb[(h * 15 + (r0 + i - r + KH - 1)) * 31 + (c0 + j - c + KW - 1)] * LOG2E;
        const float p = exp2f(s - mx); sum += p; const float pb = __builtin_bit_cast(float, f2bf(p) << 16);
#pragma unroll
        for (int d = 0; d < HD; ++d) o[d] += pb * bf2f(Vt[vt_index(HD * h + d, (int)kt)]);
    }
#pragma unroll
    for (int d = 0; d < HD; ++d) mixo[(size_t)tok * D + DPOOL + HD * h + d] = (bf16)f2bf(o[d] / sum);
}

static void launch_mk(const Args& a0, int lo, int hi, int grid, hipStream_t stream, int breg = 0) {
    Args a = a0; a.lo = lo; a.hi = hi; a.breg = breg; a.pad = 0;
    hipLaunchKernelGGL(mk_fwd, dim3(grid), dim3(512), LDS_BYTES, stream, a);
}
extern "C" void kernel_launch(void* const* d_in, const int* in_sizes, int n_in, void* d_out, int out_size, void* d_ws, size_t ws_size, hipStream_t stream) {
    static int grid = 0;
    if (grid == 0) {
        if (n_in != 17 || out_size != T * D || ws_size < WS_END) { fprintf(stderr, "kernel_launch: unexpected problem (n_in %d, out %d, ws %zu)\n", n_in, out_size, ws_size); grid = -1; return; }
        int dev = 0, cus = 0;
        if (hipGetDevice(&dev) != hipSuccess || hipDeviceGetAttribute(&cus, hipDeviceAttributeMultiprocessorCount, dev) != hipSuccess) { grid = -1; return; }
        if (hipFuncSetAttribute((const void*)mk_fwd, hipFuncAttributeMaxDynamicSharedMemorySize, LDS_BYTES) != hipSuccess) { grid = -1; return; }
        int per_cu = 0;
        if (hipOccupancyMaxActiveBlocksPerMultiprocessor(&per_cu, (const void*)mk_fwd, 512, LDS_BYTES) != hipSuccess || per_cu < 1) { fprintf(stderr, "kernel_launch: occupancy query says %d\n", per_cu); }
        (void)hipGetLastError();
        grid = cus;
    }
    if (grid < 0) return;
    hipMemsetAsync((char*)d_ws + WS_CTL, 0, CTL_ZERO_BYTES, stream);
    Args a{};
    for (int i = 0; i < 17; ++i) a.in[i] = (const float*)d_in[i];
    a.out = (float*)d_out; a.ws = (unsigned char*)d_ws; a.lo = 0; a.hi = 0;
    unsigned char* ws = (unsigned char*)d_ws;
#if MODE == 3
#if defined(REPSTEP)
    launch_mk(a, 0, REPSTEP + 1, grid, stream, 0); launch_mk(a, REPSTEP, REPSTEP + 1, grid, stream, 1); launch_mk(a, REPSTEP + 1, NSTEPS, grid, stream, 2);
#else
    launch_mk(a, 0, NSTEPS, grid, stream);
#endif
#else
    launch_mk(a, 0, 1, grid, stream);
    const bf16* HN = (const bf16*)(ws + WS_HN);
    for (int l = 0; l < DEPTH; ++l) {
        const int base = 1 + STEPS_PER_LAYER * l; const int moe = l & 1;
        const bf16* win = (const bf16*)(ws + WS_WIN) + (size_t)l * DIN * D;
        if (NAIVE & 1) {
            hipLaunchKernelGGL(nk_gemm, dim3(NPROJ / 32, T / 32), dim3(64), 0, stream, HN, D, win, D, D, (bf16*)(ws + WS_PROJ), NPROJ, QSCALE, 512, 1024, 0);
            hipLaunchKernelGGL(nk_gemm, dim3(T / 32, DATT / 32), dim3(64), 0, stream, win + (size_t)NPROJ * D, D, HN, D, D, (bf16*)(ws + WS_VT), T, 1.0f, 0, 0, 1);
        } else launch_mk(a, base + 0, base + 1, grid, stream);
        if (NAIVE & 2) {
            hipLaunchKernelGGL(nk_pool_delta, dim3(T * DPOOL / 256), dim3(256), 0, stream, (const bf16*)(ws + WS_PROJ), (bf16*)(ws + WS_MIX));
            hipLaunchKernelGGL(nk_pool_mm, dim3(T * DPOOL / 256), dim3(256), 0, stream, (const bf16*)(ws + WS_MIX), (const bf16*)(ws + WS_WP) + (size_t)l * 4 * 128 * 128, (const float*)d_in[7] + l * DPOOL, (bf16*)(ws + WS_MIXO));
            hipLaunchKernelGGL(nk_na, dim3(T * NH / 256), dim3(256), 0, stream, (const bf16*)(ws + WS_PROJ), (const bf16*)(ws + WS_VT), (const float*)d_in[8] + (size_t)l * NH * 15 * 31, (bf16*)(ws + WS_MIXO));
        } else launch_mk(a, base + 1, base + 2, grid, stream);
        if (NAIVE & 4) hipLaunchKernelGGL(nk_gemm, dim3(D / 32, T / 32), dim3(64), 0, stream, (const bf16*)(ws + WS_MIXO), D, (const bf16*)(ws + WS_WOUT) + (size_t)l * D * D, D, D, (bf16*)(ws + WS_MIX), D, 1.0f, 0, 0, 0);
        else launch_mk(a, base + 2, base + 3, grid, stream);
        launch_mk(a, base + 3, base + 4, grid, stream);
        if (NAIVE & 24) hipLaunchKernelGGL(nk_blocktab, dim3(1), dim3(64), 0, stream, (const unsigned*)(ws + WS_CTL), (int*)(ws + WS_BTAB), moe);
        const int F_ = moe ? DFFE : DFF, nchunk = moe ? MAXCHUNK : 2;
        for (int c = 0; c < nchunk; ++c) {
            if (NAIVE & 8) hipLaunchKernelGGL(nk_ffn_up, dim3(F_ / 32, CHUNK_BLK * 256 / 32), dim3(64), 0, stream, HN, moe ? (const bf16*)(ws + WS_WGUM) : (const bf16*)(ws + WS_WGU0), moe ? (const int*)(ws + WS_LIST) : (const int*)(ws + WS_LISTID), (const int*)(ws + WS_BTAB), (bf16*)(ws + WS_HFF), c * CHUNK_BLK, F_, moe);
            else launch_mk(a, base + 4 + 2 * c, base + 5 + 2 * c, grid, stream);
            if (NAIVE & 16) hipLaunchKernelGGL(nk_ffn_down, dim3(D / 32, CHUNK_BLK * 256 / 32), dim3(64), 0, stream, (const bf16*)(ws + WS_HFF), moe ? (const bf16*)(ws + WS_WDM) : (const bf16*)(ws + WS_WD0), (const int*)(ws + WS_BTAB), (bf16*)(ws + WS_Y), c * CHUNK_BLK, F_);
            else launch_mk(a, base + 5 + 2 * c, base + 6 + 2 * c, grid, stream);
        }
        launch_mk(a, base + 14, base + 15, grid, stream);
    }
#endif
}
```

```cpp
#include <hip/hip_runtime.h>
#include <cstdio>
#include <cstdint>

#ifndef MODE
#define MODE 3
#endif
#ifndef NAIVE
#define NAIVE 0
#endif
#ifndef I8_DENSE
#define I8_DENSE 1
#endif
#ifndef I8_PROJ
#define I8_PROJ 1
#endif
#ifndef FP6_UP
#define FP6_UP 1
#endif
#ifndef FP8_DDOWN
#define FP8_DDOWN 1
#endif
#ifndef FP8_MOE
#define FP8_MOE 1
#endif
#if ((FP8_MOE || I8_DENSE) && (NAIVE & 24) || I8_PROJ && (NAIVE & 1)) && MODE != 3
#error the simple reference FFN kernels are bf16 only: build with -DFP8_MOE=0 to use them
#endif

#define GAS __attribute__((address_space(1)))
#define LAS __attribute__((address_space(3)))
typedef unsigned short bf16;
typedef unsigned v4u __attribute__((ext_vector_type(4)));
typedef unsigned v2u __attribute__((ext_vector_type(2)));
typedef float f32x4 __attribute__((ext_vector_type(4)));
typedef float f32x2 __attribute__((ext_vector_type(2)));
typedef short bf16x8 __attribute__((ext_vector_type(8)));

constexpr int BATCH = 2, SEQ = 16384, T = BATCH * SEQ, D = 1024, DIN = 2048, DPOOL = 512, DATT = 512, NH = 16, HD = 32;
constexpr int GRIDW = 64, GROWS = SEQ / GRIDW, KH = 8, KW = 16;
constexpr int DFF = 4096, NE = 8, DFFE = 3584, DEPTH = 2;
constexpr int UPITCH = 512;
constexpr int NPROJ = 1536;
constexpr float RMS_EPS = 1e-6f;
constexpr float LOG2E = 1.4426950408889634f;
constexpr float QSCALE = 0.17677669529663687f * LOG2E;
__host__ __device__ __forceinline__ size_t vt_index(int ch, int tok) { return (size_t)(tok >> 6) * (DATT * 64) + (size_t)ch * 64 + (tok & 63); }
constexpr float S6A = 1.25f, S6W = 40.0f;
typedef float f32x16 __attribute__((ext_vector_type(16)));
typedef int i32x6 __attribute__((ext_vector_type(6)));
constexpr float W8_UP = 32.0f, W8_DN = 64.0f;
typedef int i32x8 __attribute__((ext_vector_type(8)));
typedef int i32x4 __attribute__((ext_vector_type(4)));
constexpr int CHUNK_BLK = 64;
constexpr int MAXCHUNK = 5;
constexpr int MAXBLK = 264;

constexpr size_t MiB = 1u << 20;
constexpr size_t WS_CTL = 0, CTL_ZERO_BYTES = 1 * MiB;
constexpr size_t WS_LIST = 1 * MiB;
constexpr size_t WS_INFO = 2 * MiB;
constexpr size_t WS_LISTID = 2 * MiB + 512 * 1024;
constexpr size_t WS_SA = 2 * MiB + 640 * 1024;
constexpr size_t WS_SWIN = 2 * MiB + 896 * 1024;
constexpr size_t WS_SW0 = 2 * MiB + 832 * 1024;
constexpr size_t WS_BTAB = 2 * MiB + 768 * 1024;
constexpr size_t WS_WP = 3 * MiB;
constexpr size_t WS_WIN = 4 * MiB;
constexpr size_t WS_WOUT = 12 * MiB;
constexpr size_t WS_WGU0 = 16 * MiB;
constexpr size_t WS_WD0 = 32 * MiB;
constexpr size_t WS_WGUM = 40 * MiB;
constexpr size_t WS_WDM = (FP8_MOE ? 160 : 152) * MiB;
constexpr size_t WS_H16 = 96 * MiB;
constexpr size_t WS_HN = 208 * MiB;
constexpr size_t WS_R = 272 * MiB;
constexpr size_t WS_HFF = WS_R;
constexpr size_t WS_Y = WS_R + 128 * MiB;
constexpr size_t WS_PQ = WS_R + 32 * MiB, WS_PK = WS_R + 64 * MiB;
constexpr size_t WS_PROJ = WS_R;
constexpr size_t WS_VT = WS_R + 96 * MiB;
constexpr size_t WS_MIXO = WS_R + 128 * MiB;
constexpr size_t WS_MIX = WS_R + 192 * MiB;
constexpr size_t WS_END = 532 * MiB;
constexpr int HFF_TILE = 256 * 128;
constexpr int TAILSPLIT = 7, TAILPART_ROWS = 8 * 256;
constexpr size_t WS_TAILPART = WS_WGU0;
static_assert(WS_TAILPART + (size_t)(TAILSPLIT - 1) * TAILPART_ROWS * D * 2 <= WS_WGUM, "tail partials");
static_assert(!FP8_MOE || (WS_WGUM + (size_t)NE * 2 * DFFE * D <= WS_H16 && WS_H16 + (size_t)T * D * 2 <= WS_WDM), "H16 sits in the gap the fp8 expert weights leave");

constexpr int CW_TMO = 0, CW_CODE = 1;
constexpr int CW_BAR = 4096;
constexpr int CW_CNT = 16384;
constexpr int CW_DBG = 20480;

constexpr int RING_BYTES = 131072;
constexpr int TOKBUF_OFF = RING_BYTES;
constexpr int BLK_OFF = TOKBUF_OFF + 9 * 1024;
constexpr int BST_OFF = BLK_OFF + 272 * 4;
constexpr int LCNT_OFF = BST_OFF + 64;
constexpr int MISC_OFF = LCNT_OFF + 64;
constexpr int LDS_BYTES = 147456;
static_assert(MISC_OFF + 64 <= LDS_BYTES, "LDS map");

#define RLX_AGENT __ATOMIC_RELAXED, __HIP_MEMORY_SCOPE_AGENT
#define LDS_WAIT() asm volatile("s_waitcnt lgkmcnt(0)" ::: "memory")
#define VM_WAIT() asm volatile("s_waitcnt vmcnt(0)" ::: "memory")
__device__ __forceinline__ unsigned f2bf(float f) { unsigned u = __builtin_bit_cast(unsigned, f); return (u + 0x7fffu + ((u >> 16) & 1u)) >> 16; }
__device__ __forceinline__ unsigned pk2(float lo, float hi) { return f2bf(lo) | (f2bf(hi) << 16); }
__device__ __forceinline__ float bflo(unsigned w) { return __builtin_bit_cast(float, w << 16); }
__device__ __forceinline__ float bfhi(unsigned w) { return __builtin_bit_cast(float, w & 0xffff0000u); }
__device__ __forceinline__ float bf2f(bf16 v) { return __builtin_bit_cast(float, (unsigned)v << 16); }
__device__ __forceinline__ unsigned cvt_pk_bf16(float lo, float hi) { unsigned r; asm volatile("v_cvt_pk_bf16_f32 %0, %1, %2" : "=v"(r) : "v"(lo), "v"(hi)); return r; }
__device__ __forceinline__ float wave_sum(float v) {
#pragma unroll
    for (int o = 1; o < 64; o <<= 1) v += __shfl_xor(v, o);
    return v;
}

#define XB_TMO      128
#define XB_XCNT(j)  (256  + 64 * (j))
#define XB_XSUB(j)  (1280 + 64 * (j))
#define XB_XGEN(j)  (2304 + 64 * (j))
#define XB_TOP      3328
#define XB_TOPGEN   3392
#define XCD_BAR_WORDS 3456
#define XB_SPIN_CAP (1u << 18)
__device__ __forceinline__ unsigned xb_ld(unsigned* p)              { return __hip_atomic_load(p, __ATOMIC_RELAXED, __HIP_MEMORY_SCOPE_AGENT); }
__device__ __forceinline__ unsigned xb_add(unsigned* p, unsigned v) { return __hip_atomic_fetch_add(p, v, __ATOMIC_RELAXED, __HIP_MEMORY_SCOPE_AGENT); }
__device__ __forceinline__ unsigned xb_xcc_id() { return (unsigned)__builtin_amdgcn_s_getreg((3 << 11) | 20) & 0xFu; }
#define XB_SPIN(cond, bar) do { unsigned _sp = 0; while (cond) { __builtin_amdgcn_s_sleep(1); \
    if ((++_sp & 255u) == 0u) { if (xb_ld(&(bar)[XB_TMO])) break; if (_sp > XB_SPIN_CAP) { atomicAdd(&(bar)[XB_TMO], 1u); break; } } } } while (0)
struct XcdBarrier { unsigned* bar; unsigned x; volatile LAS unsigned* st; };
__device__ __forceinline__ XcdBarrier xcd_barrier_post(unsigned* bar, volatile LAS unsigned* st) {
    XcdBarrier b; b.bar = bar; b.x = xb_xcc_id(); b.st = st;
    if (threadIdx.x == 0) (void)xb_add(&bar[XB_XCNT(b.x)], 1u);
    return b;
}
__device__ __forceinline__ void xcd_barrier_complete(unsigned* bar, unsigned x, unsigned& nloc, unsigned& nx) {
    const unsigned G = gridDim.x * gridDim.y * gridDim.z;
    unsigned sum, cnt, mine, sp = 0u;
    for (;;) {
        sum = 0u; cnt = 0u; mine = 0u;
#pragma unroll
        for (unsigned j = 0; j < 16; ++j) { const unsigned c = xb_ld(&bar[XB_XCNT(j)]); sum += c; cnt += (c > 0u) ? 1u : 0u; mine = (j == x) ? c : mine; }
        if (sum == G) break;
        __builtin_amdgcn_s_sleep(1);
        if ((++sp & 255u) == 0u) { if (xb_ld(&bar[XB_TMO])) break; if (sp > XB_SPIN_CAP) { atomicAdd(&bar[XB_TMO], 1u); break; } }
    }
    nloc = mine > 0u ? mine : 1u; nx = cnt > 0u ? cnt : 1u;
}
__device__ __forceinline__ void xcd_barrier(const XcdBarrier& b) {
    asm volatile("s_waitcnt vmcnt(0)" ::: "memory");
    __syncthreads();
    if (threadIdx.x == 0) {
        unsigned* bar = b.bar;
        __builtin_amdgcn_s_waitcnt(0);
        unsigned nloc = b.st[0], nx = b.st[1];
        if (nloc == 0u) { xcd_barrier_complete(bar, b.x, nloc, nx); b.st[0] = nloc; b.st[1] = nx; }
        const unsigned old = xb_add(&bar[XB_XSUB(b.x)], 1u);
        const unsigned gen = old / nloc;
        if (old + 1u == (gen + 1u) * nloc) {
            __builtin_amdgcn_fence(__ATOMIC_RELEASE, "agent");
            asm volatile("s_waitcnt vmcnt(0)" ::: "memory");
            const unsigned og = xb_add(&bar[XB_TOP], 1u);
            const unsigned tg = og / nx;
            if (og + 1u == (tg + 1u) * nx) xb_add(&bar[XB_TOPGEN], 1u);
            else XB_SPIN(xb_ld(&bar[XB_TOPGEN]) == tg, bar);
            __builtin_amdgcn_fence(__ATOMIC_ACQUIRE, "agent");
            xb_add(&bar[XB_XGEN(b.x)], 1u);
            asm volatile("s_waitcnt vmcnt(0)" ::: "memory");
        } else {
            XB_SPIN(xb_ld(&bar[XB_XGEN(b.x)]) == gen, bar);
            __builtin_amdgcn_fence(__ATOMIC_ACQUIRE, "agent");
            asm volatile("s_waitcnt vmcnt(0)" ::: "memory");
        }
    }
    __syncthreads();
}

namespace pg8 {
constexpr int BM = 256, BK = 64, HALF = 128, HTB = HALF * BK * 2, STAGE_BYTES = 8 * HTB, NXCD = 8, WGM = 8;
__host__ __device__ __forceinline__ int lds_byte(int r, int c) { const int st = (r >> 4) * 2 + (c >> 5), rr = r & 15, cc = c & 31, ob = rr * 64 + cc * 2; return st * 1024 + (ob ^ (((ob >> 9) & 1) << 5)); }
__host__ __device__ __forceinline__ void stage_rc(int b, int& R, int& C) { const int st = b / 1024, sb = b % 1024, swz = sb ^ (((sb >> 9) & 1) << 5); R = (st >> 1) * 16 + swz / 64; C = (st & 1) * 32 + (swz % 64) / 2; }
__host__ __device__ __forceinline__ int perm32(int rho) { const int n = rho >> 4, i = rho & 15; return 8 * (i >> 2) + 4 * n + (i & 3); }

struct Unit { const char* A; const char* B; const void* p0; const float* cs; bf16* obase; int orow, ocol, ldc; float scale; };

__device__ __forceinline__ bool tile_order(int i, int G, int c, int nM, int nN, int& pm, int& pn) {
    const int nwg = nM * nN; const long L = (long)i * G + c; if (L >= nwg) return false;
    int wgid = (int)L; { const int q = nwg / NXCD, r = nwg % NXCD, xcd = wgid % NXCD, off = wgid / NXCD; wgid = (xcd < r ? xcd * (q + 1) : r * (q + 1) + (xcd - r) * q) + off; }
    const int nig = WGM * nN, gid = wgid / nig, fm = gid * WGM, gsz = (nM - fm) < WGM ? (nM - fm) : WGM;
    pm = fm + ((wgid % nig) % gsz); pn = (wgid % nig) / gsz; return true;
}

template <bool VT> struct EpiBf16T {
    static constexpr bool SCL = false;
    __device__ __forceinline__ void operator()(const f32x4 (&acc)[2][2][4][2], const Unit& u, int wr, int wc, int fr, int fq, const LAS int* tok, const LAS float* scl) const {
        const int row0 = u.orow + wr * 64 + fr, col0 = u.ocol + wc * 32 + 8 * fq; const float sc = u.scale;
#pragma unroll
        for (int ai = 0; ai < 2; ++ai)
#pragma unroll
            for (int m = 0; m < 4; ++m) { const int row = row0 + ai * HALF + m * 16; bf16* rowp = u.obase + (size_t)row * u.ldc + col0;
#pragma unroll
                for (int bj = 0; bj < 2; ++bj) { const f32x4 v0 = acc[ai][bj][m][0] * sc, v1 = acc[ai][bj][m][1] * sc;
                    v4u w; w.x = cvt_pk_bf16(v0[0], v0[1]); w.y = cvt_pk_bf16(v0[2], v0[3]); w.z = cvt_pk_bf16(v1[0], v1[1]); w.w = cvt_pk_bf16(v1[2], v1[3]);
                    bf16* p = (VT && u.ldc < 0) ? u.obase + vt_index(row, col0 + bj * HALF) : rowp + bj * HALF;
                    *(v4u*)p = w; } }
    }
};
typedef EpiBf16T<false> EpiBf16;
typedef EpiBf16T<true> EpiProj;
__device__ __forceinline__ float silu_mul(float g, float u) { return g * u * __builtin_amdgcn_rcpf(1.0f + __builtin_amdgcn_exp2f(-LOG2E * g)); }
struct EpiSwiGLU {
    static constexpr bool SCL = false;
    __device__ __forceinline__ void operator()(const f32x4 (&acc)[2][2][4][2], const Unit& u, int wr, int wc, int fr, int fq, const LAS int* tok, const LAS float* scl) const {
        const int row0 = u.orow + wr * 64 + fr, col0 = u.ocol + wc * 32 + 8 * fq;
#pragma unroll
        for (int ai = 0; ai < 2; ++ai)
#pragma unroll
            for (int m = 0; m < 4; ++m) { bf16* rowp = u.obase + (size_t)(row0 + ai * HALF + m * 16) * u.ldc + col0;
                const f32x4 g0 = acc[ai][0][m][0], g1 = acc[ai][0][m][1], u0 = acc[ai][1][m][0], u1 = acc[ai][1][m][1];
                v4u w; w.x = cvt_pk_bf16(silu_mul(g0[0], u0[0]), silu_mul(g0[1], u0[1])); w.y = cvt_pk_bf16(silu_mul(g0[2], u0[2]), silu_mul(g0[3], u0[3]));
                w.z = cvt_pk_bf16(silu_mul(g1[0], u1[0]), silu_mul(g1[1], u1[1])); w.w = cvt_pk_bf16(silu_mul(g1[2], u1[2]), silu_mul(g1[3], u1[3]));
                *(v4u*)rowp = w; }
    }
};

template <bool F6> struct EpiSwiGLU8T {
    static constexpr bool SCL = false;
    static __device__ __forceinline__ f32x2 pair(f32x2 gr, f32x2 ur) {
        const float sc = F6 ? 1.0f / (S6A * S6W) : 1.0f / W8_UP; const f32x2 a = gr * (-LOG2E * sc);
        f32x2 t; t.x = __builtin_amdgcn_exp2f(a.x); t.y = __builtin_amdgcn_exp2f(a.y);
        const f32x2 d = t + 1.0f; f32x2 r; r.x = __builtin_amdgcn_rcpf(d.x); r.y = __builtin_amdgcn_rcpf(d.y);
        return (gr * ur) * (r * (sc * sc));
    }
    __device__ __forceinline__ void operator()(const f32x4 (&acc)[2][2][4][2], const Unit& u, int wr, int wc, int fr, int fq, const LAS int* tok, const LAS float* scl) const {
        const int row0 = u.orow + wr * 64 + fr, col0 = u.ocol + wc * 32 + 8 * fq;
#pragma unroll
        for (int ai = 0; ai < 2; ++ai)
#pragma unroll
            for (int m = 0; m < 4; ++m) { unsigned char* rowp = (unsigned char*)u.obase + (size_t)(row0 + ai * HALF + m * 16) * 128 + col0;
                const f32x4 g0 = acc[ai][0][m][0], g1 = acc[ai][0][m][1], u0 = acc[ai][1][m][0], u1 = acc[ai][1][m][1];
                const f32x2 o0 = pair((f32x2){g0[0], g0[1]}, (f32x2){u0[0], u0[1]}), o1 = pair((f32x2){g0[2], g0[3]}, (f32x2){u0[2], u0[3]});
                const f32x2 o2 = pair((f32x2){g1[0], g1[1]}, (f32x2){u1[0], u1[1]}), o3 = pair((f32x2){g1[2], g1[3]}, (f32x2){u1[2], u1[3]});
                int w0 = 0, w1 = 0;
                w0 = __builtin_amdgcn_cvt_pk_fp8_f32(o0.x, o0.y, w0, false); w0 = __builtin_amdgcn_cvt_pk_fp8_f32(o1.x, o1.y, w0, true);
                w1 = __builtin_amdgcn_cvt_pk_fp8_f32(o2.x, o2.y, w1, false); w1 = __builtin_amdgcn_cvt_pk_fp8_f32(o3.x, o3.y, w1, true);
                v2u w; w.x = (unsigned)w0; w.y = (unsigned)w1; *(v2u*)rowp = w; }
    }
};

typedef EpiSwiGLU8T<false> EpiSwiGLU8;
typedef EpiSwiGLU8T<true> EpiSwiGLU6;
struct EpiProj_I8 {
    static constexpr bool SCL = true;
    __device__ __forceinline__ const float* rs_ptr(const Unit& u) const { return (const float*)u.p0; }
    __device__ __forceinline__ const float* cs_ptr(const Unit& u) const { return u.cs; }
    __device__ __forceinline__ void operator()(const f32x4 (&acc)[2][2][4][2], const Unit& u, int wr, int wc, int fr, int fq, const LAS int* tok, const LAS float* scl) const {
        const int rl0 = wr * 64 + fr, cl0 = wc * 32 + 8 * fq, row0 = u.orow + rl0, col0 = u.ocol + cl0; const float sc = u.scale;
        const bool hm = u.ldc == 0; const size_t rstride = hm ? 32 : (size_t)u.ldc, bstride = hm ? (size_t)4 * T * 32 : (size_t)HALF;
        bf16* lbase = hm ? u.obase + (size_t)((u.ocol >> 5) + wc) * T * 32 + 8 * fq : u.obase + col0;
        f32x4 cv[2][2];
#pragma unroll
        for (int bj = 0; bj < 2; ++bj) { cv[bj][0] = *(const LAS f32x4*)(scl + 256 + cl0 + bj * HALF) * sc; cv[bj][1] = *(const LAS f32x4*)(scl + 256 + cl0 + bj * HALF + 4) * sc; }
#pragma unroll
        for (int ai = 0; ai < 2; ++ai)
#pragma unroll
            for (int m = 0; m < 4; ++m) { const int row = row0 + ai * HALF + m * 16; const float sr = scl[rl0 + ai * HALF + m * 16]; bf16* rowp = lbase + (size_t)row * rstride;
#pragma unroll
                for (int bj = 0; bj < 2; ++bj) { const f32x4 v0 = __builtin_convertvector(__builtin_bit_cast(i32x4, acc[ai][bj][m][0]), f32x4) * cv[bj][0] * sr, v1 = __builtin_convertvector(__builtin_bit_cast(i32x4, acc[ai][bj][m][1]), f32x4) * cv[bj][1] * sr;
                    v4u w; w.x = cvt_pk_bf16(v0[0], v0[1]); w.y = cvt_pk_bf16(v0[2], v0[3]); w.z = cvt_pk_bf16(v1[0], v1[1]); w.w = cvt_pk_bf16(v1[2], v1[3]);
                    bf16* p = (u.ldc < 0) ? u.obase + vt_index(row, col0 + bj * HALF) : rowp + bj * bstride;
                    *(v4u*)p = w; } }
    }
};
template <bool F8OUT> struct EpiSwiGLU_I8T {
    static constexpr bool SCL = true;
    const float* sA; const float* sW; const int* idl;
    __device__ __forceinline__ const float* rs_ptr(const Unit& u) const { return sA + ((const int*)u.p0 - idl); }
    __device__ __forceinline__ const float* cs_ptr(const Unit& u) const { return sW + 2 * u.ocol; }
    static __device__ __forceinline__ f32x2 pair(f32x2 gr, f32x2 ur, f32x2 ka, f32x2 k, float sa) {
        const f32x2 a = (gr * sa) * ka;
        f32x2 t; t.x = __builtin_amdgcn_exp2f(a.x); t.y = __builtin_amdgcn_exp2f(a.y);
        const f32x2 d = t * k + k; f32x2 r; r.x = __builtin_amdgcn_rcpf(d.x); r.y = __builtin_amdgcn_rcpf(d.y);
        return (gr * ur) * r;
    }
    __device__ __forceinline__ void operator()(const f32x4 (&acc)[2][2][4][2], const Unit& u, int wr, int wc, int fr, int fq, const LAS int* tok, const LAS float* scl) const {
        const int rl0 = wr * 64 + fr, row0 = u.orow + rl0, cl0 = wc * 32 + 8 * fq, col0 = u.ocol + cl0;
        f32x2 ka[4], kc[4];
#pragma unroll
        for (int i = 0; i < 4; ++i) { const f32x2 wg = *(const LAS f32x2*)(scl + 256 + cl0 + 2 * i), wu = *(const LAS f32x2*)(scl + 256 + HALF + cl0 + 2 * i); const f32x2 p = wg * wu;
            ka[i] = wg * (-LOG2E); kc[i].x = __builtin_amdgcn_rcpf(p.x); kc[i].y = __builtin_amdgcn_rcpf(p.y); }
#pragma unroll
        for (int ai = 0; ai < 2; ++ai)
#pragma unroll
            for (int m = 0; m < 4; ++m) { const float sa = scl[rl0 + ai * HALF + m * 16], rs2 = __builtin_amdgcn_rcpf(sa * sa);
                bf16* rowp = u.obase + (size_t)(row0 + ai * HALF + m * 16) * u.ldc + col0;
                f32x2 o[4];
#pragma unroll
                for (int i = 0; i < 4; ++i) { const f32x4 ga = acc[ai][0][m][i >> 1], ua = acc[ai][1][m][i >> 1];
                    const float g0 = ga[2 * (i & 1)], g1 = ga[2 * (i & 1) + 1], u0 = ua[2 * (i & 1)], u1 = ua[2 * (i & 1) + 1];
                    const f32x2 gr = (f32x2){(float)__float_as_int(g0), (float)__float_as_int(g1)}, ur = (f32x2){(float)__float_as_int(u0), (float)__float_as_int(u1)};
                    o[i] = pair(gr, ur, ka[i], kc[i] * rs2, sa); }
                if constexpr (F8OUT) { int w0 = 0, w1 = 0;
                    w0 = __builtin_amdgcn_cvt_pk_fp8_f32(o[0].x, o[0].y, w0, false); w0 = __builtin_amdgcn_cvt_pk_fp8_f32(o[1].x, o[1].y, w0, true);
                    w1 = __builtin_amdgcn_cvt_pk_fp8_f32(o[2].x, o[2].y, w1, false); w1 = __builtin_amdgcn_cvt_pk_fp8_f32(o[3].x, o[3].y, w1, true);
                    v2u w; w.x = (unsigned)w0; w.y = (unsigned)w1; *(v2u*)((unsigned char*)u.obase + (size_t)(row0 + ai * HALF + m * 16) * 128 + col0) = w; }
                else { v4u w; w.x = cvt_pk_bf16(o[0].x, o[0].y); w.y = cvt_pk_bf16(o[1].x, o[1].y); w.z = cvt_pk_bf16(o[2].x, o[2].y); w.w = cvt_pk_bf16(o[3].x, o[3].y);
                    *(v4u*)rowp = w; } }
    }
};
typedef EpiSwiGLU_I8T<FP8_DDOWN != 0> EpiSwiGLU_I8;

template <class Epi, class Sched, bool GATHER, int MT = 0  >
__device__ __forceinline__ void gemm_phase(LAS unsigned char* lds, LAS int* tokbuf, const int K, const Sched& S, const Epi& E, const int P_ = 0, const int PA_ = 0, const int KSA_ = 0) {
    const int P = P_ ? P_ : K, PA = PA_ ? PA_ : P;
    const size_t kstepA = KSA_ ? (size_t)KSA_ : (size_t)(BK * 2);
    int tid_ = threadIdx.x; asm volatile("" : "+v"(tid_));
    const int tid = tid_, wid = __builtin_amdgcn_readfirstlane(tid >> 6), lane = tid & 63, wr = wid >> 2, wc = wid & 3, fr = lane & 15, fq = lane >> 4;
    const int nt = K / BK;
    unsigned voffA[2][2], voffB[2]; int rowA[2], colA[2];
#pragma unroll
    for (int i = 0; i < 2; ++i) { int R, C; stage_rc(tid * 16 + i * 8192, R, C); const int Rb = (R & ~31) + perm32(R & 31);
        voffA[0][i] = (unsigned)(R * PA + C) * 2u; voffA[1][i] = (unsigned)((R + HALF) * PA + C) * 2u; voffB[i] = (unsigned)(Rb * P + C) * 2u; rowA[i] = R; colA[i] = C; }
    const size_t kstep = (size_t)(BK * 2);
    const size_t hstep = (size_t)HALF * P * 2, hstepA = (size_t)HALF * PA * 2;
    const unsigned ldsw = (unsigned)wid * 1024u;
    const int aoff = lds_byte(wr * 64 + fr, fq * 8), boff = lds_byte(wc * 32 + fr, fq * 8);
#define PG8_SA(b, h) (((b) * 2 + (h)) * HTB)
#define PG8_SB(b, h) ((4 + (b) * 2 + (h)) * HTB)
#define PG8_STAGE(bufoff, gbase, voff) do { _Pragma("unroll") for (int _i = 0; _i < 2; ++_i) \
        __builtin_amdgcn_global_load_lds((const unsigned*)((const char*)(gbase) + (voff)[_i]), (LAS unsigned*)(lds + (bufoff) + ldsw + _i * 8192), 16, 0, 0); } while (0)
#define PG8_STAGE_A1(bufoff, gbase) do { if constexpr (GATHER) PG8_STAGE(bufoff, gbase, voffA[1]); else PG8_STAGE(bufoff, (gbase) + hstepA, voffA[0]); } while (0)
#define PG8_LDA(dst, b, h) do { _Pragma("unroll") for (int m = 0; m < 4; ++m) _Pragma("unroll") for (int k = 0; k < 2; ++k) dst[m][k] = *(const LAS bf16x8*)(lds + PG8_SA(b, h) + aoff + m * 2048 + k * 1024); } while (0)
#define PG8_LDB(dst, b, h) do { _Pragma("unroll") for (int n = 0; n < 2; ++n) _Pragma("unroll") for (int k = 0; k < 2; ++k) dst[n][k] = *(const LAS bf16x8*)(lds + PG8_SB(b, h) + boff + n * 2048 + k * 1024); } while (0)
#define PG8_CAT8(x) __builtin_shufflevector(__builtin_bit_cast(i32x4, (x)[0]), __builtin_bit_cast(i32x4, (x)[1]), 0, 1, 2, 3, 4, 5, 6, 7)
#define PG8_MMA(ai, bj, At, Bt) do { __builtin_amdgcn_s_setprio(1); _Pragma("unroll") for (int m = 0; m < 4; ++m) _Pragma("unroll") for (int n = 0; n < 2; ++n) { \
        if constexpr (MT == 1) acc[ai][bj][m][n] = __builtin_amdgcn_mfma_scale_f32_16x16x128_f8f6f4(PG8_CAT8(Bt[n]), PG8_CAT8(At[m]), acc[ai][bj][m][n], 0, 0, 0, 0, 0, 0); \
        else if constexpr (MT == 3) acc[ai][bj][m][n] = __builtin_amdgcn_mfma_scale_f32_16x16x128_f8f6f4(PG8_CAT8(Bt[n]), PG8_CAT8(At[m]), acc[ai][bj][m][n], 2, 2, 0, 0, 0, 0); \
        else if constexpr (MT == 2) { _Pragma("unroll") for (int k = 0; k < 2; ++k) acc[ai][bj][m][n] = __builtin_bit_cast(f32x4, __builtin_amdgcn_mfma_i32_16x16x64_i8(__builtin_bit_cast(i32x4, Bt[n][k]), __builtin_bit_cast(i32x4, At[m][k]), __builtin_bit_cast(i32x4, acc[ai][bj][m][n]), 0, 0, 0)); } \
        else { _Pragma("unroll") for (int k = 0; k < 2; ++k) acc[ai][bj][m][n] = __builtin_amdgcn_mfma_f32_16x16x32_bf16(Bt[n][k], At[m][k], acc[ai][bj][m][n], 0, 0, 0); } } \
        __builtin_amdgcn_s_setprio(0); } while (0)
#define PG8_WAIT_V(n) asm volatile("s_waitcnt vmcnt(" #n ")" ::: "memory")
#define PG8_WAIT_L(n) asm volatile("s_waitcnt lgkmcnt(" #n ")" ::: "memory")
#define PG8_BAR __builtin_amdgcn_s_barrier()
#define PG8_SCHED __builtin_amdgcn_sched_barrier(0)
#define PG8_TOKOFF(dst, tb) do { _Pragma("unroll") for (int _h = 0; _h < 2; ++_h) _Pragma("unroll") for (int _i = 0; _i < 2; ++_i) \
        dst[_h][_i] = (unsigned)(tb)[_h * HALF + rowA[_i]] * (unsigned)(PA * 2) + (unsigned)(colA[_i] * 2); } while (0)
#define PG8_TOKDMA(listp, tb) do { if (wid < 4) __builtin_amdgcn_global_load_lds((const unsigned*)((listp) + tid), (LAS unsigned*)((tb) + wid * 64), 4, 0, 0); } while (0)
#define PG8_SCB(u_) ((LAS float*)(tokbuf + 768) + 512 * ((u_) % 3))
#define PG8_SCLDMA(un, u_) do { const float* sp_ = wid < 4 ? E.rs_ptr(un) + tid : E.cs_ptr(un) + (tid - 256); \
        __builtin_amdgcn_global_load_lds((const unsigned*)sp_, (LAS unsigned*)(PG8_SCB(u_) + wid * 64), 4, 0, 0); } while (0)
#define PG8_TB(u_) (tokbuf + 256 * ((u_) % 3))
    Unit cur, nxt; int ui = 0;
    if (!S.next(0, cur)) return;
    f32x4 acc[2][2][4][2];
#pragma unroll
    for (int a = 0; a < 2; ++a)
#pragma unroll
        for (int b = 0; b < 2; ++b)
#pragma unroll
            for (int m = 0; m < 4; ++m)
#pragma unroll
                for (int n = 0; n < 2; ++n) acc[a][b][m][n] = (f32x4){0.f, 0.f, 0.f, 0.f};
    bf16x8 At[4][2], B0[2][2], B1[2][2];
    const char* cA = cur.A; const char* cB = cur.B;
    if constexpr (Epi::SCL) PG8_SCLDMA(cur, 0);
    if constexpr (GATHER) {
        PG8_TOKDMA((const int*)cur.p0, PG8_TB(0)); PG8_WAIT_V(0); PG8_BAR; asm volatile("" ::: "memory");
        PG8_TOKOFF(voffA, PG8_TB(0)); PG8_WAIT_L(0); asm volatile("" ::: "memory");
    } else if constexpr (Epi::SCL) { PG8_WAIT_V(0); PG8_BAR; asm volatile("" ::: "memory"); }
    PG8_STAGE(PG8_SB(0, 0), cB, voffB); PG8_STAGE(PG8_SB(0, 1), cB + hstep, voffB); PG8_STAGE(PG8_SA(0, 0), cA, voffA[0]); PG8_STAGE_A1(PG8_SA(0, 1), cA);
    if (wr == 1) PG8_BAR;
    PG8_WAIT_V(2); PG8_BAR;
    PG8_STAGE(PG8_SB(1, 0), cB + kstep, voffB); PG8_STAGE(PG8_SA(1, 0), cA + kstepA, voffA[0]); PG8_STAGE(PG8_SB(1, 1), cB + hstep + kstep, voffB);
    PG8_WAIT_V(6); PG8_BAR;
    for (;;) {
        const bool has_next = S.next(ui + 1, nxt);
        if constexpr (Epi::SCL) { if (has_next) PG8_SCLDMA(nxt, ui + 1); }
        if constexpr (GATHER) { if (has_next) PG8_TOKDMA((const int*)nxt.p0, PG8_TB(ui + 1)); }
        const char* nA = has_next ? nxt.A : cA; const char* nB = has_next ? nxt.B : cB;
        for (int t = 0; t < nt; t += 2) {
            const bool last = (t == nt - 2);
            const char* a1 = cA + (size_t)(t + 1) * kstepA;
            const char* a2 = last ? nA : cA + (size_t)(t + 2) * kstepA; const char* b2 = last ? nB : cB + (size_t)(t + 2) * kstep;
            const char* a3 = a2 + kstepA; const char* b3 = b2 + kstep;
            PG8_LDB(B0, 0, 0); PG8_LDB(B1, 0, 1); PG8_SCHED; PG8_LDA(At, 0, 0); PG8_STAGE_A1(PG8_SA(1, 1), a1);
            if constexpr (GATHER) { if (last && has_next) { PG8_TOKOFF(voffA, PG8_TB(ui + 1)); } }
            PG8_WAIT_V(8); PG8_WAIT_L(0); PG8_BAR; PG8_MMA(0, 0, At, B0); PG8_MMA(0, 1, At, B1); PG8_BAR; PG8_SCHED;
            PG8_LDA(At, 0, 1); PG8_STAGE(PG8_SB(0, 0), b2, voffB); PG8_STAGE(PG8_SB(0, 1), b2 + hstep, voffB); PG8_STAGE(PG8_SA(0, 0), a2, voffA[0]);
            PG8_WAIT_V(8); PG8_WAIT_L(0); PG8_BAR; PG8_MMA(1, 0, At, B0); PG8_MMA(1, 1, At, B1); PG8_BAR; PG8_SCHED;
            PG8_LDB(B0, 1, 0); PG8_LDB(B1, 1, 1); PG8_SCHED; PG8_LDA(At, 1, 0); PG8_STAGE_A1(PG8_SA(0, 1), a2);
            PG8_WAIT_V(8); PG8_WAIT_L(0); PG8_BAR; PG8_MMA(0, 0, At, B0); PG8_MMA(0, 1, At, B1); PG8_BAR; PG8_SCHED;
            PG8_LDA(At, 1, 1); PG8_STAGE(PG8_SB(1, 0), b3, voffB); PG8_STAGE(PG8_SB(1, 1), b3 + hstep, voffB); PG8_STAGE(PG8_SA(1, 0), a3, voffA[0]);
            PG8_WAIT_V(8); PG8_WAIT_L(0); PG8_BAR; PG8_MMA(1, 0, At, B0); PG8_MMA(1, 1, At, B1); PG8_BAR; PG8_SCHED;
        }
        if (wr == 0) PG8_BAR;
#ifndef EPIX
#define EPIX 1
#endif
        for (int e_ = 0; e_ < EPIX; ++e_) E(acc, cur, wr, wc, fr, fq, PG8_TB(ui), PG8_SCB(ui));
        if (!has_next) break;
#pragma unroll
        for (int a = 0; a < 2; ++a)
#pragma unroll
            for (int b = 0; b < 2; ++b)
#pragma unroll
                for (int m = 0; m < 4; ++m)
#pragma unroll
                    for (int n = 0; n < 2; ++n) acc[a][b][m][n] = (f32x4){0.f, 0.f, 0.f, 0.f};
        cur = nxt; cA = nA; cB = nB; ++ui;
        if (wr == 1) PG8_BAR;
    }
    PG8_WAIT_V(0);
    PG8_BAR;
#undef PG8_SA
#undef PG8_SB
#undef PG8_STAGE
#undef PG8_LDA
#undef PG8_STAGE_A1
#undef PG8_LDB
#undef PG8_MMA
#undef PG8_CAT8
#undef PG8_WAIT_V
#undef PG8_WAIT_L
#undef PG8_BAR
#undef PG8_SCHED
#undef PG8_TOKOFF
#undef PG8_TOKDMA
#undef PG8_TB
#undef PG8_SCB
#undef PG8_SCLDMA
}
}

struct Args { const float* in[17]; float* out; unsigned char* ws; int lo, hi, breg, pad; };
struct Frame {
    LAS unsigned char* lds; volatile LAS unsigned* MISC; unsigned* ctl; int tid, lane, wave, G, bid;
    const float *x, *g_mpre, *g_mpost, *g_fpre, *g_fpost, *w_in, *pool_w, *pool_scale, *rpb, *w_out, *dwg, *dwu, *dwd, *router, *mwg, *mwu, *mwd;
    float* out; unsigned char* ws;
};

__device__ __forceinline__ void p0_transpose_item(const float* W, int K, int N, bf16* WT, int kb, int n0, int row_base, LAS float* scr, int lane) {
    const int k0 = 64 * kb;
#pragma unroll 8
    for (int i = 0; i < 32; ++i) { const int kk = 2 * i + (lane >> 5); scr[kk * 33 + (lane & 31)] = W[(size_t)(k0 + kk) * N + n0 + (lane & 31)]; }
    LDS_WAIT(); asm volatile("" ::: "memory");
    const int c = lane & 7;
#pragma unroll
    for (int j = 0; j < 4; ++j) { const int n = (lane >> 3) + 8 * j; const LAS float* s = scr + (8 * c) * 33 + n;
        v4u o; o.x = pk2(s[0 * 33], s[1 * 33]); o.y = pk2(s[2 * 33], s[3 * 33]); o.z = pk2(s[4 * 33], s[5 * 33]); o.w = pk2(s[6 * 33], s[7 * 33]);
        *(v4u*)(WT + (size_t)(row_base + n) * K + k0 + 8 * c) = o; }
    LDS_WAIT(); asm volatile("" ::: "memory");
}
__device__ __forceinline__ void p0_matrix(const float* W, int K, int N, bf16* WT, int ilv_half, LAS float* scr, int lane, int gw, int NGW, int& base) {
    const int nblk = N / 32, nitems = (K / 64) * nblk;
    int it = gw - (base % NGW); if (it < 0) it += NGW;
    for (; it < nitems; it += NGW) { const int kb = it / nblk, n0 = 32 * (it % nblk);
        const int rb = ilv_half < 0 ? n0 : (n0 / 128) * 256 + (n0 % 128) + 128 * ilv_half;
        p0_transpose_item(W, K, N, WT, kb, n0, rb, scr, lane); }
    base += nitems;
}
__device__ __forceinline__ void p0_transpose_item_fp8(const float* W, int K, int N, unsigned char* WT, int kt, int n0, int row_base, float scale, LAS float* scr, int lane) {
    const int k0 = 128 * kt;
#pragma unroll 8
    for (int i = 0; i < 64; ++i) { const int kk = 2 * i + (lane >> 5); scr[kk * 33 + (lane & 31)] = W[(size_t)(k0 + kk) * N + n0 + (lane & 31)] * scale; }
    LDS_WAIT(); asm volatile("" ::: "memory");
    const int c = lane & 7;
#pragma unroll 1
    for (int pass = 0; pass < 4; ++pass) { const int n = (lane >> 3) + 8 * pass; const LAS float* sp = scr + (16 * c) * 33 + n;
        v4u o;
#pragma unroll
        for (int d = 0; d < 4; ++d) { int w = 0; w = __builtin_amdgcn_cvt_pk_fp8_f32(sp[(4 * d) * 33], sp[(4 * d + 1) * 33], w, false); w = __builtin_amdgcn_cvt_pk_fp8_f32(sp[(4 * d + 2) * 33], sp[(4 * d + 3) * 33], w, true); o[d] = (unsigned)w; }
        *(v4u*)(WT + (size_t)(row_base + n) * K + k0 + 16 * c) = o; }
    LDS_WAIT(); asm volatile("" ::: "memory");
}
__device__ __forceinline__ void p0_transpose_item_fp6(const float* W, int K, int N, unsigned char* WT, int kt, int n0, int row_base, float scale, LAS float* scr, int lane) {
    const int k0 = 128 * kt;
#pragma unroll 8
    for (int i = 0; i < 64; ++i) { const int kk = 2 * i + (lane >> 5); scr[kk * 33 + (lane & 31)] = W[(size_t)(k0 + kk) * N + n0 + (lane & 31)] * scale; }
    LDS_WAIT(); asm volatile("" ::: "memory");
    const int n = lane & 31, g = lane >> 5;
    unsigned char* rp = WT + (size_t)(row_base + n) * K + 128 * kt;
#pragma unroll 1
    for (int h = 0; h < 2; ++h) { const int fq = 2 * h + g; const LAS float* sp = scr + (32 * fq) * 33 + n;
        f32x16 x, y;
#pragma unroll
        for (int i = 0; i < 16; ++i) { x[i] = sp[i * 33]; y[i] = sp[(16 + i) * 33]; }
        const i32x6 o = __builtin_amdgcn_cvt_scalef32_2xpk16_fp6_f32(x, y, 1.0f);
        *(v4u*)(rp + 16 * fq) = (v4u){(unsigned)o[0], (unsigned)o[1], (unsigned)o[2], (unsigned)o[3]};
        *(v4u*)(rp + 64 + 16 * fq) = (v4u){(unsigned)o[4], (unsigned)o[5], 0u, 0u}; }
    LDS_WAIT(); asm volatile("" ::: "memory");
}
__device__ __forceinline__ void p0_matrix_fp6(const float* W, int K, int N, unsigned char* WT, int ilv_half, float scale, LAS float* scr, int lane, int gw, int NGW, int& base) {
    const int nblk = N / 32, nitems = (K / 128) * nblk;
    int it = gw - (base % NGW); if (it < 0) it += NGW;
    for (; it < nitems; it += NGW) { const int kt = it / nblk, n0 = 32 * (it % nblk);
        const int rb = (n0 / 128) * 256 + (n0 % 128) + 128 * ilv_half;
        p0_transpose_item_fp6(W, K, N, WT, kt, n0, rb, scale, scr, lane); }
    base += nitems;
}
__device__ __forceinline__ void p0_matrix_fp8(const float* W, int K, int N, unsigned char* WT, int ilv_half, float scale, LAS float* scr, int lane, int gw, int NGW, int& base) {
    const int nblk = N / 32, nitems = (K / 128) * nblk;
    int it = gw - (base % NGW); if (it < 0) it += NGW;
    for (; it < nitems; it += NGW) { const int kt = it / nblk, n0 = 32 * (it % nblk);
        const int rb = ilv_half < 0 ? n0 : (n0 / 128) * 256 + (n0 % 128) + 128 * ilv_half;
        p0_transpose_item_fp8(W, K, N, WT, kt, n0, rb, scale, scr, lane); }
    base += nitems;
}
__device__ __forceinline__ void rms_row_to_bf16(const float* xrow, const float* g, bf16* orow, int lane) {
    const f32x4* xr = (const f32x4*)xrow + lane; const f32x4* gr = (const f32x4*)g + lane;
    f32x4 v[4]; float s = 0.f;
#pragma unroll
    for (int j = 0; j < 4; ++j) { v[j] = xr[64 * j]; s += (v[j].x * v[j].x + v[j].y * v[j].y) + (v[j].z * v[j].z + v[j].w * v[j].w); }
    const float rstd = 1.0f / sqrtf(wave_sum(s) * (1.f / D) + RMS_EPS);
    v2u* o8 = (v2u*)orow + lane;
#pragma unroll
    for (int j = 0; j < 4; ++j) { const f32x4 gg = gr[64 * j]; v2u w; w.x = pk2(v[j].x * rstd * gg.x, v[j].y * rstd * gg.y); w.y = pk2(v[j].z * rstd * gg.z, v[j].w * rstd * gg.w); o8[64 * j] = w; }
}
__device__ __forceinline__ float wave_max(float v) {
#pragma unroll
    for (int o = 1; o < 64; o <<= 1) v = fmaxf(v, __shfl_xor(v, o));
    return v;
}
__device__ __forceinline__ void p0_colblock_i8(Frame& F, const float* W, int N, int n0, unsigned char* W8, float* sW, int dest0) {
    const int tid = F.tid, lane = F.lane, wid = F.wave, n = lane & 31, kh = lane >> 5;
    LAS float* slab = (LAS float*)F.lds; LAS float* cmax = (LAS float*)(F.lds + RING_BYTES);
    __syncthreads();
    float mx = 0.f;
#pragma unroll 1
    for (int i0 = 0; i0 < 64; i0 += 16) {
        float v[16];
#pragma unroll
        for (int i = 0; i < 16; ++i) v[i] = W[(size_t)(128 * wid + 2 * (i0 + i) + kh) * N + n0 + n];
#pragma unroll
        for (int i = 0; i < 16; ++i) { const int k = 128 * wid + 2 * (i0 + i) + kh; slab[k * 32 + (n ^ (k & 31))] = v[i]; mx = fmaxf(mx, fabsf(v[i])); }
    }
    cmax[wid * 64 + lane] = mx;
    __syncthreads();
    float amax = 0.f;
#pragma unroll
    for (int w = 0; w < 8; ++w) amax = fmaxf(amax, fmaxf(cmax[w * 64 + n], cmax[w * 64 + 32 + n]));
    const float sc = amax > 0.f ? amax * (1.0f / 127.0f) : 1.0f, inv = amax > 0.f ? 127.0f / amax : 0.f;
    const int kc = tid >> 5, dest = dest0 + n;
#pragma unroll 1
    for (int q4 = 0; q4 < 4; ++q4) { v4u o;
#pragma unroll
        for (int d = 0; d < 4; ++d) { unsigned w = 0u;
#pragma unroll
            for (int j = 0; j < 4; ++j) { const int k = 64 * kc + 16 * q4 + 4 * d + j; w |= ((unsigned)__float2int_rn(slab[k * 32 + (n ^ (k & 31))] * inv) & 0xffu) << (8 * j); }
            o[d] = w; }
        *(v4u*)(W8 + (size_t)dest * D + 64 * kc + 16 * q4) = o; }
    if (kc == 0) sW[dest] = sc;
}
__device__ __forceinline__ void p0_i8_weights(Frame& F) {
    constexpr int NB_D = I8_DENSE ? 2 * (DFF / 32) : 0, NB_P = I8_PROJ ? DEPTH * (DIN / 32) : 0;
    for (int cb = F.bid; cb < NB_D + NB_P; cb += F.G) {
        if (cb < NB_D) { const int half = cb / (DFF / 32), n0 = 32 * (cb % (DFF / 32));
            p0_colblock_i8(F, half ? F.dwu : F.dwg, DFF, n0, F.ws + WS_WGU0, (float*)(F.ws + WS_SW0), (n0 / 128) * 256 + (n0 % 128) + 128 * half); }
        else { const int c2 = cb - NB_D, l = c2 / (DIN / 32), n0 = 32 * (c2 % (DIN / 32));
            p0_colblock_i8(F, F.w_in + (size_t)l * D * DIN, DIN, n0, F.ws + WS_WIN + (size_t)l * DIN * D, (float*)(F.ws + WS_SWIN) + l * DIN, n0); }
    }
    __syncthreads();
}
__device__ __forceinline__ void rms_row_to_i8(const float* xrow, const float* g, unsigned char* orow, float* sa, int lane) {
    const f32x4* xr = (const f32x4*)xrow + lane; const f32x4* gr = (const f32x4*)g + lane;
    f32x4 v[4]; float s = 0.f;
#pragma unroll
    for (int j = 0; j < 4; ++j) { v[j] = xr[64 * j]; s += (v[j].x * v[j].x + v[j].y * v[j].y) + (v[j].z * v[j].z + v[j].w * v[j].w); }
    const float rstd = 1.0f / sqrtf(wave_sum(s) * (1.f / D) + RMS_EPS); float am = 0.f;
#pragma unroll
    for (int j = 0; j < 4; ++j) { v[j] = v[j] * rstd * gr[64 * j]; am = fmaxf(fmaxf(am, fmaxf(fabsf(v[j].x), fabsf(v[j].y))), fmaxf(fabsf(v[j].z), fabsf(v[j].w))); }
    am = wave_max(am); const float inv = am > 0.f ? 127.0f / am : 0.f;
#pragma unroll
    for (int j = 0; j < 4; ++j) ((unsigned*)orow + lane)[64 * j] = ((unsigned)__float2int_rn(v[j].x * inv) & 0xffu) | (((unsigned)__float2int_rn(v[j].y * inv) & 0xffu) << 8) | (((unsigned)__float2int_rn(v[j].z * inv) & 0xffu) << 16) | (((unsigned)__float2int_rn(v[j].w * inv) & 0xffu) << 24);
    if (lane == 0) *sa = am > 0.f ? am * (1.0f / 127.0f) : 1.0f;
}
__device__ __forceinline__ void p0_prologue(Frame& F0) {
    Frame F = F0; { int t_ = threadIdx.x; asm volatile("" : "+v"(t_)); F.tid = t_; F.lane = t_ & 63; F.wave = __builtin_amdgcn_readfirstlane(t_ >> 6); }
    LAS float* scr = (LAS float*)(F.lds + F.wave * 16896);
    const int gw = F.bid * 8 + F.wave, NGW = F.G * 8, gt = F.bid * 512 + F.tid, NGT = F.G * 512;
    { v4u z = (v4u){0u, 0u, 0u, 0u}; v4u* L = (v4u*)(F.ws + WS_LIST); for (int i = gt; i < (int)(NE * T / 4); i += NGT) L[i] = z;
      int* id = (int*)(F.ws + WS_LISTID); for (int i = gt; i < T; i += NGT) id[i] = i; }
    int base = 0;
    for (int l = 0; l < DEPTH; ++l) {
#if !I8_PROJ
        p0_matrix(F.w_in + (size_t)l * D * DIN, D, DIN, (bf16*)(F.ws + WS_WIN) + (size_t)l * DIN * D, -1, scr, F.lane, gw, NGW, base);
#endif
        p0_matrix(F.w_out + (size_t)l * D * D, D, D, (bf16*)(F.ws + WS_WOUT) + (size_t)l * D * D, -1, scr, F.lane, gw, NGW, base);
        for (int g = 0; g < 4; ++g) p0_matrix(F.pool_w + (size_t)(l * 4 + g) * 128 * 128, 128, 128, (bf16*)(F.ws + WS_WP) + (size_t)(l * 4 + g) * 128 * 128, -1, scr, F.lane, gw, NGW, base);
    }
#if !I8_DENSE
    p0_matrix(F.dwg, D, DFF, (bf16*)(F.ws + WS_WGU0), 0, scr, F.lane, gw, NGW, base);
    p0_matrix(F.dwu, D, DFF, (bf16*)(F.ws + WS_WGU0), 1, scr, F.lane, gw, NGW, base);
#endif
#if FP8_DDOWN
    p0_matrix_fp8(F.dwd, DFF, D, F.ws + WS_WD0, -1, W8_DN, scr, F.lane, gw, NGW, base);
#else
    p0_matrix(F.dwd, DFF, D, (bf16*)(F.ws + WS_WD0), -1, scr, F.lane, gw, NGW, base);
#endif
    for (int e = 0; e < NE; ++e) {
#if FP8_MOE
#if FP6_UP
        p0_matrix_fp6(F.mwg + (size_t)e * D * DFFE, D, DFFE, F.ws + WS_WGUM + (size_t)e * 2 * DFFE * D, 0, S6W, scr, F.lane, gw, NGW, base);
        p0_matrix_fp6(F.mwu + (size_t)e * D * DFFE, D, DFFE, F.ws + WS_WGUM + (size_t)e * 2 * DFFE * D, 1, S6W, scr, F.lane, gw, NGW, base);
#else
        p0_matrix_fp8(F.mwg + (size_t)e * D * DFFE, D, DFFE, F.ws + WS_WGUM + (size_t)e * 2 * DFFE * D, 0, W8_UP, scr, F.lane, gw, NGW, base);
        p0_matrix_fp8(F.mwu + (size_t)e * D * DFFE, D, DFFE, F.ws + WS_WGUM + (size_t)e * 2 * DFFE * D, 1, W8_UP, scr, F.lane, gw, NGW, base);
#endif
        p0_matrix_fp8(F.mwd + (size_t)e * DFFE * D, DFFE, D, F.ws + WS_WDM + (size_t)e * D * DFFE, -1, W8_DN, scr, F.lane, gw, NGW, base);
#else
        p0_matrix(F.mwg + (size_t)e * D * DFFE, D, DFFE, (bf16*)(F.ws + WS_WGUM) + (size_t)e * 2 * DFFE * D, 0, scr, F.lane, gw, NGW, base);
        p0_matrix(F.mwu + (size_t)e * D * DFFE, D, DFFE, (bf16*)(F.ws + WS_WGUM) + (size_t)e * 2 * DFFE * D, 1, scr, F.lane, gw, NGW, base);
        p0_matrix(F.mwd + (size_t)e * DFFE * D, DFFE, D, (bf16*)(F.ws + WS_WDM) + (size_t)e * D * DFFE, -1, scr, F.lane, gw, NGW, base);
#endif
    }
    bf16* HN = (bf16*)(F.ws + WS_HN);
#if I8_PROJ
    for (int m = gw; m < T; m += NGW) rms_row_to_i8(F.x + (size_t)m * D, F.g_mpre, (unsigned char*)HN + (size_t)m * D, (float*)(F.ws + WS_SA) + m, F.lane);
#else
    for (int m = gw; m < T; m += NGW) rms_row_to_bf16(F.x + (size_t)m * D, F.g_mpre, HN + (size_t)m * D, F.lane);
#endif
#if I8_DENSE || I8_PROJ
    p0_i8_weights(F);
#endif
}

__device__ __forceinline__ unsigned ld_cnt(const unsigned* ctl, int e) { return __hip_atomic_load(ctl + CW_CNT + 64 * e, RLX_AGENT); }

__device__ __forceinline__ void ld_bf16_row(const bf16* row, int lane, f32x4 (&v)[4]) {
    const v2u* p = (const v2u*)row + lane;
#pragma unroll
    for (int j = 0; j < 4; ++j) { const v2u w = p[64 * j]; v[j] = (f32x4){bflo(w.x), bfhi(w.x), bflo(w.y), bfhi(w.y)}; }
}
__device__ __forceinline__ float sumsq16(const f32x4 (&v)[4]) {
    float s = 0.f;
#pragma unroll
    for (int j = 0; j < 4; ++j) s += (v[j].x * v[j].x + v[j].y * v[j].y) + (v[j].z * v[j].z + v[j].w * v[j].w);
    return s;
}
#define H16 FP8_MOE
struct NormRow { v2u a[4]; v2u b[4]; f32x4 hf[4]; v2u hb[4]; float g0, g1; };
template <bool FFN>
__device__ __forceinline__ void norm_phase(Frame& F0, int l) {
    Frame F = F0; { int t_ = threadIdx.x; asm volatile("" : "+v"(t_)); F.tid = t_; F.lane = t_ & 63; F.wave = __builtin_amdgcn_readfirstlane(t_ >> 6); }
    const int lane = F.lane, gw = F.bid * 8 + F.wave, NGW = F.G * 8;
    const bool moe = (l & 1) != 0;
    LAS float* WR = (LAS float*)F.lds;
    LAS unsigned* lcnt = (LAS unsigned*)(F.lds + LCNT_OFF); LAS unsigned* lbase = lcnt + 8;
    LAS int* bst = (LAS int*)(F.lds + BST_OFF);
    LAS float* rowbuf = (LAS float*)(F.lds + 32768 + F.wave * 4352);
    if (!FFN && moe) {
        for (int i = F.tid; i < D * NE; i += 512) { const int d = i >> 3, e = i & 7; WR[e * D + d] = F.router[i]; }
        if (F.tid < 8) lcnt[F.tid] = 0u;
        __syncthreads();
    }
    if (FFN && moe) {
        if (F.tid == 0) { int s = 0; for (int e = 0; e < NE; ++e) { bst[e] = s; s += (int)((ld_cnt(F.ctl, e) + 255u) >> 8); } }
        __syncthreads();
    }
    const float* gA = FFN ? F.g_fpost + l * D : F.g_mpost + l * D;
    const float* gB = FFN ? F.g_mpre + (l + 1) * D : F.g_fpre + l * D;
    const bool haveB = FFN ? (l + 1 < DEPTH) : true;
    const bool last = FFN && (l + 1 == DEPTH);
    const bool I8HN = FFN ? (I8_PROJ != 0) : (I8_DENSE && !moe);
    const bool hold_f32 = (!FFN && l == 0) || !H16;
    const bf16* addsrc = FFN ? (const bf16*)(F.ws + WS_Y) : (const bf16*)(F.ws + WS_MIX);
    const float* hold32 = (!FFN && l == 0) ? F.x : F.out;
    bf16* H = (bf16*)(F.ws + WS_H16);
    bf16* HN = (bf16*)(F.ws + WS_HN);
    const v2u* info = (const v2u*)(F.ws + WS_INFO); const f32x2* ginfo = (const f32x2*)(F.ws + WS_INFO + 256 * 1024);
#define NORM_LOAD(R, m_, nf_, gg_) do { \
        if (FFN && moe) { const int e0_ = (int)((nf_).x >> 16), p0_ = (int)((nf_).x & 0xffffu), e1_ = (int)((nf_).y >> 16), p1_ = (int)((nf_).y & 0xffffu); \
            const v2u* pa_ = (const v2u*)(addsrc + (size_t)(256 * bst[e0_] + p0_) * D) + lane; const v2u* pb_ = (const v2u*)(addsrc + (size_t)(256 * bst[e1_] + p1_) * D) + lane; \
            _Pragma("unroll") for (int j = 0; j < 4; ++j) { (R).a[j] = pa_[64 * j]; (R).b[j] = pb_[64 * j]; } (R).g0 = (gg_).x; (R).g1 = (gg_).y; } \
        else { const v2u* pa_ = (const v2u*)(addsrc + (size_t)(m_) * D) + lane; _Pragma("unroll") for (int j = 0; j < 4; ++j) (R).a[j] = pa_[64 * j]; } \
        if (hold_f32) { const f32x4* hp_ = (const f32x4*)(hold32 + (size_t)(m_) * D) + lane; _Pragma("unroll") for (int j = 0; j < 4; ++j) (R).hf[j] = hp_[64 * j]; } \
        else { const v2u* hp_ = (const v2u*)(H + (size_t)(m_) * D) + lane; _Pragma("unroll") for (int j = 0; j < 4; ++j) (R).hb[j] = hp_[64 * j]; } } while (0)
    int sTok = 0, sE0 = 0, sE1 = 0; float sG0 = 0.f, sG1 = 0.f;
    v2u nfL = (v2u){0u, 0u}; f32x2 ggL = (f32x2){0.f, 0.f};
    if (FFN && moe) { const int mi = gw + lane * NGW; if (mi < T) { nfL = info[mi]; ggL = ginfo[mi]; } }
    const int nfLx = (int)nfL.x, nfLy = (int)nfL.y; const float ggLx_ = ggL.x, ggLy_ = ggL.y; const int ggLx = __float_as_int(ggLx_), ggLy = __float_as_int(ggLy_);
#define NORM_INFO(nf_, gg_, it_) do { if (FFN && moe) { const int x_ = __builtin_amdgcn_readlane(nfLx, it_), y_ = __builtin_amdgcn_readlane(nfLy, it_), gx_ = __builtin_amdgcn_readlane(ggLx, it_), gy_ = __builtin_amdgcn_readlane(ggLy, it_); \
        (nf_).x = (unsigned)x_; (nf_).y = (unsigned)y_; (gg_).x = __int_as_float(gx_); (gg_).y = __int_as_float(gy_); } } while (0)
#define NORM_ROW(R, m_, it_) do { \
        f32x4 a[4]; \
        _Pragma("unroll") for (int j = 0; j < 4; ++j) { a[j] = (f32x4){bflo((R).a[j].x), bfhi((R).a[j].x), bflo((R).a[j].y), bfhi((R).a[j].y)}; \
            if (FFN && moe) { const f32x4 b = (f32x4){bflo((R).b[j].x), bfhi((R).b[j].x), bflo((R).b[j].y), bfhi((R).b[j].y)}; a[j] = a[j] * (R).g0 + b * (R).g1; } } \
        const float r1 = 1.0f / sqrtf(wave_sum(sumsq16(a)) * (1.f / D) + RMS_EPS); \
        const f32x4* gAp = (const f32x4*)gA + lane; \
        f32x4 h[4]; \
        _Pragma("unroll") for (int j = 0; j < 4; ++j) { const f32x4 ho = hold_f32 ? (R).hf[j] : (f32x4){bflo((R).hb[j].x), bfhi((R).hb[j].x), bflo((R).hb[j].y), bfhi((R).hb[j].y)}; h[j] = ho + a[j] * r1 * gAp[64 * j]; } \
        if (last || !H16) { f32x4* op = (f32x4*)(F.out + (size_t)(m_) * D) + lane; _Pragma("unroll") for (int j = 0; j < 4; ++j) __builtin_nontemporal_store(h[j], op + 64 * j); }   \
        else { v2u* op = (v2u*)(H + (size_t)(m_) * D) + lane; _Pragma("unroll") for (int j = 0; j < 4; ++j) { v2u w; w.x = cvt_pk_bf16(h[j].x, h[j].y); w.y = cvt_pk_bf16(h[j].z, h[j].w); op[64 * j] = w; } } \
        if (haveB) { \
            const float r2 = 1.0f / sqrtf(wave_sum(sumsq16(h)) * (1.f / D) + RMS_EPS); \
            const f32x4* gBp = (const f32x4*)gB + lane; v2u* o8 = (v2u*)(HN + (size_t)(m_) * D) + lane; \
            _Pragma("unroll") for (int j = 0; j < 4; ++j) { h[j] = h[j] * r2 * gBp[64 * j]; \
                if (FP8_MOE && FP6_UP && !FFN && moe) { const int e_ = 256 * j + 4 * lane, ix_ = e_ + (e_ >> 5); rowbuf[ix_] = h[j].x * S6A; rowbuf[ix_ + 1] = h[j].y * S6A; rowbuf[ix_ + 2] = h[j].z * S6A; rowbuf[ix_ + 3] = h[j].w * S6A; } \
                else if (FP8_MOE && !FFN && moe) { int w = 0; w = __builtin_amdgcn_cvt_pk_fp8_f32(h[j].x, h[j].y, w, false); w = __builtin_amdgcn_cvt_pk_fp8_f32(h[j].z, h[j].w, w, true); ((unsigned*)((unsigned char*)HN + (size_t)(m_) * D) + lane)[64 * j] = (unsigned)w; } \
                else if (!I8HN) { v2u w; w.x = cvt_pk_bf16(h[j].x, h[j].y); w.y = cvt_pk_bf16(h[j].z, h[j].w); o8[64 * j] = w; } } \
            if (FP8_MOE && FP6_UP && !FFN && moe) { asm volatile("s_waitcnt lgkmcnt(0)" ::: "memory"); \
                if (lane < 32) { f32x16 x_, y_; _Pragma("unroll") for (int i = 0; i < 16; ++i) { x_[i] = rowbuf[33 * lane + i]; y_[i] = rowbuf[33 * lane + 16 + i]; } \
                    const i32x6 o_ = __builtin_amdgcn_cvt_scalef32_2xpk16_fp6_f32(x_, y_, 1.0f); unsigned char* rp_ = (unsigned char*)HN + (size_t)(m_) * D + 128 * (lane >> 2); \
                    *(v4u*)(rp_ + 16 * (lane & 3)) = (v4u){(unsigned)o_[0], (unsigned)o_[1], (unsigned)o_[2], (unsigned)o_[3]}; *(v4u*)(rp_ + 64 + 16 * (lane & 3)) = (v4u){(unsigned)o_[4], (unsigned)o_[5], 0u, 0u}; } \
                asm volatile("s_waitcnt lgkmcnt(0)" ::: "memory"); } \
            if (I8HN) { float am = 0.f; \
                _Pragma("unroll") for (int j = 0; j < 4; ++j) am = fmaxf(fmaxf(am, fmaxf(fabsf(h[j].x), fabsf(h[j].y))), fmaxf(fabsf(h[j].z), fabsf(h[j].w))); \
                am = wave_max(am); const float sa_ = am > 0.f ? am * (1.0f / 127.0f) : 1.0f, inv_ = am > 0.f ? 127.0f / am : 0.f; \
                _Pragma("unroll") for (int j = 0; j < 4; ++j) { const unsigned w = ((unsigned)__float2int_rn(h[j].x * inv_) & 0xffu) | (((unsigned)__float2int_rn(h[j].y * inv_) & 0xffu) << 8) | (((unsigned)__float2int_rn(h[j].z * inv_) & 0xffu) << 16) | (((unsigned)__float2int_rn(h[j].w * inv_) & 0xffu) << 24); \
                    ((unsigned*)((unsigned char*)HN + (size_t)(m_) * D) + lane)[64 * j] = w; } \
                if (lane == 0) ((float*)(F.ws + WS_SA))[(m_)] = sa_; } \
            if (!FFN && moe) { \
                float lg[NE]; \
                _Pragma("unroll") for (int e = 0; e < NE; ++e) { float s_ = 0.f; \
                    _Pragma("unroll") for (int j = 0; j < 4; ++j) { const f32x4 w = *(const LAS f32x4*)(WR + e * D + 256 * j + 4 * lane); s_ += (h[j].x * w.x + h[j].y * w.y) + (h[j].z * w.z + h[j].w * w.w); } \
                    lg[e] = wave_sum(s_); } \
                int e0 = 0; float l0 = lg[0]; \
                _Pragma("unroll") for (int e = 1; e < NE; ++e) if (lg[e] > l0) { l0 = lg[e]; e0 = e; } \
                int e1 = -1; float l1 = -INFINITY; \
                _Pragma("unroll") for (int e = 0; e < NE; ++e) if (e != e0 && lg[e] > l1) { l1 = lg[e]; e1 = e; } \
                const float g0 = 1.0f / (1.0f + __expf(l1 - l0)), g1 = 1.0f - g0; \
                if (lane == (it_)) { sTok = (m_); sE0 = e0; sE1 = e1; sG0 = g0; sG1 = g1; } \
            } \
        } } while (0)
    int it = 0;
    NormRow c0, c1; v2u nf = (v2u){0u, 0u}; f32x2 gg = (f32x2){0.f, 0.f};
    if (gw < T) { NORM_INFO(nf, gg, 0); NORM_LOAD(c0, gw, nf, gg); }
    if (gw + NGW < T) { NORM_INFO(nf, gg, 1); NORM_LOAD(c1, gw + NGW, nf, gg); }
    for (int m = gw; m < T; m += 2 * NGW, it += 2) {
        const int m1 = m + NGW, m2 = m + 2 * NGW, m3 = m + 3 * NGW;
        NormRow n0, n1;
        if (m2 < T) { NORM_INFO(nf, gg, it + 2); NORM_LOAD(n0, m2, nf, gg); }
        if (m3 < T) { NORM_INFO(nf, gg, it + 3); NORM_LOAD(n1, m3, nf, gg); }
        NORM_ROW(c0, m, it);
        if (m1 < T) NORM_ROW(c1, m1, it + 1);
        c0 = n0; c1 = n1;
    }
    it = (T - gw + NGW - 1) / NGW; if (it < 0) it = 0;
#undef NORM_ROW
#undef NORM_INFO
#undef NORM_LOAD
    if (!FFN && moe) {
        unsigned loc0 = 0u, loc1 = 0u;
        if (lane < it) { loc0 = __hip_atomic_fetch_add(lcnt + sE0, 1u, __ATOMIC_RELAXED, __HIP_MEMORY_SCOPE_WORKGROUP); loc1 = __hip_atomic_fetch_add(lcnt + sE1, 1u, __ATOMIC_RELAXED, __HIP_MEMORY_SCOPE_WORKGROUP); }
        __syncthreads();
        if (F.tid < 8) lbase[F.tid] = __hip_atomic_fetch_add(F.ctl + CW_CNT + 64 * F.tid, lcnt[F.tid], RLX_AGENT);
        __syncthreads();
        if (lane < it) {
            const unsigned p0 = lbase[sE0] + loc0, p1 = lbase[sE1] + loc1;
            int* list = (int*)(F.ws + WS_LIST);
            list[(size_t)sE0 * T + p0] = sTok; list[(size_t)sE1 * T + p1] = sTok;
            v2u nf; nf.x = ((unsigned)sE0 << 16) | p0; nf.y = ((unsigned)sE1 << 16) | p1;
            ((v2u*)(F.ws + WS_INFO))[sTok] = nf; ((f32x2*)(F.ws + WS_INFO + 256 * 1024))[sTok] = (f32x2){sG0, sG1};
        }
    }
}

__device__ __forceinline__ size_t mixo_index(size_t tok, int ch) { return ((tok >> 8) * 16 + (size_t)(ch >> 6)) * (256 * 64) + (tok & 255) * 64 + (ch & 63); }
constexpr int U_PITCH = 1040, U_ROWS = 80, BIAS_OFF = U_PITCH * U_ROWS;
typedef __bf16 bf16x2_t __attribute__((ext_vector_type(2)));
template <int HW>
__device__ __forceinline__ void pool_frags(bf16x8 (&dfr)[2][4], const LAS unsigned char* cb, const float (&inv)[2]) {
    unsigned one_lo_ = 0x00003f80u, one_hi_ = 0x3f800000u; asm volatile("" : "+v"(one_lo_), "+v"(one_hi_));
    const bf16x2_t ONE_LO = __builtin_bit_cast(bf16x2_t, one_lo_), ONE_HI = __builtin_bit_cast(bf16x2_t, one_hi_);
#pragma unroll
    for (int mt = 0; mt < 2; ++mt)
#pragma unroll
        for (int ks = 0; ks < 4; ++ks) {
            const LAS unsigned char* cp = cb + mt * 16 * U_PITCH + ks * 64;
            float s0 = 0.f, s1 = 0.f, s2 = 0.f, s3 = 0.f, s4 = 0.f, s5 = 0.f, s6 = 0.f, s7 = 0.f;
#pragma unroll
            for (int d = -HW; d < HW; ++d) { const v4u v = *(const LAS v4u*)(cp + d * U_PITCH); const unsigned vx = v.x, vy = v.y, vz = v.z, vw = v.w;
                const bf16x2_t px = __builtin_bit_cast(bf16x2_t, vx), py = __builtin_bit_cast(bf16x2_t, vy), pz = __builtin_bit_cast(bf16x2_t, vz), pw = __builtin_bit_cast(bf16x2_t, vw);
                s0 = __builtin_amdgcn_fdot2_f32_bf16(px, ONE_LO, s0, false); s1 = __builtin_amdgcn_fdot2_f32_bf16(px, ONE_HI, s1, false);
                s2 = __builtin_amdgcn_fdot2_f32_bf16(py, ONE_LO, s2, false); s3 = __builtin_amdgcn_fdot2_f32_bf16(py, ONE_HI, s3, false);
                s4 = __builtin_amdgcn_fdot2_f32_bf16(pz, ONE_LO, s4, false); s5 = __builtin_amdgcn_fdot2_f32_bf16(pz, ONE_HI, s5, false);
                s6 = __builtin_amdgcn_fdot2_f32_bf16(pw, ONE_LO, s6, false); s7 = __builtin_amdgcn_fdot2_f32_bf16(pw, ONE_HI, s7, false); }
            const v4u c = *(const LAS v4u*)cp; const float iv = inv[mt];
            v4u p; p.x = cvt_pk_bf16(s0 * iv - bflo(c.x), s1 * iv - bfhi(c.x)); p.y = cvt_pk_bf16(s2 * iv - bflo(c.y), s3 * iv - bfhi(c.y));
            p.z = cvt_pk_bf16(s4 * iv - bflo(c.z), s5 * iv - bfhi(c.z)); p.w = cvt_pk_bf16(s6 * iv - bflo(c.w), s7 * iv - bfhi(c.w));
            dfr[mt][ks] = __builtin_bit_cast(bf16x8, p);
        }
}
__device__ __forceinline__ void mixer_phase(Frame& F0, int l) {
    Frame F = F0; { int t_ = threadIdx.x; asm volatile("" : "+v"(t_)); F.tid = t_; F.lane = t_ & 63; F.wave = __builtin_amdgcn_readfirstlane(t_ >> 6); }
    const int tid = F.tid, lane = F.lane, wid = F.wave, fr = lane & 15, fq = lane >> 4;
    const bf16* proj = (const bf16*)(F.ws + WS_PROJ); bf16* mixo = (bf16*)(F.ws + WS_MIXO);
    const bf16* Wp = (const bf16*)(F.ws + WS_WP) + (size_t)l * 4 * 128 * 128; const float* pscale = F.pool_scale + l * DPOOL;
    const int vcu = (F.G % 8 == 0) ? (F.bid % 8) * (F.G / 8) + F.bid / 8 : F.bid;
    for (int unit = vcu; unit < BATCH * GROWS; unit += F.G) {
        const int b = unit / GROWS, r = unit % GROWS, tb0 = b * SEQ, trow0 = 64 * r - 8;
        __syncthreads();
        { v4u uv[10];
#pragma unroll
          for (int k = 0; k < 10; ++k) { const int idx = tid + 512 * k, row = idx >> 6, pc = idx & 63, t = trow0 + row; uv[k] = (v4u){0u, 0u, 0u, 0u}; if (t >= 0 && t < SEQ) uv[k] = *(const v4u*)(proj + (size_t)(tb0 + t) * UPITCH + pc * 8); }
#pragma unroll
          for (int k = 0; k < 10; ++k) { const int idx = tid + 512 * k, row = idx >> 6, pc = idx & 63; *(LAS v4u*)(F.lds + row * U_PITCH + pc * 16) = uv[k]; } }
        __syncthreads();
#ifndef REP_POOL
#define REP_POOL 1
#endif
        for (int rep_ = 0; rep_ < REP_POOL; ++rep_) {
            const int g = wid >> 1, half = wid & 1, hw = 1 << g;
            const bf16* Wg = Wp + (size_t)g * 128 * 128;
            bf16x8 wnext[4];
#pragma unroll
            for (int ks = 0; ks < 4; ++ks) wnext[ks] = *(const bf16x8*)(Wg + (size_t)fr * 128 + 32 * ks + 8 * fq);
            bf16x8 dfr[2][4];
            { const LAS unsigned char* cb = F.lds + (8 + 32 * half + fr) * U_PITCH + (128 * g + 8 * fq) * 2;
              float inv[2];
#pragma unroll
              for (int mt = 0; mt < 2; ++mt) { const int t = 64 * r + 32 * half + 16 * mt + fr; inv[mt] = 1.0f / (float)(min(t + hw, SEQ) - max(t - hw, 0)); }
              switch (g) { case 0: pool_frags<1>(dfr, cb, inv); break; case 1: pool_frags<2>(dfr, cb, inv); break; case 2: pool_frags<4>(dfr, cb, inv); break; default: pool_frags<8>(dfr, cb, inv); break; } }
#pragma unroll
            for (int nt = 0; nt < 8; ++nt) {
                bf16x8 wf[4];
#pragma unroll
                for (int ks = 0; ks < 4; ++ks) wf[ks] = wnext[ks];
                if (nt + 1 < 8) {
#pragma unroll
                    for (int ks = 0; ks < 4; ++ks) wnext[ks] = *(const bf16x8*)(Wg + (size_t)(16 * (nt + 1) + fr) * 128 + 32 * ks + 8 * fq); }
                const f32x4 sc = *(const f32x4*)(pscale + 128 * g + 16 * nt + 4 * fq);
#pragma unroll
                for (int mt = 0; mt < 2; ++mt) {
                    f32x4 acc = (f32x4){0.f, 0.f, 0.f, 0.f};
#pragma unroll
                    for (int ks = 0; ks < 4; ++ks) acc = __builtin_amdgcn_mfma_f32_16x16x32_bf16(wf[ks], dfr[mt][ks], acc, 0, 0, 0);
                    acc = acc * sc;
                    v2u w; w.x = cvt_pk_bf16(acc[0], acc[1]); w.y = cvt_pk_bf16(acc[2], acc[3]);
                    *(v2u*)(mixo + mixo_index((size_t)(tb0 + 64 * r + 32 * half + 16 * mt + fr), 128 * g + 16 * nt + 4 * fq)) = w;
                }
            }
        }
    }
    __syncthreads();
}

constexpr int NA_KTOK = 80, NA_KROW = 64 * NA_KTOK, NA_VD = 144, NA_VROW = 32 * NA_VD, NA_NKR = 11, NA_NPC = NA_NKR * 256;
constexpr int NA_K_OFF = 0, NA_V_OFF = NA_NKR * NA_KROW, NA_B_OFF = NA_V_OFF + NA_NKR * NA_VROW;
static_assert(NA_B_OFF + 15 * 128 <= RING_BYTES, "NA LDS map");
#ifndef REP_NA
#define REP_NA 1
#endif
__device__ __forceinline__ void na_phase(Frame& F0, int l) {
    Frame F = F0; { int t_ = threadIdx.x; asm volatile("" : "+v"(t_)); F.tid = t_; F.lane = t_ & 63; F.wave = __builtin_amdgcn_readfirstlane(t_ >> 6); }
    const int tid = F.tid, lane = F.lane, wid = F.wave, fr = lane & 15, fq = lane >> 4;
    const bf16* projq = (const bf16*)(F.ws + WS_PQ); const bf16* projk = (const bf16*)(F.ws + WS_PK); const bf16* Vt = (const bf16*)(F.ws + WS_VT); bf16* mixo = (bf16*)(F.ws + WS_MIXO);
    const float* rpb = F.rpb + (size_t)l * NH * 15 * 31;
    const int vcu = (F.G % 8 == 0) ? (F.bid % 8) * (F.G / 8) + F.bid / 8 : F.bid;
    constexpr int NU = BATCH * NH * (GROWS / 4);
    const int upc = (NU + F.G - 1) / F.G, u0 = vcu * upc, u1 = min(u0 + upc, NU);
    v4u kreg[6], vreg[6];
    int w_hi = -1, w_bh = -1;
#define NA_UNIT(u, b, h, sg, krlo, nrows) const int b = (u) / (NH * 64), h = ((u) / 64) % NH, sg = (u) % 64, krlo = min(max(4 * sg - 4, 0), GROWS - KH), nrows = min(NA_NKR, GROWS - krlo)
#define NA_PLAN(u, newlo, nnew) NA_UNIT(u, pb_, ph_, psg_, pkrlo_, pnrows_); const bool keep_ = ((u) / 64 == w_bh) && pkrlo_ <= w_hi && pkrlo_ + NA_NKR > w_hi - 1; \
        const int newlo = keep_ ? max(pkrlo_, w_hi) : pkrlo_, nnew = pkrlo_ + pnrows_ - newlo; (void)psg_
#define NA_LOAD(newlo, nnew, b_, h_) do { const size_t tb_ = (size_t)(b_) * SEQ + 64 * (newlo); \
        _Pragma("unroll") for (int k = 0; k < 6; ++k) { const int p = tid + 512 * k, row = p >> 8, rem = p & 255; \
            if (row < (nnew)) { kreg[k] = *(const v4u*)(projk + ((size_t)(h_) * T + tb_ + 64 * row + (rem >> 2)) * 32 + 8 * (rem & 3)); \
                vreg[k] = *(const v4u*)(Vt + vt_index(32 * (h_) + (rem >> 3), (int)tb_ + 64 * row) + 8 * (rem & 7)); } } } while (0)
    int c_newlo = 0, c_nnew = 0;
    if (u0 < u1) { NA_PLAN(u0, nl_, nn_); c_newlo = nl_; c_nnew = nn_; NA_LOAD(nl_, nn_, pb_, ph_); }
    for (int u = u0; u < u1; ++u) {
        NA_UNIT(u, b, h, sg, krlo, nrows);
        __syncthreads();
#pragma unroll
        for (int k = 0; k < 6; ++k) { const int p = tid + 512 * k, row = p >> 8, rem = p & 255;
            if (row < c_nnew) { const int slot = (c_newlo + row) % NA_NKR;
                *(LAS v4u*)(F.lds + NA_K_OFF + slot * NA_KROW + (rem >> 2) * NA_KTOK + 16 * (rem & 3)) = kreg[k];
                *(LAS v4u*)(F.lds + NA_V_OFF + slot * NA_VROW + (rem >> 3) * NA_VD + 16 * (rem & 7)) = vreg[k]; } }
        if (tid < 15 * 32) { const int col = tid & 31, row = tid >> 5; *(LAS float*)(F.lds + NA_B_OFF + tid * 4) = col < 31 ? rpb[(h * 15 + row) * 31 + col] * LOG2E : -INFINITY; }
        __syncthreads();
        w_hi = krlo + nrows; w_bh = u / 64;
        if (u + 1 < u1) { NA_PLAN(u + 1, nl_, nn_); c_newlo = nl_; c_nnew = nn_; NA_LOAD(nl_, nn_, pb_, ph_); }
        const size_t tb0 = (size_t)b * SEQ;
#pragma unroll 1
        for (int tt = 0; tt < 2; ++tt) {
            const int t = wid + 8 * tt, j = t >> 2, qb = t & 3, r = 4 * sg + j, r0 = min(max(r - KH / 2, 0), GROWS - KH);
            const int cs = qb == 0 ? 0 : (qb == 1 ? 8 : (qb == 2 ? 24 : 32));
            const int c = 16 * qb + fr, c0 = min(max(c - KW / 2, 0), GRIDW - KW);
            const int th = c0 - cs;
            bool vq[4]; int boff[4];
#pragma unroll
            for (int q = 0; q < 4; ++q) { vq[q] = (4 * fq + q) >= th; boff[q] = (cs + 4 * fq + q + (vq[q] ? 0 : 16) - c + KW - 1) * 4; }
            const unsigned M0 = (vq[0] ? 0xffffu : 0u) | (vq[1] ? 0xffff0000u : 0u), M1 = (vq[2] ? 0xffffu : 0u) | (vq[3] ? 0xffff0000u : 0u), N0 = ~M0, N1 = ~M1;
            const size_t qtok = tb0 + 64 * r + 16 * qb + fr;
            const bf16x8 qf = *(const bf16x8*)(projq + ((size_t)h * T + qtok) * 32 + 8 * fq);
            int slot[KH];
#pragma unroll
            for (int kr = 0; kr < KH; ++kr) slot[kr] = (r0 + kr) % NA_NKR;
            const LAS unsigned char* kb = F.lds + NA_K_OFF + (cs + fr) * NA_KTOK + 16 * fq;
            const LAS unsigned char* bb = F.lds + NA_B_OFF + (r0 - r + KH - 1) * 128;
            f32x2 sv[KH][2];
            float mx = -INFINITY;
#pragma unroll
            for (int kr = 0; kr < KH; ++kr) {
                f32x4 bv;
#pragma unroll
                for (int q = 0; q < 4; ++q) bv[q] = *(const LAS float*)(bb + boff[q] + kr * 128);
                const f32x4 s0 = __builtin_amdgcn_mfma_f32_16x16x32_bf16(*(const LAS bf16x8*)(kb + slot[kr] * NA_KROW), qf, bv, 0, 0, 0);
                const f32x4 s1 = __builtin_amdgcn_mfma_f32_16x16x32_bf16(*(const LAS bf16x8*)(kb + slot[kr] * NA_KROW + 16 * NA_KTOK), qf, bv, 0, 0, 0);
                const float e0 = vq[0] ? s0[0] : s1[0], e1 = vq[1] ? s0[1] : s1[1], e2 = vq[2] ? s0[2] : s1[2], e3 = vq[3] ? s0[3] : s1[3];
                sv[kr][0] = (f32x2){e0, e1}; sv[kr][1] = (f32x2){e2, e3};
                mx = fmaxf(fmaxf(mx, e0), e1); mx = fmaxf(fmaxf(mx, e2), e3);
            }
            mx = fmaxf(mx, __shfl_xor(mx, 16)); mx = fmaxf(mx, __shfl_xor(mx, 32));
            const f32x2 mx2 = (f32x2){mx, mx};
            f32x2 sum2 = (f32x2){0.f, 0.f};
#pragma unroll
            for (int kr = 0; kr < KH; ++kr)
#pragma unroll
                for (int hh = 0; hh < 2; ++hh) { const f32x2 dlt = sv[kr][hh] - mx2; f32x2 p; p.x = __builtin_amdgcn_exp2f(dlt.x); p.y = __builtin_amdgcn_exp2f(dlt.y); sv[kr][hh] = p; sum2 += p; }
            float sum = sum2.x + sum2.y;
            sum += __shfl_xor(sum, 16); sum += __shfl_xor(sum, 32);
            const LAS unsigned char* vb = F.lds + NA_V_OFF + fr * NA_VD + (cs + 4 * fq) * 2;
            f32x4 o[2] = {(f32x4){0.f, 0.f, 0.f, 0.f}, (f32x4){0.f, 0.f, 0.f, 0.f}};
#pragma unroll
            for (int kr = 0; kr < KH; ++kr) {
                const unsigned u01 = cvt_pk_bf16(sv[kr][0].x, sv[kr][0].y), u23 = cvt_pk_bf16(sv[kr][1].x, sv[kr][1].y);
                v4u pw; pw.x = u01 & M0; pw.y = u23 & M1; pw.z = u01 & N0; pw.w = u23 & N1;
                const bf16x8 pf = __builtin_bit_cast(bf16x8, pw);
#pragma unroll
                for (int dt = 0; dt < 2; ++dt) {
                    const LAS unsigned char* vp = vb + slot[kr] * NA_VROW + 16 * dt * NA_VD;
                    const v2u lo = *(const LAS v2u*)vp, hi = *(const LAS v2u*)(vp + 32);
                    v4u vw; vw.x = lo.x; vw.y = lo.y; vw.z = hi.x; vw.w = hi.y;
                    o[dt] = __builtin_amdgcn_mfma_f32_16x16x32_bf16(__builtin_bit_cast(bf16x8, vw), pf, o[dt], 0, 0, 0);
                }
            }
            const float inv = __builtin_amdgcn_rcpf(sum);
            bf16* orow = mixo + mixo_index(qtok, DPOOL + 32 * h + 4 * fq);
#pragma unroll
            for (int dt = 0; dt < 2; ++dt) { v2u w; w.x = cvt_pk_bf16(o[dt][0] * inv, o[dt][1] * inv); w.y = cvt_pk_bf16(o[dt][2] * inv, o[dt][3] * inv); *(v2u*)(orow + 16 * dt) = w; }
        }
    }
    __syncthreads();
#undef NA_UNIT
#undef NA_PLAN
#undef NA_LOAD
}

struct SchedProj {
    const char* hn; const char* win; bf16* proj; bf16* vt; int G, c, esz; const float* sa; const float* sw;
    __device__ __forceinline__ bool next(int i, pg8::Unit& u) const {
        int pm, pn; if (!pg8::tile_order(i, G, c, T / 256, 8, pm, pn)) return false;
        const size_t tstep = (size_t)256 * D * esz;
        if (pn < 6) { u.A = hn + pm * tstep; u.B = win + pn * tstep; u.orow = 256 * pm;
            if (pn < 2) { u.obase = proj; u.ocol = 256 * pn; u.ldc = UPITCH; } else { u.obase = proj + (size_t)(pn >> 1) * T * 512; u.ocol = 256 * (pn & 1); u.ldc = 0; }
            u.scale = (pn == 2 || pn == 3) ? QSCALE : 1.0f; u.p0 = sa + 256 * pm; u.cs = sw + 256 * pn; }
        else { u.A = win + pn * tstep; u.B = hn + pm * tstep; u.obase = vt; u.orow = 256 * (pn - 6); u.ocol = 256 * pm; u.ldc = -1; u.scale = 1.0f; u.p0 = sw + 256 * pn; u.cs = sa + 256 * pm; }
        return true;
    }
};
struct SchedOut {
    const char* a; const char* w; bf16* o; int G, c;
    __device__ __forceinline__ bool next(int i, pg8::Unit& u) const {
        int pm, pn; if (!pg8::tile_order(i, G, c, T / 256, 4, pm, pn)) return false;
        const size_t tstep = (size_t)256 * D * 2; u.p0 = nullptr; u.cs = nullptr;
        u.A = a + pm * tstep; u.B = w + pn * tstep; u.obase = o; u.orow = 256 * pm; u.ocol = 256 * pn; u.ldc = D; u.scale = 1.0f; return true;
    }
};
__device__ __forceinline__ void ffn_table(Frame& F0, bool moe) {
    Frame F = F0; { int t_ = threadIdx.x; asm volatile("" : "+v"(t_)); F.tid = t_; F.lane = t_ & 63; F.wave = __builtin_amdgcn_readfirstlane(t_ >> 6); }
    LAS int* blk = (LAS int*)(F.lds + BLK_OFF); LAS int* bst = (LAS int*)(F.lds + BST_OFF);
    __syncthreads();
    if (F.tid == 0) { int s = 0; for (int e = 0; e < NE; ++e) { bst[e] = s; s += moe ? (int)((ld_cnt(F.ctl, e) + 255u) >> 8) : (e == 0 ? T / 256 : 0); } bst[8] = s; }
    __syncthreads();
    for (int b = F.tid; b < MAXBLK + 8; b += 512) { int e = 0; for (int k = 1; k < NE; ++k) if (b >= bst[k]) e = k; blk[b] = e; }
    __syncthreads();
}
__device__ __forceinline__ bool tail_reduce(Frame& F0) {
    int t_ = threadIdx.x; asm volatile("" : "+v"(t_));
    const int lane = t_ & 63, gw = F0.bid * 8 + __builtin_amdgcn_readfirstlane(t_ >> 6), NGW = F0.G * 8;
    int nb = 0;
    for (int e = 0; e < NE; ++e) nb += (int)((ld_cnt(F0.ctl, e) + 255u) >> 8);
    const int nrows = (nb - 256) * 256;
    if (nrows <= 0) return false;
    bf16* y = (bf16*)(F0.ws + WS_Y) + (size_t)256 * 256 * D; const bf16* part = (const bf16*)(F0.ws + WS_TAILPART);
    for (int r = gw; r < nrows; r += NGW) {
        v4u w[TAILSPLIT][2];
#pragma unroll
        for (int h = 0; h < 2; ++h) { w[0][h] = *((const v4u*)(y + (size_t)r * D) + lane + 64 * h);
#pragma unroll
            for (int p = 1; p < TAILSPLIT; ++p) w[p][h] = *((const v4u*)(part + ((size_t)(p - 1) * TAILPART_ROWS + r) * D) + lane + 64 * h); }
#pragma unroll
        for (int h = 0; h < 2; ++h) { v4u o;
#pragma unroll
            for (int j = 0; j < 4; ++j) { float lo = 0.f, hi = 0.f;
#pragma unroll
                for (int p = 0; p < TAILSPLIT; ++p) { lo += bflo(w[p][h][j]); hi += bfhi(w[p][h][j]); }
                o[j] = cvt_pk_bf16(lo, hi); }
            *((v4u*)(y + (size_t)r * D) + lane + 64 * h) = o; }
    }
    return true;
}
template <bool TILED> struct SchedUpT {
    const char* hn; const char* wgu; const int* lists; bf16* hff; LAS int* blk; LAS int* bst; int G, c, cstart, nblk, nN, F_, moe, esz;
    __device__ __forceinline__ bool next(int i, pg8::Unit& u) const {
        int pm, pn; if (!pg8::tile_order(i, G, c, nblk, nN, pm, pn)) return false;
        const int b = cstart + pm, e = __builtin_amdgcn_readfirstlane(blk[b]), lb = b - __builtin_amdgcn_readfirstlane(bst[e]);
        u.A = hn; u.p0 = lists + (moe ? (size_t)e * T + 256 * lb : (size_t)256 * b); u.cs = nullptr;
        u.B = wgu + ((size_t)e * 2 * F_ + 256 * pn) * D * esz; u.obase = hff; u.orow = 256 * pm; u.ocol = 128 * pn; u.ldc = F_; u.scale = 1.0f;
        if constexpr (TILED) { u.obase = (bf16*)((char*)hff + ((size_t)pm * nN + pn) * HFF_TILE - 128 * pn - (size_t)256 * pm * 128); }
        return true;
    }
};
template <bool TILED> struct SchedDownT {
    const char* hff; const char* wd; bf16* y; LAS int* blk; int G, c, cstart, nblk, F_, esz; float scale; const int* idl; int pm0, split;
    __device__ __forceinline__ bool next(int i, pg8::Unit& u) const {
        int pm, pn; if (!pg8::tile_order(i, G, c, nblk, 4 * split, pm, pn)) return false;
        const int p = pn >> 2; pn &= 3;
        const int b = cstart + pm, e = __builtin_amdgcn_readfirstlane(blk[b]); u.p0 = idl; u.cs = nullptr;
        const size_t koff = (size_t)p * (F_ / split) * esz;
        u.A = hff + (size_t)(pm0 + pm) * 256 * F_ * esz + (TILED ? (size_t)p * (F_ / split / 128) * HFF_TILE : koff); u.B = wd + ((size_t)e * D + 256 * pn) * F_ * esz + koff;
        const long long poff = p == 0 ? 0ll : ((long long)WS_TAILPART - (long long)WS_Y) / 2 + (long long)(p - 1) * TAILPART_ROWS * D;
        u.obase = y + poff; u.orow = p == 0 ? 256 * b : 256 * pm; u.ocol = 256 * pn; u.ldc = D; u.scale = scale; return true;
    }
};

constexpr int STEPS_PER_LAYER = 16, NSTEPS = 1 + DEPTH * STEPS_PER_LAYER;
#define RUN(s) (lo <= (s) && (s) < hi)
#ifndef BARX
#define BARX 1
#endif
#define SEAM(s) do { if (RUN(s) && RUN((s) + 1)) { for (int b_ = 0; b_ < BARX; ++b_) xcd_barrier(bar); } } while (0)
template <int L>
__device__ __forceinline__ void run_layer(Frame& F, const XcdBarrier& bar, const int lo, const int hi) {
    constexpr int l = L, base = 1 + STEPS_PER_LAYER * L; constexpr bool moe = (L & 1) != 0, f8 = FP8_MOE && moe, i8 = I8_DENSE && !moe; constexpr bool h8 = f8 || (FP8_DDOWN && !moe);
    LAS int* tokbuf = (LAS int*)(F.lds + TOKBUF_OFF); LAS int* blk = (LAS int*)(F.lds + BLK_OFF); LAS int* bst = (LAS int*)(F.lds + BST_OFF);
    const char* HN = (const char*)(F.ws + WS_HN);
#ifndef NO_P1
    if (RUN(base + 0)) {
        SchedProj S{HN, (const char*)(F.ws + WS_WIN) + (size_t)l * DIN * D * (I8_PROJ ? 1 : 2), (bf16*)(F.ws + WS_PROJ), (bf16*)(F.ws + WS_VT), F.G, F.bid, I8_PROJ ? 1 : 2, (const float*)(F.ws + WS_SA), (const float*)(F.ws + WS_SWIN) + l * DIN};
        if constexpr (I8_PROJ != 0) pg8::gemm_phase<pg8::EpiProj_I8, SchedProj, false, 2>(F.lds, tokbuf, D / 2, S, pg8::EpiProj_I8{});
        else pg8::gemm_phase<pg8::EpiProj, SchedProj, false>(F.lds, tokbuf, D, S, pg8::EpiProj{});
    } SEAM(base + 0);
#endif
#ifndef NO_P2
#ifndef NA_CALLS
#define NA_CALLS 1
#endif
#ifndef POOL_CALLS
#define POOL_CALLS 1
#endif
    if (RUN(base + 1)) { for (int i_ = 0; i_ < POOL_CALLS; ++i_) mixer_phase(F, l); for (int i_ = 0; i_ < NA_CALLS; ++i_) na_phase(F, l); } SEAM(base + 1);
#endif
#ifndef NO_P3
    if (RUN(base + 2)) {
        SchedOut S{(const char*)(F.ws + WS_MIXO), (const char*)(F.ws + WS_WOUT) + (size_t)l * D * D * 2, (bf16*)(F.ws + WS_MIX), F.G, F.bid};
        pg8::gemm_phase<pg8::EpiBf16, SchedOut, false>(F.lds, tokbuf, D, S, pg8::EpiBf16{}, D, 64, 256 * 128);
    } SEAM(base + 2);
#endif
#ifndef NO_P4
    if (RUN(base + 3)) { norm_phase<false>(F, l); } SEAM(base + 3);
#endif
    constexpr int F_ = moe ? DFFE : DFF, cblk = h8 ? 2 * CHUNK_BLK : CHUNK_BLK;
    bool table = false; int NB = 0;
    for (int c = 0; c < MAXCHUNK; ++c) {
        const int s5 = base + 4 + 2 * c, s6 = s5 + 1;
        if (!(RUN(s5) || RUN(s6))) continue;
        if (!table) { ffn_table(F, moe); NB = __builtin_amdgcn_readfirstlane(bst[8]); table = true; }
        const int cstart = c * cblk; int nblk = min(NB - cstart, cblk);
        if constexpr (f8) { if (c == 1) nblk = NB - cstart; else if (c > 1) continue; }
        if (nblk <= 0) continue;
#ifndef NO_P5
        if (RUN(s5)) {
            typedef SchedUpT<h8> SchedUp; SchedUp S{HN, moe ? (const char*)(F.ws + WS_WGUM) : (const char*)(F.ws + WS_WGU0), moe ? (const int*)(F.ws + WS_LIST) : (const int*)(F.ws + WS_LISTID), (bf16*)(F.ws + WS_HFF), blk, bst, F.G, F.bid, cstart, nblk, F_ / 128, F_, moe ? 1 : 0, (f8 || i8) ? 1 : 2};
            if constexpr (f8 && FP6_UP) pg8::gemm_phase<pg8::EpiSwiGLU6, SchedUp, true, 3>(F.lds, tokbuf, D / 2, S, pg8::EpiSwiGLU6{});
            else if constexpr (f8) pg8::gemm_phase<pg8::EpiSwiGLU8, SchedUp, true, 1>(F.lds, tokbuf, D / 2, S, pg8::EpiSwiGLU8{});
            else if constexpr (i8) pg8::gemm_phase<pg8::EpiSwiGLU_I8, SchedUp, true, 2>(F.lds, tokbuf, D / 2, S, pg8::EpiSwiGLU_I8{(const float*)(F.ws + WS_SA), (const float*)(F.ws + WS_SW0), (const int*)(F.ws + WS_LISTID)});
            else pg8::gemm_phase<pg8::EpiSwiGLU, SchedUp, true>(F.lds, tokbuf, D, S, pg8::EpiSwiGLU{});
        } SEAM(s5);
#endif
#ifndef NO_P6
        if (RUN(s6)) {
            const int nfull = h8 ? min(nblk, cblk) : nblk;
            typedef SchedDownT<h8> SchedDown; SchedDown S{(const char*)(F.ws + WS_HFF), moe ? (const char*)(F.ws + WS_WDM) : (const char*)(F.ws + WS_WD0), (bf16*)(F.ws + WS_Y), blk, F.G, F.bid, cstart, nfull, F_, h8 ? 1 : 2, h8 ? 1.0f / W8_DN : 1.0f, (const int*)(F.ws + WS_LISTID), 0, 1};
            if constexpr (h8) {
                const int npass = (f8 && nblk > nfull) ? 2 : 1;
#pragma clang loop unroll(disable)
                for (int pass = 0; pass < npass; ++pass) {
                    if (pass == 1) { S.cstart = cstart + nfull; S.nblk = nblk - nfull; S.pm0 = nfull; S.split = TAILSPLIT; }
                    pg8::gemm_phase<pg8::EpiBf16, SchedDown, true, 1>(F.lds, tokbuf, pass == 0 ? F_ / 2 : F_ / 2 / TAILSPLIT, S, pg8::EpiBf16{}, F_ / 2, 64, HFF_TILE);
                }
            }
            else pg8::gemm_phase<pg8::EpiBf16, SchedDown, false>(F.lds, tokbuf, F_, S, pg8::EpiBf16{});
        } SEAM(s6);
#endif
    }
#ifndef NO_P7
    if (RUN(base + 14)) { if constexpr (f8) { if (tail_reduce(F)) xcd_barrier(bar); } norm_phase<true>(F, l); }
#endif
    if (l + 1 < DEPTH) { if (RUN(base + 14) && RUN(base + 16)) xcd_barrier(bar); }
}
__global__ void __launch_bounds__(512, 2) mk_fwd(Args args) {
    extern __shared__ __attribute__((aligned(16))) unsigned char lds_raw[];
    Frame F;
    F.lds = (LAS unsigned char*)lds_raw; F.MISC = (volatile LAS unsigned*)(F.lds + MISC_OFF);
    F.tid = threadIdx.x; F.lane = F.tid & 63; F.wave = __builtin_amdgcn_readfirstlane(F.tid >> 6); F.G = gridDim.x; F.bid = blockIdx.x;
    F.ws = args.ws; F.ctl = (unsigned*)(args.ws + WS_CTL); F.out = args.out;
    F.x = args.in[0]; F.g_mpre = args.in[1]; F.g_mpost = args.in[2]; F.g_fpre = args.in[3]; F.g_fpost = args.in[4]; F.w_in = args.in[5]; F.pool_w = args.in[6]; F.pool_scale = args.in[7];
    F.rpb = args.in[8]; F.w_out = args.in[9]; F.dwg = args.in[10]; F.dwu = args.in[11]; F.dwd = args.in[12]; F.router = args.in[13]; F.mwg = args.in[14]; F.mwu = args.in[15]; F.mwd = args.in[16];
    if (F.tid < 16) F.MISC[F.tid] = 0u;
    __syncthreads();
    const int lo = args.lo, hi = args.hi;
    XcdBarrier bar; bar.bar = F.ctl + CW_BAR + args.breg * XCD_BAR_WORDS; bar.x = 0; bar.st = F.MISC;
    if (hi - lo > 1) bar = xcd_barrier_post(F.ctl + CW_BAR + args.breg * XCD_BAR_WORDS, F.MISC);
#ifndef NO_P0
#ifndef REP_P0
#define REP_P0 1
#endif
    if (RUN(0)) { for (int r_ = 0; r_ < REP_P0; ++r_) p0_prologue(F); } SEAM(0);
#endif
    run_layer<0>(F, bar, lo, hi);
    run_layer<1>(F, bar, lo, hi);
}
#undef RUN
#undef SEAM

__global__ void __launch_bounds__(64) nk_gemm(const bf16* A, int lda, const bf16* Bt, int ldb, int K, bf16* O, int ldo, float scale, int sc_lo, int sc_hi, int vt) {
    const int m0 = 32 * blockIdx.y, n0 = 32 * blockIdx.x, lane = threadIdx.x, fr = lane & 15, fq = lane >> 4;
    f32x4 acc[2][2];
#pragma unroll
    for (int a = 0; a < 2; ++a)
#pragma unroll
        for (int b = 0; b < 2; ++b) acc[a][b] = (f32x4){0.f, 0.f, 0.f, 0.f};
    for (int k0 = 0; k0 < K; k0 += 32) {
        bf16x8 a[2], b[2];
#pragma unroll
        for (int i = 0; i < 2; ++i) { a[i] = *(const bf16x8*)(A + (size_t)(m0 + 16 * i + fr) * lda + k0 + 8 * fq); b[i] = *(const bf16x8*)(Bt + (size_t)(n0 + 16 * i + fr) * ldb + k0 + 8 * fq); }
#pragma unroll
        for (int mt = 0; mt < 2; ++mt)
#pragma unroll
            for (int nt = 0; nt < 2; ++nt) acc[mt][nt] = __builtin_amdgcn_mfma_f32_16x16x32_bf16(a[mt], b[nt], acc[mt][nt], 0, 0, 0);
    }
#pragma unroll
    for (int mt = 0; mt < 2; ++mt)
#pragma unroll
        for (int nt = 0; nt < 2; ++nt)
#pragma unroll
            for (int q = 0; q < 4; ++q) { const int m = m0 + 16 * mt + 4 * fq + q, n = n0 + 16 * nt + fr; const float sc = (n >= sc_lo && n < sc_hi) ? scale : 1.0f;
                O[vt ? vt_index(m, n) : (size_t)m * ldo + n] = (bf16)f2bf(acc[mt][nt][q] * sc); }
}
__global__ void nk_blocktab(const unsigned* ctl, int* btab, int moe) {
    if (threadIdx.x != 0 || blockIdx.x != 0) return;
    int b = 0;
    for (int e = 0; e < NE; ++e) { const int nb = moe ? (int)((ctl[CW_CNT + 64 * e] + 255u) >> 8) : (e == 0 ? T / 256 : 0); for (int k = 0; k < nb; ++k) btab[b++] = e | (k << 8); }
    btab[MAXBLK] = b;
}
__global__ void __launch_bounds__(64) nk_ffn_up(const bf16* hn, const bf16* wgu, const int* lists, const int* btab, bf16* hff, int cstart, int F_, int moe) {
    const int m0 = 32 * blockIdx.y, f0 = 32 * blockIdx.x, lane = threadIdx.x, fr = lane & 15, fq = lane >> 4;
    const int b = cstart + m0 / 256; if (b >= btab[MAXBLK]) return;
    const int e = btab[b] & 0xff, lb = btab[b] >> 8;
    const int* list = lists + (moe ? (size_t)e * T + 256 * lb : (size_t)256 * b) + (m0 % 256);
    const bf16* W = wgu + (size_t)e * 2 * F_ * D; const int rg = (f0 / 128) * 256 + (f0 % 128);
    const bf16* arow[2]; arow[0] = hn + (size_t)list[fr] * D; arow[1] = hn + (size_t)list[16 + fr] * D;
    f32x4 ag[2][2], au[2][2];
#pragma unroll
    for (int a = 0; a < 2; ++a)
#pragma unroll
        for (int c = 0; c < 2; ++c) { ag[a][c] = (f32x4){0.f, 0.f, 0.f, 0.f}; au[a][c] = (f32x4){0.f, 0.f, 0.f, 0.f}; }
    for (int k0 = 0; k0 < D; k0 += 32) {
        bf16x8 a[2], bg[2], bu[2];
#pragma unroll
        for (int i = 0; i < 2; ++i) { a[i] = *(const bf16x8*)(arow[i] + k0 + 8 * fq); bg[i] = *(const bf16x8*)(W + (size_t)(rg + 16 * i + fr) * D + k0 + 8 * fq); bu[i] = *(const bf16x8*)(W + (size_t)(rg + 128 + 16 * i + fr) * D + k0 + 8 * fq); }
#pragma unroll
        for (int mt = 0; mt < 2; ++mt)
#pragma unroll
            for (int nt = 0; nt < 2; ++nt) { ag[mt][nt] = __builtin_amdgcn_mfma_f32_16x16x32_bf16(a[mt], bg[nt], ag[mt][nt], 0, 0, 0); au[mt][nt] = __builtin_amdgcn_mfma_f32_16x16x32_bf16(a[mt], bu[nt], au[mt][nt], 0, 0, 0); }
    }
#pragma unroll
    for (int mt = 0; mt < 2; ++mt)
#pragma unroll
        for (int nt = 0; nt < 2; ++nt)
#pragma unroll
            for (int q = 0; q < 4; ++q) { const float g = ag[mt][nt][q], u = au[mt][nt][q]; const float v = g * u / (1.0f + __expf(-g));
                hff[(size_t)(m0 + 16 * mt + 4 * fq + q) * F_ + f0 + 16 * nt + fr] = (bf16)f2bf(v); }
}
__global__ void __launch_bounds__(64) nk_ffn_down(const bf16* hff, const bf16* wd, const int* btab, bf16* y, int cstart, int F_) {
    const int m0 = 32 * blockIdx.y, n0 = 32 * blockIdx.x, lane = threadIdx.x, fr = lane & 15, fq = lane >> 4;
    const int b = cstart + m0 / 256; if (b >= btab[MAXBLK]) return;
    const int e = btab[b] & 0xff; const bf16* W = wd + (size_t)e * D * F_;
    f32x4 acc[2][2];
#pragma unroll
    for (int a = 0; a < 2; ++a)
#pragma unroll
        for (int c = 0; c < 2; ++c) acc[a][c] = (f32x4){0.f, 0.f, 0.f, 0.f};
    for (int k0 = 0; k0 < F_; k0 += 32) {
        bf16x8 a[2], bb[2];
#pragma unroll
        for (int i = 0; i < 2; ++i) { a[i] = *(const bf16x8*)(hff + (size_t)(m0 + 16 * i + fr) * F_ + k0 + 8 * fq); bb[i] = *(const bf16x8*)(W + (size_t)(n0 + 16 * i + fr) * F_ + k0 + 8 * fq); }
#pragma unroll
        for (int mt = 0; mt < 2; ++mt)
#pragma unroll
            for (int nt = 0; nt < 2; ++nt) acc[mt][nt] = __builtin_amdgcn_mfma_f32_16x16x32_bf16(a[mt], bb[nt], acc[mt][nt], 0, 0, 0);
    }
#pragma unroll
    for (int mt = 0; mt < 2; ++mt)
#pragma unroll
        for (int nt = 0; nt < 2; ++nt)
#pragma unroll
            for (int q = 0; q < 4; ++q) y[(size_t)(256 * cstart + m0 + 16 * mt + 4 * fq + q) * D + n0 + 16 * nt + fr] = (bf16)f2bf(acc[mt][nt][q]);
}
__global__ void nk_pool_delta(const bf16* proj, bf16* delta) {
    const int idx = blockIdx.x * 256 + threadIdx.x, tok = idx / DPOOL, ch = idx % DPOOL, b = tok / SEQ, t = tok % SEQ, g = ch / 128, hw = 1 << g;
    const int lo = max(t - hw, 0), hi = min(t + hw, SEQ); float s = 0.f;
    for (int tt = lo; tt < hi; ++tt) s += bf2f(proj[(size_t)(b * SEQ + tt) * NPROJ + ch]);
    delta[(size_t)tok * DPOOL + ch] = (bf16)f2bf(s / (float)(hi - lo) - bf2f(proj[(size_t)tok * NPROJ + ch]));
}
__global__ void nk_pool_mm(const bf16* delta, const bf16* Wp, const float* pscale, bf16* mixo) {
    const int idx = blockIdx.x * 256 + threadIdx.x, tok = idx / DPOOL, dd = idx % DPOOL, g = dd / 128, d = dd % 128; float s = 0.f;
    for (int c = 0; c < 128; ++c) s += bf2f(delta[(size_t)tok * DPOOL + 128 * g + c]) * bf2f(Wp[(size_t)(g * 128 + d) * 128 + c]);
    mixo[(size_t)tok * D + dd] = (bf16)f2bf(s * pscale[dd]);
}
__global__ void nk_na(const bf16* proj, const bf16* Vt, const float* rpb, bf16* mixo) {
    const int idx = blockIdx.x * 256 + threadIdx.x, tok = idx / NH, h = idx % NH, b = tok / SEQ, t = tok % SEQ, r = t / GRIDW, c = t % GRIDW;
    const int r0 = min(max(r - KH / 2, 0), GROWS - KH), c0 = min(max(c - KW / 2, 0), GRIDW - KW);
    float q[HD];
#pragma unroll
    for (int d = 0; d < HD; ++d) q[d] = bf2f(proj[(size_t)tok * NPROJ + 512 + HD * h + d]);
    float mx = -INFINITY;
    for (int i = 0; i < KH; ++i) for (int j = 0; j < KW; ++j) {
        const size_t kt = (size_t)(b * SEQ + (r0 + i) * GRIDW + c0 + j); float s = 0.f;
#pragma unroll
        for (int d = 0; d < HD; ++d) s += q[d] * bf2f(proj[kt * NPROJ + 1024 + HD * h + d]);
        s += rpb[(h * 15 + (r0 + i - r + KH - 1)) * 31 + (c0 + j - c + KW - 1)] * LOG2E; mx = fmaxf(mx, s);
    }
    float o[HD], sum = 0.f;
#pragma unroll
    for (int d = 0; d < HD; ++d) o[d] = 0.f;
    for (int i = 0; i < KH; ++i) for (int j = 0; j < KW; ++j) {
        const size_t kt = (size_t)(b * SEQ + (r0 + i) * GRIDW + c0 + j); float s = 0.f;
#pragma unroll
        for (int d = 0; d < HD; ++d) s += q[d] * bf2f(proj[kt * NPROJ + 1024 + HD * h + d]);
        s += rpb[(h * 15 + (r0 + i - r + KH - 1)) * 31 + (c0 + j - c + KW - 1)] * LOG2E;
        const float p = exp2f(s - mx); sum += p; const float pb = __builtin_bit_cast(float, f2bf(p) << 16);
#pragma unroll
        for (int d = 0; d < HD; ++d) o[d] += pb * bf2f(Vt[vt_index(HD * h + d, (int)kt)]);
    }
#pragma unroll
    for (int d = 0; d < HD; ++d) mixo[(size_t)tok * D + DPOOL + HD * h + d] = (bf16)f2bf(o[d] / sum);
}

static void launch_mk(const Args& a0, int lo, int hi, int grid, hipStream_t stream, int breg = 0) {
    Args a = a0; a.lo = lo; a.hi = hi; a.breg = breg; a.pad = 0;
    hipLaunchKernelGGL(mk_fwd, dim3(grid), dim3(512), LDS_BYTES, stream, a);
}
extern "C" void kernel_launch(void* const* d_in, const int* in_sizes, int n_in, void* d_out, int out_size, void* d_ws, size_t ws_size, hipStream_t stream) {
    static int grid = 0;
    if (grid == 0) {
        if (n_in != 17 || out_size != T * D || ws_size < WS_END) { fprintf(stderr, "kernel_launch: unexpected problem (n_in %d, out %d, ws %zu)\n", n_in, out_size, ws_size); grid = -1; return; }
        int dev = 0, cus = 0;
        if (hipGetDevice(&dev) != hipSuccess || hipDeviceGetAttribute(&cus, hipDeviceAttributeMultiprocessorCount, dev) != hipSuccess) { grid = -1; return; }
        if (hipFuncSetAttribute((const void*)mk_fwd, hipFuncAttributeMaxDynamicSharedMemorySize, LDS_BYTES) != hipSuccess) { grid = -1; return; }
        int per_cu = 0;
        if (hipOccupancyMaxActiveBlocksPerMultiprocessor(&per_cu, (const void*)mk_fwd, 512, LDS_BYTES) != hipSuccess || per_cu < 1) { fprintf(stderr, "kernel_launch: occupancy query says %d\n", per_cu); }
        (void)hipGetLastError();
        grid = cus;
    }
    if (grid < 0) return;
    hipMemsetAsync((char*)d_ws + WS_CTL, 0, CTL_ZERO_BYTES, stream);
    Args a{};
    for (int i = 0; i < 17; ++i) a.in[i] = (const float*)d_in[i];
    a.out = (float*)d_out; a.ws = (unsigned char*)d_ws; a.lo = 0; a.hi = 0;
    unsigned char* ws = (unsigned char*)d_ws;
#if MODE == 3
#if defined(REPSTEP)
    launch_mk(a, 0, REPSTEP + 1, grid, stream, 0); launch_mk(a, REPSTEP, REPSTEP + 1, grid, stream, 1); launch_mk(a, REPSTEP + 1, NSTEPS, grid, stream, 2);
#else
    launch_mk(a, 0, NSTEPS, grid, stream);
#endif
#else
    launch_mk(a, 0, 1, grid, stream);
    const bf16* HN = (const bf16*)(ws + WS_HN);
    for (int l = 0; l < DEPTH; ++l) {
        const int base = 1 + STEPS_PER_LAYER * l; const int moe = l & 1;
        const bf16* win = (const bf16*)(ws + WS_WIN) + (size_t)l * DIN * D;
        if (NAIVE & 1) {
            hipLaunchKernelGGL(nk_gemm, dim3(NPROJ / 32, T / 32), dim3(64), 0, stream, HN, D, win, D, D, (bf16*)(ws + WS_PROJ), NPROJ, QSCALE, 512, 1024, 0);
            hipLaunchKernelGGL(nk_gemm, dim3(T / 32, DATT / 32), dim3(64), 0, stream, win + (size_t)NPROJ * D, D, HN, D, D, (bf16*)(ws + WS_VT), T, 1.0f, 0, 0, 1);
        } else launch_mk(a, base + 0, base + 1, grid, stream);
        if (NAIVE & 2) {
            hipLaunchKernelGGL(nk_pool_delta, dim3(T * DPOOL / 256), dim3(256), 0, stream, (const bf16*)(ws + WS_PROJ), (bf16*)(ws + WS_MIX));
            hipLaunchKernelGGL(nk_pool_mm, dim3(T * DPOOL / 256), dim3(256), 0, stream, (const bf16*)(ws + WS_MIX), (const bf16*)(ws + WS_WP) + (size_t)l * 4 * 128 * 128, (const float*)d_in[7] + l * DPOOL, (bf16*)(ws + WS_MIXO));
            hipLaunchKernelGGL(nk_na, dim3(T * NH / 256), dim3(256), 0, stream, (const bf16*)(ws + WS_PROJ), (const bf16*)(ws + WS_VT), (const float*)d_in[8] + (size_t)l * NH * 15 * 31, (bf16*)(ws + WS_MIXO));
        } else launch_mk(a, base + 1, base + 2, grid, stream);
        if (NAIVE & 4) hipLaunchKernelGGL(nk_gemm, dim3(D / 32, T / 32), dim3(64), 0, stream, (const bf16*)(ws + WS_MIXO), D, (const bf16*)(ws + WS_WOUT) + (size_t)l * D * D, D, D, (bf16*)(ws + WS_MIX), D, 1.0f, 0, 0, 0);
        else launch_mk(a, base + 2, base + 3, grid, stream);
        launch_mk(a, base + 3, base + 4, grid, stream);
        if (NAIVE & 24) hipLaunchKernelGGL(nk_blocktab, dim3(1), dim3(64), 0, stream, (const unsigned*)(ws + WS_CTL), (int*)(ws + WS_BTAB), moe);
        const int F_ = moe ? DFFE : DFF, nchunk = moe ? MAXCHUNK : 2;
        for (int c = 0; c < nchunk; ++c) {
            if (NAIVE & 8) hipLaunchKernelGGL(nk_ffn_up, dim3(F_ / 32, CHUNK_BLK * 256 / 32), dim3(64), 0, stream, HN, moe ? (const bf16*)(ws + WS_WGUM) : (const bf16*)(ws + WS_WGU0), moe ? (const int*)(ws + WS_LIST) : (const int*)(ws + WS_LISTID), (const int*)(ws + WS_BTAB), (bf16*)(ws + WS_HFF), c * CHUNK_BLK, F_, moe);
            else launch_mk(a, base + 4 + 2 * c, base + 5 + 2 * c, grid, stream);
            if (NAIVE & 16) hipLaunchKernelGGL(nk_ffn_down, dim3(D / 32, CHUNK_BLK * 256 / 32), dim3(64), 0, stream, (const bf16*)(ws + WS_HFF), moe ? (const bf16*)(ws + WS_WDM) : (const bf16*)(ws + WS_WD0), (const int*)(ws + WS_BTAB), (bf16*)(ws + WS_Y), c * CHUNK_BLK, F_);
            else launch_mk(a, base + 5 + 2 * c, base + 6 + 2 * c, grid, stream);
        }
        launch_mk(a, base + 14, base + 15, grid, stream);
    }
#endif
}
```

```cpp
#include <hip/hip_runtime.h>
#include <cstdio>
#include <cstdint>

#ifndef MODE
#define MODE 3
#endif
#ifndef NAIVE
#define NAIVE 0
#endif
#ifndef I8_DENSE
#define I8_DENSE 1
#endif
#ifndef I8_PROJ
#define I8_PROJ 1
#endif
#ifndef FP6_UP
#define FP6_UP 1
#endif
#ifndef FP8_DDOWN
#define FP8_DDOWN 1
#endif
#ifndef FP8_MOE
#define FP8_MOE 1
#endif
#if ((FP8_MOE || I8_DENSE) && (NAIVE & 24) || I8_PROJ && (NAIVE & 1)) && MODE != 3
#error the simple reference FFN kernels are bf16 only: build with -DFP8_MOE=0 to use them
#endif

#define GAS __attribute__((address_space(1)))
#define LAS __attribute__((address_space(3)))
typedef unsigned short bf16;
typedef unsigned v4u __attribute__((ext_vector_type(4)));
typedef unsigned v2u __attribute__((ext_vector_type(2)));
typedef float f32x4 __attribute__((ext_vector_type(4)));
typedef float f32x2 __attribute__((ext_vector_type(2)));
typedef short bf16x8 __attribute__((ext_vector_type(8)));

constexpr int BATCH = 2, SEQ = 16384, T = BATCH * SEQ, D = 1024, DIN = 2048, DPOOL = 512, DATT = 512, NH = 16, HD = 32;
constexpr int GRIDW = 64, GROWS = SEQ / GRIDW, KH = 8, KW = 16;
constexpr int DFF = 4096, NE = 8, DFFE = 3584, DEPTH = 2;
constexpr int UPITCH = 512;
constexpr int NPROJ = 1536;
constexpr float RMS_EPS = 1e-6f;
constexpr float LOG2E = 1.4426950408889634f;
constexpr float QSCALE = 0.17677669529663687f * LOG2E;
__host__ __device__ __forceinline__ size_t vt_index(int ch, int tok) { return (size_t)(tok >> 6) * (DATT * 64) + (size_t)ch * 64 + (tok & 63); }
constexpr float S6A = 1.25f, S6W = 40.0f;
typedef float f32x16 __attribute__((ext_vector_type(16)));
typedef int i32x6 __attribute__((ext_vector_type(6)));
constexpr float W8_UP = 32.0f, W8_DN = 64.0f;
typedef int i32x8 __attribute__((ext_vector_type(8)));
typedef int i32x4 __attribute__((ext_vector_type(4)));
constexpr int CHUNK_BLK = 64;
constexpr int MAXCHUNK = 5;
constexpr int MAXBLK = 264;

constexpr size_t MiB = 1u << 20;
constexpr size_t WS_CTL = 0, CTL_ZERO_BYTES = 1 * MiB;
constexpr size_t WS_LIST = 1 * MiB;
constexpr size_t WS_INFO = 2 * MiB;
constexpr size_t WS_LISTID = 2 * MiB + 512 * 1024;
constexpr size_t WS_SA = 2 * MiB + 640 * 1024;
constexpr size_t WS_SWIN = 2 * MiB + 896 * 1024;
constexpr size_t WS_SW0 = 2 * MiB + 832 * 1024;
constexpr size_t WS_BTAB = 2 * MiB + 768 * 1024;
constexpr size_t WS_WP = 3 * MiB;
constexpr size_t WS_WIN = 4 * MiB;
constexpr size_t WS_WOUT = 12 * MiB;
constexpr size_t WS_WGU0 = 16 * MiB;
constexpr size_t WS_WD0 = 32 * MiB;
constexpr size_t WS_WGUM = 40 * MiB;
constexpr size_t WS_WDM = (FP8_MOE ? 160 : 152) * MiB;
constexpr size_t WS_H16 = 96 * MiB;
constexpr size_t WS_HN = 208 * MiB;
constexpr size_t WS_R = 272 * MiB;
constexpr size_t WS_HFF = WS_R;
constexpr size_t WS_Y = WS_R + 128 * MiB;
constexpr size_t WS_PQ = WS_R + 32 * MiB, WS_PK = WS_R + 64 * MiB;
constexpr size_t WS_PROJ = WS_R;
constexpr size_t WS_VT = WS_R + 96 * MiB;
constexpr size_t WS_MIXO = WS_R + 128 * MiB;
constexpr size_t WS_MIX = WS_R + 192 * MiB;
constexpr size_t WS_END = 532 * MiB;
constexpr int HFF_TILE = 256 * 128;
constexpr int TAILSPLIT = 7, TAILPART_ROWS = 8 * 256;
constexpr size_t WS_TAILPART = WS_WGU0;
static_assert(WS_TAILPART + (size_t)(TAILSPLIT - 1) * TAILPART_ROWS * D * 2 <= WS_WGUM, "tail partials");
static_assert(!FP8_MOE || (WS_WGUM + (size_t)NE * 2 * DFFE * D <= WS_H16 && WS_H16 + (size_t)T * D * 2 <= WS_WDM), "H16 sits in the gap the fp8 expert weights leave");

constexpr int CW_TMO = 0, CW_CODE = 1;
constexpr int CW_BAR = 4096;
constexpr int CW_CNT = 16384;
constexpr int CW_DBG = 20480;

constexpr int RING_BYTES = 131072;
constexpr int TOKBUF_OFF = RING_BYTES;
constexpr int BLK_OFF = TOKBUF_OFF + 9 * 1024;
constexpr int BST_OFF = BLK_OFF + 272 * 4;
constexpr int LCNT_OFF = BST_OFF + 64;
constexpr int MISC_OFF = LCNT_OFF + 64;
constexpr int LDS_BYTES = 147456;
static_assert(MISC_OFF + 64 <= LDS_BYTES, "LDS map");

#define RLX_AGENT __ATOMIC_RELAXED, __HIP_MEMORY_SCOPE_AGENT
#define LDS_WAIT() asm volatile("s_waitcnt lgkmcnt(0)" ::: "memory")
#define VM_WAIT() asm volatile("s_waitcnt vmcnt(0)" ::: "memory")
__device__ __forceinline__ unsigned f2bf(float f) { unsigned u = __builtin_bit_cast(unsigned, f); return (u + 0x7fffu + ((u >> 16) & 1u)) >> 16; }
__device__ __forceinline__ unsigned pk2(float lo, float hi) { return f2bf(lo) | (f2bf(hi) << 16); }
__device__ __forceinline__ float bflo(unsigned w) { return __builtin_bit_cast(float, w << 16); }
__device__ __forceinline__ float bfhi(unsigned w) { return __builtin_bit_cast(float, w & 0xffff0000u); }
__device__ __forceinline__ float bf2f(bf16 v) { return __builtin_bit_cast(float, (unsigned)v << 16); }
__device__ __forceinline__ unsigned cvt_pk_bf16(float lo, float hi) { unsigned r; asm volatile("v_cvt_pk_bf16_f32 %0, %1, %2" : "=v"(r) : "v"(lo), "v"(hi)); return r; }
__device__ __forceinline__ float wave_sum(float v) {
#pragma unroll
    for (int o = 1; o < 64; o <<= 1) v += __shfl_xor(v, o);
    return v;
}

#define XB_TMO      128
#define XB_XCNT(j)  (256  + 64 * (j))
#define XB_XSUB(j)  (1280 + 64 * (j))
#define XB_XGEN(j)  (2304 + 64 * (j))
#define XB_TOP      3328
#define XB_TOPGEN   3392
#define XCD_BAR_WORDS 3456
#define XB_SPIN_CAP (1u << 18)
__device__ __forceinline__ unsigned xb_ld(unsigned* p)              { return __hip_atomic_load(p, __ATOMIC_RELAXED, __HIP_MEMORY_SCOPE_AGENT); }
__device__ __forceinline__ unsigned xb_add(unsigned* p, unsigned v) { return __hip_atomic_fetch_add(p, v, __ATOMIC_RELAXED, __HIP_MEMORY_SCOPE_AGENT); }
__device__ __forceinline__ unsigned xb_xcc_id() { return (unsigned)__builtin_amdgcn_s_getreg((3 << 11) | 20) & 0xFu; }
#define XB_SPIN(cond, bar) do { unsigned _sp = 0; while (cond) { __builtin_amdgcn_s_sleep(1); \
    if ((++_sp & 255u) == 0u) { if (xb_ld(&(bar)[XB_TMO])) break; if (_sp > XB_SPIN_CAP) { atomicAdd(&(bar)[XB_TMO], 1u); break; } } } } while (0)
struct XcdBarrier { unsigned* bar; unsigned x; volatile LAS unsigned* st; };
__device__ __forceinline__ XcdBarrier xcd_barrier_post(unsigned* bar, volatile LAS unsigned* st) {
    XcdBarrier b; b.bar = bar; b.x = xb_xcc_id(); b.st = st;
    if (threadIdx.x == 0) (void)xb_add(&bar[XB_XCNT(b.x)], 1u);
    return b;
}
__device__ __forceinline__ void xcd_barrier_complete(unsigned* bar, unsigned x, unsigned& nloc, unsigned& nx) {
    const unsigned G = gridDim.x * gridDim.y * gridDim.z;
    unsigned sum, cnt, mine, sp = 0u;
    for (;;) {
        sum = 0u; cnt = 0u; mine = 0u;
#pragma unroll
        for (unsigned j = 0; j < 16; ++j) { const unsigned c = xb_ld(&bar[XB_XCNT(j)]); sum += c; cnt += (c > 0u) ? 1u : 0u; mine = (j == x) ? c : mine; }
        if (sum == G) break;
        __builtin_amdgcn_s_sleep(1);
        if ((++sp & 255u) == 0u) { if (xb_ld(&bar[XB_TMO])) break; if (sp > XB_SPIN_CAP) { atomicAdd(&bar[XB_TMO], 1u); break; } }
    }
    nloc = mine > 0u ? mine : 1u; nx = cnt > 0u ? cnt : 1u;
}
__device__ __forceinline__ void xcd_barrier(const XcdBarrier& b) {
    asm volatile("s_waitcnt vmcnt(0)" ::: "memory");
    __syncthreads();
    if (threadIdx.x == 0) {
        unsigned* bar = b.bar;
        __builtin_amdgcn_s_waitcnt(0);
        unsigned nloc = b.st[0], nx = b.st[1];
        if (nloc == 0u) { xcd_barrier_complete(bar, b.x, nloc, nx); b.st[0] = nloc; b.st[1] = nx; }
        const unsigned old = xb_add(&bar[XB_XSUB(b.x)], 1u);
        const unsigned gen = old / nloc;
        if (old + 1u == (gen + 1u) * nloc) {
            __builtin_amdgcn_fence(__ATOMIC_RELEASE, "agent");
            asm volatile("s_waitcnt vmcnt(0)" ::: "memory");
            const unsigned og = xb_add(&bar[XB_TOP], 1u);
            const unsigned tg = og / nx;
            if (og + 1u == (tg + 1u) * nx) xb_add(&bar[XB_TOPGEN], 1u);
            else XB_SPIN(xb_ld(&bar[XB_TOPGEN]) == tg, bar);
            __builtin_amdgcn_fence(__ATOMIC_ACQUIRE, "agent");
            xb_add(&bar[XB_XGEN(b.x)], 1u);
            asm volatile("s_waitcnt vmcnt(0)" ::: "memory");
        } else {
            XB_SPIN(xb_ld(&bar[XB_XGEN(b.x)]) == gen, bar);
            __builtin_amdgcn_fence(__ATOMIC_ACQUIRE, "agent");
            asm volatile("s_waitcnt vmcnt(0)" ::: "memory");
        }
    }
    __syncthreads();
}

namespace pg8 {
constexpr int BM = 256, BK = 64, HALF = 128, HTB = HALF * BK * 2, STAGE_BYTES = 8 * HTB, NXCD = 8, WGM = 8;
__host__ __device__ __forceinline__ int lds_byte(int r, int c) { const int st = (r >> 4) * 2 + (c >> 5), rr = r & 15, cc = c & 31, ob = rr * 64 + cc * 2; return st * 1024 + (ob ^ (((ob >> 9) & 1) << 5)); }
__host__ __device__ __forceinline__ void stage_rc(int b, int& R, int& C) { const int st = b / 1024, sb = b % 1024, swz = sb ^ (((sb >> 9) & 1) << 5); R = (st >> 1) * 16 + swz / 64; C = (st & 1) * 32 + (swz % 64) / 2; }
__host__ __device__ __forceinline__ int perm32(int rho) { const int n = rho >> 4, i = rho & 15; return 8 * (i >> 2) + 4 * n + (i & 3); }

struct Unit { const char* A; const char* B; const void* p0; const float* cs; bf16* obase; int orow, ocol, ldc; float scale; };

__device__ __forceinline__ bool tile_order(int i, int G, int c, int nM, int nN, int& pm, int& pn) {
    const int nwg = nM * nN; const long L = (long)i * G + c; if (L >= nwg) return false;
    int wgid = (int)L; { const int q = nwg / NXCD, r = nwg % NXCD, xcd = wgid % NXCD, off = wgid / NXCD; wgid = (xcd < r ? xcd * (q + 1) : r * (q + 1) + (xcd - r) * q) + off; }
    const int nig = WGM * nN, gid = wgid / nig, fm = gid * WGM, gsz = (nM - fm) < WGM ? (nM - fm) : WGM;
    pm = fm + ((wgid % nig) % gsz); pn = (wgid % nig) / gsz; return true;
}

template <bool VT> struct EpiBf16T {
    static constexpr bool SCL = false;
    __device__ __forceinline__ void operator()(const f32x4 (&acc)[2][2][4][2], const Unit& u, int wr, int wc, int fr, int fq, const LAS int* tok, const LAS float* scl) const {
        const int row0 = u.orow + wr * 64 + fr, col0 = u.ocol + wc * 32 + 8 * fq; const float sc = u.scale;
#pragma unroll
        for (int ai = 0; ai < 2; ++ai)
#pragma unroll
            for (int m = 0; m < 4; ++m) { const int row = row0 + ai * HALF + m * 16; bf16* rowp = u.obase + (size_t)row * u.ldc + col0;
#pragma unroll
                for (int bj = 0; bj < 2; ++bj) { const f32x4 v0 = acc[ai][bj][m][0] * sc, v1 = acc[ai][bj][m][1] * sc;
                    v4u w; w.x = cvt_pk_bf16(v0[0], v0[1]); w.y = cvt_pk_bf16(v0[2], v0[3]); w.z = cvt_pk_bf16(v1[0], v1[1]); w.w = cvt_pk_bf16(v1[2], v1[3]);
                    bf16* p = (VT && u.ldc < 0) ? u.obase + vt_index(row, col0 + bj * HALF) : rowp + bj * HALF;
                    *(v4u*)p = w; } }
    }
};
typedef EpiBf16T<false> EpiBf16;
typedef EpiBf16T<true> EpiProj;
__device__ __forceinline__ float silu_mul(float g, float u) { return g * u * __builtin_amdgcn_rcpf(1.0f + __builtin_amdgcn_exp2f(-LOG2E * g)); }
struct EpiSwiGLU {
    static constexpr bool SCL = false;
    __device__ __forceinline__ void operator()(const f32x4 (&acc)[2][2][4][2], const Unit& u, int wr, int wc, int fr, int fq, const LAS int* tok, const LAS float* scl) const {
        const int row0 = u.orow + wr * 64 + fr, col0 = u.ocol + wc * 32 + 8 * fq;
#pragma unroll
        for (int ai = 0; ai < 2; ++ai)
#pragma unroll
            for (int m = 0; m < 4; ++m) { bf16* rowp = u.obase + (size_t)(row0 + ai * HALF + m * 16) * u.ldc + col0;
                const f32x4 g0 = acc[ai][0][m][0], g1 = acc[ai][0][m][1], u0 = acc[ai][1][m][0], u1 = acc[ai][1][m][1];
                v4u w; w.x = cvt_pk_bf16(silu_mul(g0[0], u0[0]), silu_mul(g0[1], u0[1])); w.y = cvt_pk_bf16(silu_mul(g0[2], u0[2]), silu_mul(g0[3], u0[3]));
                w.z = cvt_pk_bf16(silu_mul(g1[0], u1[0]), silu_mul(g1[1], u1[1])); w.w = cvt_pk_bf16(silu_mul(g1[2], u1[2]), silu_mul(g1[3], u1[3]));
                *(v4u*)rowp = w; }
    }
};

template <bool F6> struct EpiSwiGLU8T {
    static constexpr bool SCL = false;
    static __device__ __forceinline__ f32x2 pair(f32x2 gr, f32x2 ur) {
        const float sc = F6 ? 1.0f / (S6A * S6W) : 1.0f / W8_UP; const f32x2 a = gr * (-LOG2E * sc);
        f32x2 t; t.x = __builtin_amdgcn_exp2f(a.x); t.y = __builtin_amdgcn_exp2f(a.y);
        const f32x2 d = t + 1.0f; f32x2 r; r.x = __builtin_amdgcn_rcpf(d.x); r.y = __builtin_amdgcn_rcpf(d.y);
        return (gr * ur) * (r * (sc * sc));
    }
    __device__ __forceinline__ void operator()(const f32x4 (&acc)[2][2][4][2], const Unit& u, int wr, int wc, int fr, int fq, const LAS int* tok, const LAS float* scl) const {
        const int row0 = u.orow + wr * 64 + fr, col0 = u.ocol + wc * 32 + 8 * fq;
#pragma unroll
        for (int ai = 0; ai < 2; ++ai)
#pragma unroll
            for (int m = 0; m < 4; ++m) { unsigned char* rowp = (unsigned char*)u.obase + (size_t)(row0 + ai * HALF + m * 16) * 128 + col0;
                const f32x4 g0 = acc[ai][0][m][0], g1 = acc[ai][0][m][1], u0 = acc[ai][1][m][0], u1 = acc[ai][1][m][1];
                const f32x2 o0 = pair((f32x2){g0[0], g0[1]}, (f32x2){u0[0], u0[1]}), o1 = pair((f32x2){g0[2], g0[3]}, (f32x2){u0[2], u0[3]});
                const f32x2 o2 = pair((f32x2){g1[0], g1[1]}, (f32x2){u1[0], u1[1]}), o3 = pair((f32x2){g1[2], g1[3]}, (f32x2){u1[2], u1[3]});
                int w0 = 0, w1 = 0;
                w0 = __builtin_amdgcn_cvt_pk_fp8_f32(o0.x, o0.y, w0, false); w0 = __builtin_amdgcn_cvt_pk_fp8_f32(o1.x, o1.y, w0, true);
                w1 = __builtin_amdgcn_cvt_pk_fp8_f32(o2.x, o2.y, w1, false); w1 = __builtin_amdgcn_cvt_pk_fp8_f32(o3.x, o3.y, w1, true);
                v2u w; w.x = (unsigned)w0; w.y = (unsigned)w1; *(v2u*)rowp = w; }
    }
};

typedef EpiSwiGLU8T<false> EpiSwiGLU8;
typedef EpiSwiGLU8T<true> EpiSwiGLU6;
struct EpiProj_I8 {
    static constexpr bool SCL = true;
    __device__ __forceinline__ const float* rs_ptr(const Unit& u) const { return (const float*)u.p0; }
    __device__ __forceinline__ const float* cs_ptr(const Unit& u) const { return u.cs; }
    __device__ __forceinline__ void operator()(const f32x4 (&acc)[2][2][4][2], const Unit& u, int wr, int wc, int fr, int fq, const LAS int* tok, const LAS float* scl) const {
        const int rl0 = wr * 64 + fr, cl0 = wc * 32 + 8 * fq, row0 = u.orow + rl0, col0 = u.ocol + cl0; const float sc = u.scale;
        const bool hm = u.ldc == 0; const size_t rstride = hm ? 32 : (size_t)u.ldc, bstride = hm ? (size_t)4 * T * 32 : (size_t)HALF;
        bf16* lbase = hm ? u.obase + (size_t)((u.ocol >> 5) + wc) * T * 32 + 8 * fq : u.obase + col0;
        f32x4 cv[2][2];
#pragma unroll
        for (int bj = 0; bj < 2; ++bj) { cv[bj][0] = *(const LAS f32x4*)(scl + 256 + cl0 + bj * HALF) * sc; cv[bj][1] = *(const LAS f32x4*)(scl + 256 + cl0 + bj * HALF + 4) * sc; }
#pragma unroll
        for (int ai = 0; ai < 2; ++ai)
#pragma unroll
            for (int m = 0; m < 4; ++m) { const int row = row0 + ai * HALF + m * 16; const float sr = scl[rl0 + ai * HALF + m * 16]; bf16* rowp = lbase + (size_t)row * rstride;
#pragma unroll
                for (int bj = 0; bj < 2; ++bj) { const f32x4 v0 = __builtin_convertvector(__builtin_bit_cast(i32x4, acc[ai][bj][m][0]), f32x4) * cv[bj][0] * sr, v1 = __builtin_convertvector(__builtin_bit_cast(i32x4, acc[ai][bj][m][1]), f32x4) * cv[bj][1] * sr;
                    v4u w; w.x = cvt_pk_bf16(v0[0], v0[1]); w.y = cvt_pk_bf16(v0[2], v0[3]); w.z = cvt_pk_bf16(v1[0], v1[1]); w.w = cvt_pk_bf16(v1[2], v1[3]);
                    bf16* p = (u.ldc < 0) ? u.obase + vt_index(row, col0 + bj * HALF) : rowp + bj * bstride;
                    *(v4u*)p = w; } }
    }
};
template <bool F8OUT> struct EpiSwiGLU_I8T {
    static constexpr bool SCL = true;
    const float* sA; const float* sW; const int* idl;
    __device__ __forceinline__ const float* rs_ptr(const Unit& u) const { return sA + ((const int*)u.p0 - idl); }
    __device__ __forceinline__ const float* cs_ptr(const Unit& u) const { return sW + 2 * u.ocol; }
    static __device__ __forceinline__ f32x2 pair(f32x2 gr, f32x2 ur, f32x2 ka, f32x2 k, float sa) {
        const f32x2 a = (gr * sa) * ka;
        f32x2 t; t.x = __builtin_amdgcn_exp2f(a.x); t.y = __builtin_amdgcn_exp2f(a.y);
        const f32x2 d = t * k + k; f32x2 r; r.x = __builtin_amdgcn_rcpf(d.x); r.y = __builtin_amdgcn_rcpf(d.y);
        return (gr * ur) * r;
    }
    __device__ __forceinline__ void operator()(const f32x4 (&acc)[2][2][4][2], const Unit& u, int wr, int wc, int fr, int fq, const LAS int* tok, const LAS float* scl) const {
        const int rl0 = wr * 64 + fr, row0 = u.orow + rl0, cl0 = wc * 32 + 8 * fq, col0 = u.ocol + cl0;
        f32x2 ka[4], kc[4];
#pragma unroll
        for (int i = 0; i < 4; ++i) { const f32x2 wg = *(const LAS f32x2*)(scl + 256 + cl0 + 2 * i), wu = *(const LAS f32x2*)(scl + 256 + HALF + cl0 + 2 * i); const f32x2 p = wg * wu;
            ka[i] = wg * (-LOG2E); kc[i].x = __builtin_amdgcn_rcpf(p.x); kc[i].y = __builtin_amdgcn_rcpf(p.y); }
#pragma unroll
        for (int ai = 0; ai < 2; ++ai)
#pragma unroll
            for (int m = 0; m < 4; ++m) { const float sa = scl[rl0 + ai * HALF + m * 16], rs2 = __builtin_amdgcn_rcpf(sa * sa);
                bf16* rowp = u.obase + (size_t)(row0 + ai * HALF + m * 16) * u.ldc + col0;
                f32x2 o[4];
#pragma unroll
                for (int i = 0; i < 4; ++i) { const f32x4 ga = acc[ai][0][m][i >> 1], ua = acc[ai][1][m][i >> 1];
                    const float g0 = ga[2 * (i & 1)], g1 = ga[2 * (i & 1) + 1], u0 = ua[2 * (i & 1)], u1 = ua[2 * (i & 1) + 1];
                    const f32x2 gr = (f32x2){(float)__float_as_int(g0), (float)__float_as_int(g1)}, ur = (f32x2){(float)__float_as_int(u0), (float)__float_as_int(u1)};
                    o[i] = pair(gr, ur, ka[i], kc[i] * rs2, sa); }
                if constexpr (F8OUT) { int w0 = 0, w1 = 0;
                    w0 = __builtin_amdgcn_cvt_pk_fp8_f32(o[0].x, o[0].y, w0, false); w0 = __builtin_amdgcn_cvt_pk_fp8_f32(o[1].x, o[1].y, w0, true);
                    w1 = __builtin_amdgcn_cvt_pk_fp8_f32(o[2].x, o[2].y, w1, false); w1 = __builtin_amdgcn_cvt_pk_fp8_f32(o[3].x, o[3].y, w1, true);
                    v2u w; w.x = (unsigned)w0; w.y = (unsigned)w1; *(v2u*)((unsigned char*)u.obase + (size_t)(row0 + ai * HALF + m * 16) * 128 + col0) = w; }
                else { v4u w; w.x = cvt_pk_bf16(o[0].x, o[0].y); w.y = cvt_pk_bf16(o[1].x, o[1].y); w.z = cvt_pk_bf16(o[2].x, o[2].y); w.w = cvt_pk_bf16(o[3].x, o[3].y);
                    *(v4u*)rowp = w; } }
    }
};
typedef EpiSwiGLU_I8T<FP8_DDOWN != 0> EpiSwiGLU_I8;

template <class Epi, class Sched, bool GATHER, int MT = 0  >
__device__ __forceinline__ void gemm_phase(LAS unsigned char* lds, LAS int* tokbuf, const int K, const Sched& S, const Epi& E, const int P_ = 0, const int PA_ = 0, const int KSA_ = 0) {
    const int P = P_ ? P_ : K, PA = PA_ ? PA_ : P;
    const size_t kstepA = KSA_ ? (size_t)KSA_ : (size_t)(BK * 2);
    int tid_ = threadIdx.x; asm volatile("" : "+v"(tid_));
    const int tid = tid_, wid = __builtin_amdgcn_readfirstlane(tid >> 6), lane = tid & 63, wr = wid >> 2, wc = wid & 3, fr = lane & 15, fq = lane >> 4;
    const int nt = K / BK;
    unsigned voffA[2][2], voffB[2]; int rowA[2], colA[2];
#pragma unroll
    for (int i = 0; i < 2; ++i) { int R, C; stage_rc(tid * 16 + i * 8192, R, C); const int Rb = (R & ~31) + perm32(R & 31);
        voffA[0][i] = (unsigned)(R * PA + C) * 2u; voffA[1][i] = (unsigned)((R + HALF) * PA + C) * 2u; voffB[i] = (unsigned)(Rb * P + C) * 2u; rowA[i] = R; colA[i] = C; }
    const size_t kstep = (size_t)(BK * 2);
    const size_t hstep = (size_t)HALF * P * 2, hstepA = (size_t)HALF * PA * 2;
    const unsigned ldsw = (unsigned)wid * 1024u;
    const int aoff = lds_byte(wr * 64 + fr, fq * 8), boff = lds_byte(wc * 32 + fr, fq * 8);
#define PG8_SA(b, h) (((b) * 2 + (h)) * HTB)
#define PG8_SB(b, h) ((4 + (b) * 2 + (h)) * HTB)
#define PG8_STAGE(bufoff, gbase, voff) do { _Pragma("unroll") for (int _i = 0; _i < 2; ++_i) \
        __builtin_amdgcn_global_load_lds((const unsigned*)((const char*)(gbase) + (voff)[_i]), (LAS unsigned*)(lds + (bufoff) + ldsw + _i * 8192), 16, 0, 0); } while (0)
#define PG8_STAGE_A1(bufoff, gbase) do { if constexpr (GATHER) PG8_STAGE(bufoff, gbase, voffA[1]); else PG8_STAGE(bufoff, (gbase) + hstepA, voffA[0]); } while (0)
#define PG8_LDA(dst, b, h) do { _Pragma("unroll") for (int m = 0; m < 4; ++m) _Pragma("unroll") for (int k = 0; k < 2; ++k) dst[m][k] = *(const LAS bf16x8*)(lds + PG8_SA(b, h) + aoff + m * 2048 + k * 1024); } while (0)
#define PG8_LDB(dst, b, h) do { _Pragma("unroll") for (int n = 0; n < 2; ++n) _Pragma("unroll") for (int k = 0; k < 2; ++k) dst[n][k] = *(const LAS bf16x8*)(lds + PG8_SB(b, h) + boff + n * 2048 + k * 1024); } while (0)
#define PG8_CAT8(x) __builtin_shufflevector(__builtin_bit_cast(i32x4, (x)[0]), __builtin_bit_cast(i32x4, (x)[1]), 0, 1, 2, 3, 4, 5, 6, 7)
#define PG8_MMA(ai, bj, At, Bt) do { __builtin_amdgcn_s_setprio(1); _Pragma("unroll") for (int m = 0; m < 4; ++m) _Pragma("unroll") for (int n = 0; n < 2; ++n) { \
        if constexpr (MT == 1) acc[ai][bj][m][n] = __builtin_amdgcn_mfma_scale_f32_16x16x128_f8f6f4(PG8_CAT8(Bt[n]), PG8_CAT8(At[m]), acc[ai][bj][m][n], 0, 0, 0, 0, 0, 0); \
        else if constexpr (MT == 3) acc[ai][bj][m][n] = __builtin_amdgcn_mfma_scale_f32_16x16x128_f8f6f4(PG8_CAT8(Bt[n]), PG8_CAT8(At[m]), acc[ai][bj][m][n], 2, 2, 0, 0, 0, 0); \
        else if constexpr (MT == 2) { _Pragma("unroll") for (int k = 0; k < 2; ++k) acc[ai][bj][m][n] = __builtin_bit_cast(f32x4, __builtin_amdgcn_mfma_i32_16x16x64_i8(__builtin_bit_cast(i32x4, Bt[n][k]), __builtin_bit_cast(i32x4, At[m][k]), __builtin_bit_cast(i32x4, acc[ai][bj][m][n]), 0, 0, 0)); } \
        else { _Pragma("unroll") for (int k = 0; k < 2; ++k) acc[ai][bj][m][n] = __builtin_amdgcn_mfma_f32_16x16x32_bf16(Bt[n][k], At[m][k], acc[ai][bj][m][n], 0, 0, 0); } } \
        __builtin_amdgcn_s_setprio(0); } while (0)
#define PG8_WAIT_V(n) asm volatile("s_waitcnt vmcnt(" #n ")" ::: "memory")
#define PG8_WAIT_L(n) asm volatile("s_waitcnt lgkmcnt(" #n ")" ::: "memory")
#define PG8_BAR __builtin_amdgcn_s_barrier()
#define PG8_SCHED __builtin_amdgcn_sched_barrier(0)
#define PG8_TOKOFF(dst, tb) do { _Pragma("unroll") for (int _h = 0; _h < 2; ++_h) _Pragma("unroll") for (int _i = 0; _i < 2; ++_i) \
        dst[_h][_i] = (unsigned)(tb)[_h * HALF + rowA[_i]] * (unsigned)(PA * 2) + (unsigned)(colA[_i] * 2); } while (0)
#define PG8_TOKDMA(listp, tb) do { if (wid < 4) __builtin_amdgcn_global_load_lds((const unsigned*)((listp) + tid), (LAS unsigned*)((tb) + wid * 64), 4, 0, 0); } while (0)
#define PG8_SCB(u_) ((LAS float*)(tokbuf + 768) + 512 * ((u_) % 3))
#define PG8_SCLDMA(un, u_) do { const float* sp_ = wid < 4 ? E.rs_ptr(un) + tid : E.cs_ptr(un) + (tid - 256); \
        __builtin_amdgcn_global_load_lds((const unsigned*)sp_, (LAS unsigned*)(PG8_SCB(u_) + wid * 64), 4, 0, 0); } while (0)
#define PG8_TB(u_) (tokbuf + 256 * ((u_) % 3))
    Unit cur, nxt; int ui = 0;
    if (!S.next(0, cur)) return;
    f32x4 acc[2][2][4][2];
#pragma unroll
    for (int a = 0; a < 2; ++a)
#pragma unroll
        for (int b = 0; b < 2; ++b)
#pragma unroll
            for (int m = 0; m < 4; ++m)
#pragma unroll
                for (int n = 0; n < 2; ++n) acc[a][b][m][n] = (f32x4){0.f, 0.f, 0.f, 0.f};
    bf16x8 At[4][2], B0[2][2], B1[2][2];
    const char* cA = cur.A; const char* cB = cur.B;
    if constexpr (Epi::SCL) PG8_SCLDMA(cur, 0);
    if constexpr (GATHER) {
        PG8_TOKDMA((const int*)cur.p0, PG8_TB(0)); PG8_WAIT_V(0); PG8_BAR; asm volatile("" ::: "memory");
        PG8_TOKOFF(voffA, PG8_TB(0)); PG8_WAIT_L(0); asm volatile("" ::: "memory");
    } else if constexpr (Epi::SCL) { PG8_WAIT_V(0); PG8_BAR; asm volatile("" ::: "memory"); }
    PG8_STAGE(PG8_SB(0, 0), cB, voffB); PG8_STAGE(PG8_SB(0, 1), cB + hstep, voffB); PG8_STAGE(PG8_SA(0, 0), cA, voffA[0]); PG8_STAGE_A1(PG8_SA(0, 1), cA);
    if (wr == 1) PG8_BAR;
    PG8_WAIT_V(2); PG8_BAR;
    PG8_STAGE(PG8_SB(1, 0), cB + kstep, voffB); PG8_STAGE(PG8_SA(1, 0), cA + kstepA, voffA[0]); PG8_STAGE(PG8_SB(1, 1), cB + hstep + kstep, voffB);
    PG8_WAIT_V(6); PG8_BAR;
    for (;;) {
        const bool has_next = S.next(ui + 1, nxt);
        if constexpr (Epi::SCL) { if (has_next) PG8_SCLDMA(nxt, ui + 1); }
        if constexpr (GATHER) { if (has_next) PG8_TOKDMA((const int*)nxt.p0, PG8_TB(ui + 1)); }
        const char* nA = has_next ? nxt.A : cA; const char* nB = has_next ? nxt.B : cB;
        for (int t = 0; t < nt; t += 2) {
            const bool last = (t == nt - 2);
            const char* a1 = cA + (size_t)(t + 1) * kstepA;
            const char* a2 = last ? nA : cA + (size_t)(t + 2) * kstepA; const char* b2 = last ? nB : cB + (size_t)(t + 2) * kstep;
            const char* a3 = a2 + kstepA; const char* b3 = b2 + kstep;
            if constexpr (MT == 3) {
            PG8_LDB(B0, 0, 0); PG8_LDB(B1, 0, 1); PG8_SCHED; PG8_LDA(At, 0, 0);
            PG8_WAIT_V(6); PG8_WAIT_L(0); PG8_BAR; PG8_MMA(0, 0, At, B0); PG8_SCHED; PG8_STAGE_A1(PG8_SA(1, 1), a1); PG8_SCHED; PG8_MMA(0, 1, At, B1); PG8_BAR; PG8_SCHED;
            if constexpr (GATHER) { if (last && has_next) { PG8_TOKOFF(voffA, PG8_TB(ui + 1)); } }
            PG8_LDA(At, 0, 1);
            PG8_WAIT_V(2); PG8_WAIT_L(0); PG8_BAR; PG8_STAGE(PG8_SB(0, 0), b2, voffB); PG8_SCHED; PG8_MMA(1, 0, At, B0); PG8_SCHED; PG8_STAGE(PG8_SB(0, 1), b2 + hstep, voffB); PG8_SCHED; PG8_MMA(1, 1, At, B1); PG8_SCHED; PG8_STAGE(PG8_SA(0, 0), a2, voffA[0]); PG8_BAR; PG8_SCHED;
            PG8_LDB(B0, 1, 0); PG8_LDB(B1, 1, 1); PG8_SCHED; PG8_LDA(At, 1, 0);
            PG8_WAIT_V(6); PG8_WAIT_L(0); PG8_BAR; PG8_MMA(0, 0, At, B0); PG8_SCHED; PG8_STAGE_A1(PG8_SA(0, 1), a2); PG8_SCHED; PG8_MMA(0, 1, At, B1); PG8_BAR; PG8_SCHED;
            PG8_LDA(At, 1, 1);
            PG8_WAIT_V(2); PG8_WAIT_L(0); PG8_BAR; PG8_STAGE(PG8_SB(1, 0), b3, voffB); PG8_SCHED; PG8_MMA(1, 0, At, B0); PG8_SCHED; PG8_STAGE(PG8_SB(1, 1), b3 + hstep, voffB); PG8_SCHED; PG8_MMA(1, 1, At, B1); PG8_SCHED; PG8_STAGE(PG8_SA(1, 0), a3, voffA[0]); PG8_BAR; PG8_SCHED;
            } else {
            PG8_LDB(B0, 0, 0); PG8_LDB(B1, 0, 1); PG8_SCHED; PG8_LDA(At, 0, 0); PG8_STAGE_A1(PG8_SA(1, 1), a1);
            if constexpr (GATHER) { if (last && has_next) { PG8_TOKOFF(voffA, PG8_TB(ui + 1)); } }
            PG8_WAIT_V(8); PG8_WAIT_L(0); PG8_BAR; PG8_MMA(0, 0, At, B0); PG8_MMA(0, 1, At, B1); PG8_BAR; PG8_SCHED;
            PG8_LDA(At, 0, 1); PG8_STAGE(PG8_SB(0, 0), b2, voffB); PG8_STAGE(PG8_SB(0, 1), b2 + hstep, voffB); PG8_STAGE(PG8_SA(0, 0), a2, voffA[0]);
            PG8_WAIT_V(8); PG8_WAIT_L(0); PG8_BAR; PG8_MMA(1, 0, At, B0); PG8_MMA(1, 1, At, B1); PG8_BAR; PG8_SCHED;
            PG8_LDB(B0, 1, 0); PG8_LDB(B1, 1, 1); PG8_SCHED; PG8_LDA(At, 1, 0); PG8_STAGE_A1(PG8_SA(0, 1), a2);
            PG8_WAIT_V(8); PG8_WAIT_L(0); PG8_BAR; PG8_MMA(0, 0, At, B0); PG8_MMA(0, 1, At, B1); PG8_BAR; PG8_SCHED;
            PG8_LDA(At, 1, 1); PG8_STAGE(PG8_SB(1, 0), b3, voffB); PG8_STAGE(PG8_SB(1, 1), b3 + hstep, voffB); PG8_STAGE(PG8_SA(1, 0), a3, voffA[0]);
            PG8_WAIT_V(8); PG8_WAIT_L(0); PG8_BAR; PG8_MMA(1, 0, At, B0); PG8_MMA(1, 1, At, B1); PG8_BAR; PG8_SCHED;
                    }
        }
        if (wr == 0) PG8_BAR;
#ifndef EPIX
#define EPIX 1
#endif
        for (int e_ = 0; e_ < EPIX; ++e_) E(acc, cur, wr, wc, fr, fq, PG8_TB(ui), PG8_SCB(ui));
        if (!has_next) break;
#pragma unroll
        for (int a = 0; a < 2; ++a)
#pragma unroll
            for (int b = 0; b < 2; ++b)
#pragma unroll
                for (int m = 0; m < 4; ++m)
#pragma unroll
                    for (int n = 0; n < 2; ++n) acc[a][b][m][n] = (f32x4){0.f, 0.f, 0.f, 0.f};
        cur = nxt; cA = nA; cB = nB; ++ui;
        if (wr == 1) PG8_BAR;
    }
    PG8_WAIT_V(0);
    PG8_BAR;
#undef PG8_SA
#undef PG8_SB
#undef PG8_STAGE
#undef PG8_LDA
#undef PG8_STAGE_A1
#undef PG8_LDB
#undef PG8_MMA
#undef PG8_CAT8
#undef PG8_WAIT_V
#undef PG8_WAIT_L
#undef PG8_BAR
#undef PG8_SCHED
#undef PG8_TOKOFF
#undef PG8_TOKDMA
#undef PG8_TB
#undef PG8_SCB
#undef PG8_SCLDMA
}
}

struct Args { const float* in[17]; float* out; unsigned char* ws; int lo, hi, breg, pad; };
struct Frame {
    LAS unsigned char* lds; volatile LAS unsigned* MISC; unsigned* ctl; int tid, lane, wave, G, bid;
    const float *x, *g_mpre, *g_mpost, *g_fpre, *g_fpost, *w_in, *pool_w, *pool_scale, *rpb, *w_out, *dwg, *dwu, *dwd, *router, *mwg, *mwu, *mwd;
    float* out; unsigned char* ws;
};

__device__ __forceinline__ void p0_transpose_item(const float* W, int K, int N, bf16* WT, int kb, int n0, int row_base, LAS float* scr, int lane) {
    const int k0 = 64 * kb;
#pragma unroll 8
    for (int i = 0; i < 32; ++i) { const int kk = 2 * i + (lane >> 5); scr[kk * 33 + (lane & 31)] = W[(size_t)(k0 + kk) * N + n0 + (lane & 31)]; }
    LDS_WAIT(); asm volatile("" ::: "memory");
    const int c = lane & 7;
#pragma unroll
    for (int j = 0; j < 4; ++j) { const int n = (lane >> 3) + 8 * j; const LAS float* s = scr + (8 * c) * 33 + n;
        v4u o; o.x = pk2(s[0 * 33], s[1 * 33]); o.y = pk2(s[2 * 33], s[3 * 33]); o.z = pk2(s[4 * 33], s[5 * 33]); o.w = pk2(s[6 * 33], s[7 * 33]);
        *(v4u*)(WT + (size_t)(row_base + n) * K + k0 + 8 * c) = o; }
    LDS_WAIT(); asm volatile("" ::: "memory");
}
__device__ __forceinline__ void p0_matrix(const float* W, int K, int N, bf16* WT, int ilv_half, LAS float* scr, int lane, int gw, int NGW, int& base) {
    const int nblk = N / 32, nitems = (K / 64) * nblk;
    int it = gw - (base % NGW); if (it < 0) it += NGW;
    for (; it < nitems; it += NGW) { const int kb = it / nblk, n0 = 32 * (it % nblk);
        const int rb = ilv_half < 0 ? n0 : (n0 / 128) * 256 + (n0 % 128) + 128 * ilv_half;
        p0_transpose_item(W, K, N, WT, kb, n0, rb, scr, lane); }
    base += nitems;
}
__device__ __forceinline__ void p0_transpose_item_fp8(const float* W, int K, int N, unsigned char* WT, int kt, int n0, int row_base, float scale, LAS float* scr, int lane) {
    const int k0 = 128 * kt;
#pragma unroll 8
    for (int i = 0; i < 64; ++i) { const int kk = 2 * i + (lane >> 5); scr[kk * 33 + (lane & 31)] = W[(size_t)(k0 + kk) * N + n0 + (lane & 31)] * scale; }
    LDS_WAIT(); asm volatile("" ::: "memory");
    const int c = lane & 7;
#pragma unroll 1
    for (int pass = 0; pass < 4; ++pass) { const int n = (lane >> 3) + 8 * pass; const LAS float* sp = scr + (16 * c) * 33 + n;
        v4u o;
#pragma unroll
        for (int d = 0; d < 4; ++d) { int w = 0; w = __builtin_amdgcn_cvt_pk_fp8_f32(sp[(4 * d) * 33], sp[(4 * d + 1) * 33], w, false); w = __builtin_amdgcn_cvt_pk_fp8_f32(sp[(4 * d + 2) * 33], sp[(4 * d + 3) * 33], w, true); o[d] = (unsigned)w; }
        *(v4u*)(WT + (size_t)(row_base + n) * K + k0 + 16 * c) = o; }
    LDS_WAIT(); asm volatile("" ::: "memory");
}
__device__ __forceinline__ void p0_transpose_item_fp6(const float* W, int K, int N, unsigned char* WT, int kt, int n0, int row_base, float scale, LAS float* scr, int lane) {
    const int k0 = 128 * kt;
#pragma unroll 8
    for (int i = 0; i < 64; ++i) { const int kk = 2 * i + (lane >> 5); scr[kk * 33 + (lane & 31)] = W[(size_t)(k0 + kk) * N + n0 + (lane & 31)] * scale; }
    LDS_WAIT(); asm volatile("" ::: "memory");
    const int n = lane & 31, g = lane >> 5;
    unsigned char* rp = WT + (size_t)(row_base + n) * K + 128 * kt;
#pragma unroll 1
    for (int h = 0; h < 2; ++h) { const int fq = 2 * h + g; const LAS float* sp = scr + (32 * fq) * 33 + n;
        f32x16 x, y;
#pragma unroll
        for (int i = 0; i < 16; ++i) { x[i] = sp[i * 33]; y[i] = sp[(16 + i) * 33]; }
        const i32x6 o = __builtin_amdgcn_cvt_scalef32_2xpk16_fp6_f32(x, y, 1.0f);
        *(v4u*)(rp + 16 * fq) = (v4u){(unsigned)o[0], (unsigned)o[1], (unsigned)o[2], (unsigned)o[3]};
        *(v4u*)(rp + 64 + 16 * fq) = (v4u){(unsigned)o[4], (unsigned)o[5], 0u, 0u}; }
    LDS_WAIT(); asm volatile("" ::: "memory");
}
__device__ __forceinline__ void p0_matrix_fp6(const float* W, int K, int N, unsigned char* WT, int ilv_half, float scale, LAS float* scr, int lane, int gw, int NGW, int& base) {
    const int nblk = N / 32, nitems = (K / 128) * nblk;
    int it = gw - (base % NGW); if (it < 0) it += NGW;
    for (; it < nitems; it += NGW) { const int kt = it / nblk, n0 = 32 * (it % nblk);
        const int rb = (n0 / 128) * 256 + (n0 % 128) + 128 * ilv_half;
        p0_transpose_item_fp6(W, K, N, WT, kt, n0, rb, scale, scr, lane); }
    base += nitems;
}
__device__ __forceinline__ void p0_matrix_fp8(const float* W, int K, int N, unsigned char* WT, int ilv_half, float scale, LAS float* scr, int lane, int gw, int NGW, int& base) {
    const int nblk = N / 32, nitems = (K / 128) * nblk;
    int it = gw - (base % NGW); if (it < 0) it += NGW;
    for (; it < nitems; it += NGW) { const int kt = it / nblk, n0 = 32 * (it % nblk);
        const int rb = ilv_half < 0 ? n0 : (n0 / 128) * 256 + (n0 % 128) + 128 * ilv_half;
        p0_transpose_item_fp8(W, K, N, WT, kt, n0, rb, scale, scr, lane); }
    base += nitems;
}
__device__ __forceinline__ void rms_row_to_bf16(const float* xrow, const float* g, bf16* orow, int lane) {
    const f32x4* xr = (const f32x4*)xrow + lane; const f32x4* gr = (const f32x4*)g + lane;
    f32x4 v[4]; float s = 0.f;
#pragma unroll
    for (int j = 0; j < 4; ++j) { v[j] = xr[64 * j]; s += (v[j].x * v[j].x + v[j].y * v[j].y) + (v[j].z * v[j].z + v[j].w * v[j].w); }
    const float rstd = 1.0f / sqrtf(wave_sum(s) * (1.f / D) + RMS_EPS);
    v2u* o8 = (v2u*)orow + lane;
#pragma unroll
    for (int j = 0; j < 4; ++j) { const f32x4 gg = gr[64 * j]; v2u w; w.x = pk2(v[j].x * rstd * gg.x, v[j].y * rstd * gg.y); w.y = pk2(v[j].z * rstd * gg.z, v[j].w * rstd * gg.w); o8[64 * j] = w; }
}
__device__ __forceinline__ float wave_max(float v) {
#pragma unroll
    for (int o = 1; o < 64; o <<= 1) v = fmaxf(v, __shfl_xor(v, o));
    return v;
}
__device__ __forceinline__ void p0_colblock_i8(Frame& F, const float* W, int N, int n0, unsigned char* W8, float* sW, int dest0) {
    const int tid = F.tid, lane = F.lane, wid = F.wave, n = lane & 31, kh = lane >> 5;
    LAS float* slab = (LAS float*)F.lds; LAS float* cmax = (LAS float*)(F.lds + RING_BYTES);
    __syncthreads();
    float mx = 0.f;
#pragma unroll 1
    for (int i0 = 0; i0 < 64; i0 += 16) {
        float v[16];
#pragma unroll
        for (int i = 0; i < 16; ++i) v[i] = W[(size_t)(128 * wid + 2 * (i0 + i) + kh) * N + n0 + n];
#pragma unroll
        for (int i = 0; i < 16; ++i) { const int k = 128 * wid + 2 * (i0 + i) + kh; slab[k * 32 + (n ^ (k & 31))] = v[i]; mx = fmaxf(mx, fabsf(v[i])); }
    }
    cmax[wid * 64 + lane] = mx;
    __syncthreads();
    float amax = 0.f;
#pragma unroll
    for (int w = 0; w < 8; ++w) amax = fmaxf(amax, fmaxf(cmax[w * 64 + n], cmax[w * 64 + 32 + n]));
    const float sc = amax > 0.f ? amax * (1.0f / 127.0f) : 1.0f, inv = amax > 0.f ? 127.0f / amax : 0.f;
    const int kc = tid >> 5, dest = dest0 + n;
#pragma unroll 1
    for (int q4 = 0; q4 < 4; ++q4) { v4u o;
#pragma unroll
        for (int d = 0; d < 4; ++d) { unsigned w = 0u;
#pragma unroll
            for (int j = 0; j < 4; ++j) { const int k = 64 * kc + 16 * q4 + 4 * d + j; w |= ((unsigned)__float2int_rn(slab[k * 32 + (n ^ (k & 31))] * inv) & 0xffu) << (8 * j); }
            o[d] = w; }
        *(v4u*)(W8 + (size_t)dest * D + 64 * kc + 16 * q4) = o; }
    if (kc == 0) sW[dest] = sc;
}
__device__ __forceinline__ void p0_i8_weights(Frame& F) {
    constexpr int NB_D = I8_DENSE ? 2 * (DFF / 32) : 0, NB_P = I8_PROJ ? DEPTH * (DIN / 32) : 0;
    for (int cb = F.bid; cb < NB_D + NB_P; cb += F.G) {
        if (cb < NB_D) { const int half = cb / (DFF / 32), n0 = 32 * (cb % (DFF / 32));
            p0_colblock_i8(F, half ? F.dwu : F.dwg, DFF, n0, F.ws + WS_WGU0, (float*)(F.ws + WS_SW0), (n0 / 128) * 256 + (n0 % 128) + 128 * half); }
        else { const int c2 = cb - NB_D, l = c2 / (DIN / 32), n0 = 32 * (c2 % (DIN / 32));
            p0_colblock_i8(F, F.w_in + (size_t)l * D * DIN, DIN, n0, F.ws + WS_WIN + (size_t)l * DIN * D, (float*)(F.ws + WS_SWIN) + l * DIN, n0); }
    }
    __syncthreads();
}
__device__ __forceinline__ void rms_row_to_i8(const float* xrow, const float* g, unsigned char* orow, float* sa, int lane) {
    const f32x4* xr = (const f32x4*)xrow + lane; const f32x4* gr = (const f32x4*)g + lane;
    f32x4 v[4]; float s = 0.f;
#pragma unroll
    for (int j = 0; j < 4; ++j) { v[j] = xr[64 * j]; s += (v[j].x * v[j].x + v[j].y * v[j].y) + (v[j].z * v[j].z + v[j].w * v[j].w); }
    const float rstd = 1.0f / sqrtf(wave_sum(s) * (1.f / D) + RMS_EPS); float am = 0.f;
#pragma unroll
    for (int j = 0; j < 4; ++j) { v[j] = v[j] * rstd * gr[64 * j]; am = fmaxf(fmaxf(am, fmaxf(fabsf(v[j].x), fabsf(v[j].y))), fmaxf(fabsf(v[j].z), fabsf(v[j].w))); }
    am = wave_max(am); const float inv = am > 0.f ? 127.0f / am : 0.f;
#pragma unroll
    for (int j = 0; j < 4; ++j) ((unsigned*)orow + lane)[64 * j] = ((unsigned)__float2int_rn(v[j].x * inv) & 0xffu) | (((unsigned)__float2int_rn(v[j].y * inv) & 0xffu) << 8) | (((unsigned)__float2int_rn(v[j].z * inv) & 0xffu) << 16) | (((unsigned)__float2int_rn(v[j].w * inv) & 0xffu) << 24);
    if (lane == 0) *sa = am > 0.f ? am * (1.0f / 127.0f) : 1.0f;
}
__device__ __forceinline__ void p0_prologue(Frame& F0) {
    Frame F = F0; { int t_ = threadIdx.x; asm volatile("" : "+v"(t_)); F.tid = t_; F.lane = t_ & 63; F.wave = __builtin_amdgcn_readfirstlane(t_ >> 6); }
    LAS float* scr = (LAS float*)(F.lds + F.wave * 16896);
    const int gw = F.bid * 8 + F.wave, NGW = F.G * 8, gt = F.bid * 512 + F.tid, NGT = F.G * 512;
    { v4u z = (v4u){0u, 0u, 0u, 0u}; v4u* L = (v4u*)(F.ws + WS_LIST); for (int i = gt; i < (int)(NE * T / 4); i += NGT) L[i] = z;
      int* id = (int*)(F.ws + WS_LISTID); for (int i = gt; i < T; i += NGT) id[i] = i; }
    int base = 0;
    for (int l = 0; l < DEPTH; ++l) {
#if !I8_PROJ
        p0_matrix(F.w_in + (size_t)l * D * DIN, D, DIN, (bf16*)(F.ws + WS_WIN) + (size_t)l * DIN * D, -1, scr, F.lane, gw, NGW, base);
#endif
        p0_matrix(F.w_out + (size_t)l * D * D, D, D, (bf16*)(F.ws + WS_WOUT) + (size_t)l * D * D, -1, scr, F.lane, gw, NGW, base);
        for (int g = 0; g < 4; ++g) p0_matrix(F.pool_w + (size_t)(l * 4 + g) * 128 * 128, 128, 128, (bf16*)(F.ws + WS_WP) + (size_t)(l * 4 + g) * 128 * 128, -1, scr, F.lane, gw, NGW, base);
    }
#if !I8_DENSE
    p0_matrix(F.dwg, D, DFF, (bf16*)(F.ws + WS_WGU0), 0, scr, F.lane, gw, NGW, base);
    p0_matrix(F.dwu, D, DFF, (bf16*)(F.ws + WS_WGU0), 1, scr, F.lane, gw, NGW, base);
#endif
#if FP8_DDOWN
    p0_matrix_fp8(F.dwd, DFF, D, F.ws + WS_WD0, -1, W8_DN, scr, F.lane, gw, NGW, base);
#else
    p0_matrix(F.dwd, DFF, D, (bf16*)(F.ws + WS_WD0), -1, scr, F.lane, gw, NGW, base);
#endif
    for (int e = 0; e < NE; ++e) {
#if FP8_MOE
#if FP6_UP
        p0_matrix_fp6(F.mwg + (size_t)e * D * DFFE, D, DFFE, F.ws + WS_WGUM + (size_t)e * 2 * DFFE * D, 0, S6W, scr, F.lane, gw, NGW, base);
        p0_matrix_fp6(F.mwu + (size_t)e * D * DFFE, D, DFFE, F.ws + WS_WGUM + (size_t)e * 2 * DFFE * D, 1, S6W, scr, F.lane, gw, NGW, base);
#else
        p0_matrix_fp8(F.mwg + (size_t)e * D * DFFE, D, DFFE, F.ws + WS_WGUM + (size_t)e * 2 * DFFE * D, 0, W8_UP, scr, F.lane, gw, NGW, base);
        p0_matrix_fp8(F.mwu + (size_t)e * D * DFFE, D, DFFE, F.ws + WS_WGUM + (size_t)e * 2 * DFFE * D, 1, W8_UP, scr, F.lane, gw, NGW, base);
#endif
        p0_matrix_fp8(F.mwd + (size_t)e * DFFE * D, DFFE, D, F.ws + WS_WDM + (size_t)e * D * DFFE, -1, W8_DN, scr, F.lane, gw, NGW, base);
#else
        p0_matrix(F.mwg + (size_t)e * D * DFFE, D, DFFE, (bf16*)(F.ws + WS_WGUM) + (size_t)e * 2 * DFFE * D, 0, scr, F.lane, gw, NGW, base);
        p0_matrix(F.mwu + (size_t)e * D * DFFE, D, DFFE, (bf16*)(F.ws + WS_WGUM) + (size_t)e * 2 * DFFE * D, 1, scr, F.lane, gw, NGW, base);
        p0_matrix(F.mwd + (size_t)e * DFFE * D, DFFE, D, (bf16*)(F.ws + WS_WDM) + (size_t)e * D * DFFE, -1, scr, F.lane, gw, NGW, base);
#endif
    }
    bf16* HN = (bf16*)(F.ws + WS_HN);
#if I8_PROJ
    for (int m = gw; m < T; m += NGW) rms_row_to_i8(F.x + (size_t)m * D, F.g_mpre, (unsigned char*)HN + (size_t)m * D, (float*)(F.ws + WS_SA) + m, F.lane);
#else
    for (int m = gw; m < T; m += NGW) rms_row_to_bf16(F.x + (size_t)m * D, F.g_mpre, HN + (size_t)m * D, F.lane);
#endif
#if I8_DENSE || I8_PROJ
    p0_i8_weights(F);
#endif
}

__device__ __forceinline__ unsigned ld_cnt(const unsigned* ctl, int e) { return __hip_atomic_load(ctl + CW_CNT + 64 * e, RLX_AGENT); }

__device__ __forceinline__ void ld_bf16_row(const bf16* row, int lane, f32x4 (&v)[4]) {
    const v2u* p = (const v2u*)row + lane;
#pragma unroll
    for (int j = 0; j < 4; ++j) { const v2u w = p[64 * j]; v[j] = (f32x4){bflo(w.x), bfhi(w.x), bflo(w.y), bfhi(w.y)}; }
}
__device__ __forceinline__ float sumsq16(const f32x4 (&v)[4]) {
    float s = 0.f;
#pragma unroll
    for (int j = 0; j < 4; ++j) s += (v[j].x * v[j].x + v[j].y * v[j].y) + (v[j].z * v[j].z + v[j].w * v[j].w);
    return s;
}
#define H16 FP8_MOE
struct NormRow { v2u a[4]; v2u b[4]; f32x4 hf[4]; v2u hb[4]; float g0, g1; };
template <bool FFN>
__device__ __forceinline__ void norm_phase(Frame& F0, int l) {
    Frame F = F0; { int t_ = threadIdx.x; asm volatile("" : "+v"(t_)); F.tid = t_; F.lane = t_ & 63; F.wave = __builtin_amdgcn_readfirstlane(t_ >> 6); }
    const int lane = F.lane, gw = F.bid * 8 + F.wave, NGW = F.G * 8;
    const bool moe = (l & 1) != 0;
    LAS float* WR = (LAS float*)F.lds;
    LAS unsigned* lcnt = (LAS unsigned*)(F.lds + LCNT_OFF); LAS unsigned* lbase = lcnt + 8;
    LAS int* bst = (LAS int*)(F.lds + BST_OFF);
    LAS float* rowbuf = (LAS float*)(F.lds + 32768 + F.wave * 4352);
    if (!FFN && moe) {
        for (int i = F.tid; i < D * NE; i += 512) { const int d = i >> 3, e = i & 7; WR[e * D + d] = F.router[i]; }
        if (F.tid < 8) lcnt[F.tid] = 0u;
        __syncthreads();
    }
    if (FFN && moe) {
        if (F.tid == 0) { int s = 0; for (int e = 0; e < NE; ++e) { bst[e] = s; s += (int)((ld_cnt(F.ctl, e) + 255u) >> 8); } }
        __syncthreads();
    }
    const float* gA = FFN ? F.g_fpost + l * D : F.g_mpost + l * D;
    const float* gB = FFN ? F.g_mpre + (l + 1) * D : F.g_fpre + l * D;
    const bool haveB = FFN ? (l + 1 < DEPTH) : true;
    const bool last = FFN && (l + 1 == DEPTH);
    const bool I8HN = FFN ? (I8_PROJ != 0) : (I8_DENSE && !moe);
    const bool hold_f32 = (!FFN && l == 0) || !H16;
    const bf16* addsrc = FFN ? (const bf16*)(F.ws + WS_Y) : (const bf16*)(F.ws + WS_MIX);
    const float* hold32 = (!FFN && l == 0) ? F.x : F.out;
    bf16* H = (bf16*)(F.ws + WS_H16);
    bf16* HN = (bf16*)(F.ws + WS_HN);
    const v2u* info = (const v2u*)(F.ws + WS_INFO); const f32x2* ginfo = (const f32x2*)(F.ws + WS_INFO + 256 * 1024);
#define NORM_LOAD(R, m_, nf_, gg_) do { \
        if (FFN && moe) { const int e0_ = (int)((nf_).x >> 16), p0_ = (int)((nf_).x & 0xffffu), e1_ = (int)((nf_).y >> 16), p1_ = (int)((nf_).y & 0xffffu); \
            const v2u* pa_ = (const v2u*)(addsrc + (size_t)(256 * bst[e0_] + p0_) * D) + lane; const v2u* pb_ = (const v2u*)(addsrc + (size_t)(256 * bst[e1_] + p1_) * D) + lane; \
            _Pragma("unroll") for (int j = 0; j < 4; ++j) { (R).a[j] = pa_[64 * j]; (R).b[j] = pb_[64 * j]; } (R).g0 = (gg_).x; (R).g1 = (gg_).y; } \
        else { const v2u* pa_ = (const v2u*)(addsrc + (size_t)(m_) * D) + lane; _Pragma("unroll") for (int j = 0; j < 4; ++j) (R).a[j] = pa_[64 * j]; } \
        if (hold_f32) { const f32x4* hp_ = (const f32x4*)(hold32 + (size_t)(m_) * D) + lane; _Pragma("unroll") for (int j = 0; j < 4; ++j) (R).hf[j] = hp_[64 * j]; } \
        else { const v2u* hp_ = (const v2u*)(H + (size_t)(m_) * D) + lane; _Pragma("unroll") for (int j = 0; j < 4; ++j) (R).hb[j] = hp_[64 * j]; } } while (0)
    int sTok = 0, sE0 = 0, sE1 = 0; float sG0 = 0.f, sG1 = 0.f;
    v2u nfL = (v2u){0u, 0u}; f32x2 ggL = (f32x2){0.f, 0.f};
    if (FFN && moe) { const int mi = gw + lane * NGW; if (mi < T) { nfL = info[mi]; ggL = ginfo[mi]; } }
    const int nfLx = (int)nfL.x, nfLy = (int)nfL.y; const float ggLx_ = ggL.x, ggLy_ = ggL.y; const int ggLx = __float_as_int(ggLx_), ggLy = __float_as_int(ggLy_);
#define NORM_INFO(nf_, gg_, it_) do { if (FFN && moe) { const int x_ = __builtin_amdgcn_readlane(nfLx, it_), y_ = __builtin_amdgcn_readlane(nfLy, it_), gx_ = __builtin_amdgcn_readlane(ggLx, it_), gy_ = __builtin_amdgcn_readlane(ggLy, it_); \
        (nf_).x = (unsigned)x_; (nf_).y = (unsigned)y_; (gg_).x = __int_as_float(gx_); (gg_).y = __int_as_float(gy_); } } while (0)
#define NORM_ROW(R, m_, it_) do { \
        f32x4 a[4]; \
        _Pragma("unroll") for (int j = 0; j < 4; ++j) { a[j] = (f32x4){bflo((R).a[j].x), bfhi((R).a[j].x), bflo((R).a[j].y), bfhi((R).a[j].y)}; \
            if (FFN && moe) { const f32x4 b = (f32x4){bflo((R).b[j].x), bfhi((R).b[j].x), bflo((R).b[j].y), bfhi((R).b[j].y)}; a[j] = a[j] * (R).g0 + b * (R).g1; } } \
        const float r1 = 1.0f / sqrtf(wave_sum(sumsq16(a)) * (1.f / D) + RMS_EPS); \
        const f32x4* gAp = (const f32x4*)gA + lane; \
        f32x4 h[4]; \
        _Pragma("unroll") for (int j = 0; j < 4; ++j) { const f32x4 ho = hold_f32 ? (R).hf[j] : (f32x4){bflo((R).hb[j].x), bfhi((R).hb[j].x), bflo((R).hb[j].y), bfhi((R).hb[j].y)}; h[j] = ho + a[j] * r1 * gAp[64 * j]; } \
        if (last || !H16) { f32x4* op = (f32x4*)(F.out + (size_t)(m_) * D) + lane; _Pragma("unroll") for (int j = 0; j < 4; ++j) op[64 * j] = h[j]; } \
        else { v2u* op = (v2u*)(H + (size_t)(m_) * D) + lane; _Pragma("unroll") for (int j = 0; j < 4; ++j) { v2u w; w.x = cvt_pk_bf16(h[j].x, h[j].y); w.y = cvt_pk_bf16(h[j].z, h[j].w); op[64 * j] = w; } } \
        if (haveB) { \
            const float r2 = 1.0f / sqrtf(wave_sum(sumsq16(h)) * (1.f / D) + RMS_EPS); \
            const f32x4* gBp = (const f32x4*)gB + lane; v2u* o8 = (v2u*)(HN + (size_t)(m_) * D) + lane; \
            _Pragma("unroll") for (int j = 0; j < 4; ++j) { h[j] = h[j] * r2 * gBp[64 * j]; \
                if (FP8_MOE && FP6_UP && !FFN && moe) { const int e_ = 256 * j + 4 * lane, ix_ = e_ + (e_ >> 5); rowbuf[ix_] = h[j].x * S6A; rowbuf[ix_ + 1] = h[j].y * S6A; rowbuf[ix_ + 2] = h[j].z * S6A; rowbuf[ix_ + 3] = h[j].w * S6A; } \
                else if (FP8_MOE && !FFN && moe) { int w = 0; w = __builtin_amdgcn_cvt_pk_fp8_f32(h[j].x, h[j].y, w, false); w = __builtin_amdgcn_cvt_pk_fp8_f32(h[j].z, h[j].w, w, true); ((unsigned*)((unsigned char*)HN + (size_t)(m_) * D) + lane)[64 * j] = (unsigned)w; } \
                else if (!I8HN) { v2u w; w.x = cvt_pk_bf16(h[j].x, h[j].y); w.y = cvt_pk_bf16(h[j].z, h[j].w); o8[64 * j] = w; } } \
            if (FP8_MOE && FP6_UP && !FFN && moe) { asm volatile("s_waitcnt lgkmcnt(0)" ::: "memory"); \
                if (lane < 32) { f32x16 x_, y_; _Pragma("unroll") for (int i = 0; i < 16; ++i) { x_[i] = rowbuf[33 * lane + i]; y_[i] = rowbuf[33 * lane + 16 + i]; } \
                    const i32x6 o_ = __builtin_amdgcn_cvt_scalef32_2xpk16_fp6_f32(x_, y_, 1.0f); unsigned char* rp_ = (unsigned char*)HN + (size_t)(m_) * D + 128 * (lane >> 2); \
                    *(v4u*)(rp_ + 16 * (lane & 3)) = (v4u){(unsigned)o_[0], (unsigned)o_[1], (unsigned)o_[2], (unsigned)o_[3]}; *(v4u*)(rp_ + 64 + 16 * (lane & 3)) = (v4u){(unsigned)o_[4], (unsigned)o_[5], 0u, 0u}; } \
                asm volatile("s_waitcnt lgkmcnt(0)" ::: "memory"); } \
            if (I8HN) { float am = 0.f; \
                _Pragma("unroll") for (int j = 0; j < 4; ++j) am = fmaxf(fmaxf(am, fmaxf(fabsf(h[j].x), fabsf(h[j].y))), fmaxf(fabsf(h[j].z), fabsf(h[j].w))); \
                am = wave_max(am); const float sa_ = am > 0.f ? am * (1.0f / 127.0f) : 1.0f, inv_ = am > 0.f ? 127.0f / am : 0.f; \
                _Pragma("unroll") for (int j = 0; j < 4; ++j) { const unsigned w = ((unsigned)__float2int_rn(h[j].x * inv_) & 0xffu) | (((unsigned)__float2int_rn(h[j].y * inv_) & 0xffu) << 8) | (((unsigned)__float2int_rn(h[j].z * inv_) & 0xffu) << 16) | (((unsigned)__float2int_rn(h[j].w * inv_) & 0xffu) << 24); \
                    ((unsigned*)((unsigned char*)HN + (size_t)(m_) * D) + lane)[64 * j] = w; } \
                if (lane == 0) ((float*)(F.ws + WS_SA))[(m_)] = sa_; } \
            if (!FFN && moe) { \
                float lg[NE]; \
                _Pragma("unroll") for (int e = 0; e < NE; ++e) { float s_ = 0.f; \
                    _Pragma("unroll") for (int j = 0; j < 4; ++j) { const f32x4 w = *(const LAS f32x4*)(WR + e * D + 256 * j + 4 * lane); s_ += (h[j].x * w.x + h[j].y * w.y) + (h[j].z * w.z + h[j].w * w.w); } \
                    lg[e] = wave_sum(s_); } \
                int e0 = 0; float l0 = lg[0]; \
                _Pragma("unroll") for (int e = 1; e < NE; ++e) if (lg[e] > l0) { l0 = lg[e]; e0 = e; } \
                int e1 = -1; float l1 = -INFINITY; \
                _Pragma("unroll") for (int e = 0; e < NE; ++e) if (e != e0 && lg[e] > l1) { l1 = lg[e]; e1 = e; } \
                const float g0 = 1.0f / (1.0f + __expf(l1 - l0)), g1 = 1.0f - g0; \
                if (lane == (it_)) { sTok = (m_); sE0 = e0; sE1 = e1; sG0 = g0; sG1 = g1; } \
            } \
        } } while (0)
    int it = 0;
    NormRow c0, c1; v2u nf = (v2u){0u, 0u}; f32x2 gg = (f32x2){0.f, 0.f};
    if (gw < T) { NORM_INFO(nf, gg, 0); NORM_LOAD(c0, gw, nf, gg); }
    if (gw + NGW < T) { NORM_INFO(nf, gg, 1); NORM_LOAD(c1, gw + NGW, nf, gg); }
    for (int m = gw; m < T; m += 2 * NGW, it += 2) {
        const int m1 = m + NGW, m2 = m + 2 * NGW, m3 = m + 3 * NGW;
        NormRow n0, n1;
        if (m2 < T) { NORM_INFO(nf, gg, it + 2); NORM_LOAD(n0, m2, nf, gg); }
        if (m3 < T) { NORM_INFO(nf, gg, it + 3); NORM_LOAD(n1, m3, nf, gg); }
        NORM_ROW(c0, m, it);
        if (m1 < T) NORM_ROW(c1, m1, it + 1);
        c0 = n0; c1 = n1;
    }
    it = (T - gw + NGW - 1) / NGW; if (it < 0) it = 0;
#undef NORM_ROW
#undef NORM_INFO
#undef NORM_LOAD
    if (!FFN && moe) {
        unsigned loc0 = 0u, loc1 = 0u;
        if (lane < it) { loc0 = __hip_atomic_fetch_add(lcnt + sE0, 1u, __ATOMIC_RELAXED, __HIP_MEMORY_SCOPE_WORKGROUP); loc1 = __hip_atomic_fetch_add(lcnt + sE1, 1u, __ATOMIC_RELAXED, __HIP_MEMORY_SCOPE_WORKGROUP); }
        __syncthreads();
        if (F.tid < 8) lbase[F.tid] = __hip_atomic_fetch_add(F.ctl + CW_CNT + 64 * F.tid, lcnt[F.tid], RLX_AGENT);
        __syncthreads();
        if (lane < it) {
            const unsigned p0 = lbase[sE0] + loc0, p1 = lbase[sE1] + loc1;
            int* list = (int*)(F.ws + WS_LIST);
            list[(size_t)sE0 * T + p0] = sTok; list[(size_t)sE1 * T + p1] = sTok;
            v2u nf; nf.x = ((unsigned)sE0 << 16) | p0; nf.y = ((unsigned)sE1 << 16) | p1;
            ((v2u*)(F.ws + WS_INFO))[sTok] = nf; ((f32x2*)(F.ws + WS_INFO + 256 * 1024))[sTok] = (f32x2){sG0, sG1};
        }
    }
}

__device__ __forceinline__ size_t mixo_index(size_t tok, int ch) { return ((tok >> 8) * 16 + (size_t)(ch >> 6)) * (256 * 64) + (tok & 255) * 64 + (ch & 63); }
constexpr int U_PITCH = 1040, U_ROWS = 80, BIAS_OFF = U_PITCH * U_ROWS;
typedef __bf16 bf16x2_t __attribute__((ext_vector_type(2)));
template <int HW>
__device__ __forceinline__ void pool_frags(bf16x8 (&dfr)[2][4], const LAS unsigned char* cb, const float (&inv)[2]) {
    unsigned one_lo_ = 0x00003f80u, one_hi_ = 0x3f800000u; asm volatile("" : "+v"(one_lo_), "+v"(one_hi_));
    const bf16x2_t ONE_LO = __builtin_bit_cast(bf16x2_t, one_lo_), ONE_HI = __builtin_bit_cast(bf16x2_t, one_hi_);
#pragma unroll
    for (int mt = 0; mt < 2; ++mt)
#pragma unroll
        for (int ks = 0; ks < 4; ++ks) {
            const LAS unsigned char* cp = cb + mt * 16 * U_PITCH + ks * 64;
            float s0 = 0.f, s1 = 0.f, s2 = 0.f, s3 = 0.f, s4 = 0.f, s5 = 0.f, s6 = 0.f, s7 = 0.f;
#pragma unroll
            for (int d = -HW; d < HW; ++d) { const v4u v = *(const LAS v4u*)(cp + d * U_PITCH); const unsigned vx = v.x, vy = v.y, vz = v.z, vw = v.w;
                const bf16x2_t px = __builtin_bit_cast(bf16x2_t, vx), py = __builtin_bit_cast(bf16x2_t, vy), pz = __builtin_bit_cast(bf16x2_t, vz), pw = __builtin_bit_cast(bf16x2_t, vw);
                s0 = __builtin_amdgcn_fdot2_f32_bf16(px, ONE_LO, s0, false); s1 = __builtin_amdgcn_fdot2_f32_bf16(px, ONE_HI, s1, false);
                s2 = __builtin_amdgcn_fdot2_f32_bf16(py, ONE_LO, s2, false); s3 = __builtin_amdgcn_fdot2_f32_bf16(py, ONE_HI, s3, false);
                s4 = __builtin_amdgcn_fdot2_f32_bf16(pz, ONE_LO, s4, false); s5 = __builtin_amdgcn_fdot2_f32_bf16(pz, ONE_HI, s5, false);
                s6 = __builtin_amdgcn_fdot2_f32_bf16(pw, ONE_LO, s6, false); s7 = __builtin_amdgcn_fdot2_f32_bf16(pw, ONE_HI, s7, false); }
            const v4u c = *(const LAS v4u*)cp; const float iv = inv[mt];
            v4u p; p.x = cvt_pk_bf16(s0 * iv - bflo(c.x), s1 * iv - bfhi(c.x)); p.y = cvt_pk_bf16(s2 * iv - bflo(c.y), s3 * iv - bfhi(c.y));
            p.z = cvt_pk_bf16(s4 * iv - bflo(c.z), s5 * iv - bfhi(c.z)); p.w = cvt_pk_bf16(s6 * iv - bflo(c.w), s7 * iv - bfhi(c.w));
            dfr[mt][ks] = __builtin_bit_cast(bf16x8, p);
        }
}
__device__ __forceinline__ void mixer_phase(Frame& F0, int l) {
    Frame F = F0; { int t_ = threadIdx.x; asm volatile("" : "+v"(t_)); F.tid = t_; F.lane = t_ & 63; F.wave = __builtin_amdgcn_readfirstlane(t_ >> 6); }
    const int tid = F.tid, lane = F.lane, wid = F.wave, fr = lane & 15, fq = lane >> 4;
    const bf16* proj = (const bf16*)(F.ws + WS_PROJ); bf16* mixo = (bf16*)(F.ws + WS_MIXO);
    const bf16* Wp = (const bf16*)(F.ws + WS_WP) + (size_t)l * 4 * 128 * 128; const float* pscale = F.pool_scale + l * DPOOL;
    const int vcu = (F.G % 8 == 0) ? (F.bid % 8) * (F.G / 8) + F.bid / 8 : F.bid;
    for (int unit = vcu; unit < BATCH * GROWS; unit += F.G) {
        const int b = unit / GROWS, r = unit % GROWS, tb0 = b * SEQ, trow0 = 64 * r - 8;
        __syncthreads();
        { v4u uv[10];
#pragma unroll
          for (int k = 0; k < 10; ++k) { const int idx = tid + 512 * k, row = idx >> 6, pc = idx & 63, t = trow0 + row; uv[k] = (v4u){0u, 0u, 0u, 0u}; if (t >= 0 && t < SEQ) uv[k] = *(const v4u*)(proj + (size_t)(tb0 + t) * UPITCH + pc * 8); }
#pragma unroll
          for (int k = 0; k < 10; ++k) { const int idx = tid + 512 * k, row = idx >> 6, pc = idx & 63; *(LAS v4u*)(F.lds + row * U_PITCH + pc * 16) = uv[k]; } }
        __syncthreads();
#ifndef REP_POOL
#define REP_POOL 1
#endif
        for (int rep_ = 0; rep_ < REP_POOL; ++rep_) {
            const int g = wid >> 1, half = wid & 1, hw = 1 << g;
            const bf16* Wg = Wp + (size_t)g * 128 * 128;
            bf16x8 wnext[4];
#pragma unroll
            for (int ks = 0; ks < 4; ++ks) wnext[ks] = *(const bf16x8*)(Wg + (size_t)fr * 128 + 32 * ks + 8 * fq);
            bf16x8 dfr[2][4];
            { const LAS unsigned char* cb = F.lds + (8 + 32 * half + fr) * U_PITCH + (128 * g + 8 * fq) * 2;
              float inv[2];
#pragma unroll
              for (int mt = 0; mt < 2; ++mt) { const int t = 64 * r + 32 * half + 16 * mt + fr; inv[mt] = 1.0f / (float)(min(t + hw, SEQ) - max(t - hw, 0)); }
              switch (g) { case 0: pool_frags<1>(dfr, cb, inv); break; case 1: pool_frags<2>(dfr, cb, inv); break; case 2: pool_frags<4>(dfr, cb, inv); break; default: pool_frags<8>(dfr, cb, inv); break; } }
#pragma unroll
            for (int nt = 0; nt < 8; ++nt) {
                bf16x8 wf[4];
#pragma unroll
                for (int ks = 0; ks < 4; ++ks) wf[ks] = wnext[ks];
                if (nt + 1 < 8) {
#pragma unroll
                    for (int ks = 0; ks < 4; ++ks) wnext[ks] = *(const bf16x8*)(Wg + (size_t)(16 * (nt + 1) + fr) * 128 + 32 * ks + 8 * fq); }
                const f32x4 sc = *(const f32x4*)(pscale + 128 * g + 16 * nt + 4 * fq);
#pragma unroll
                for (int mt = 0; mt < 2; ++mt) {
                    f32x4 acc = (f32x4){0.f, 0.f, 0.f, 0.f};
#pragma unroll
                    for (int ks = 0; ks < 4; ++ks) acc = __builtin_amdgcn_mfma_f32_16x16x32_bf16(wf[ks], dfr[mt][ks], acc, 0, 0, 0);
                    acc = acc * sc;
                    v2u w; w.x = cvt_pk_bf16(acc[0], acc[1]); w.y = cvt_pk_bf16(acc[2], acc[3]);
                    *(v2u*)(mixo + mixo_index((size_t)(tb0 + 64 * r + 32 * half + 16 * mt + fr), 128 * g + 16 * nt + 4 * fq)) = w;
                }
            }
        }
    }
    __syncthreads();
}

constexpr int NA_KTOK = 80, NA_KROW = 64 * NA_KTOK, NA_VD = 144, NA_VROW = 32 * NA_VD, NA_NKR = 11, NA_NPC = NA_NKR * 256;
constexpr int NA_K_OFF = 0, NA_V_OFF = NA_NKR * NA_KROW, NA_B_OFF = NA_V_OFF + NA_NKR * NA_VROW;
static_assert(NA_B_OFF + 15 * 128 <= RING_BYTES, "NA LDS map");
#ifndef REP_NA
#define REP_NA 1
#endif
__device__ __forceinline__ void na_phase(Frame& F0, int l) {
    Frame F = F0; { int t_ = threadIdx.x; asm volatile("" : "+v"(t_)); F.tid = t_; F.lane = t_ & 63; F.wave = __builtin_amdgcn_readfirstlane(t_ >> 6); }
    const int tid = F.tid, lane = F.lane, wid = F.wave, fr = lane & 15, fq = lane >> 4;
    const bf16* projq = (const bf16*)(F.ws + WS_PQ); const bf16* projk = (const bf16*)(F.ws + WS_PK); const bf16* Vt = (const bf16*)(F.ws + WS_VT); bf16* mixo = (bf16*)(F.ws + WS_MIXO);
    const float* rpb = F.rpb + (size_t)l * NH * 15 * 31;
    const int vcu = (F.G % 8 == 0) ? (F.bid % 8) * (F.G / 8) + F.bid / 8 : F.bid;
    constexpr int NU = BATCH * NH * (GROWS / 4);
    const int upc = (NU + F.G - 1) / F.G, u0 = vcu * upc, u1 = min(u0 + upc, NU);
    v4u kreg[6], vreg[6];
    int w_hi = -1, w_bh = -1;
#define NA_UNIT(u, b, h, sg, krlo, nrows) const int b = (u) / (NH * 64), h = ((u) / 64) % NH, sg = (u) % 64, krlo = min(max(4 * sg - 4, 0), GROWS - KH), nrows = min(NA_NKR, GROWS - krlo)
#define NA_PLAN(u, newlo, nnew) NA_UNIT(u, pb_, ph_, psg_, pkrlo_, pnrows_); const bool keep_ = ((u) / 64 == w_bh) && pkrlo_ <= w_hi && pkrlo_ + NA_NKR > w_hi - 1; \
        const int newlo = keep_ ? max(pkrlo_, w_hi) : pkrlo_, nnew = pkrlo_ + pnrows_ - newlo; (void)psg_
#define NA_LOAD(newlo, nnew, b_, h_) do { const size_t tb_ = (size_t)(b_) * SEQ + 64 * (newlo); \
        _Pragma("unroll") for (int k = 0; k < 6; ++k) { const int p = tid + 512 * k, row = p >> 8, rem = p & 255; \
            if (row < (nnew)) { kreg[k] = *(const v4u*)(projk + ((size_t)(h_) * T + tb_ + 64 * row + (rem >> 2)) * 32 + 8 * (rem & 3)); \
                vreg[k] = *(const v4u*)(Vt + vt_index(32 * (h_) + (rem >> 3), (int)tb_ + 64 * row) + 8 * (rem & 7)); } } } while (0)
    int c_newlo = 0, c_nnew = 0;
    if (u0 < u1) { NA_PLAN(u0, nl_, nn_); c_newlo = nl_; c_nnew = nn_; NA_LOAD(nl_, nn_, pb_, ph_); }
    for (int u = u0; u < u1; ++u) {
        NA_UNIT(u, b, h, sg, krlo, nrows);
        __syncthreads();
#pragma unroll
        for (int k = 0; k < 6; ++k) { const int p = tid + 512 * k, row = p >> 8, rem = p & 255;
            if (row < c_nnew) { const int slot = (c_newlo + row) % NA_NKR;
                *(LAS v4u*)(F.lds + NA_K_OFF + slot * NA_KROW + (rem >> 2) * NA_KTOK + 16 * (rem & 3)) = kreg[k];
                *(LAS v4u*)(F.lds + NA_V_OFF + slot * NA_VROW + (rem >> 3) * NA_VD + 16 * (rem & 7)) = vreg[k]; } }
        if (tid < 15 * 32) { const int col = tid & 31, row = tid >> 5; *(LAS float*)(F.lds + NA_B_OFF + tid * 4) = col < 31 ? rpb[(h * 15 + row) * 31 + col] * LOG2E : -INFINITY; }
        __syncthreads();
        w_hi = krlo + nrows; w_bh = u / 64;
        if (u + 1 < u1) { NA_PLAN(u + 1, nl_, nn_); c_newlo = nl_; c_nnew = nn_; NA_LOAD(nl_, nn_, pb_, ph_); }
        const size_t tb0 = (size_t)b * SEQ;
#pragma unroll 1
        for (int tt = 0; tt < 2; ++tt) {
            const int t = wid + 8 * tt, j = t >> 2, qb = t & 3, r = 4 * sg + j, r0 = min(max(r - KH / 2, 0), GROWS - KH);
            const int cs = qb == 0 ? 0 : (qb == 1 ? 8 : (qb == 2 ? 24 : 32));
            const int c = 16 * qb + fr, c0 = min(max(c - KW / 2, 0), GRIDW - KW);
            const int th = c0 - cs;
            bool vq[4]; int boff[4];
#pragma unroll
            for (int q = 0; q < 4; ++q) { vq[q] = (4 * fq + q) >= th; boff[q] = (cs + 4 * fq + q + (vq[q] ? 0 : 16) - c + KW - 1) * 4; }
            const unsigned M0 = (vq[0] ? 0xffffu : 0u) | (vq[1] ? 0xffff0000u : 0u), M1 = (vq[2] ? 0xffffu : 0u) | (vq[3] ? 0xffff0000u : 0u), N0 = ~M0, N1 = ~M1;
            const size_t qtok = tb0 + 64 * r + 16 * qb + fr;
            const bf16x8 qf = *(const bf16x8*)(projq + ((size_t)h * T + qtok) * 32 + 8 * fq);
            int slot[KH];
#pragma unroll
            for (int kr = 0; kr < KH; ++kr) slot[kr] = (r0 + kr) % NA_NKR;
            const LAS unsigned char* kb = F.lds + NA_K_OFF + (cs + fr) * NA_KTOK + 16 * fq;
            const LAS unsigned char* bb = F.lds + NA_B_OFF + (r0 - r + KH - 1) * 128;
            f32x2 sv[KH][2];
            float mx = -INFINITY;
#pragma unroll
            for (int kr = 0; kr < KH; ++kr) {
                f32x4 bv;
#pragma unroll
                for (int q = 0; q < 4; ++q) bv[q] = *(const LAS float*)(bb + boff[q] + kr * 128);
                const f32x4 s0 = __builtin_amdgcn_mfma_f32_16x16x32_bf16(*(const LAS bf16x8*)(kb + slot[kr] * NA_KROW), qf, bv, 0, 0, 0);
                const f32x4 s1 = __builtin_amdgcn_mfma_f32_16x16x32_bf16(*(const LAS bf16x8*)(kb + slot[kr] * NA_KROW + 16 * NA_KTOK), qf, bv, 0, 0, 0);
                const float e0 = vq[0] ? s0[0] : s1[0], e1 = vq[1] ? s0[1] : s1[1], e2 = vq[2] ? s0[2] : s1[2], e3 = vq[3] ? s0[3] : s1[3];
                sv[kr][0] = (f32x2){e0, e1}; sv[kr][1] = (f32x2){e2, e3};
                mx = fmaxf(fmaxf(mx, e0), e1); mx = fmaxf(fmaxf(mx, e2), e3);
            }
            mx = fmaxf(mx, __shfl_xor(mx, 16)); mx = fmaxf(mx, __shfl_xor(mx, 32));
            const f32x2 mx2 = (f32x2){mx, mx};
            f32x2 sum2 = (f32x2){0.f, 0.f};
#pragma unroll
            for (int kr = 0; kr < KH; ++kr)
#pragma unroll
                for (int hh = 0; hh < 2; ++hh) { const f32x2 dlt = sv[kr][hh] - mx2; f32x2 p; p.x = __builtin_amdgcn_exp2f(dlt.x); p.y = __builtin_amdgcn_exp2f(dlt.y); sv[kr][hh] = p; sum2 += p; }
            float sum = sum2.x + sum2.y;
            sum += __shfl_xor(sum, 16); sum += __shfl_xor(sum, 32);
            const LAS unsigned char* vb = F.lds + NA_V_OFF + fr * NA_VD + (cs + 4 * fq) * 2;
            f32x4 o[2] = {(f32x4){0.f, 0.f, 0.f, 0.f}, (f32x4){0.f, 0.f, 0.f, 0.f}};
#pragma unroll
            for (int kr = 0; kr < KH; ++kr) {
                const unsigned u01 = cvt_pk_bf16(sv[kr][0].x, sv[kr][0].y), u23 = cvt_pk_bf16(sv[kr][1].x, sv[kr][1].y);
                v4u pw; pw.x = u01 & M0; pw.y = u23 & M1; pw.z = u01 & N0; pw.w = u23 & N1;
                const bf16x8 pf = __builtin_bit_cast(bf16x8, pw);
#pragma unroll
                for (int dt = 0; dt < 2; ++dt) {
                    const LAS unsigned char* vp = vb + slot[kr] * NA_VROW + 16 * dt * NA_VD;
                    const v2u lo = *(const LAS v2u*)vp, hi = *(const LAS v2u*)(vp + 32);
                    v4u vw; vw.x = lo.x; vw.y = lo.y; vw.z = hi.x; vw.w = hi.y;
                    o[dt] = __builtin_amdgcn_mfma_f32_16x16x32_bf16(__builtin_bit_cast(bf16x8, vw), pf, o[dt], 0, 0, 0);
                }
            }
            const float inv = __builtin_amdgcn_rcpf(sum);
            bf16* orow = mixo + mixo_index(qtok, DPOOL + 32 * h + 4 * fq);
#pragma unroll
            for (int dt = 0; dt < 2; ++dt) { v2u w; w.x = cvt_pk_bf16(o[dt][0] * inv, o[dt][1] * inv); w.y = cvt_pk_bf16(o[dt][2] * inv, o[dt][3] * inv); *(v2u*)(orow + 16 * dt) = w; }
        }
    }
    __syncthreads();
#undef NA_UNIT
#undef NA_PLAN
#undef NA_LOAD
}

struct SchedProj {
    const char* hn; const char* win; bf16* proj; bf16* vt; int G, c, esz; const float* sa; const float* sw;
    __device__ __forceinline__ bool next(int i, pg8::Unit& u) const {
        int pm, pn; if (!pg8::tile_order(i, G, c, T / 256, 8, pm, pn)) return false;
        const size_t tstep = (size_t)256 * D * esz;
        if (pn < 6) { u.A = hn + pm * tstep; u.B = win + pn * tstep; u.orow = 256 * pm;
            if (pn < 2) { u.obase = proj; u.ocol = 256 * pn; u.ldc = UPITCH; } else { u.obase = proj + (size_t)(pn >> 1) * T * 512; u.ocol = 256 * (pn & 1); u.ldc = 0; }
            u.scale = (pn == 2 || pn == 3) ? QSCALE : 1.0f; u.p0 = sa + 256 * pm; u.cs = sw + 256 * pn; }
        else { u.A = win + pn * tstep; u.B = hn + pm * tstep; u.obase = vt; u.orow = 256 * (pn - 6); u.ocol = 256 * pm; u.ldc = -1; u.scale = 1.0f; u.p0 = sw + 256 * pn; u.cs = sa + 256 * pm; }
        return true;
    }
};
struct SchedOut {
    const char* a; const char* w; bf16* o; int G, c;
    __device__ __forceinline__ bool next(int i, pg8::Unit& u) const {
        int pm, pn; if (!pg8::tile_order(i, G, c, T / 256, 4, pm, pn)) return false;
        const size_t tstep = (size_t)256 * D * 2; u.p0 = nullptr; u.cs = nullptr;
        u.A = a + pm * tstep; u.B = w + pn * tstep; u.obase = o; u.orow = 256 * pm; u.ocol = 256 * pn; u.ldc = D; u.scale = 1.0f; return true;
    }
};
__device__ __forceinline__ void ffn_table(Frame& F0, bool moe) {
    Frame F = F0; { int t_ = threadIdx.x; asm volatile("" : "+v"(t_)); F.tid = t_; F.lane = t_ & 63; F.wave = __builtin_amdgcn_readfirstlane(t_ >> 6); }
    LAS int* blk = (LAS int*)(F.lds + BLK_OFF); LAS int* bst = (LAS int*)(F.lds + BST_OFF);
    __syncthreads();
    if (F.tid == 0) { int s = 0; for (int e = 0; e < NE; ++e) { bst[e] = s; s += moe ? (int)((ld_cnt(F.ctl, e) + 255u) >> 8) : (e == 0 ? T / 256 : 0); } bst[8] = s; }
    __syncthreads();
    for (int b = F.tid; b < MAXBLK + 8; b += 512) { int e = 0; for (int k = 1; k < NE; ++k) if (b >= bst[k]) e = k; blk[b] = e; }
    __syncthreads();
}
__device__ __forceinline__ bool tail_reduce(Frame& F0) {
    int t_ = threadIdx.x; asm volatile("" : "+v"(t_));
    const int lane = t_ & 63, gw = F0.bid * 8 + __builtin_amdgcn_readfirstlane(t_ >> 6), NGW = F0.G * 8;
    int nb = 0;
    for (int e = 0; e < NE; ++e) nb += (int)((ld_cnt(F0.ctl, e) + 255u) >> 8);
    const int nrows = (nb - 256) * 256;
    if (nrows <= 0) return false;
    bf16* y = (bf16*)(F0.ws + WS_Y) + (size_t)256 * 256 * D; const bf16* part = (const bf16*)(F0.ws + WS_TAILPART);
    for (int r = gw; r < nrows; r += NGW) {
        v4u w[TAILSPLIT][2];
#pragma unroll
        for (int h = 0; h < 2; ++h) { w[0][h] = *((const v4u*)(y + (size_t)r * D) + lane + 64 * h);
#pragma unroll
            for (int p = 1; p < TAILSPLIT; ++p) w[p][h] = *((const v4u*)(part + ((size_t)(p - 1) * TAILPART_ROWS + r) * D) + lane + 64 * h); }
#pragma unroll
        for (int h = 0; h < 2; ++h) { v4u o;
#pragma unroll
            for (int j = 0; j < 4; ++j) { float lo = 0.f, hi = 0.f;
#pragma unroll
                for (int p = 0; p < TAILSPLIT; ++p) { lo += bflo(w[p][h][j]); hi += bfhi(w[p][h][j]); }
                o[j] = cvt_pk_bf16(lo, hi); }
            *((v4u*)(y + (size_t)r * D) + lane + 64 * h) = o; }
    }
    return true;
}
template <bool TILED> struct SchedUpT {
    const char* hn; const char* wgu; const int* lists; bf16* hff; LAS int* blk; LAS int* bst; int G, c, cstart, nblk, nN, F_, moe, esz;
    __device__ __forceinline__ bool next(int i, pg8::Unit& u) const {
        int pm, pn; if (!pg8::tile_order(i, G, c, nblk, nN, pm, pn)) return false;
        const int b = cstart + pm, e = __builtin_amdgcn_readfirstlane(blk[b]), lb = b - __builtin_amdgcn_readfirstlane(bst[e]);
        u.A = hn; u.p0 = lists + (moe ? (size_t)e * T + 256 * lb : (size_t)256 * b); u.cs = nullptr;
        u.B = wgu + ((size_t)e * 2 * F_ + 256 * pn) * D * esz; u.obase = hff; u.orow = 256 * pm; u.ocol = 128 * pn; u.ldc = F_; u.scale = 1.0f;
        if constexpr (TILED) { u.obase = (bf16*)((char*)hff + ((size_t)pm * nN + pn) * HFF_TILE - 128 * pn - (size_t)256 * pm * 128); }
        return true;
    }
};
template <bool TILED> struct SchedDownT {
    const char* hff; const char* wd; bf16* y; LAS int* blk; int G, c, cstart, nblk, F_, esz; float scale; const int* idl; int pm0, split;
    __device__ __forceinline__ bool next(int i, pg8::Unit& u) const {
        int pm, pn; if (!pg8::tile_order(i, G, c, nblk, 4 * split, pm, pn)) return false;
        const int p = pn >> 2; pn &= 3;
        const int b = cstart + pm, e = __builtin_amdgcn_readfirstlane(blk[b]); u.p0 = idl; u.cs = nullptr;
        const size_t koff = (size_t)p * (F_ / split) * esz;
        u.A = hff + (size_t)(pm0 + pm) * 256 * F_ * esz + (TILED ? (size_t)p * (F_ / split / 128) * HFF_TILE : koff); u.B = wd + ((size_t)e * D + 256 * pn) * F_ * esz + koff;
        const long long poff = p == 0 ? 0ll : ((long long)WS_TAILPART - (long long)WS_Y) / 2 + (long long)(p - 1) * TAILPART_ROWS * D;
        u.obase = y + poff; u.orow = p == 0 ? 256 * b : 256 * pm; u.ocol = 256 * pn; u.ldc = D; u.scale = scale; return true;
    }
};

constexpr int STEPS_PER_LAYER = 16, NSTEPS = 1 + DEPTH * STEPS_PER_LAYER;
#define RUN(s) (lo <= (s) && (s) < hi)
#ifndef BARX
#define BARX 1
#endif
#define SEAM(s) do { if (RUN(s) && RUN((s) + 1)) { for (int b_ = 0; b_ < BARX; ++b_) xcd_barrier(bar); } } while (0)
template <int L>
__device__ __forceinline__ void run_layer(Frame& F, const XcdBarrier& bar, const int lo, const int hi) {
    constexpr int l = L, base = 1 + STEPS_PER_LAYER * L; constexpr bool moe = (L & 1) != 0, f8 = FP8_MOE && moe, i8 = I8_DENSE && !moe; constexpr bool h8 = f8 || (FP8_DDOWN && !moe);
    LAS int* tokbuf = (LAS int*)(F.lds + TOKBUF_OFF); LAS int* blk = (LAS int*)(F.lds + BLK_OFF); LAS int* bst = (LAS int*)(F.lds + BST_OFF);
    const char* HN = (const char*)(F.ws + WS_HN);
#ifndef NO_P1
    if (RUN(base + 0)) {
        SchedProj S{HN, (const char*)(F.ws + WS_WIN) + (size_t)l * DIN * D * (I8_PROJ ? 1 : 2), (bf16*)(F.ws + WS_PROJ), (bf16*)(F.ws + WS_VT), F.G, F.bid, I8_PROJ ? 1 : 2, (const float*)(F.ws + WS_SA), (const float*)(F.ws + WS_SWIN) + l * DIN};
        if constexpr (I8_PROJ != 0) pg8::gemm_phase<pg8::EpiProj_I8, SchedProj, false, 2>(F.lds, tokbuf, D / 2, S, pg8::EpiProj_I8{});
        else pg8::gemm_phase<pg8::EpiProj, SchedProj, false>(F.lds, tokbuf, D, S, pg8::EpiProj{});
    } SEAM(base + 0);
#endif
#ifndef NO_P2
#ifndef NA_CALLS
#define NA_CALLS 1
#endif
#ifndef POOL_CALLS
#define POOL_CALLS 1
#endif
    if (RUN(base + 1)) { for (int i_ = 0; i_ < POOL_CALLS; ++i_) mixer_phase(F, l); for (int i_ = 0; i_ < NA_CALLS; ++i_) na_phase(F, l); } SEAM(base + 1);
#endif
#ifndef NO_P3
    if (RUN(base + 2)) {
        SchedOut S{(const char*)(F.ws + WS_MIXO), (const char*)(F.ws + WS_WOUT) + (size_t)l * D * D * 2, (bf16*)(F.ws + WS_MIX), F.G, F.bid};
        pg8::gemm_phase<pg8::EpiBf16, SchedOut, false>(F.lds, tokbuf, D, S, pg8::EpiBf16{}, D, 64, 256 * 128);
    } SEAM(base + 2);
#endif
#ifndef NO_P4
    if (RUN(base + 3)) { norm_phase<false>(F, l); } SEAM(base + 3);
#endif
    constexpr int F_ = moe ? DFFE : DFF, cblk = h8 ? 2 * CHUNK_BLK : CHUNK_BLK;
    bool table = false; int NB = 0;
    for (int c = 0; c < MAXCHUNK; ++c) {
        const int s5 = base + 4 + 2 * c, s6 = s5 + 1;
        if (!(RUN(s5) || RUN(s6))) continue;
        if (!table) { ffn_table(F, moe); NB = __builtin_amdgcn_readfirstlane(bst[8]); table = true; }
        const int cstart = c * cblk; int nblk = min(NB - cstart, cblk);
        if constexpr (f8) { if (c == 1) nblk = NB - cstart; else if (c > 1) continue; }
        if (nblk <= 0) continue;
#ifndef NO_P5
        if (RUN(s5)) {
            typedef SchedUpT<h8> SchedUp; SchedUp S{HN, moe ? (const char*)(F.ws + WS_WGUM) : (const char*)(F.ws + WS_WGU0), moe ? (const int*)(F.ws + WS_LIST) : (const int*)(F.ws + WS_LISTID), (bf16*)(F.ws + WS_HFF), blk, bst, F.G, F.bid, cstart, nblk, F_ / 128, F_, moe ? 1 : 0, (f8 || i8) ? 1 : 2};
            if constexpr (f8 && FP6_UP) pg8::gemm_phase<pg8::EpiSwiGLU6, SchedUp, true, 3>(F.lds, tokbuf, D / 2, S, pg8::EpiSwiGLU6{});
            else if constexpr (f8) pg8::gemm_phase<pg8::EpiSwiGLU8, SchedUp, true, 1>(F.lds, tokbuf, D / 2, S, pg8::EpiSwiGLU8{});
            else if constexpr (i8) pg8::gemm_phase<pg8::EpiSwiGLU_I8, SchedUp, true, 2>(F.lds, tokbuf, D / 2, S, pg8::EpiSwiGLU_I8{(const float*)(F.ws + WS_SA), (const float*)(F.ws + WS_SW0), (const int*)(F.ws + WS_LISTID)});
            else pg8::gemm_phase<pg8::EpiSwiGLU, SchedUp, true>(F.lds, tokbuf, D, S, pg8::EpiSwiGLU{});
        } SEAM(s5);
#endif
#ifndef NO_P6
        if (RUN(s6)) {
            const int nfull = h8 ? min(nblk, cblk) : nblk;
            typedef SchedDownT<h8> SchedDown; SchedDown S{(const char*)(F.ws + WS_HFF), moe ? (const char*)(F.ws + WS_WDM) : (const char*)(F.ws + WS_WD0), (bf16*)(F.ws + WS_Y), blk, F.G, F.bid, cstart, nfull, F_, h8 ? 1 : 2, h8 ? 1.0f / W8_DN : 1.0f, (const int*)(F.ws + WS_LISTID), 0, 1};
            if constexpr (h8) {
                const int npass = (f8 && nblk > nfull) ? 2 : 1;
#pragma clang loop unroll(disable)
                for (int pass = 0; pass < npass; ++pass) {
                    if (pass == 1) { S.cstart = cstart + nfull; S.nblk = nblk - nfull; S.pm0 = nfull; S.split = TAILSPLIT; }
                    pg8::gemm_phase<pg8::EpiBf16, SchedDown, true, 1>(F.lds, tokbuf, pass == 0 ? F_ / 2 : F_ / 2 / TAILSPLIT, S, pg8::EpiBf16{}, F_ / 2, 64, HFF_TILE);
                }
            }
            else pg8::gemm_phase<pg8::EpiBf16, SchedDown, false>(F.lds, tokbuf, F_, S, pg8::EpiBf16{});
        } SEAM(s6);
#endif
    }
#ifndef NO_P7
    if (RUN(base + 14)) { if constexpr (f8) { if (tail_reduce(F)) xcd_barrier(bar); } norm_phase<true>(F, l); }
#endif
    if (l + 1 < DEPTH) { if (RUN(base + 14) && RUN(base + 16)) xcd_barrier(bar); }
}
__global__ void __launch_bounds__(512, 2) mk_fwd(Args args) {
    extern __shared__ __attribute__((aligned(16))) unsigned char lds_raw[];
    Frame F;
    F.lds = (LAS unsigned char*)lds_raw; F.MISC = (volatile LAS unsigned*)(F.lds + MISC_OFF);
    F.tid = threadIdx.x; F.lane = F.tid & 63; F.wave = __builtin_amdgcn_readfirstlane(F.tid >> 6); F.G = gridDim.x; F.bid = blockIdx.x;
    F.ws = args.ws; F.ctl = (unsigned*)(args.ws + WS_CTL); F.out = args.out;
    F.x = args.in[0]; F.g_mpre = args.in[1]; F.g_mpost = args.in[2]; F.g_fpre = args.in[3]; F.g_fpost = args.in[4]; F.w_in = args.in[5]; F.pool_w = args.in[6]; F.pool_scale = args.in[7];
    F.rpb = args.in[8]; F.w_out = args.in[9]; F.dwg = args.in[10]; F.dwu = args.in[11]; F.dwd = args.in[12]; F.router = args.in[13]; F.mwg = args.in[14]; F.mwu = args.in[15]; F.mwd = args.in[16];
    if (F.tid < 16) F.MISC[F.tid] = 0u;
    __syncthreads();
    const int lo = args.lo, hi = args.hi;
    XcdBarrier bar; bar.bar = F.ctl + CW_BAR + args.breg * XCD_BAR_WORDS; bar.x = 0; bar.st = F.MISC;
    if (hi - lo > 1) bar = xcd_barrier_post(F.ctl + CW_BAR + args.breg * XCD_BAR_WORDS, F.MISC);
#ifndef NO_P0
#ifndef REP_P0
#define REP_P0 1
#endif
    if (RUN(0)) { for (int r_ = 0; r_ < REP_P0; ++r_) p0_prologue(F); } SEAM(0);
#endif
    run_layer<0>(F, bar, lo, hi);
    run_layer<1>(F, bar, lo, hi);
}
#undef RUN
#undef SEAM

__global__ void __launch_bounds__(64) nk_gemm(const bf16* A, int lda, const bf16* Bt, int ldb, int K, bf16* O, int ldo, float scale, int sc_lo, int sc_hi, int vt) {
    const int m0 = 32 * blockIdx.y, n0 = 32 * blockIdx.x, lane = threadIdx.x, fr = lane & 15, fq = lane >> 4;
    f32x4 acc[2][2];
#pragma unroll
    for (int a = 0; a < 2; ++a)
#pragma unroll
        for (int b = 0; b < 2; ++b) acc[a][b] = (f32x4){0.f, 0.f, 0.f, 0.f};
    for (int k0 = 0; k0 < K; k0 += 32) {
        bf16x8 a[2], b[2];
#pragma unroll
        for (int i = 0; i < 2; ++i) { a[i] = *(const bf16x8*)(A + (size_t)(m0 + 16 * i + fr) * lda + k0 + 8 * fq); b[i] = *(const bf16x8*)(Bt + (size_t)(n0 + 16 * i + fr) * ldb + k0 + 8 * fq); }
#pragma unroll
        for (int mt = 0; mt < 2; ++mt)
#pragma unroll
            for (int nt = 0; nt < 2; ++nt) acc[mt][nt] = __builtin_amdgcn_mfma_f32_16x16x32_bf16(a[mt], b[nt], acc[mt][nt], 0, 0, 0);
    }
#pragma unroll
    for (int mt = 0; mt < 2; ++mt)
#pragma unroll
        for (int nt = 0; nt < 2; ++nt)
#pragma unroll
            for (int q = 0; q < 4; ++q) { const int m = m0 + 16 * mt + 4 * fq + q, n = n0 + 16 * nt + fr; const float sc = (n >= sc_lo && n < sc_hi) ? scale : 1.0f;
                O[vt ? vt_index(m, n) : (size_t)m * ldo + n] = (bf16)f2bf(acc[mt][nt][q] * sc); }
}
__global__ void nk_blocktab(const unsigned* ctl, int* btab, int moe) {
    if (threadIdx.x != 0 || blockIdx.x != 0) return;
    int b = 0;
    for (int e = 0; e < NE; ++e) { const int nb = moe ? (int)((ctl[CW_CNT + 64 * e] + 255u) >> 8) : (e == 0 ? T / 256 : 0); for (int k = 0; k < nb; ++k) btab[b++] = e | (k << 8); }
    btab[MAXBLK] = b;
}
__global__ void __launch_bounds__(64) nk_ffn_up(const bf16* hn, const bf16* wgu, const int* lists, const int* btab, bf16* hff, int cstart, int F_, int moe) {
    const int m0 = 32 * blockIdx.y, f0 = 32 * blockIdx.x, lane = threadIdx.x, fr = lane & 15, fq = lane >> 4;
    const int b = cstart + m0 / 256; if (b >= btab[MAXBLK]) return;
    const int e = btab[b] & 0xff, lb = btab[b] >> 8;
    const int* list = lists + (moe ? (size_t)e * T + 256 * lb : (size_t)256 * b) + (m0 % 256);
    const bf16* W = wgu + (size_t)e * 2 * F_ * D; const int rg = (f0 / 128) * 256 + (f0 % 128);
    const bf16* arow[2]; arow[0] = hn + (size_t)list[fr] * D; arow[1] = hn + (size_t)list[16 + fr] * D;
    f32x4 ag[2][2], au[2][2];
#pragma unroll
    for (int a = 0; a < 2; ++a)
#pragma unroll
        for (int c = 0; c < 2; ++c) { ag[a][c] = (f32x4){0.f, 0.f, 0.f, 0.f}; au[a][c] = (f32x4){0.f, 0.f, 0.f, 0.f}; }
    for (int k0 = 0; k0 < D; k0 += 32) {
        bf16x8 a[2], bg[2], bu[2];
#pragma unroll
        for (int i = 0; i < 2; ++i) { a[i] = *(const bf16x8*)(arow[i] + k0 + 8 * fq); bg[i] = *(const bf16x8*)(W + (size_t)(rg + 16 * i + fr) * D + k0 + 8 * fq); bu[i] = *(const bf16x8*)(W + (size_t)(rg + 128 + 16 * i + fr) * D + k0 + 8 * fq); }
#pragma unroll
        for (int mt = 0; mt < 2; ++mt)
#pragma unroll
            for (int nt = 0; nt < 2; ++nt) { ag[mt][nt] = __builtin_amdgcn_mfma_f32_16x16x32_bf16(a[mt], bg[nt], ag[mt][nt], 0, 0, 0); au[mt][nt] = __builtin_amdgcn_mfma_f32_16x16x32_bf16(a[mt], bu[nt], au[mt][nt], 0, 0, 0); }
    }
#pragma unroll
    for (int mt = 0; mt < 2; ++mt)
#pragma unroll
        for (int nt = 0; nt < 2; ++nt)
#pragma unroll
            for (int q = 0; q < 4; ++q) { const float g = ag[mt][nt][q], u = au[mt][nt][q]; const float v = g * u / (1.0f + __expf(-g));
                hff[(size_t)(m0 + 16 * mt + 4 * fq + q) * F_ + f0 + 16 * nt + fr] = (bf16)f2bf(v); }
}
__global__ void __launch_bounds__(64) nk_ffn_down(const bf16* hff, const bf16* wd, const int* btab, bf16* y, int cstart, int F_) {
    const int m0 = 32 * blockIdx.y, n0 = 32 * blockIdx.x, lane = threadIdx.x, fr = lane & 15, fq = lane >> 4;
    const int b = cstart + m0 / 256; if (b >= btab[MAXBLK]) return;
    const int e = btab[b] & 0xff; const bf16* W = wd + (size_t)e * D * F_;
    f32x4 acc[2][2];
#pragma unroll
    for (int a = 0; a < 2; ++a)
#pragma unroll
        for (int c = 0; c < 2; ++c) acc[a][c] = (f32x4){0.f, 0.f, 0.f, 0.f};
    for (int k0 = 0; k0 < F_; k0 += 32) {
        bf16x8 a[2], bb[2];
#pragma unroll
        for (int i = 0; i < 2; ++i) { a[i] = *(const bf16x8*)(hff + (size_t)(m0 + 16 * i + fr) * F_ + k0 + 8 * fq); bb[i] = *(const bf16x8*)(W + (size_t)(n0 + 16 * i + fr) * F_ + k0 + 8 * fq); }
#pragma unroll
        for (int mt = 0; mt < 2; ++mt)
#pragma unroll
            for (int nt = 0; nt < 2; ++nt) acc[mt][nt] = __builtin_amdgcn_mfma_f32_16x16x32_bf16(a[mt], bb[nt], acc[mt][nt], 0, 0, 0);
    }
#pragma unroll
    for (int mt = 0; mt < 2; ++mt)
#pragma unroll
        for (int nt = 0; nt < 2; ++nt)
#pragma unroll
            for (int q = 0; q < 4; ++q) y[(size_t)(256 * cstart + m0 + 16 * mt + 4 * fq + q) * D + n0 + 16 * nt + fr] = (bf16)f2bf(acc[mt][nt][q]);
}
__global__ void nk_pool_delta(const bf16* proj, bf16* delta) {
    const int idx = blockIdx.x * 256 + threadIdx.x, tok = idx / DPOOL, ch = idx % DPOOL, b = tok / SEQ, t = tok % SEQ, g = ch / 128, hw = 1 << g;
    const int lo = max(t - hw, 0), hi = min(t + hw, SEQ); float s = 0.f;
    for (int tt = lo; tt < hi; ++tt) s += bf2f(proj[(size_t)(b * SEQ + tt) * NPROJ + ch]);
    delta[(size_t)tok * DPOOL + ch] = (bf16)f2bf(s / (float)(hi - lo) - bf2f(proj[(size_t)tok * NPROJ + ch]));
}
__global__ void nk_pool_mm(const bf16* delta, const bf16* Wp, const float* pscale, bf16* mixo) {
    const int idx = blockIdx.x * 256 + threadIdx.x, tok = idx / DPOOL, dd = idx % DPOOL, g = dd / 128, d = dd % 128; float s = 0.f;
    for (int c = 0; c < 128; ++c) s += bf2f(delta[(size_t)tok * DPOOL + 128 * g + c]) * bf2f(Wp[(size_t)(g * 128 + d) * 128 + c]);
    mixo[(size_t)tok * D + dd] = (bf16)f2bf(s * pscale[dd]);
}
__global__ void nk_na(const bf16* proj, const bf16* Vt, const float* rpb, bf16* mixo) {
    const int idx = blockIdx.x * 256 + threadIdx.x, tok = idx / NH, h = idx % NH, b = tok / SEQ, t = tok % SEQ, r = t / GRIDW, c = t % GRIDW;
    const int r0 = min(max(r - KH / 2, 0), GROWS - KH), c0 = min(max(c - KW / 2, 0), GRIDW - KW);
    float q[HD];
#pragma unroll
    for (int d = 0; d < HD; ++d) q[d] = bf2f(proj[(size_t)tok * NPROJ + 512 + HD * h + d]);
    float mx = -INFINITY;
    for (int i = 0; i < KH; ++i) for (int j = 0; j < KW; ++j) {
        const size_t kt = (size_t)(b * SEQ + (r0 + i) * GRIDW + c0 + j); float s = 0.f;
#pragma unroll
        for (int d = 0; d < HD; ++d) s += q[d] * bf2f(proj[kt * NPROJ + 1024 + HD * h + d]);
        s += rpb[(h * 15 + (r0 + i - r + KH - 1)) * 31 + (c0 + j - c + KW - 1)] * LOG2E; mx = fmaxf(mx, s);
    }
    float o[HD], sum = 0.f;
#pragma unroll
    for (int d = 0; d < HD; ++d) o[d] = 0.f;
    for (int i = 0; i < KH; ++i) for (int j = 0; j < KW; ++j) {
        const size_t kt = (size_t)(b * SEQ + (r0 + i) * GRIDW + c0 + j); float s = 0.f;
#pragma unroll
        for (int d = 0; d < HD; ++d) s += q[d] * bf2f(proj[kt * NPROJ + 1024 + HD * h + d]);
        s += rpb[(h * 15 + (r0 + i - r + KH - 1)) * 31 + (c0 + j - c + KW - 1)] * LOG2E;
        const float p = exp2f(s - mx); sum += p; const float pb = __builtin_bit_cast(float, f2bf(p) << 16);
#pragma unroll
        for (int d = 0; d < HD; ++d) o[d] += pb * bf2f(Vt[vt_index(HD * h + d, (int)kt)]);
    }
#pragma unroll
    for (int d = 0; d < HD; ++d) mixo[(size_t)tok * D + DPOOL + HD * h + d] = (bf16)f2bf(o[d] / sum);
}

static void launch_mk(const Args& a0, int lo, int hi, int grid, hipStream_t stream, int breg = 0) {
    Args a = a0; a.lo = lo; a.hi = hi; a.breg = breg; a.pad = 0;
    hipLaunchKernelGGL(mk_fwd, dim3(grid), dim3(512), LDS_BYTES, stream, a);
}
extern "C" void kernel_launch(void* const* d_in, const int* in_sizes, int n_in, void* d_out, int out_size, void* d_ws, size_t ws_size, hipStream_t stream) {
    static int grid = 0;
    if (grid == 0) {
        if (n_in != 17 || out_size != T * D || ws_size < WS_END) { fprintf(stderr, "kernel_launch: unexpected problem (n_in %d, out %d, ws %zu)\n", n_in, out_size, ws_size); grid = -1; return; }
        int dev = 0, cus = 0;
        if (hipGetDevice(&dev) != hipSuccess || hipDeviceGetAttribute(&cus, hipDeviceAttributeMultiprocessorCount, dev) != hipSuccess) { grid = -1; return; }
        if (hipFuncSetAttribute((const void*)mk_fwd, hipFuncAttributeMaxDynamicSharedMemorySize, LDS_BYTES) != hipSuccess) { grid = -1; return; }
        int per_cu = 0;
        if (hipOccupancyMaxActiveBlocksPerMultiprocessor(&per_cu, (const void*)mk_fwd, 512, LDS_BYTES) != hipSuccess || per_cu < 1) { fprintf(stderr, "kernel_launch: occupancy query says %d\n", per_cu); }
        (void)hipGetLastError();
        grid = cus;
    }
    if (grid < 0) return;
    hipMemsetAsync((char*)d_ws + WS_CTL, 0, CTL_ZERO_BYTES, stream);
    Args a{};
    for (int i = 0; i < 17; ++i) a.in[i] = (const float*)d_in[i];
    a.out = (float*)d_out; a.ws = (unsigned char*)d_ws; a.lo = 0; a.hi = 0;
    unsigned char* ws = (unsigned char*)d_ws;
#if MODE == 3
#if defined(REPSTEP)
    launch_mk(a, 0, REPSTEP + 1, grid, stream, 0); launch_mk(a, REPSTEP, REPSTEP + 1, grid, stream, 1); launch_mk(a, REPSTEP + 1, NSTEPS, grid, stream, 2);
#else
    launch_mk(a, 0, NSTEPS, grid, stream);
#endif
#else
    launch_mk(a, 0, 1, grid, stream);
    const bf16* HN = (const bf16*)(ws + WS_HN);
    for (int l = 0; l < DEPTH; ++l) {
        const int base = 1 + STEPS_PER_LAYER * l; const int moe = l & 1;
        const bf16* win = (const bf16*)(ws + WS_WIN) + (size_t)l * DIN * D;
        if (NAIVE & 1) {
            hipLaunchKernelGGL(nk_gemm, dim3(NPROJ / 32, T / 32), dim3(64), 0, stream, HN, D, win, D, D, (bf16*)(ws + WS_PROJ), NPROJ, QSCALE, 512, 1024, 0);
            hipLaunchKernelGGL(nk_gemm, dim3(T / 32, DATT / 32), dim3(64), 0, stream, win + (size_t)NPROJ * D, D, HN, D, D, (bf16*)(ws + WS_VT), T, 1.0f, 0, 0, 1);
        } else launch_mk(a, base + 0, base + 1, grid, stream);
        if (NAIVE & 2) {
            hipLaunchKernelGGL(nk_pool_delta, dim3(T * DPOOL / 256), dim3(256), 0, stream, (const bf16*)(ws + WS_PROJ), (bf16*)(ws + WS_MIX));
            hipLaunchKernelGGL(nk_pool_mm, dim3(T * DPOOL / 256), dim3(256), 0, stream, (const bf16*)(ws + WS_MIX), (const bf16*)(ws + WS_WP) + (size_t)l * 4 * 128 * 128, (const float*)d_in[7] + l * DPOOL, (bf16*)(ws + WS_MIXO));
            hipLaunchKernelGGL(nk_na, dim3(T * NH / 256), dim3(256), 0, stream, (const bf16*)(ws + WS_PROJ), (const bf16*)(ws + WS_VT), (const float*)d_in[8] + (size_t)l * NH * 15 * 31, (bf16*)(ws + WS_MIXO));
        } else launch_mk(a, base + 1, base + 2, grid, stream);
        if (NAIVE & 4) hipLaunchKernelGGL(nk_gemm, dim3(D / 32, T / 32), dim3(64), 0, stream, (const bf16*)(ws + WS_MIXO), D, (const bf16*)(ws + WS_WOUT) + (size_t)l * D * D, D, D, (bf16*)(ws + WS_MIX), D, 1.0f, 0, 0, 0);
        else launch_mk(a, base + 2, base + 3, grid, stream);
        launch_mk(a, base + 3, base + 4, grid, stream);
        if (NAIVE & 24) hipLaunchKernelGGL(nk_blocktab, dim3(1), dim3(64), 0, stream, (const unsigned*)(ws + WS_CTL), (int*)(ws + WS_BTAB), moe);
        const int F_ = moe ? DFFE : DFF, nchunk = moe ? MAXCHUNK : 2;
        for (int c = 0; c < nchunk; ++c) {
            if (NAIVE & 8) hipLaunchKernelGGL(nk_ffn_up, dim3(F_ / 32, CHUNK_BLK * 256 / 32), dim3(64), 0, stream, HN, moe ? (const bf16*)(ws + WS_WGUM) : (const bf16*)(ws + WS_WGU0), moe ? (const int*)(ws + WS_LIST) : (const int*)(ws + WS_LISTID), (const int*)(ws + WS_BTAB), (bf16*)(ws + WS_HFF), c * CHUNK_BLK, F_, moe);
            else launch_mk(a, base + 4 + 2 * c, base + 5 + 2 * c, grid, stream);
            if (NAIVE & 16) hipLaunchKernelGGL(nk_ffn_down, dim3(D / 32, CHUNK_BLK * 256 / 32), dim3(64), 0, stream, (const bf16*)(ws + WS_HFF), moe ? (const bf16*)(ws + WS_WDM) : (const bf16*)(ws + WS_WD0), (const int*)(ws + WS_BTAB), (bf16*)(ws + WS_Y), c * CHUNK_BLK, F_);
            else launch_mk(a, base + 5 + 2 * c, base + 6 + 2 * c, grid, stream);
        }
        launch_mk(a, base + 14, base + 15, grid, stream);
    }
#endif
}
```

```cpp
#include <hip/hip_runtime.h>
#include <cstdio>
#include <cstdint>

#ifndef MODE
#define MODE 3
#endif
#ifndef NAIVE
#define NAIVE 0
#endif
#ifndef I8_DENSE
#define I8_DENSE 1
#endif
#ifndef I8_PROJ
#define I8_PROJ 1
#endif
#ifndef FP6_UP
#define FP6_UP 1
#endif
#ifndef FP8_DDOWN
#define FP8_DDOWN 1
#endif
#ifndef FP8_MOE
#define FP8_MOE 1
#endif
#if ((FP8_MOE || I8_DENSE) && (NAIVE & 24) || I8_PROJ && (NAIVE & 1)) && MODE != 3
#error the simple reference FFN kernels are bf16 only: build with -DFP8_MOE=0 to use them
#endif

#define GAS __attribute__((address_space(1)))
#define LAS __attribute__((address_space(3)))
typedef unsigned short bf16;
typedef unsigned v4u __attribute__((ext_vector_type(4)));
typedef unsigned v2u __attribute__((ext_vector_type(2)));
typedef float f32x4 __attribute__((ext_vector_type(4)));
typedef float f32x2 __attribute__((ext_vector_type(2)));
typedef short bf16x8 __attribute__((ext_vector_type(8)));

constexpr int BATCH = 2, SEQ = 16384, T = BATCH * SEQ, D = 1024, DIN = 2048, DPOOL = 512, DATT = 512, NH = 16, HD = 32;
constexpr int GRIDW = 64, GROWS = SEQ / GRIDW, KH = 8, KW = 16;
constexpr int DFF = 4096, NE = 8, DFFE = 3584, DEPTH = 2;
constexpr int UPITCH = 512;
constexpr int NPROJ = 1536;
constexpr float RMS_EPS = 1e-6f;
constexpr float LOG2E = 1.4426950408889634f;
constexpr float QSCALE = 0.17677669529663687f * LOG2E;
__host__ __device__ __forceinline__ size_t vt_index(int ch, int tok) { return (size_t)(tok >> 6) * (DATT * 64) + (size_t)ch * 64 + (tok & 63); }
constexpr float S6A = 1.25f, S6W = 40.0f;
typedef float f32x16 __attribute__((ext_vector_type(16)));
typedef int i32x6 __attribute__((ext_vector_type(6)));
constexpr float W8_UP = 32.0f, W8_DN = 64.0f;
typedef int i32x8 __attribute__((ext_vector_type(8)));
typedef int i32x4 __attribute__((ext_vector_type(4)));
constexpr int CHUNK_BLK = 64;
constexpr int MAXCHUNK = 5;
constexpr int MAXBLK = 264;

constexpr size_t MiB = 1u << 20;
constexpr size_t WS_CTL = 0, CTL_ZERO_BYTES = 1 * MiB;
constexpr size_t WS_LIST = 1 * MiB;
constexpr size_t WS_INFO = 2 * MiB;
constexpr size_t WS_LISTID = 2 * MiB + 512 * 1024;
constexpr size_t WS_SA = 2 * MiB + 640 * 1024;
constexpr size_t WS_SWIN = 2 * MiB + 896 * 1024;
constexpr size_t WS_SW0 = 2 * MiB + 832 * 1024;
constexpr size_t WS_BTAB = 2 * MiB + 768 * 1024;
constexpr size_t WS_WP = 3 * MiB;
constexpr size_t WS_WIN = 4 * MiB;
constexpr size_t WS_WOUT = 12 * MiB;
constexpr size_t WS_WGU0 = 16 * MiB;
constexpr size_t WS_WD0 = 32 * MiB;
constexpr size_t WS_WGUM = 40 * MiB;
constexpr size_t WS_WDM = (FP8_MOE ? 160 : 152) * MiB;
constexpr size_t WS_H16 = 96 * MiB;
constexpr size_t WS_HN = 208 * MiB;
constexpr size_t WS_R = 272 * MiB;
constexpr size_t WS_HFF = WS_R;
constexpr size_t WS_Y = WS_R + 128 * MiB;
constexpr size_t WS_PQ = WS_R + 32 * MiB, WS_PK = WS_R + 64 * MiB;
constexpr size_t WS_PROJ = WS_R;
constexpr size_t WS_VT = WS_R + 96 * MiB;
constexpr size_t WS_MIXO = WS_R + 128 * MiB;
constexpr size_t WS_MIX = WS_R + 192 * MiB;
constexpr size_t WS_END = 532 * MiB;
constexpr int HFF_TILE = 256 * 128;
constexpr int TAILSPLIT = 7, TAILPART_ROWS = 8 * 256;
constexpr size_t WS_TAILPART = WS_WGU0;
static_assert(WS_TAILPART + (size_t)(TAILSPLIT - 1) * TAILPART_ROWS * D * 2 <= WS_WGUM, "tail partials");
static_assert(!FP8_MOE || (WS_WGUM + (size_t)NE * 2 * DFFE * D <= WS_H16 && WS_H16 + (size_t)T * D * 2 <= WS_WDM), "H16 sits in the gap the fp8 expert weights leave");

constexpr int CW_TMO = 0, CW_CODE = 1;
constexpr int CW_BAR = 4096;
constexpr int CW_CNT = 16384;
constexpr int CW_DBG = 20480;

constexpr int RING_BYTES = 131072;
constexpr int TOKBUF_OFF = RING_BYTES;
constexpr int BLK_OFF = TOKBUF_OFF + 9 * 1024;
constexpr int BST_OFF = BLK_OFF + 272 * 4;
constexpr int LCNT_OFF = BST_OFF + 64;
constexpr int MISC_OFF = LCNT_OFF + 64;
constexpr int LDS_BYTES = 147456;
static_assert(MISC_OFF + 64 <= LDS_BYTES, "LDS map");

#define RLX_AGENT __ATOMIC_RELAXED, __HIP_MEMORY_SCOPE_AGENT
#define LDS_WAIT() asm volatile("s_waitcnt lgkmcnt(0)" ::: "memory")
#define VM_WAIT() asm volatile("s_waitcnt vmcnt(0)" ::: "memory")
__device__ __forceinline__ unsigned f2bf(float f) { unsigned u = __builtin_bit_cast(unsigned, f); return (u + 0x7fffu + ((u >> 16) & 1u)) >> 16; }
__device__ __forceinline__ unsigned pk2(float lo, float hi) { return f2bf(lo) | (f2bf(hi) << 16); }
__device__ __forceinline__ float bflo(unsigned w) { return __builtin_bit_cast(float, w << 16); }
__device__ __forceinline__ float bfhi(unsigned w) { return __builtin_bit_cast(float, w & 0xffff0000u); }
__device__ __forceinline__ float bf2f(bf16 v) { return __builtin_bit_cast(float, (unsigned)v << 16); }
__device__ __forceinline__ unsigned cvt_pk_bf16(float lo, float hi) { unsigned r; asm volatile("v_cvt_pk_bf16_f32 %0, %1, %2" : "=v"(r) : "v"(lo), "v"(hi)); return r; }
__device__ __forceinline__ float wave_sum(float v) {
#pragma unroll
    for (int o = 1; o < 64; o <<= 1) v += __shfl_xor(v, o);
    return v;
}

#define XB_TMO      128
#define XB_XCNT(j)  (256  + 64 * (j))
#define XB_XSUB(j)  (1280 + 64 * (j))
#define XB_XGEN(j)  (2304 + 64 * (j))
#define XB_TOP      3328
#define XB_TOPGEN   3392
#define XCD_BAR_WORDS 3456
#define XB_SPIN_CAP (1u << 18)
__device__ __forceinline__ unsigned xb_ld(unsigned* p)              { return __hip_atomic_load(p, __ATOMIC_RELAXED, __HIP_MEMORY_SCOPE_AGENT); }
__device__ __forceinline__ unsigned xb_add(unsigned* p, unsigned v) { return __hip_atomic_fetch_add(p, v, __ATOMIC_RELAXED, __HIP_MEMORY_SCOPE_AGENT); }
__device__ __forceinline__ unsigned xb_xcc_id() { return (unsigned)__builtin_amdgcn_s_getreg((3 << 11) | 20) & 0xFu; }
#define XB_SPIN(cond, bar) do { unsigned _sp = 0; while (cond) { __builtin_amdgcn_s_sleep(1); \
    if ((++_sp & 255u) == 0u) { if (xb_ld(&(bar)[XB_TMO])) break; if (_sp > XB_SPIN_CAP) { atomicAdd(&(bar)[XB_TMO], 1u); break; } } } } while (0)
struct XcdBarrier { unsigned* bar; unsigned x; volatile LAS unsigned* st; };
__device__ __forceinline__ XcdBarrier xcd_barrier_post(unsigned* bar, volatile LAS unsigned* st) {
    XcdBarrier b; b.bar = bar; b.x = xb_xcc_id(); b.st = st;
    if (threadIdx.x == 0) (void)xb_add(&bar[XB_XCNT(b.x)], 1u);
    return b;
}
__device__ __forceinline__ void xcd_barrier_complete(unsigned* bar, unsigned x, unsigned& nloc, unsigned& nx) {
    const unsigned G = gridDim.x * gridDim.y * gridDim.z;
    unsigned sum, cnt, mine, sp = 0u;
    for (;;) {
        sum = 0u; cnt = 0u; mine = 0u;
#pragma unroll
        for (unsigned j = 0; j < 16; ++j) { const unsigned c = xb_ld(&bar[XB_XCNT(j)]); sum += c; cnt += (c > 0u) ? 1u : 0u; mine = (j == x) ? c : mine; }
        if (sum == G) break;
        __builtin_amdgcn_s_sleep(1);
        if ((++sp & 255u) == 0u) { if (xb_ld(&bar[XB_TMO])) break; if (sp > XB_SPIN_CAP) { atomicAdd(&bar[XB_TMO], 1u); break; } }
    }
    nloc = mine > 0u ? mine : 1u; nx = cnt > 0u ? cnt : 1u;
}
__device__ __forceinline__ void xcd_barrier(const XcdBarrier& b) {
    asm volatile("s_waitcnt vmcnt(0)" ::: "memory");
    __syncthreads();
    if (threadIdx.x == 0) {
        unsigned* bar = b.bar;
        __builtin_amdgcn_s_waitcnt(0);
        unsigned nloc = b.st[0], nx = b.st[1];
        if (nloc == 0u) { xcd_barrier_complete(bar, b.x, nloc, nx); b.st[0] = nloc; b.st[1] = nx; }
        const unsigned old = xb_add(&bar[XB_XSUB(b.x)], 1u);
        const unsigned gen = old / nloc;
        if (old + 1u == (gen + 1u) * nloc) {
            __builtin_amdgcn_fence(__ATOMIC_RELEASE, "agent");
            asm volatile("s_waitcnt vmcnt(0)" ::: "memory");
            const unsigned og = xb_add(&bar[XB_TOP], 1u);
            const unsigned tg = og / nx;
            if (og + 1u == (tg + 1u) * nx) xb_add(&bar[XB_TOPGEN], 1u);
            else XB_SPIN(xb_ld(&bar[XB_TOPGEN]) == tg, bar);
            __builtin_amdgcn_fence(__ATOMIC_ACQUIRE, "agent");
            xb_add(&bar[XB_XGEN(b.x)], 1u);
            asm volatile("s_waitcnt vmcnt(0)" ::: "memory");
        } else {
            XB_SPIN(xb_ld(&bar[XB_XGEN(b.x)]) == gen, bar);
            __builtin_amdgcn_fence(__ATOMIC_ACQUIRE, "agent");
            asm volatile("s_waitcnt vmcnt(0)" ::: "memory");
        }
    }
    __syncthreads();
}

namespace pg8 {
constexpr int BM = 256, BK = 64, HALF = 128, HTB = HALF * BK * 2, STAGE_BYTES = 8 * HTB, NXCD = 8, WGM = 4;
__host__ __device__ __forceinline__ int lds_byte(int r, int c) { const int st = (r >> 4) * 2 + (c >> 5), rr = r & 15, cc = c & 31, ob = rr * 64 + cc * 2; return st * 1024 + (ob ^ (((ob >> 9) & 1) << 5)); }
__host__ __device__ __forceinline__ void stage_rc(int b, int& R, int& C) { const int st = b / 1024, sb = b % 1024, swz = sb ^ (((sb >> 9) & 1) << 5); R = (st >> 1) * 16 + swz / 64; C = (st & 1) * 32 + (swz % 64) / 2; }
__host__ __device__ __forceinline__ int perm32(int rho) { const int n = rho >> 4, i = rho & 15; return 8 * (i >> 2) + 4 * n + (i & 3); }

struct Unit { const char* A; const char* B; const void* p0; const float* cs; bf16* obase; int orow, ocol, ldc; float scale; };

__device__ __forceinline__ bool tile_order(int i, int G, int c, int nM, int nN, int& pm, int& pn) {
    const int nwg = nM * nN; const long L = (long)i * G + c; if (L >= nwg) return false;
    int wgid = (int)L; { const int q = nwg / NXCD, r = nwg % NXCD, xcd = wgid % NXCD, off = wgid / NXCD; wgid = (xcd < r ? xcd * (q + 1) : r * (q + 1) + (xcd - r) * q) + off; }
    const int nig = WGM * nN, gid = wgid / nig, fm = gid * WGM, gsz = (nM - fm) < WGM ? (nM - fm) : WGM;
    pm = fm + ((wgid % nig) % gsz); pn = (wgid % nig) / gsz; return true;
}

template <bool VT> struct EpiBf16T {
    static constexpr bool SCL = false;
    __device__ __forceinline__ void operator()(const f32x4 (&acc)[2][2][4][2], const Unit& u, int wr, int wc, int fr, int fq, const LAS int* tok, const LAS float* scl) const {
        const int row0 = u.orow + wr * 64 + fr, col0 = u.ocol + wc * 32 + 8 * fq; const float sc = u.scale;
#pragma unroll
        for (int ai = 0; ai < 2; ++ai)
#pragma unroll
            for (int m = 0; m < 4; ++m) { const int row = row0 + ai * HALF + m * 16; bf16* rowp = u.obase + (size_t)row * u.ldc + col0;
#pragma unroll
                for (int bj = 0; bj < 2; ++bj) { const f32x4 v0 = acc[ai][bj][m][0] * sc, v1 = acc[ai][bj][m][1] * sc;
                    v4u w; w.x = cvt_pk_bf16(v0[0], v0[1]); w.y = cvt_pk_bf16(v0[2], v0[3]); w.z = cvt_pk_bf16(v1[0], v1[1]); w.w = cvt_pk_bf16(v1[2], v1[3]);
                    bf16* p = (VT && u.ldc < 0) ? u.obase + vt_index(row, col0 + bj * HALF) : rowp + bj * HALF;
                    *(v4u*)p = w; } }
    }
};
typedef EpiBf16T<false> EpiBf16;
typedef EpiBf16T<true> EpiProj;
__device__ __forceinline__ float silu_mul(float g, float u) { return g * u * __builtin_amdgcn_rcpf(1.0f + __builtin_amdgcn_exp2f(-LOG2E * g)); }
struct EpiSwiGLU {
    static constexpr bool SCL = false;
    __device__ __forceinline__ void operator()(const f32x4 (&acc)[2][2][4][2], const Unit& u, int wr, int wc, int fr, int fq, const LAS int* tok, const LAS float* scl) const {
        const int row0 = u.orow + wr * 64 + fr, col0 = u.ocol + wc * 32 + 8 * fq;
#pragma unroll
        for (int ai = 0; ai < 2; ++ai)
#pragma unroll
            for (int m = 0; m < 4; ++m) { bf16* rowp = u.obase + (size_t)(row0 + ai * HALF + m * 16) * u.ldc + col0;
                const f32x4 g0 = acc[ai][0][m][0], g1 = acc[ai][0][m][1], u0 = acc[ai][1][m][0], u1 = acc[ai][1][m][1];
                v4u w; w.x = cvt_pk_bf16(silu_mul(g0[0], u0[0]), silu_mul(g0[1], u0[1])); w.y = cvt_pk_bf16(silu_mul(g0[2], u0[2]), silu_mul(g0[3], u0[3]));
                w.z = cvt_pk_bf16(silu_mul(g1[0], u1[0]), silu_mul(g1[1], u1[1])); w.w = cvt_pk_bf16(silu_mul(g1[2], u1[2]), silu_mul(g1[3], u1[3]));
                *(v4u*)rowp = w; }
    }
};

template <bool F6> struct EpiSwiGLU8T {
    static constexpr bool SCL = false;
    static __device__ __forceinline__ f32x2 pair(f32x2 gr, f32x2 ur) {
        const float sc = F6 ? 1.0f / (S6A * S6W) : 1.0f / W8_UP; const f32x2 a = gr * (-LOG2E * sc);
        f32x2 t; t.x = __builtin_amdgcn_exp2f(a.x); t.y = __builtin_amdgcn_exp2f(a.y);
        const f32x2 d = t + 1.0f; f32x2 r; r.x = __builtin_amdgcn_rcpf(d.x); r.y = __builtin_amdgcn_rcpf(d.y);
        return (gr * ur) * (r * (sc * sc));
    }
    __device__ __forceinline__ void operator()(const f32x4 (&acc)[2][2][4][2], const Unit& u, int wr, int wc, int fr, int fq, const LAS int* tok, const LAS float* scl) const {
        const int row0 = u.orow + wr * 64 + fr, col0 = u.ocol + wc * 32 + 8 * fq;
#pragma unroll
        for (int ai = 0; ai < 2; ++ai)
#pragma unroll
            for (int m = 0; m < 4; ++m) { unsigned char* rowp = (unsigned char*)u.obase + (size_t)(row0 + ai * HALF + m * 16) * 128 + col0;
                const f32x4 g0 = acc[ai][0][m][0], g1 = acc[ai][0][m][1], u0 = acc[ai][1][m][0], u1 = acc[ai][1][m][1];
                const f32x2 o0 = pair((f32x2){g0[0], g0[1]}, (f32x2){u0[0], u0[1]}), o1 = pair((f32x2){g0[2], g0[3]}, (f32x2){u0[2], u0[3]});
                const f32x2 o2 = pair((f32x2){g1[0], g1[1]}, (f32x2){u1[0], u1[1]}), o3 = pair((f32x2){g1[2], g1[3]}, (f32x2){u1[2], u1[3]});
                int w0 = 0, w1 = 0;
                w0 = __builtin_amdgcn_cvt_pk_fp8_f32(o0.x, o0.y, w0, false); w0 = __builtin_amdgcn_cvt_pk_fp8_f32(o1.x, o1.y, w0, true);
                w1 = __builtin_amdgcn_cvt_pk_fp8_f32(o2.x, o2.y, w1, false); w1 = __builtin_amdgcn_cvt_pk_fp8_f32(o3.x, o3.y, w1, true);
                v2u w; w.x = (unsigned)w0; w.y = (unsigned)w1; *(v2u*)rowp = w; }
    }
};

typedef EpiSwiGLU8T<false> EpiSwiGLU8;
typedef EpiSwiGLU8T<true> EpiSwiGLU6;
struct EpiProj_I8 {
    static constexpr bool SCL = true;
    __device__ __forceinline__ const float* rs_ptr(const Unit& u) const { return (const float*)u.p0; }
    __device__ __forceinline__ const float* cs_ptr(const Unit& u) const { return u.cs; }
    __device__ __forceinline__ void operator()(const f32x4 (&acc)[2][2][4][2], const Unit& u, int wr, int wc, int fr, int fq, const LAS int* tok, const LAS float* scl) const {
        const int rl0 = wr * 64 + fr, cl0 = wc * 32 + 8 * fq, row0 = u.orow + rl0, col0 = u.ocol + cl0; const float sc = u.scale;
        const bool hm = u.ldc == 0; const size_t rstride = hm ? 32 : (size_t)u.ldc, bstride = hm ? (size_t)4 * T * 32 : (size_t)HALF;
        bf16* lbase = hm ? u.obase + (size_t)((u.ocol >> 5) + wc) * T * 32 + 8 * fq : u.obase + col0;
        f32x4 cv[2][2];
#pragma unroll
        for (int bj = 0; bj < 2; ++bj) { cv[bj][0] = *(const LAS f32x4*)(scl + 256 + cl0 + bj * HALF) * sc; cv[bj][1] = *(const LAS f32x4*)(scl + 256 + cl0 + bj * HALF + 4) * sc; }
#pragma unroll
        for (int ai = 0; ai < 2; ++ai)
#pragma unroll
            for (int m = 0; m < 4; ++m) { const int row = row0 + ai * HALF + m * 16; const float sr = scl[rl0 + ai * HALF + m * 16]; bf16* rowp = lbase + (size_t)row * rstride;
#pragma unroll
                for (int bj = 0; bj < 2; ++bj) { const f32x4 v0 = __builtin_convertvector(__builtin_bit_cast(i32x4, acc[ai][bj][m][0]), f32x4) * cv[bj][0] * sr, v1 = __builtin_convertvector(__builtin_bit_cast(i32x4, acc[ai][bj][m][1]), f32x4) * cv[bj][1] * sr;
                    v4u w; w.x = cvt_pk_bf16(v0[0], v0[1]); w.y = cvt_pk_bf16(v0[2], v0[3]); w.z = cvt_pk_bf16(v1[0], v1[1]); w.w = cvt_pk_bf16(v1[2], v1[3]);
                    bf16* p = (u.ldc < 0) ? u.obase + vt_index(row, col0 + bj * HALF) : rowp + bj * bstride;
                    *(v4u*)p = w; } }
    }
};
template <bool F8OUT> struct EpiSwiGLU_I8T {
    static constexpr bool SCL = true;
    const float* sA; const float* sW; const int* idl;
    __device__ __forceinline__ const float* rs_ptr(const Unit& u) const { return sA + ((const int*)u.p0 - idl); }
    __device__ __forceinline__ const float* cs_ptr(const Unit& u) const { return sW + 2 * u.ocol; }
    static __device__ __forceinline__ f32x2 pair(f32x2 gr, f32x2 ur, f32x2 ka, f32x2 k, float sa) {
        const f32x2 a = (gr * sa) * ka;
        f32x2 t; t.x = __builtin_amdgcn_exp2f(a.x); t.y = __builtin_amdgcn_exp2f(a.y);
        const f32x2 d = t * k + k; f32x2 r; r.x = __builtin_amdgcn_rcpf(d.x); r.y = __builtin_amdgcn_rcpf(d.y);
        return (gr * ur) * r;
    }
    __device__ __forceinline__ void operator()(const f32x4 (&acc)[2][2][4][2], const Unit& u, int wr, int wc, int fr, int fq, const LAS int* tok, const LAS float* scl) const {
        const int rl0 = wr * 64 + fr, row0 = u.orow + rl0, cl0 = wc * 32 + 8 * fq, col0 = u.ocol + cl0;
        f32x2 ka[4], kc[4];
#pragma unroll
        for (int i = 0; i < 4; ++i) { const f32x2 wg = *(const LAS f32x2*)(scl + 256 + cl0 + 2 * i), wu = *(const LAS f32x2*)(scl + 256 + HALF + cl0 + 2 * i); const f32x2 p = wg * wu;
            ka[i] = wg * (-LOG2E); kc[i].x = __builtin_amdgcn_rcpf(p.x); kc[i].y = __builtin_amdgcn_rcpf(p.y); }
#pragma unroll
        for (int ai = 0; ai < 2; ++ai)
#pragma unroll
            for (int m = 0; m < 4; ++m) { const float sa = scl[rl0 + ai * HALF + m * 16], rs2 = __builtin_amdgcn_rcpf(sa * sa);
                bf16* rowp = u.obase + (size_t)(row0 + ai * HALF + m * 16) * u.ldc + col0;
                f32x2 o[4];
#pragma unroll
                for (int i = 0; i < 4; ++i) { const f32x4 ga = acc[ai][0][m][i >> 1], ua = acc[ai][1][m][i >> 1];
                    const float g0 = ga[2 * (i & 1)], g1 = ga[2 * (i & 1) + 1], u0 = ua[2 * (i & 1)], u1 = ua[2 * (i & 1) + 1];
                    const f32x2 gr = (f32x2){(float)__float_as_int(g0), (float)__float_as_int(g1)}, ur = (f32x2){(float)__float_as_int(u0), (float)__float_as_int(u1)};
                    o[i] = pair(gr, ur, ka[i], kc[i] * rs2, sa); }
                if constexpr (F8OUT) { int w0 = 0, w1 = 0;
                    w0 = __builtin_amdgcn_cvt_pk_fp8_f32(o[0].x, o[0].y, w0, false); w0 = __builtin_amdgcn_cvt_pk_fp8_f32(o[1].x, o[1].y, w0, true);
                    w1 = __builtin_amdgcn_cvt_pk_fp8_f32(o[2].x, o[2].y, w1, false); w1 = __builtin_amdgcn_cvt_pk_fp8_f32(o[3].x, o[3].y, w1, true);
                    v2u w; w.x = (unsigned)w0; w.y = (unsigned)w1; *(v2u*)((unsigned char*)u.obase + (size_t)(row0 + ai * HALF + m * 16) * 128 + col0) = w; }
                else { v4u w; w.x = cvt_pk_bf16(o[0].x, o[0].y); w.y = cvt_pk_bf16(o[1].x, o[1].y); w.z = cvt_pk_bf16(o[2].x, o[2].y); w.w = cvt_pk_bf16(o[3].x, o[3].y);
                    *(v4u*)rowp = w; } }
    }
};
typedef EpiSwiGLU_I8T<FP8_DDOWN != 0> EpiSwiGLU_I8;

template <class Epi, class Sched, bool GATHER, int MT = 0  >
__device__ __forceinline__ void gemm_phase(LAS unsigned char* lds, LAS int* tokbuf, const int K, const Sched& S, const Epi& E, const int P_ = 0, const int PA_ = 0, const int KSA_ = 0) {
    const int P = P_ ? P_ : K, PA = PA_ ? PA_ : P;
    const size_t kstepA = KSA_ ? (size_t)KSA_ : (size_t)(BK * 2);
    int tid_ = threadIdx.x; asm volatile("" : "+v"(tid_));
    const int tid = tid_, wid = __builtin_amdgcn_readfirstlane(tid >> 6), lane = tid & 63, wr = wid >> 2, wc = wid & 3, fr = lane & 15, fq = lane >> 4;
    const int nt = K / BK;
    unsigned voffA[2][2], voffB[2]; int rowA[2], colA[2];
#pragma unroll
    for (int i = 0; i < 2; ++i) { int R, C; stage_rc(tid * 16 + i * 8192, R, C); const int Rb = (R & ~31) + perm32(R & 31);
        voffA[0][i] = (unsigned)(R * PA + C) * 2u; voffA[1][i] = (unsigned)((R + HALF) * PA + C) * 2u; voffB[i] = (unsigned)(Rb * P + C) * 2u; rowA[i] = R; colA[i] = C; }
    const size_t kstep = (size_t)(BK * 2);
    const size_t hstep = (size_t)HALF * P * 2, hstepA = (size_t)HALF * PA * 2;
    const unsigned ldsw = (unsigned)wid * 1024u;
    const int aoff = lds_byte(wr * 64 + fr, fq * 8), boff = lds_byte(wc * 32 + fr, fq * 8);
#define PG8_SA(b, h) (((b) * 2 + (h)) * HTB)
#define PG8_SB(b, h) ((4 + (b) * 2 + (h)) * HTB)
#define PG8_STAGE(bufoff, gbase, voff) do { _Pragma("unroll") for (int _i = 0; _i < 2; ++_i) \
        __builtin_amdgcn_global_load_lds((const unsigned*)((const char*)(gbase) + (voff)[_i]), (LAS unsigned*)(lds + (bufoff) + ldsw + _i * 8192), 16, 0, 0); } while (0)
#define PG8_STAGE_A1(bufoff, gbase) do { if constexpr (GATHER) PG8_STAGE(bufoff, gbase, voffA[1]); else PG8_STAGE(bufoff, (gbase) + hstepA, voffA[0]); } while (0)
#define PG8_LDA(dst, b, h) do { _Pragma("unroll") for (int m = 0; m < 4; ++m) _Pragma("unroll") for (int k = 0; k < 2; ++k) dst[m][k] = *(const LAS bf16x8*)(lds + PG8_SA(b, h) + aoff + m * 2048 + k * 1024); } while (0)
#define PG8_LDB(dst, b, h) do { _Pragma("unroll") for (int n = 0; n < 2; ++n) _Pragma("unroll") for (int k = 0; k < 2; ++k) dst[n][k] = *(const LAS bf16x8*)(lds + PG8_SB(b, h) + boff + n * 2048 + k * 1024); } while (0)
#define PG8_CAT8(x) __builtin_shufflevector(__builtin_bit_cast(i32x4, (x)[0]), __builtin_bit_cast(i32x4, (x)[1]), 0, 1, 2, 3, 4, 5, 6, 7)
#define PG8_MMA(ai, bj, At, Bt) do { __builtin_amdgcn_s_setprio(1); _Pragma("unroll") for (int m = 0; m < 4; ++m) _Pragma("unroll") for (int n = 0; n < 2; ++n) { \
        if constexpr (MT == 1) acc[ai][bj][m][n] = __builtin_amdgcn_mfma_scale_f32_16x16x128_f8f6f4(PG8_CAT8(Bt[n]), PG8_CAT8(At[m]), acc[ai][bj][m][n], 0, 0, 0, 0, 0, 0); \
        else if constexpr (MT == 3) acc[ai][bj][m][n] = __builtin_amdgcn_mfma_scale_f32_16x16x128_f8f6f4(PG8_CAT8(Bt[n]), PG8_CAT8(At[m]), acc[ai][bj][m][n], 2, 2, 0, 0, 0, 0); \
        else if constexpr (MT == 2) { _Pragma("unroll") for (int k = 0; k < 2; ++k) acc[ai][bj][m][n] = __builtin_bit_cast(f32x4, __builtin_amdgcn_mfma_i32_16x16x64_i8(__builtin_bit_cast(i32x4, Bt[n][k]), __builtin_bit_cast(i32x4, At[m][k]), __builtin_bit_cast(i32x4, acc[ai][bj][m][n]), 0, 0, 0)); } \
        else { _Pragma("unroll") for (int k = 0; k < 2; ++k) acc[ai][bj][m][n] = __builtin_amdgcn_mfma_f32_16x16x32_bf16(Bt[n][k], At[m][k], acc[ai][bj][m][n], 0, 0, 0); } } \
        __builtin_amdgcn_s_setprio(0); } while (0)
#define PG8_WAIT_V(n) asm volatile("s_waitcnt vmcnt(" #n ")" ::: "memory")
#define PG8_WAIT_L(n) asm volatile("s_waitcnt lgkmcnt(" #n ")" ::: "memory")
#define PG8_BAR __builtin_amdgcn_s_barrier()
#define PG8_SCHED __builtin_amdgcn_sched_barrier(0)
#define PG8_TOKOFF(dst, tb) do { _Pragma("unroll") for (int _h = 0; _h < 2; ++_h) _Pragma("unroll") for (int _i = 0; _i < 2; ++_i) \
        dst[_h][_i] = (unsigned)(tb)[_h * HALF + rowA[_i]] * (unsigned)(PA * 2) + (unsigned)(colA[_i] * 2); } while (0)
#define PG8_TOKDMA(listp, tb) do { if (wid < 4) __builtin_amdgcn_global_load_lds((const unsigned*)((listp) + tid), (LAS unsigned*)((tb) + wid * 64), 4, 0, 0); } while (0)
#define PG8_SCB(u_) ((LAS float*)(tokbuf + 768) + 512 * ((u_) % 3))
#define PG8_SCLDMA(un, u_) do { const float* sp_ = wid < 4 ? E.rs_ptr(un) + tid : E.cs_ptr(un) + (tid - 256); \
        __builtin_amdgcn_global_load_lds((const unsigned*)sp_, (LAS unsigned*)(PG8_SCB(u_) + wid * 64), 4, 0, 0); } while (0)
#define PG8_TB(u_) (tokbuf + 256 * ((u_) % 3))
    Unit cur, nxt; int ui = 0;
    if (!S.next(0, cur)) return;
    f32x4 acc[2][2][4][2];
#pragma unroll
    for (int a = 0; a < 2; ++a)
#pragma unroll
        for (int b = 0; b < 2; ++b)
#pragma unroll
            for (int m = 0; m < 4; ++m)
#pragma unroll
                for (int n = 0; n < 2; ++n) acc[a][b][m][n] = (f32x4){0.f, 0.f, 0.f, 0.f};
    bf16x8 At[4][2], B0[2][2], B1[2][2];
    const char* cA = cur.A; const char* cB = cur.B;
    if constexpr (Epi::SCL) PG8_SCLDMA(cur, 0);
    if constexpr (GATHER) {
        PG8_TOKDMA((const int*)cur.p0, PG8_TB(0)); PG8_WAIT_V(0); PG8_BAR; asm volatile("" ::: "memory");
        PG8_TOKOFF(voffA, PG8_TB(0)); PG8_WAIT_L(0); asm volatile("" ::: "memory");
    } else if constexpr (Epi::SCL) { PG8_WAIT_V(0); PG8_BAR; asm volatile("" ::: "memory"); }
    PG8_STAGE(PG8_SB(0, 0), cB, voffB); PG8_STAGE(PG8_SB(0, 1), cB + hstep, voffB); PG8_STAGE(PG8_SA(0, 0), cA, voffA[0]); PG8_STAGE_A1(PG8_SA(0, 1), cA);
    if (wr == 1) PG8_BAR;
    PG8_WAIT_V(2); PG8_BAR;
    PG8_STAGE(PG8_SB(1, 0), cB + kstep, voffB); PG8_STAGE(PG8_SA(1, 0), cA + kstepA, voffA[0]); PG8_STAGE(PG8_SB(1, 1), cB + hstep + kstep, voffB);
    PG8_WAIT_V(6); PG8_BAR;
    for (;;) {
        const bool has_next = S.next(ui + 1, nxt);
        if constexpr (Epi::SCL) { if (has_next) PG8_SCLDMA(nxt, ui + 1); }
        if constexpr (GATHER) { if (has_next) PG8_TOKDMA((const int*)nxt.p0, PG8_TB(ui + 1)); }
        const char* nA = has_next ? nxt.A : cA; const char* nB = has_next ? nxt.B : cB;
        for (int t = 0; t < nt; t += 2) {
            const bool last = (t == nt - 2);
            const char* a1 = cA + (size_t)(t + 1) * kstepA;
            const char* a2 = last ? nA : cA + (size_t)(t + 2) * kstepA; const char* b2 = last ? nB : cB + (size_t)(t + 2) * kstep;
            const char* a3 = a2 + kstepA; const char* b3 = b2 + kstep;
            PG8_LDB(B0, 0, 0); PG8_LDB(B1, 0, 1); PG8_SCHED; PG8_LDA(At, 0, 0); PG8_STAGE_A1(PG8_SA(1, 1), a1);
            if constexpr (GATHER) { if (last && has_next) { PG8_TOKOFF(voffA, PG8_TB(ui + 1)); } }
            PG8_WAIT_V(8); PG8_WAIT_L(0); PG8_BAR; PG8_MMA(0, 0, At, B0); PG8_MMA(0, 1, At, B1); PG8_BAR; PG8_SCHED;
            PG8_LDA(At, 0, 1); PG8_STAGE(PG8_SB(0, 0), b2, voffB); PG8_STAGE(PG8_SB(0, 1), b2 + hstep, voffB); PG8_STAGE(PG8_SA(0, 0), a2, voffA[0]);
            PG8_WAIT_V(8); PG8_WAIT_L(0); PG8_BAR; PG8_MMA(1, 0, At, B0); PG8_MMA(1, 1, At, B1); PG8_BAR; PG8_SCHED;
            PG8_LDB(B0, 1, 0); PG8_LDB(B1, 1, 1); PG8_SCHED; PG8_LDA(At, 1, 0); PG8_STAGE_A1(PG8_SA(0, 1), a2);
            PG8_WAIT_V(8); PG8_WAIT_L(0); PG8_BAR; PG8_MMA(0, 0, At, B0); PG8_MMA(0, 1, At, B1); PG8_BAR; PG8_SCHED;
            PG8_LDA(At, 1, 1); PG8_STAGE(PG8_SB(1, 0), b3, voffB); PG8_STAGE(PG8_SB(1, 1), b3 + hstep, voffB); PG8_STAGE(PG8_SA(1, 0), a3, voffA[0]);
            PG8_WAIT_V(8); PG8_WAIT_L(0); PG8_BAR; PG8_MMA(1, 0, At, B0); PG8_MMA(1, 1, At, B1); PG8_BAR; PG8_SCHED;
        }
        if (wr == 0) PG8_BAR;
#ifndef EPIX
#define EPIX 1
#endif
        for (int e_ = 0; e_ < EPIX; ++e_) E(acc, cur, wr, wc, fr, fq, PG8_TB(ui), PG8_SCB(ui));
        if (!has_next) break;
#pragma unroll
        for (int a = 0; a < 2; ++a)
#pragma unroll
            for (int b = 0; b < 2; ++b)
#pragma unroll
                for (int m = 0; m < 4; ++m)
#pragma unroll
                    for (int n = 0; n < 2; ++n) acc[a][b][m][n] = (f32x4){0.f, 0.f, 0.f, 0.f};
        cur = nxt; cA = nA; cB = nB; ++ui;
        if (wr == 1) PG8_BAR;
    }
    PG8_WAIT_V(0);
    PG8_BAR;
#undef PG8_SA
#undef PG8_SB
#undef PG8_STAGE
#undef PG8_LDA
#undef PG8_STAGE_A1
#undef PG8_LDB
#undef PG8_MMA
#undef PG8_CAT8
#undef PG8_WAIT_V
#undef PG8_WAIT_L
#undef PG8_BAR
#undef PG8_SCHED
#undef PG8_TOKOFF
#undef PG8_TOKDMA
#undef PG8_TB
#undef PG8_SCB
#undef PG8_SCLDMA
}
}

struct Args { const float* in[17]; float* out; unsigned char* ws; int lo, hi, breg, pad; };
struct Frame {
    LAS unsigned char* lds; volatile LAS unsigned* MISC; unsigned* ctl; int tid, lane, wave, G, bid;
    const float *x, *g_mpre, *g_mpost, *g_fpre, *g_fpost, *w_in, *pool_w, *pool_scale, *rpb, *w_out, *dwg, *dwu, *dwd, *router, *mwg, *mwu, *mwd;
    float* out; unsigned char* ws;
};

__device__ __forceinline__ void p0_transpose_item(const float* W, int K, int N, bf16* WT, int kb, int n0, int row_base, LAS float* scr, int lane) {
    const int k0 = 64 * kb;
#pragma unroll 8
    for (int i = 0; i < 32; ++i) { const int kk = 2 * i + (lane >> 5); scr[kk * 33 + (lane & 31)] = W[(size_t)(k0 + kk) * N + n0 + (lane & 31)]; }
    LDS_WAIT(); asm volatile("" ::: "memory");
    const int c = lane & 7;
#pragma unroll
    for (int j = 0; j < 4; ++j) { const int n = (lane >> 3) + 8 * j; const LAS float* s = scr + (8 * c) * 33 + n;
        v4u o; o.x = pk2(s[0 * 33], s[1 * 33]); o.y = pk2(s[2 * 33], s[3 * 33]); o.z = pk2(s[4 * 33], s[5 * 33]); o.w = pk2(s[6 * 33], s[7 * 33]);
        *(v4u*)(WT + (size_t)(row_base + n) * K + k0 + 8 * c) = o; }
    LDS_WAIT(); asm volatile("" ::: "memory");
}
__device__ __forceinline__ void p0_matrix(const float* W, int K, int N, bf16* WT, int ilv_half, LAS float* scr, int lane, int gw, int NGW, int& base) {
    const int nblk = N / 32, nitems = (K / 64) * nblk;
    int it = gw - (base % NGW); if (it < 0) it += NGW;
    for (; it < nitems; it += NGW) { const int kb = it / nblk, n0 = 32 * (it % nblk);
        const int rb = ilv_half < 0 ? n0 : (n0 / 128) * 256 + (n0 % 128) + 128 * ilv_half;
        p0_transpose_item(W, K, N, WT, kb, n0, rb, scr, lane); }
    base += nitems;
}
__device__ __forceinline__ void p0_transpose_item_fp8(const float* W, int K, int N, unsigned char* WT, int kt, int n0, int row_base, float scale, LAS float* scr, int lane) {
    const int k0 = 128 * kt;
#pragma unroll 8
    for (int i = 0; i < 64; ++i) { const int kk = 2 * i + (lane >> 5); scr[kk * 33 + (lane & 31)] = W[(size_t)(k0 + kk) * N + n0 + (lane & 31)] * scale; }
    LDS_WAIT(); asm volatile("" ::: "memory");
    const int c = lane & 7;
#pragma unroll 1
    for (int pass = 0; pass < 4; ++pass) { const int n = (lane >> 3) + 8 * pass; const LAS float* sp = scr + (16 * c) * 33 + n;
        v4u o;
#pragma unroll
        for (int d = 0; d < 4; ++d) { int w = 0; w = __builtin_amdgcn_cvt_pk_fp8_f32(sp[(4 * d) * 33], sp[(4 * d + 1) * 33], w, false); w = __builtin_amdgcn_cvt_pk_fp8_f32(sp[(4 * d + 2) * 33], sp[(4 * d + 3) * 33], w, true); o[d] = (unsigned)w; }
        *(v4u*)(WT + (size_t)(row_base + n) * K + k0 + 16 * c) = o; }
    LDS_WAIT(); asm volatile("" ::: "memory");
}
__device__ __forceinline__ void p0_transpose_item_fp6(const float* W, int K, int N, unsigned char* WT, int kt, int n0, int row_base, float scale, LAS float* scr, int lane) {
    const int k0 = 128 * kt;
#pragma unroll 8
    for (int i = 0; i < 64; ++i) { const int kk = 2 * i + (lane >> 5); scr[kk * 33 + (lane & 31)] = W[(size_t)(k0 + kk) * N + n0 + (lane & 31)] * scale; }
    LDS_WAIT(); asm volatile("" ::: "memory");
    const int n = lane & 31, g = lane >> 5;
    unsigned char* rp = WT + (size_t)(row_base + n) * K + 128 * kt;
#pragma unroll 1
    for (int h = 0; h < 2; ++h) { const int fq = 2 * h + g; const LAS float* sp = scr + (32 * fq) * 33 + n;
        f32x16 x, y;
#pragma unroll
        for (int i = 0; i < 16; ++i) { x[i] = sp[i * 33]; y[i] = sp[(16 + i) * 33]; }
        const i32x6 o = __builtin_amdgcn_cvt_scalef32_2xpk16_fp6_f32(x, y, 1.0f);
        *(v4u*)(rp + 16 * fq) = (v4u){(unsigned)o[0], (unsigned)o[1], (unsigned)o[2], (unsigned)o[3]};
        *(v4u*)(rp + 64 + 16 * fq) = (v4u){(unsigned)o[4], (unsigned)o[5], 0u, 0u}; }
    LDS_WAIT(); asm volatile("" ::: "memory");
}
__device__ __forceinline__ void p0_matrix_fp6(const float* W, int K, int N, unsigned char* WT, int ilv_half, float scale, LAS float* scr, int lane, int gw, int NGW, int& base) {
    const int nblk = N / 32, nitems = (K / 128) * nblk;
    int it = gw - (base % NGW); if (it < 0) it += NGW;
    for (; it < nitems; it += NGW) { const int kt = it / nblk, n0 = 32 * (it % nblk);
        const int rb = (n0 / 128) * 256 + (n0 % 128) + 128 * ilv_half;
        p0_transpose_item_fp6(W, K, N, WT, kt, n0, rb, scale, scr, lane); }
    base += nitems;
}
__device__ __forceinline__ void p0_matrix_fp8(const float* W, int K, int N, unsigned char* WT, int ilv_half, float scale, LAS float* scr, int lane, int gw, int NGW, int& base) {
    const int nblk = N / 32, nitems = (K / 128) * nblk;
    int it = gw - (base % NGW); if (it < 0) it += NGW;
    for (; it < nitems; it += NGW) { const int kt = it / nblk, n0 = 32 * (it % nblk);
        const int rb = ilv_half < 0 ? n0 : (n0 / 128) * 256 + (n0 % 128) + 128 * ilv_half;
        p0_transpose_item_fp8(W, K, N, WT, kt, n0, rb, scale, scr, lane); }
    base += nitems;
}
__device__ __forceinline__ void rms_row_to_bf16(const float* xrow, const float* g, bf16* orow, int lane) {
    const f32x4* xr = (const f32x4*)xrow + lane; const f32x4* gr = (const f32x4*)g + lane;
    f32x4 v[4]; float s = 0.f;
#pragma unroll
    for (int j = 0; j < 4; ++j) { v[j] = xr[64 * j]; s += (v[j].x * v[j].x + v[j].y * v[j].y) + (v[j].z * v[j].z + v[j].w * v[j].w); }
    const float rstd = 1.0f / sqrtf(wave_sum(s) * (1.f / D) + RMS_EPS);
    v2u* o8 = (v2u*)orow + lane;
#pragma unroll
    for (int j = 0; j < 4; ++j) { const f32x4 gg = gr[64 * j]; v2u w; w.x = pk2(v[j].x * rstd * gg.x, v[j].y * rstd * gg.y); w.y = pk2(v[j].z * rstd * gg.z, v[j].w * rstd * gg.w); o8[64 * j] = w; }
}
__device__ __forceinline__ float wave_max(float v) {
#pragma unroll
    for (int o = 1; o < 64; o <<= 1) v = fmaxf(v, __shfl_xor(v, o));
    return v;
}
__device__ __forceinline__ void p0_colblock_i8(Frame& F, const float* W, int N, int n0, unsigned char* W8, float* sW, int dest0) {
    const int tid = F.tid, lane = F.lane, wid = F.wave, n = lane & 31, kh = lane >> 5;
    LAS float* slab = (LAS float*)F.lds; LAS float* cmax = (LAS float*)(F.lds + RING_BYTES);
    __syncthreads();
    float mx = 0.f;
#pragma unroll 1
    for (int i0 = 0; i0 < 64; i0 += 16) {
        float v[16];
#pragma unroll
        for (int i = 0; i < 16; ++i) v[i] = W[(size_t)(128 * wid + 2 * (i0 + i) + kh) * N + n0 + n];
#pragma unroll
        for (int i = 0; i < 16; ++i) { const int k = 128 * wid + 2 * (i0 + i) + kh; slab[k * 32 + (n ^ (k & 31))] = v[i]; mx = fmaxf(mx, fabsf(v[i])); }
    }
    cmax[wid * 64 + lane] = mx;
    __syncthreads();
    float amax = 0.f;
#pragma unroll
    for (int w = 0; w < 8; ++w) amax = fmaxf(amax, fmaxf(cmax[w * 64 + n], cmax[w * 64 + 32 + n]));
    const float sc = amax > 0.f ? amax * (1.0f / 127.0f) : 1.0f, inv = amax > 0.f ? 127.0f / amax : 0.f;
    const int kc = tid >> 5, dest = dest0 + n;
#pragma unroll 1
    for (int q4 = 0; q4 < 4; ++q4) { v4u o;
#pragma unroll
        for (int d = 0; d < 4; ++d) { unsigned w = 0u;
#pragma unroll
            for (int j = 0; j < 4; ++j) { const int k = 64 * kc + 16 * q4 + 4 * d + j; w |= ((unsigned)__float2int_rn(slab[k * 32 + (n ^ (k & 31))] * inv) & 0xffu) << (8 * j); }
            o[d] = w; }
        *(v4u*)(W8 + (size_t)dest * D + 64 * kc + 16 * q4) = o; }
    if (kc == 0) sW[dest] = sc;
}
__device__ __forceinline__ void p0_i8_weights(Frame& F) {
    constexpr int NB_D = I8_DENSE ? 2 * (DFF / 32) : 0, NB_P = I8_PROJ ? DEPTH * (DIN / 32) : 0;
    for (int cb = F.bid; cb < NB_D + NB_P; cb += F.G) {
        if (cb < NB_D) { const int half = cb / (DFF / 32), n0 = 32 * (cb % (DFF / 32));
            p0_colblock_i8(F, half ? F.dwu : F.dwg, DFF, n0, F.ws + WS_WGU0, (float*)(F.ws + WS_SW0), (n0 / 128) * 256 + (n0 % 128) + 128 * half); }
        else { const int c2 = cb - NB_D, l = c2 / (DIN / 32), n0 = 32 * (c2 % (DIN / 32));
            p0_colblock_i8(F, F.w_in + (size_t)l * D * DIN, DIN, n0, F.ws + WS_WIN + (size_t)l * DIN * D, (float*)(F.ws + WS_SWIN) + l * DIN, n0); }
    }
    __syncthreads();
}
__device__ __forceinline__ void rms_row_to_i8(const float* xrow, const float* g, unsigned char* orow, float* sa, int lane) {
    const f32x4* xr = (const f32x4*)xrow + lane; const f32x4* gr = (const f32x4*)g + lane;
    f32x4 v[4]; float s = 0.f;
#pragma unroll
    for (int j = 0; j < 4; ++j) { v[j] = xr[64 * j]; s += (v[j].x * v[j].x + v[j].y * v[j].y) + (v[j].z * v[j].z + v[j].w * v[j].w); }
    const float rstd = 1.0f / sqrtf(wave_sum(s) * (1.f / D) + RMS_EPS); float am = 0.f;
#pragma unroll
    for (int j = 0; j < 4; ++j) { v[j] = v[j] * rstd * gr[64 * j]; am = fmaxf(fmaxf(am, fmaxf(fabsf(v[j].x), fabsf(v[j].y))), fmaxf(fabsf(v[j].z), fabsf(v[j].w))); }
    am = wave_max(am); const float inv = am > 0.f ? 127.0f / am : 0.f;
#pragma unroll
    for (int j = 0; j < 4; ++j) ((unsigned*)orow + lane)[64 * j] = ((unsigned)__float2int_rn(v[j].x * inv) & 0xffu) | (((unsigned)__float2int_rn(v[j].y * inv) & 0xffu) << 8) | (((unsigned)__float2int_rn(v[j].z * inv) & 0xffu) << 16) | (((unsigned)__float2int_rn(v[j].w * inv) & 0xffu) << 24);
    if (lane == 0) *sa = am > 0.f ? am * (1.0f / 127.0f) : 1.0f;
}
__device__ __forceinline__ void p0_prologue(Frame& F0) {
    Frame F = F0; { int t_ = threadIdx.x; asm volatile("" : "+v"(t_)); F.tid = t_; F.lane = t_ & 63; F.wave = __builtin_amdgcn_readfirstlane(t_ >> 6); }
    LAS float* scr = (LAS float*)(F.lds + F.wave * 16896);
    const int gw = F.bid * 8 + F.wave, NGW = F.G * 8, gt = F.bid * 512 + F.tid, NGT = F.G * 512;
    { v4u z = (v4u){0u, 0u, 0u, 0u}; v4u* L = (v4u*)(F.ws + WS_LIST); for (int i = gt; i < (int)(NE * T / 4); i += NGT) L[i] = z;
      int* id = (int*)(F.ws + WS_LISTID); for (int i = gt; i < T; i += NGT) id[i] = i; }
    int base = 0;
    for (int l = 0; l < DEPTH; ++l) {
#if !I8_PROJ
        p0_matrix(F.w_in + (size_t)l * D * DIN, D, DIN, (bf16*)(F.ws + WS_WIN) + (size_t)l * DIN * D, -1, scr, F.lane, gw, NGW, base);
#endif
        p0_matrix(F.w_out + (size_t)l * D * D, D, D, (bf16*)(F.ws + WS_WOUT) + (size_t)l * D * D, -1, scr, F.lane, gw, NGW, base);
        for (int g = 0; g < 4; ++g) p0_matrix(F.pool_w + (size_t)(l * 4 + g) * 128 * 128, 128, 128, (bf16*)(F.ws + WS_WP) + (size_t)(l * 4 + g) * 128 * 128, -1, scr, F.lane, gw, NGW, base);
    }
#if !I8_DENSE
    p0_matrix(F.dwg, D, DFF, (bf16*)(F.ws + WS_WGU0), 0, scr, F.lane, gw, NGW, base);
    p0_matrix(F.dwu, D, DFF, (bf16*)(F.ws + WS_WGU0), 1, scr, F.lane, gw, NGW, base);
#endif
#if FP8_DDOWN
    p0_matrix_fp8(F.dwd, DFF, D, F.ws + WS_WD0, -1, W8_DN, scr, F.lane, gw, NGW, base);
#else
    p0_matrix(F.dwd, DFF, D, (bf16*)(F.ws + WS_WD0), -1, scr, F.lane, gw, NGW, base);
#endif
    for (int e = 0; e < NE; ++e) {
#if FP8_MOE
#if FP6_UP
        p0_matrix_fp6(F.mwg + (size_t)e * D * DFFE, D, DFFE, F.ws + WS_WGUM + (size_t)e * 2 * DFFE * D, 0, S6W, scr, F.lane, gw, NGW, base);
        p0_matrix_fp6(F.mwu + (size_t)e * D * DFFE, D, DFFE, F.ws + WS_WGUM + (size_t)e * 2 * DFFE * D, 1, S6W, scr, F.lane, gw, NGW, base);
#else
        p0_matrix_fp8(F.mwg + (size_t)e * D * DFFE, D, DFFE, F.ws + WS_WGUM + (size_t)e * 2 * DFFE * D, 0, W8_UP, scr, F.lane, gw, NGW, base);
        p0_matrix_fp8(F.mwu + (size_t)e * D * DFFE, D, DFFE, F.ws + WS_WGUM + (size_t)e * 2 * DFFE * D, 1, W8_UP, scr, F.lane, gw, NGW, base);
#endif
        p0_matrix_fp8(F.mwd + (size_t)e * DFFE * D, DFFE, D, F.ws + WS_WDM + (size_t)e * D * DFFE, -1, W8_DN, scr, F.lane, gw, NGW, base);
#else
        p0_matrix(F.mwg + (size_t)e * D * DFFE, D, DFFE, (bf16*)(F.ws + WS_WGUM) + (size_t)e * 2 * DFFE * D, 0, scr, F.lane, gw, NGW, base);
        p0_matrix(F.mwu + (size_t)e * D * DFFE, D, DFFE, (bf16*)(F.ws + WS_WGUM) + (size_t)e * 2 * DFFE * D, 1, scr, F.lane, gw, NGW, base);
        p0_matrix(F.mwd + (size_t)e * DFFE * D, DFFE, D, (bf16*)(F.ws + WS_WDM) + (size_t)e * D * DFFE, -1, scr, F.lane, gw, NGW, base);
#endif
    }
    bf16* HN = (bf16*)(F.ws + WS_HN);
#if I8_PROJ
    for (int m = gw; m < T; m += NGW) rms_row_to_i8(F.x + (size_t)m * D, F.g_mpre, (unsigned char*)HN + (size_t)m * D, (float*)(F.ws + WS_SA) + m, F.lane);
#else
    for (int m = gw; m < T; m += NGW) rms_row_to_bf16(F.x + (size_t)m * D, F.g_mpre, HN + (size_t)m * D, F.lane);
#endif
#if I8_DENSE || I8_PROJ
    p0_i8_weights(F);
#endif
}

__device__ __forceinline__ unsigned ld_cnt(const unsigned* ctl, int e) { return __hip_atomic_load(ctl + CW_CNT + 64 * e, RLX_AGENT); }

__device__ __forceinline__ void ld_bf16_row(const bf16* row, int lane, f32x4 (&v)[4]) {
    const v2u* p = (const v2u*)row + lane;
#pragma unroll
    for (int j = 0; j < 4; ++j) { const v2u w = p[64 * j]; v[j] = (f32x4){bflo(w.x), bfhi(w.x), bflo(w.y), bfhi(w.y)}; }
}
__device__ __forceinline__ float sumsq16(const f32x4 (&v)[4]) {
    float s = 0.f;
#pragma unroll
    for (int j = 0; j < 4; ++j) s += (v[j].x * v[j].x + v[j].y * v[j].y) + (v[j].z * v[j].z + v[j].w * v[j].w);
    return s;
}
#define H16 FP8_MOE
struct NormRow { v2u a[4]; v2u b[4]; f32x4 hf[4]; v2u hb[4]; float g0, g1; };
template <bool FFN>
__device__ __forceinline__ void norm_phase(Frame& F0, int l) {
    Frame F = F0; { int t_ = threadIdx.x; asm volatile("" : "+v"(t_)); F.tid = t_; F.lane = t_ & 63; F.wave = __builtin_amdgcn_readfirstlane(t_ >> 6); }
    const int lane = F.lane, gw = F.bid * 8 + F.wave, NGW = F.G * 8;
    const bool moe = (l & 1) != 0;
    LAS float* WR = (LAS float*)F.lds;
    LAS unsigned* lcnt = (LAS unsigned*)(F.lds + LCNT_OFF); LAS unsigned* lbase = lcnt + 8;
    LAS int* bst = (LAS int*)(F.lds + BST_OFF);
    LAS float* rowbuf = (LAS float*)(F.lds + 32768 + F.wave * 4352);
    if (!FFN && moe) {
        for (int i = F.tid; i < D * NE; i += 512) { const int d = i >> 3, e = i & 7; WR[e * D + d] = F.router[i]; }
        if (F.tid < 8) lcnt[F.tid] = 0u;
        __syncthreads();
    }
    if (FFN && moe) {
        if (F.tid == 0) { int s = 0; for (int e = 0; e < NE; ++e) { bst[e] = s; s += (int)((ld_cnt(F.ctl, e) + 255u) >> 8); } }
        __syncthreads();
    }
    const float* gA = FFN ? F.g_fpost + l * D : F.g_mpost + l * D;
    const float* gB = FFN ? F.g_mpre + (l + 1) * D : F.g_fpre + l * D;
    const bool haveB = FFN ? (l + 1 < DEPTH) : true;
    const bool last = FFN && (l + 1 == DEPTH);
    const bool I8HN = FFN ? (I8_PROJ != 0) : (I8_DENSE && !moe);
    const bool hold_f32 = (!FFN && l == 0) || !H16;
    const bf16* addsrc = FFN ? (const bf16*)(F.ws + WS_Y) : (const bf16*)(F.ws + WS_MIX);
    const float* hold32 = (!FFN && l == 0) ? F.x : F.out;
    bf16* H = (bf16*)(F.ws + WS_H16);
    bf16* HN = (bf16*)(F.ws + WS_HN);
    const v2u* info = (const v2u*)(F.ws + WS_INFO); const f32x2* ginfo = (const f32x2*)(F.ws + WS_INFO + 256 * 1024);
#define NORM_LOAD(R, m_, nf_, gg_) do { \
        if (FFN && moe) { const int e0_ = (int)((nf_).x >> 16), p0_ = (int)((nf_).x & 0xffffu), e1_ = (int)((nf_).y >> 16), p1_ = (int)((nf_).y & 0xffffu); \
            const v2u* pa_ = (const v2u*)(addsrc + (size_t)(256 * bst[e0_] + p0_) * D) + lane; const v2u* pb_ = (const v2u*)(addsrc + (size_t)(256 * bst[e1_] + p1_) * D) + lane; \
            _Pragma("unroll") for (int j = 0; j < 4; ++j) { (R).a[j] = pa_[64 * j]; (R).b[j] = pb_[64 * j]; } (R).g0 = (gg_).x; (R).g1 = (gg_).y; } \
        else { const v2u* pa_ = (const v2u*)(addsrc + (size_t)(m_) * D) + lane; _Pragma("unroll") for (int j = 0; j < 4; ++j) (R).a[j] = pa_[64 * j]; } \
        if (hold_f32) { const f32x4* hp_ = (const f32x4*)(hold32 + (size_t)(m_) * D) + lane; _Pragma("unroll") for (int j = 0; j < 4; ++j) (R).hf[j] = hp_[64 * j]; } \
        else { const v2u* hp_ = (const v2u*)(H + (size_t)(m_) * D) + lane; _Pragma("unroll") for (int j = 0; j < 4; ++j) (R).hb[j] = hp_[64 * j]; } } while (0)
    int sTok = 0, sE0 = 0, sE1 = 0; float sG0 = 0.f, sG1 = 0.f;
    v2u nfL = (v2u){0u, 0u}; f32x2 ggL = (f32x2){0.f, 0.f};
    if (FFN && moe) { const int mi = gw + lane * NGW; if (mi < T) { nfL = info[mi]; ggL = ginfo[mi]; } }
    const int nfLx = (int)nfL.x, nfLy = (int)nfL.y; const float ggLx_ = ggL.x, ggLy_ = ggL.y; const int ggLx = __float_as_int(ggLx_), ggLy = __float_as_int(ggLy_);
#define NORM_INFO(nf_, gg_, it_) do { if (FFN && moe) { const int x_ = __builtin_amdgcn_readlane(nfLx, it_), y_ = __builtin_amdgcn_readlane(nfLy, it_), gx_ = __builtin_amdgcn_readlane(ggLx, it_), gy_ = __builtin_amdgcn_readlane(ggLy, it_); \
        (nf_).x = (unsigned)x_; (nf_).y = (unsigned)y_; (gg_).x = __int_as_float(gx_); (gg_).y = __int_as_float(gy_); } } while (0)
#define NORM_ROW(R, m_, it_) do { \
        f32x4 a[4]; \
        _Pragma("unroll") for (int j = 0; j < 4; ++j) { a[j] = (f32x4){bflo((R).a[j].x), bfhi((R).a[j].x), bflo((R).a[j].y), bfhi((R).a[j].y)}; \
            if (FFN && moe) { const f32x4 b = (f32x4){bflo((R).b[j].x), bfhi((R).b[j].x), bflo((R).b[j].y), bfhi((R).b[j].y)}; a[j] = a[j] * (R).g0 + b * (R).g1; } } \
        const float r1 = 1.0f / sqrtf(wave_sum(sumsq16(a)) * (1.f / D) + RMS_EPS); \
        const f32x4* gAp = (const f32x4*)gA + lane; \
        f32x4 h[4]; \
        _Pragma("unroll") for (int j = 0; j < 4; ++j) { const f32x4 ho = hold_f32 ? (R).hf[j] : (f32x4){bflo((R).hb[j].x), bfhi((R).hb[j].x), bflo((R).hb[j].y), bfhi((R).hb[j].y)}; h[j] = ho + a[j] * r1 * gAp[64 * j]; } \
        if (last || !H16) { f32x4* op = (f32x4*)(F.out + (size_t)(m_) * D) + lane; _Pragma("unroll") for (int j = 0; j < 4; ++j) op[64 * j] = h[j]; } \
        else { v2u* op = (v2u*)(H + (size_t)(m_) * D) + lane; _Pragma("unroll") for (int j = 0; j < 4; ++j) { v2u w; w.x = cvt_pk_bf16(h[j].x, h[j].y); w.y = cvt_pk_bf16(h[j].z, h[j].w); op[64 * j] = w; } } \
        if (haveB) { \
            const float r2 = 1.0f / sqrtf(wave_sum(sumsq16(h)) * (1.f / D) + RMS_EPS); \
            const f32x4* gBp = (const f32x4*)gB + lane; v2u* o8 = (v2u*)(HN + (size_t)(m_) * D) + lane; \
            _Pragma("unroll") for (int j = 0; j < 4; ++j) { h[j] = h[j] * r2 * gBp[64 * j]; \
                if (FP8_MOE && FP6_UP && !FFN && moe) { const int e_ = 256 * j + 4 * lane, ix_ = e_ + (e_ >> 5); rowbuf[ix_] = h[j].x * S6A; rowbuf[ix_ + 1] = h[j].y * S6A; rowbuf[ix_ + 2] = h[j].z * S6A; rowbuf[ix_ + 3] = h[j].w * S6A; } \
                else if (FP8_MOE && !FFN && moe) { int w = 0; w = __builtin_amdgcn_cvt_pk_fp8_f32(h[j].x, h[j].y, w, false); w = __builtin_amdgcn_cvt_pk_fp8_f32(h[j].z, h[j].w, w, true); ((unsigned*)((unsigned char*)HN + (size_t)(m_) * D) + lane)[64 * j] = (unsigned)w; } \
                else if (!I8HN) { v2u w; w.x = cvt_pk_bf16(h[j].x, h[j].y); w.y = cvt_pk_bf16(h[j].z, h[j].w); o8[64 * j] = w; } } \
            if (FP8_MOE && FP6_UP && !FFN && moe) { asm volatile("s_waitcnt lgkmcnt(0)" ::: "memory"); \
                if (lane < 32) { f32x16 x_, y_; _Pragma("unroll") for (int i = 0; i < 16; ++i) { x_[i] = rowbuf[33 * lane + i]; y_[i] = rowbuf[33 * lane + 16 + i]; } \
                    const i32x6 o_ = __builtin_amdgcn_cvt_scalef32_2xpk16_fp6_f32(x_, y_, 1.0f); unsigned char* rp_ = (unsigned char*)HN + (size_t)(m_) * D + 128 * (lane >> 2); \
                    *(v4u*)(rp_ + 16 * (lane & 3)) = (v4u){(unsigned)o_[0], (unsigned)o_[1], (unsigned)o_[2], (unsigned)o_[3]}; *(v4u*)(rp_ + 64 + 16 * (lane & 3)) = (v4u){(unsigned)o_[4], (unsigned)o_[5], 0u, 0u}; } \
                asm volatile("s_waitcnt lgkmcnt(0)" ::: "memory"); } \
            if (I8HN) { float am = 0.f; \
                _Pragma("unroll") for (int j = 0; j < 4; ++j) am = fmaxf(fmaxf(am, fmaxf(fabsf(h[j].x), fabsf(h[j].y))), fmaxf(fabsf(h[j].z), fabsf(h[j].w))); \
                am = wave_max(am); const float sa_ = am > 0.f ? am * (1.0f / 127.0f) : 1.0f, inv_ = am > 0.f ? 127.0f / am : 0.f; \
                _Pragma("unroll") for (int j = 0; j < 4; ++j) { const unsigned w = ((unsigned)__float2int_rn(h[j].x * inv_) & 0xffu) | (((unsigned)__float2int_rn(h[j].y * inv_) & 0xffu) << 8) | (((unsigned)__float2int_rn(h[j].z * inv_) & 0xffu) << 16) | (((unsigned)__float2int_rn(h[j].w * inv_) & 0xffu) << 24); \
                    ((unsigned*)((unsigned char*)HN + (size_t)(m_) * D) + lane)[64 * j] = w; } \
                if (lane == 0) ((float*)(F.ws + WS_SA))[(m_)] = sa_; } \
            if (!FFN && moe) { \
                float lg[NE]; \
                _Pragma("unroll") for (int e = 0; e < NE; ++e) { float s_ = 0.f; \
                    _Pragma("unroll") for (int j = 0; j < 4; ++j) { const f32x4 w = *(const LAS f32x4*)(WR + e * D + 256 * j + 4 * lane); s_ += (h[j].x * w.x + h[j].y * w.y) + (h[j].z * w.z + h[j].w * w.w); } \
                    lg[e] = wave_sum(s_); } \
                int e0 = 0; float l0 = lg[0]; \
                _Pragma("unroll") for (int e = 1; e < NE; ++e) if (lg[e] > l0) { l0 = lg[e]; e0 = e; } \
                int e1 = -1; float l1 = -INFINITY; \
                _Pragma("unroll") for (int e = 0; e < NE; ++e) if (e != e0 && lg[e] > l1) { l1 = lg[e]; e1 = e; } \
                const float g0 = 1.0f / (1.0f + __expf(l1 - l0)), g1 = 1.0f - g0; \
                if (lane == (it_)) { sTok = (m_); sE0 = e0; sE1 = e1; sG0 = g0; sG1 = g1; } \
            } \
        } } while (0)
    int it = 0;
    NormRow c0, c1; v2u nf = (v2u){0u, 0u}; f32x2 gg = (f32x2){0.f, 0.f};
    if (gw < T) { NORM_INFO(nf, gg, 0); NORM_LOAD(c0, gw, nf, gg); }
    if (gw + NGW < T) { NORM_INFO(nf, gg, 1); NORM_LOAD(c1, gw + NGW, nf, gg); }
    for (int m = gw; m < T; m += 2 * NGW, it += 2) {
        const int m1 = m + NGW, m2 = m + 2 * NGW, m3 = m + 3 * NGW;
        NormRow n0, n1;
        if (m2 < T) { NORM_INFO(nf, gg, it + 2); NORM_LOAD(n0, m2, nf, gg); }
        if (m3 < T) { NORM_INFO(nf, gg, it + 3); NORM_LOAD(n1, m3, nf, gg); }
        NORM_ROW(c0, m, it);
        if (m1 < T) NORM_ROW(c1, m1, it + 1);
        c0 = n0; c1 = n1;
    }
    it = (T - gw + NGW - 1) / NGW; if (it < 0) it = 0;
#undef NORM_ROW
#undef NORM_INFO
#undef NORM_LOAD
    if (!FFN && moe) {
        unsigned loc0 = 0u, loc1 = 0u;
        if (lane < it) { loc0 = __hip_atomic_fetch_add(lcnt + sE0, 1u, __ATOMIC_RELAXED, __HIP_MEMORY_SCOPE_WORKGROUP); loc1 = __hip_atomic_fetch_add(lcnt + sE1, 1u, __ATOMIC_RELAXED, __HIP_MEMORY_SCOPE_WORKGROUP); }
        __syncthreads();
        if (F.tid < 8) lbase[F.tid] = __hip_atomic_fetch_add(F.ctl + CW_CNT + 64 * F.tid, lcnt[F.tid], RLX_AGENT);
        __syncthreads();
        if (lane < it) {
            const unsigned p0 = lbase[sE0] + loc0, p1 = lbase[sE1] + loc1;
            int* list = (int*)(F.ws + WS_LIST);
            list[(size_t)sE0 * T + p0] = sTok; list[(size_t)sE1 * T + p1] = sTok;
            v2u nf; nf.x = ((unsigned)sE0 << 16) | p0; nf.y = ((unsigned)sE1 << 16) | p1;
            ((v2u*)(F.ws + WS_INFO))[sTok] = nf; ((f32x2*)(F.ws + WS_INFO + 256 * 1024))[sTok] = (f32x2){sG0, sG1};
        }
    }
}

__device__ __forceinline__ size_t mixo_index(size_t tok, int ch) { return ((tok >> 8) * 16 + (size_t)(ch >> 6)) * (256 * 64) + (tok & 255) * 64 + (ch & 63); }
constexpr int U_PITCH = 1040, U_ROWS = 80, BIAS_OFF = U_PITCH * U_ROWS;
typedef __bf16 bf16x2_t __attribute__((ext_vector_type(2)));
template <int HW>
__device__ __forceinline__ void pool_frags(bf16x8 (&dfr)[2][4], const LAS unsigned char* cb, const float (&inv)[2]) {
    unsigned one_lo_ = 0x00003f80u, one_hi_ = 0x3f800000u; asm volatile("" : "+v"(one_lo_), "+v"(one_hi_));
    const bf16x2_t ONE_LO = __builtin_bit_cast(bf16x2_t, one_lo_), ONE_HI = __builtin_bit_cast(bf16x2_t, one_hi_);
#pragma unroll
    for (int mt = 0; mt < 2; ++mt)
#pragma unroll
        for (int ks = 0; ks < 4; ++ks) {
            const LAS unsigned char* cp = cb + mt * 16 * U_PITCH + ks * 64;
            float s0 = 0.f, s1 = 0.f, s2 = 0.f, s3 = 0.f, s4 = 0.f, s5 = 0.f, s6 = 0.f, s7 = 0.f;
#pragma unroll
            for (int d = -HW; d < HW; ++d) { const v4u v = *(const LAS v4u*)(cp + d * U_PITCH); const unsigned vx = v.x, vy = v.y, vz = v.z, vw = v.w;
                const bf16x2_t px = __builtin_bit_cast(bf16x2_t, vx), py = __builtin_bit_cast(bf16x2_t, vy), pz = __builtin_bit_cast(bf16x2_t, vz), pw = __builtin_bit_cast(bf16x2_t, vw);
                s0 = __builtin_amdgcn_fdot2_f32_bf16(px, ONE_LO, s0, false); s1 = __builtin_amdgcn_fdot2_f32_bf16(px, ONE_HI, s1, false);
                s2 = __builtin_amdgcn_fdot2_f32_bf16(py, ONE_LO, s2, false); s3 = __builtin_amdgcn_fdot2_f32_bf16(py, ONE_HI, s3, false);
                s4 = __builtin_amdgcn_fdot2_f32_bf16(pz, ONE_LO, s4, false); s5 = __builtin_amdgcn_fdot2_f32_bf16(pz, ONE_HI, s5, false);
                s6 = __builtin_amdgcn_fdot2_f32_bf16(pw, ONE_LO, s6, false); s7 = __builtin_amdgcn_fdot2_f32_bf16(pw, ONE_HI, s7, false); }
            const v4u c = *(const LAS v4u*)cp; const float iv = inv[mt];
            v4u p; p.x = cvt_pk_bf16(s0 * iv - bflo(c.x), s1 * iv - bfhi(c.x)); p.y = cvt_pk_bf16(s2 * iv - bflo(c.y), s3 * iv - bfhi(c.y));
            p.z = cvt_pk_bf16(s4 * iv - bflo(c.z), s5 * iv - bfhi(c.z)); p.w = cvt_pk_bf16(s6 * iv - bflo(c.w), s7 * iv - bfhi(c.w));
            dfr[mt][ks] = __builtin_bit_cast(bf16x8, p);
        }
}
__device__ __forceinline__ void mixer_phase(Frame& F0, int l) {
    Frame F = F0; { int t_ = threadIdx.x; asm volatile("" : "+v"(t_)); F.tid = t_; F.lane = t_ & 63; F.wave = __builtin_amdgcn_readfirstlane(t_ >> 6); }
    const int tid = F.tid, lane = F.lane, wid = F.wave, fr = lane & 15, fq = lane >> 4;
    const bf16* proj = (const bf16*)(F.ws + WS_PROJ); bf16* mixo = (bf16*)(F.ws + WS_MIXO);
    const bf16* Wp = (const bf16*)(F.ws + WS_WP) + (size_t)l * 4 * 128 * 128; const float* pscale = F.pool_scale + l * DPOOL;
    const int vcu = (F.G % 8 == 0) ? (F.bid % 8) * (F.G / 8) + F.bid / 8 : F.bid;
    for (int unit = vcu; unit < BATCH * GROWS; unit += F.G) {
        const int b = unit / GROWS, r = unit % GROWS, tb0 = b * SEQ, trow0 = 64 * r - 8;
        __syncthreads();
        { v4u uv[10];
#pragma unroll
          for (int k = 0; k < 10; ++k) { const int idx = tid + 512 * k, row = idx >> 6, pc = idx & 63, t = trow0 + row; uv[k] = (v4u){0u, 0u, 0u, 0u}; if (t >= 0 && t < SEQ) uv[k] = *(const v4u*)(proj + (size_t)(tb0 + t) * UPITCH + pc * 8); }
#pragma unroll
          for (int k = 0; k < 10; ++k) { const int idx = tid + 512 * k, row = idx >> 6, pc = idx & 63; *(LAS v4u*)(F.lds + row * U_PITCH + pc * 16) = uv[k]; } }
        __syncthreads();
#ifndef REP_POOL
#define REP_POOL 1
#endif
        for (int rep_ = 0; rep_ < REP_POOL; ++rep_) {
            const int g = wid >> 1, half = wid & 1, hw = 1 << g;
            const bf16* Wg = Wp + (size_t)g * 128 * 128;
            bf16x8 wnext[4];
#pragma unroll
            for (int ks = 0; ks < 4; ++ks) wnext[ks] = *(const bf16x8*)(Wg + (size_t)fr * 128 + 32 * ks + 8 * fq);
            bf16x8 dfr[2][4];
            { const LAS unsigned char* cb = F.lds + (8 + 32 * half + fr) * U_PITCH + (128 * g + 8 * fq) * 2;
              float inv[2];
#pragma unroll
              for (int mt = 0; mt < 2; ++mt) { const int t = 64 * r + 32 * half + 16 * mt + fr; inv[mt] = 1.0f / (float)(min(t + hw, SEQ) - max(t - hw, 0)); }
              switch (g) { case 0: pool_frags<1>(dfr, cb, inv); break; case 1: pool_frags<2>(dfr, cb, inv); break; case 2: pool_frags<4>(dfr, cb, inv); break; default: pool_frags<8>(dfr, cb, inv); break; } }
#pragma unroll
            for (int nt = 0; nt < 8; ++nt) {
                bf16x8 wf[4];
#pragma unroll
                for (int ks = 0; ks < 4; ++ks) wf[ks] = wnext[ks];
                if (nt + 1 < 8) {
#pragma unroll
                    for (int ks = 0; ks < 4; ++ks) wnext[ks] = *(const bf16x8*)(Wg + (size_t)(16 * (nt + 1) + fr) * 128 + 32 * ks + 8 * fq); }
                const f32x4 sc = *(const f32x4*)(pscale + 128 * g + 16 * nt + 4 * fq);
#pragma unroll
                for (int mt = 0; mt < 2; ++mt) {
                    f32x4 acc = (f32x4){0.f, 0.f, 0.f, 0.f};
#pragma unroll
                    for (int ks = 0; ks < 4; ++ks) acc = __builtin_amdgcn_mfma_f32_16x16x32_bf16(wf[ks], dfr[mt][ks], acc, 0, 0, 0);
                    acc = acc * sc;
                    v2u w; w.x = cvt_pk_bf16(acc[0], acc[1]); w.y = cvt_pk_bf16(acc[2], acc[3]);
                    *(v2u*)(mixo + mixo_index((size_t)(tb0 + 64 * r + 32 * half + 16 * mt + fr), 128 * g + 16 * nt + 4 * fq)) = w;
                }
            }
        }
    }
    __syncthreads();
}

constexpr int NA_KTOK = 80, NA_KROW = 64 * NA_KTOK, NA_VD = 144, NA_VROW = 32 * NA_VD, NA_NKR = 11, NA_NPC = NA_NKR * 256;
constexpr int NA_K_OFF = 0, NA_V_OFF = NA_NKR * NA_KROW, NA_B_OFF = NA_V_OFF + NA_NKR * NA_VROW;
static_assert(NA_B_OFF + 15 * 128 <= RING_BYTES, "NA LDS map");
#ifndef REP_NA
#define REP_NA 1
#endif
__device__ __forceinline__ void na_phase(Frame& F0, int l) {
    Frame F = F0; { int t_ = threadIdx.x; asm volatile("" : "+v"(t_)); F.tid = t_; F.lane = t_ & 63; F.wave = __builtin_amdgcn_readfirstlane(t_ >> 6); }
    const int tid = F.tid, lane = F.lane, wid = F.wave, fr = lane & 15, fq = lane >> 4;
    const bf16* projq = (const bf16*)(F.ws + WS_PQ); const bf16* projk = (const bf16*)(F.ws + WS_PK); const bf16* Vt = (const bf16*)(F.ws + WS_VT); bf16* mixo = (bf16*)(F.ws + WS_MIXO);
    const float* rpb = F.rpb + (size_t)l * NH * 15 * 31;
    const int vcu = (F.G % 8 == 0) ? (F.bid % 8) * (F.G / 8) + F.bid / 8 : F.bid;
    constexpr int NU = BATCH * NH * (GROWS / 4);
    const int upc = (NU + F.G - 1) / F.G, u0 = vcu * upc, u1 = min(u0 + upc, NU);
    v4u kreg[6], vreg[6];
    int w_hi = -1, w_bh = -1;
#define NA_UNIT(u, b, h, sg, krlo, nrows) const int b = (u) / (NH * 64), h = ((u) / 64) % NH, sg = (u) % 64, krlo = min(max(4 * sg - 4, 0), GROWS - KH), nrows = min(NA_NKR, GROWS - krlo)
#define NA_PLAN(u, newlo, nnew) NA_UNIT(u, pb_, ph_, psg_, pkrlo_, pnrows_); const bool keep_ = ((u) / 64 == w_bh) && pkrlo_ <= w_hi && pkrlo_ + NA_NKR > w_hi - 1; \
        const int newlo = keep_ ? max(pkrlo_, w_hi) : pkrlo_, nnew = pkrlo_ + pnrows_ - newlo; (void)psg_
#define NA_LOAD(newlo, nnew, b_, h_) do { const size_t tb_ = (size_t)(b_) * SEQ + 64 * (newlo); \
        _Pragma("unroll") for (int k = 0; k < 6; ++k) { const int p = tid + 512 * k, row = p >> 8, rem = p & 255; \
            if (row < (nnew)) { kreg[k] = *(const v4u*)(projk + ((size_t)(h_) * T + tb_ + 64 * row + (rem >> 2)) * 32 + 8 * (rem & 3)); \
                vreg[k] = *(const v4u*)(Vt + vt_index(32 * (h_) + (rem >> 3), (int)tb_ + 64 * row) + 8 * (rem & 7)); } } } while (0)
    int c_newlo = 0, c_nnew = 0;
    if (u0 < u1) { NA_PLAN(u0, nl_, nn_); c_newlo = nl_; c_nnew = nn_; NA_LOAD(nl_, nn_, pb_, ph_); }
    for (int u = u0; u < u1; ++u) {
        NA_UNIT(u, b, h, sg, krlo, nrows);
        __syncthreads();
#pragma unroll
        for (int k = 0; k < 6; ++k) { const int p = tid + 512 * k, row = p >> 8, rem = p & 255;
            if (row < c_nnew) { const int slot = (c_newlo + row) % NA_NKR;
                *(LAS v4u*)(F.lds + NA_K_OFF + slot * NA_KROW + (rem >> 2) * NA_KTOK + 16 * (rem & 3)) = kreg[k];
                *(LAS v4u*)(F.lds + NA_V_OFF + slot * NA_VROW + (rem >> 3) * NA_VD + 16 * (rem & 7)) = vreg[k]; } }
        if (tid < 15 * 32) { const int col = tid & 31, row = tid >> 5; *(LAS float*)(F.lds + NA_B_OFF + tid * 4) = col < 31 ? rpb[(h * 15 + row) * 31 + col] * LOG2E : -INFINITY; }
        __syncthreads();
        w_hi = krlo + nrows; w_bh = u / 64;
        if (u + 1 < u1) { NA_PLAN(u + 1, nl_, nn_); c_newlo = nl_; c_nnew = nn_; NA_LOAD(nl_, nn_, pb_, ph_); }
        const size_t tb0 = (size_t)b * SEQ;
#pragma unroll 1
        for (int tt = 0; tt < 2; ++tt) {
            const int t = wid + 8 * tt, j = t >> 2, qb = t & 3, r = 4 * sg + j, r0 = min(max(r - KH / 2, 0), GROWS - KH);
            const int cs = qb == 0 ? 0 : (qb == 1 ? 8 : (qb == 2 ? 24 : 32));
            const int c = 16 * qb + fr, c0 = min(max(c - KW / 2, 0), GRIDW - KW);
            const int th = c0 - cs;
            bool vq[4]; int boff[4];
#pragma unroll
            for (int q = 0; q < 4; ++q) { vq[q] = (4 * fq + q) >= th; boff[q] = (cs + 4 * fq + q + (vq[q] ? 0 : 16) - c + KW - 1) * 4; }
            const unsigned M0 = (vq[0] ? 0xffffu : 0u) | (vq[1] ? 0xffff0000u : 0u), M1 = (vq[2] ? 0xffffu : 0u) | (vq[3] ? 0xffff0000u : 0u), N0 = ~M0, N1 = ~M1;
            const size_t qtok = tb0 + 64 * r + 16 * qb + fr;
            const bf16x8 qf = *(const bf16x8*)(projq + ((size_t)h * T + qtok) * 32 + 8 * fq);
            int slot[KH];
#pragma unroll
            for (int kr = 0; kr < KH; ++kr) slot[kr] = (r0 + kr) % NA_NKR;
            const LAS unsigned char* kb = F.lds + NA_K_OFF + (cs + fr) * NA_KTOK + 16 * fq;
            const LAS unsigned char* bb = F.lds + NA_B_OFF + (r0 - r + KH - 1) * 128;
            f32x2 sv[KH][2];
            float mx = -INFINITY;
#pragma unroll
            for (int kr = 0; kr < KH; ++kr) {
                f32x4 bv;
#pragma unroll
                for (int q = 0; q < 4; ++q) bv[q] = *(const LAS float*)(bb + boff[q] + kr * 128);
                const f32x4 s0 = __builtin_amdgcn_mfma_f32_16x16x32_bf16(*(const LAS bf16x8*)(kb + slot[kr] * NA_KROW), qf, bv, 0, 0, 0);
                const f32x4 s1 = __builtin_amdgcn_mfma_f32_16x16x32_bf16(*(const LAS bf16x8*)(kb + slot[kr] * NA_KROW + 16 * NA_KTOK), qf, bv, 0, 0, 0);
                const float e0 = vq[0] ? s0[0] : s1[0], e1 = vq[1] ? s0[1] : s1[1], e2 = vq[2] ? s0[2] : s1[2], e3 = vq[3] ? s0[3] : s1[3];
                sv[kr][0] = (f32x2){e0, e1}; sv[kr][1] = (f32x2){e2, e3};
                mx = fmaxf(fmaxf(mx, e0), e1); mx = fmaxf(fmaxf(mx, e2), e3);
            }
            mx = fmaxf(mx, __shfl_xor(mx, 16)); mx = fmaxf(mx, __shfl_xor(mx, 32));
            const f32x2 mx2 = (f32x2){mx, mx};
            f32x2 sum2 = (f32x2){0.f, 0.f};
#pragma unroll
            for (int kr = 0; kr < KH; ++kr)
#pragma unroll
                for (int hh = 0; hh < 2; ++hh) { const f32x2 dlt = sv[kr][hh] - mx2; f32x2 p; p.x = __builtin_amdgcn_exp2f(dlt.x); p.y = __builtin_amdgcn_exp2f(dlt.y); sv[kr][hh] = p; sum2 += p; }
            float sum = sum2.x + sum2.y;
            sum += __shfl_xor(sum, 16); sum += __shfl_xor(sum, 32);
            const LAS unsigned char* vb = F.lds + NA_V_OFF + fr * NA_VD + (cs + 4 * fq) * 2;
            f32x4 o[2] = {(f32x4){0.f, 0.f, 0.f, 0.f}, (f32x4){0.f, 0.f, 0.f, 0.f}};
#pragma unroll
            for (int kr = 0; kr < KH; ++kr) {
                const unsigned u01 = cvt_pk_bf16(sv[kr][0].x, sv[kr][0].y), u23 = cvt_pk_bf16(sv[kr][1].x, sv[kr][1].y);
                v4u pw; pw.x = u01 & M0; pw.y = u23 & M1; pw.z = u01 & N0; pw.w = u23 & N1;
                const bf16x8 pf = __builtin_bit_cast(bf16x8, pw);
#pragma unroll
                for (int dt = 0; dt < 2; ++dt) {
                    const LAS unsigned char* vp = vb + slot[kr] * NA_VROW + 16 * dt * NA_VD;
                    const v2u lo = *(const LAS v2u*)vp, hi = *(const LAS v2u*)(vp + 32);
                    v4u vw; vw.x = lo.x; vw.y = lo.y; vw.z = hi.x; vw.w = hi.y;
                    o[dt] = __builtin_amdgcn_mfma_f32_16x16x32_bf16(__builtin_bit_cast(bf16x8, vw), pf, o[dt], 0, 0, 0);
                }
            }
            const float inv = __builtin_amdgcn_rcpf(sum);
            bf16* orow = mixo + mixo_index(qtok, DPOOL + 32 * h + 4 * fq);
#pragma unroll
            for (int dt = 0; dt < 2; ++dt) { v2u w; w.x = cvt_pk_bf16(o[dt][0] * inv, o[dt][1] * inv); w.y = cvt_pk_bf16(o[dt][2] * inv, o[dt][3] * inv); *(v2u*)(orow + 16 * dt) = w; }
        }
    }
    __syncthreads();
#undef NA_UNIT
#undef NA_PLAN
#undef NA_LOAD
}

struct SchedProj {
    const char* hn; const char* win; bf16* proj; bf16* vt; int G, c, esz; const float* sa; const float* sw;
    __device__ __forceinline__ bool next(int i, pg8::Unit& u) const {
        int pm, pn; if (!pg8::tile_order(i, G, c, T / 256, 8, pm, pn)) return false;
        const size_t tstep = (size_t)256 * D * esz;
        if (pn < 6) { u.A = hn + pm * tstep; u.B = win + pn * tstep; u.orow = 256 * pm;
            if (pn < 2) { u.obase = proj; u.ocol = 256 * pn; u.ldc = UPITCH; } else { u.obase = proj + (size_t)(pn >> 1) * T * 512; u.ocol = 256 * (pn & 1); u.ldc = 0; }
            u.scale = (pn == 2 || pn == 3) ? QSCALE : 1.0f; u.p0 = sa + 256 * pm; u.cs = sw + 256 * pn; }
        else { u.A = win + pn * tstep; u.B = hn + pm * tstep; u.obase = vt; u.orow = 256 * (pn - 6); u.ocol = 256 * pm; u.ldc = -1; u.scale = 1.0f; u.p0 = sw + 256 * pn; u.cs = sa + 256 * pm; }
        return true;
    }
};
struct SchedOut {
    const char* a; const char* w; bf16* o; int G, c;
    __device__ __forceinline__ bool next(int i, pg8::Unit& u) const {
        int pm, pn; if (!pg8::tile_order(i, G, c, T / 256, 4, pm, pn)) return false;
        const size_t tstep = (size_t)256 * D * 2; u.p0 = nullptr; u.cs = nullptr;
        u.A = a + pm * tstep; u.B = w + pn * tstep; u.obase = o; u.orow = 256 * pm; u.ocol = 256 * pn; u.ldc = D; u.scale = 1.0f; return true;
    }
};
__device__ __forceinline__ void ffn_table(Frame& F0, bool moe) {
    Frame F = F0; { int t_ = threadIdx.x; asm volatile("" : "+v"(t_)); F.tid = t_; F.lane = t_ & 63; F.wave = __builtin_amdgcn_readfirstlane(t_ >> 6); }
    LAS int* blk = (LAS int*)(F.lds + BLK_OFF); LAS int* bst = (LAS int*)(F.lds + BST_OFF);
    __syncthreads();
    if (F.tid == 0) { int s = 0; for (int e = 0; e < NE; ++e) { bst[e] = s; s += moe ? (int)((ld_cnt(F.ctl, e) + 255u) >> 8) : (e == 0 ? T / 256 : 0); } bst[8] = s; }
    __syncthreads();
    for (int b = F.tid; b < MAXBLK + 8; b += 512) { int e = 0; for (int k = 1; k < NE; ++k) if (b >= bst[k]) e = k; blk[b] = e; }
    __syncthreads();
}
__device__ __forceinline__ bool tail_reduce(Frame& F0) {
    int t_ = threadIdx.x; asm volatile("" : "+v"(t_));
    const int lane = t_ & 63, gw = F0.bid * 8 + __builtin_amdgcn_readfirstlane(t_ >> 6), NGW = F0.G * 8;
    int nb = 0;
    for (int e = 0; e < NE; ++e) nb += (int)((ld_cnt(F0.ctl, e) + 255u) >> 8);
    const int nrows = (nb - 256) * 256;
    if (nrows <= 0) return false;
    bf16* y = (bf16*)(F0.ws + WS_Y) + (size_t)256 * 256 * D; const bf16* part = (const bf16*)(F0.ws + WS_TAILPART);
    for (int r = gw; r < nrows; r += NGW) {
        v4u w[TAILSPLIT][2];
#pragma unroll
        for (int h = 0; h < 2; ++h) { w[0][h] = *((const v4u*)(y + (size_t)r * D) + lane + 64 * h);
#pragma unroll
            for (int p = 1; p < TAILSPLIT; ++p) w[p][h] = *((const v4u*)(part + ((size_t)(p - 1) * TAILPART_ROWS + r) * D) + lane + 64 * h); }
#pragma unroll
        for (int h = 0; h < 2; ++h) { v4u o;
#pragma unroll
            for (int j = 0; j < 4; ++j) { float lo = 0.f, hi = 0.f;
#pragma unroll
                for (int p = 0; p < TAILSPLIT; ++p) { lo += bflo(w[p][h][j]); hi += bfhi(w[p][h][j]); }
                o[j] = cvt_pk_bf16(lo, hi); }
            *((v4u*)(y + (size_t)r * D) + lane + 64 * h) = o; }
    }
    return true;
}
template <bool TILED> struct SchedUpT {
    const char* hn; const char* wgu; const int* lists; bf16* hff; LAS int* blk; LAS int* bst; int G, c, cstart, nblk, nN, F_, moe, esz;
    __device__ __forceinline__ bool next(int i, pg8::Unit& u) const {
        int pm, pn; if (!pg8::tile_order(i, G, c, nblk, nN, pm, pn)) return false;
        const int b = cstart + pm, e = __builtin_amdgcn_readfirstlane(blk[b]), lb = b - __builtin_amdgcn_readfirstlane(bst[e]);
        u.A = hn; u.p0 = lists + (moe ? (size_t)e * T + 256 * lb : (size_t)256 * b); u.cs = nullptr;
        u.B = wgu + ((size_t)e * 2 * F_ + 256 * pn) * D * esz; u.obase = hff; u.orow = 256 * pm; u.ocol = 128 * pn; u.ldc = F_; u.scale = 1.0f;
        if constexpr (TILED) { u.obase = (bf16*)((char*)hff + ((size_t)pm * nN + pn) * HFF_TILE - 128 * pn - (size_t)256 * pm * 128); }
        return true;
    }
};
template <bool TILED> struct SchedDownT {
    const char* hff; const char* wd; bf16* y; LAS int* blk; int G, c, cstart, nblk, F_, esz; float scale; const int* idl; int pm0, split;
    __device__ __forceinline__ bool next(int i, pg8::Unit& u) const {
        int pm, pn; if (!pg8::tile_order(i, G, c, nblk, 4 * split, pm, pn)) return false;
        const int p = pn >> 2; pn &= 3;
        const int b = cstart + pm, e = __builtin_amdgcn_readfirstlane(blk[b]); u.p0 = idl; u.cs = nullptr;
        const size_t koff = (size_t)p * (F_ / split) * esz;
        u.A = hff + (size_t)(pm0 + pm) * 256 * F_ * esz + (TILED ? (size_t)p * (F_ / split / 128) * HFF_TILE : koff); u.B = wd + ((size_t)e * D + 256 * pn) * F_ * esz + koff;
        const long long poff = p == 0 ? 0ll : ((long long)WS_TAILPART - (long long)WS_Y) / 2 + (long long)(p - 1) * TAILPART_ROWS * D;
        u.obase = y + poff; u.orow = p == 0 ? 256 * b : 256 * pm; u.ocol = 256 * pn; u.ldc = D; u.scale = scale; return true;
    }
};

constexpr int STEPS_PER_LAYER = 16, NSTEPS = 1 + DEPTH * STEPS_PER_LAYER;
#define RUN(s) (lo <= (s) && (s) < hi)
#ifndef BARX
#define BARX 1
#endif
#define SEAM(s) do { if (RUN(s) && RUN((s) + 1)) { for (int b_ = 0; b_ < BARX; ++b_) xcd_barrier(bar); } } while (0)
template <int L>
__device__ __forceinline__ void run_layer(Frame& F, const XcdBarrier& bar, const int lo, const int hi) {
    constexpr int l = L, base = 1 + STEPS_PER_LAYER * L; constexpr bool moe = (L & 1) != 0, f8 = FP8_MOE && moe, i8 = I8_DENSE && !moe; constexpr bool h8 = f8 || (FP8_DDOWN && !moe);
    LAS int* tokbuf = (LAS int*)(F.lds + TOKBUF_OFF); LAS int* blk = (LAS int*)(F.lds + BLK_OFF); LAS int* bst = (LAS int*)(F.lds + BST_OFF);
    const char* HN = (const char*)(F.ws + WS_HN);
#ifndef NO_P1
    if (RUN(base + 0)) {
        SchedProj S{HN, (const char*)(F.ws + WS_WIN) + (size_t)l * DIN * D * (I8_PROJ ? 1 : 2), (bf16*)(F.ws + WS_PROJ), (bf16*)(F.ws + WS_VT), F.G, F.bid, I8_PROJ ? 1 : 2, (const float*)(F.ws + WS_SA), (const float*)(F.ws + WS_SWIN) + l * DIN};
        if constexpr (I8_PROJ != 0) pg8::gemm_phase<pg8::EpiProj_I8, SchedProj, false, 2>(F.lds, tokbuf, D / 2, S, pg8::EpiProj_I8{});
        else pg8::gemm_phase<pg8::EpiProj, SchedProj, false>(F.lds, tokbuf, D, S, pg8::EpiProj{});
    } SEAM(base + 0);
#endif
#ifndef NO_P2
#ifndef NA_CALLS
#define NA_CALLS 1
#endif
#ifndef POOL_CALLS
#define POOL_CALLS 1
#endif
    if (RUN(base + 1)) { for (int i_ = 0; i_ < POOL_CALLS; ++i_) mixer_phase(F, l); for (int i_ = 0; i_ < NA_CALLS; ++i_) na_phase(F, l); } SEAM(base + 1);
#endif
#ifndef NO_P3
    if (RUN(base + 2)) {
        SchedOut S{(const char*)(F.ws + WS_MIXO), (const char*)(F.ws + WS_WOUT) + (size_t)l * D * D * 2, (bf16*)(F.ws + WS_MIX), F.G, F.bid};
        pg8::gemm_phase<pg8::EpiBf16, SchedOut, false>(F.lds, tokbuf, D, S, pg8::EpiBf16{}, D, 64, 256 * 128);
    } SEAM(base + 2);
#endif
#ifndef NO_P4
    if (RUN(base + 3)) { norm_phase<false>(F, l); } SEAM(base + 3);
#endif
    constexpr int F_ = moe ? DFFE : DFF, cblk = h8 ? 2 * CHUNK_BLK : CHUNK_BLK;
    bool table = false; int NB = 0;
    for (int c = 0; c < MAXCHUNK; ++c) {
        const int s5 = base + 4 + 2 * c, s6 = s5 + 1;
        if (!(RUN(s5) || RUN(s6))) continue;
        if (!table) { ffn_table(F, moe); NB = __builtin_amdgcn_readfirstlane(bst[8]); table = true; }
        const int cstart = c * cblk; int nblk = min(NB - cstart, cblk);
        if constexpr (f8) { if (c == 1) nblk = NB - cstart; else if (c > 1) continue; }
        if (nblk <= 0) continue;
#ifndef NO_P5
        if (RUN(s5)) {
            typedef SchedUpT<h8> SchedUp; SchedUp S{HN, moe ? (const char*)(F.ws + WS_WGUM) : (const char*)(F.ws + WS_WGU0), moe ? (const int*)(F.ws + WS_LIST) : (const int*)(F.ws + WS_LISTID), (bf16*)(F.ws + WS_HFF), blk, bst, F.G, F.bid, cstart, nblk, F_ / 128, F_, moe ? 1 : 0, (f8 || i8) ? 1 : 2};
            if constexpr (f8 && FP6_UP) pg8::gemm_phase<pg8::EpiSwiGLU6, SchedUp, true, 3>(F.lds, tokbuf, D / 2, S, pg8::EpiSwiGLU6{});
            else if constexpr (f8) pg8::gemm_phase<pg8::EpiSwiGLU8, SchedUp, true, 1>(F.lds, tokbuf, D / 2, S, pg8::EpiSwiGLU8{});
            else if constexpr (i8) pg8::gemm_phase<pg8::EpiSwiGLU_I8, SchedUp, true, 2>(F.lds, tokbuf, D / 2, S, pg8::EpiSwiGLU_I8{(const float*)(F.ws + WS_SA), (const float*)(F.ws + WS_SW0), (const int*)(F.ws + WS_LISTID)});
            else pg8::gemm_phase<pg8::EpiSwiGLU, SchedUp, true>(F.lds, tokbuf, D, S, pg8::EpiSwiGLU{});
        } SEAM(s5);
#endif
#ifndef NO_P6
        if (RUN(s6)) {
            const int nfull = h8 ? min(nblk, cblk) : nblk;
            typedef SchedDownT<h8> SchedDown; SchedDown S{(const char*)(F.ws + WS_HFF), moe ? (const char*)(F.ws + WS_WDM) : (const char*)(F.ws + WS_WD0), (bf16*)(F.ws + WS_Y), blk, F.G, F.bid, cstart, nfull, F_, h8 ? 1 : 2, h8 ? 1.0f / W8_DN : 1.0f, (const int*)(F.ws + WS_LISTID), 0, 1};
            if constexpr (h8) {
                const int npass = (f8 && nblk > nfull) ? 2 : 1;
#pragma clang loop unroll(disable)
                for (int pass = 0; pass < npass; ++pass) {
                    if (pass == 1) { S.cstart = cstart + nfull; S.nblk = nblk - nfull; S.pm0 = nfull; S.split = TAILSPLIT; }
                    pg8::gemm_phase<pg8::EpiBf16, SchedDown, true, 1>(F.lds, tokbuf, pass == 0 ? F_ / 2 : F_ / 2 / TAILSPLIT, S, pg8::EpiBf16{}, F_ / 2, 64, HFF_TILE);
                }
            }
            else pg8::gemm_phase<pg8::EpiBf16, SchedDown, false>(F.lds, tokbuf, F_, S, pg8::EpiBf16{});
        } SEAM(s6);
#endif
    }
#ifndef NO_P7
    if (RUN(base + 14)) { if constexpr (f8) { if (tail_reduce(F)) xcd_barrier(bar); } norm_phase<true>(F, l); }
#endif
    if (l + 1 < DEPTH) { if (RUN(base + 14) && RUN(base + 16)) xcd_barrier(bar); }
}
__global__ void __launch_bounds__(512, 2) mk_fwd(Args args) {
    extern __shared__ __attribute__((aligned(16))) unsigned char lds_raw[];
    Frame F;
    F.lds = (LAS unsigned char*)lds_raw; F.MISC = (volatile LAS unsigned*)(F.lds + MISC_OFF);
    F.tid = threadIdx.x; F.lane = F.tid & 63; F.wave = __builtin_amdgcn_readfirstlane(F.tid >> 6); F.G = gridDim.x; F.bid = blockIdx.x;
    F.ws = args.ws; F.ctl = (unsigned*)(args.ws + WS_CTL); F.out = args.out;
    F.x = args.in[0]; F.g_mpre = args.in[1]; F.g_mpost = args.in[2]; F.g_fpre = args.in[3]; F.g_fpost = args.in[4]; F.w_in = args.in[5]; F.pool_w = args.in[6]; F.pool_scale = args.in[7];
    F.rpb = args.in[8]; F.w_out = args.in[9]; F.dwg = args.in[10]; F.dwu = args.in[11]; F.dwd = args.in[12]; F.router = args.in[13]; F.mwg = args.in[14]; F.mwu = args.in[15]; F.mwd = args.in[16];
    if (F.tid < 16) F.MISC[F.tid] = 0u;
    __syncthreads();
    const int lo = args.lo, hi = args.hi;
    XcdBarrier bar; bar.bar = F.ctl + CW_BAR + args.breg * XCD_BAR_WORDS; bar.x = 0; bar.st = F.MISC;
    if (hi - lo > 1) bar = xcd_barrier_post(F.ctl + CW_BAR + args.breg * XCD_BAR_WORDS, F.MISC);
#ifndef NO_P0
#ifndef REP_P0
#define REP_P0 1
#endif
    if (RUN(0)) { for (int r_ = 0; r_ < REP_P0; ++r_) p0_prologue(F); } SEAM(0);
#endif
    run_layer<0>(F, bar, lo, hi);
    run_layer<1>(F, bar, lo, hi);
}
#undef RUN
#undef SEAM

__global__ void __launch_bounds__(64) nk_gemm(const bf16* A, int lda, const bf16* Bt, int ldb, int K, bf16* O, int ldo, float scale, int sc_lo, int sc_hi, int vt) {
    const int m0 = 32 * blockIdx.y, n0 = 32 * blockIdx.x, lane = threadIdx.x, fr = lane & 15, fq = lane >> 4;
    f32x4 acc[2][2];
#pragma unroll
    for (int a = 0; a < 2; ++a)
#pragma unroll
        for (int b = 0; b < 2; ++b) acc[a][b] = (f32x4){0.f, 0.f, 0.f, 0.f};
    for (int k0 = 0; k0 < K; k0 += 32) {
        bf16x8 a[2], b[2];
#pragma unroll
        for (int i = 0; i < 2; ++i) { a[i] = *(const bf16x8*)(A + (size_t)(m0 + 16 * i + fr) * lda + k0 + 8 * fq); b[i] = *(const bf16x8*)(Bt + (size_t)(n0 + 16 * i + fr) * ldb + k0 + 8 * fq); }
#pragma unroll
        for (int mt = 0; mt < 2; ++mt)
#pragma unroll
            for (int nt = 0; nt < 2; ++nt) acc[mt][nt] = __builtin_amdgcn_mfma_f32_16x16x32_bf16(a[mt], b[nt], acc[mt][nt], 0, 0, 0);
    }
#pragma unroll
    for (int mt = 0; mt < 2; ++mt)
#pragma unroll
        for (int nt = 0; nt < 2; ++nt)
#pragma unroll
            for (int q = 0; q < 4; ++q) { const int m = m0 + 16 * mt + 4 * fq + q, n = n0 + 16 * nt + fr; const float sc = (n >= sc_lo && n < sc_hi) ? scale : 1.0f;
                O[vt ? vt_index(m, n) : (size_t)m * ldo + n] = (bf16)f2bf(acc[mt][nt][q] * sc); }
}
__global__ void nk_blocktab(const unsigned* ctl, int* btab, int moe) {
    if (threadIdx.x != 0 || blockIdx.x != 0) return;
    int b = 0;
    for (int e = 0; e < NE; ++e) { const int nb = moe ? (int)((ctl[CW_CNT + 64 * e] + 255u) >> 8) : (e == 0 ? T / 256 : 0); for (int k = 0; k < nb; ++k) btab[b++] = e | (k << 8); }
    btab[MAXBLK] = b;
}
__global__ void __launch_bounds__(64) nk_ffn_up(const bf16* hn, const bf16* wgu, const int* lists, const int* btab, bf16* hff, int cstart, int F_, int moe) {
    const int m0 = 32 * blockIdx.y, f0 = 32 * blockIdx.x, lane = threadIdx.x, fr = lane & 15, fq = lane >> 4;
    const int b = cstart + m0 / 256; if (b >= btab[MAXBLK]) return;
    const int e = btab[b] & 0xff, lb = btab[b] >> 8;
    const int* list = lists + (moe ? (size_t)e * T + 256 * lb : (size_t)256 * b) + (m0 % 256);
    const bf16* W = wgu + (size_t)e * 2 * F_ * D; const int rg = (f0 / 128) * 256 + (f0 % 128);
    const bf16* arow[2]; arow[0] = hn + (size_t)list[fr] * D; arow[1] = hn + (size_t)list[16 + fr] * D;
    f32x4 ag[2][2], au[2][2];
#pragma unroll
    for (int a = 0; a < 2; ++a)
#pragma unroll
        for (int c = 0; c < 2; ++c) { ag[a][c] = (f32x4){0.f, 0.f, 0.f, 0.f}; au[a][c] = (f32x4){0.f, 0.f, 0.f, 0.f}; }
    for (int k0 = 0; k0 < D; k0 += 32) {
        bf16x8 a[2], bg[2], bu[2];
#pragma unroll
        for (int i = 0; i < 2; ++i) { a[i] = *(const bf16x8*)(arow[i] + k0 + 8 * fq); bg[i] = *(const bf16x8*)(W + (size_t)(rg + 16 * i + fr) * D + k0 + 8 * fq); bu[i] = *(const bf16x8*)(W + (size_t)(rg + 128 + 16 * i + fr) * D + k0 + 8 * fq); }
#pragma unroll
        for (int mt = 0; mt < 2; ++mt)
#pragma unroll
            for (int nt = 0; nt < 2; ++nt) { ag[mt][nt] = __builtin_amdgcn_mfma_f32_16x16x32_bf16(a[mt], bg[nt], ag[mt][nt], 0, 0, 0); au[mt][nt] = __builtin_amdgcn_mfma_f32_16x16x32_bf16(a[mt], bu[nt], au[mt][nt], 0, 0, 0); }
    }
#pragma unroll
    for (int mt = 0; mt < 2; ++mt)
#pragma unroll
        for (int nt = 0; nt < 2; ++nt)
#pragma unroll
            for (int q = 0; q < 4; ++q) { const float g = ag[mt][nt][q], u = au[mt][nt][q]; const float v = g * u / (1.0f + __expf(-g));
                hff[(size_t)(m0 + 16 * mt + 4 * fq + q) * F_ + f0 + 16 * nt + fr] = (bf16)f2bf(v); }
}
__global__ void __launch_bounds__(64) nk_ffn_down(const bf16* hff, const bf16* wd, const int* btab, bf16* y, int cstart, int F_) {
    const int m0 = 32 * blockIdx.y, n0 = 32 * blockIdx.x, lane = threadIdx.x, fr = lane & 15, fq = lane >> 4;
    const int b = cstart + m0 / 256; if (b >= btab[MAXBLK]) return;
    const int e = btab[b] & 0xff; const bf16* W = wd + (size_t)e * D * F_;
    f32x4 acc[2][2];
#pragma unroll
    for (int a = 0; a < 2; ++a)
#pragma unroll
        for (int c = 0; c < 2; ++c) acc[a][c] = (f32x4){0.f, 0.f, 0.f, 0.f};
    for (int k0 = 0; k0 < F_; k0 += 32) {
        bf16x8 a[2], bb[2];
#pragma unroll
        for (int i = 0; i < 2; ++i) { a[i] = *(const bf16x8*)(hff + (size_t)(m0 + 16 * i + fr) * F_ + k0 + 8 * fq); bb[i] = *(const bf16x8*)(W + (size_t)(n0 + 16 * i + fr) * F_ + k0 + 8 * fq); }
#pragma unroll
        for (int mt = 0; mt < 2; ++mt)
#pragma unroll
            for (int nt = 0; nt < 2; ++nt) acc[mt][nt] = __builtin_amdgcn_mfma_f32_16x16x32_bf16(a[mt], bb[nt], acc[mt][nt], 0, 0, 0);
    }
#pragma unroll
    for (int mt = 0; mt < 2; ++mt)
#pragma unroll
        for (int nt = 0; nt < 2; ++nt)
#pragma unroll
            for (int q = 0; q < 4; ++q) y[(size_t)(256 * cstart + m0 + 16 * mt + 4 * fq + q) * D + n0 + 16 * nt + fr] = (bf16)f2bf(acc[mt][nt][q]);
}
__global__ void nk_pool_delta(const bf16* proj, bf16* delta) {
    const int idx = blockIdx.x * 256 + threadIdx.x, tok = idx / DPOOL, ch = idx % DPOOL, b = tok / SEQ, t = tok % SEQ, g = ch / 128, hw = 1 << g;
    const int lo = max(t - hw, 0), hi = min(t + hw, SEQ); float s = 0.f;
    for (int tt = lo; tt < hi; ++tt) s += bf2f(proj[(size_t)(b * SEQ + tt) * NPROJ + ch]);
    delta[(size_t)tok * DPOOL + ch] = (bf16)f2bf(s / (float)(hi - lo) - bf2f(proj[(size_t)tok * NPROJ + ch]));
}
__global__ void nk_pool_mm(const bf16* delta, const bf16* Wp, const float* pscale, bf16* mixo) {
    const int idx = blockIdx.x * 256 + threadIdx.x, tok = idx / DPOOL, dd = idx % DPOOL, g = dd / 128, d = dd % 128; float s = 0.f;
    for (int c = 0; c < 128; ++c) s += bf2f(delta[(size_t)tok * DPOOL + 128 * g + c]) * bf2f(Wp[(size_t)(g * 128 + d) * 128 + c]);
    mixo[(size_t)tok * D + dd] = (bf16)f2bf(s * pscale[dd]);
}
__global__ void nk_na(const bf16* proj, const bf16* Vt, const float* rpb, bf16* mixo) {
    const int idx = blockIdx.x * 256 + threadIdx.x, tok = idx / NH, h = idx % NH, b = tok / SEQ, t = tok % SEQ, r = t / GRIDW, c = t % GRIDW;
    const int r0 = min(max(r - KH / 2, 0), GROWS - KH), c0 = min(max(c - KW / 2, 0), GRIDW - KW);
    float q[HD];
#pragma unroll
    for (int d = 0; d < HD; ++d) q[d] = bf2f(proj[(size_t)tok * NPROJ + 512 + HD * h + d]);
    float mx = -INFINITY;
    for (int i = 0; i < KH; ++i) for (int j = 0; j < KW; ++j) {
        const size_t kt = (size_t)(b * SEQ + (r0 + i) * GRIDW + c0 + j); float s = 0.f;
#pragma unroll
        for (int d = 0; d < HD; ++d) s += q[d] * bf2f(proj[kt * NPROJ + 1024 + HD * h + d]);
        s += rpb[(h * 15 + (r0 + i - r + KH - 1)) * 31 + (c0 + j - c + KW - 1)] * LOG2E; mx = fmaxf(mx, s);
    }
    float o[HD], sum = 0.f;
#pragma unroll
    for (int d = 0; d < HD; ++d) o[d] = 0.f;
    for (int i = 0; i < KH; ++i) for (int j = 0; j < KW; ++j) {
        const size_t kt = (size_t)(b * SEQ + (r0 + i) * GRIDW + c0 + j); float s = 0.f;
#pragma unroll
        for (int d = 0; d < HD; ++d) s += q[d] * bf2f(proj[kt * NPROJ + 1024 + HD * h + d]);
        s += rpb[(h * 15 + (r0 + i - r + KH - 1)) * 31 + (c0 + j - c + KW - 1)] * LOG2E;
        const float p = exp2f(s - mx); sum += p; const float pb = __builtin_bit_cast(float, f2bf(p) << 16);
#pragma unroll
        for (int d = 0; d < HD; ++d) o[d] += pb * bf2f(Vt[vt_index(HD * h + d, (int)kt)]);
    }
#pragma unroll
    for (int d = 0; d < HD; ++d) mixo[(size_t)tok * D + DPOOL + HD * h + d] = (bf16)f2bf(o[d] / sum);
}

static void launch_mk(const Args& a0, int lo, int hi, int grid, hipStream_t stream, int breg = 0) {
    Args a = a0; a.lo = lo; a.hi = hi; a.breg = breg; a.pad = 0;
    hipLaunchKernelGGL(mk_fwd, dim3(grid), dim3(512), LDS_BYTES, stream, a);
}
extern "C" void kernel_launch(void* const* d_in, const int* in_sizes, int n_in, void* d_out, int out_size, void* d_ws, size_t ws_size, hipStream_t stream) {
    static int grid = 0;
    if (grid == 0) {
        if (n_in != 17 || out_size != T * D || ws_size < WS_END) { fprintf(stderr, "kernel_launch: unexpected problem (n_in %d, out %d, ws %zu)\n", n_in, out_size, ws_size); grid = -1; return; }
        int dev = 0, cus = 0;
        if (hipGetDevice(&dev) != hipSuccess || hipDeviceGetAttribute(&cus, hipDeviceAttributeMultiprocessorCount, dev) != hipSuccess) { grid = -1; return; }
        if (hipFuncSetAttribute((const void*)mk_fwd, hipFuncAttributeMaxDynamicSharedMemorySize, LDS_BYTES) != hipSuccess) { grid = -1; return; }
        int per_cu = 0;
        if (hipOccupancyMaxActiveBlocksPerMultiprocessor(&per_cu, (const void*)mk_fwd, 512, LDS_BYTES) != hipSuccess || per_cu < 1) { fprintf(stderr, "kernel_launch: occupancy query says %d\n", per_cu); }
        (void)hipGetLastError();
        grid = cus;
    }
    if (grid < 0) return;
    hipMemsetAsync((char*)d_ws + WS_CTL, 0, CTL_ZERO_BYTES, stream);
    Args a{};
    for (int i = 0; i < 17; ++i) a.in[i] = (const float*)d_in[i];
    a.out = (float*)d_out; a.ws = (unsigned char*)d_ws; a.lo = 0; a.hi = 0;
    unsigned char* ws = (unsigned char*)d_ws;
#if MODE == 3
#if defined(REPSTEP)
    launch_mk(a, 0, REPSTEP + 1, grid, stream, 0); launch_mk(a, REPSTEP, REPSTEP + 1, grid, stream, 1); launch_mk(a, REPSTEP + 1, NSTEPS, grid, stream, 2);
#else
    launch_mk(a, 0, NSTEPS, grid, stream);
#endif
#else
    launch_mk(a, 0, 1, grid, stream);
    const bf16* HN = (const bf16*)(ws + WS_HN);
    for (int l = 0; l < DEPTH; ++l) {
        const int base = 1 + STEPS_PER_LAYER * l; const int moe = l & 1;
        const bf16* win = (const bf16*)(ws + WS_WIN) + (size_t)l * DIN * D;
        if (NAIVE & 1) {
            hipLaunchKernelGGL(nk_gemm, dim3(NPROJ / 32, T / 32), dim3(64), 0, stream, HN, D, win, D, D, (bf16*)(ws + WS_PROJ), NPROJ, QSCALE, 512, 1024, 0);
            hipLaunchKernelGGL(nk_gemm, dim3(T / 32, DATT / 32), dim3(64), 0, stream, win + (size_t)NPROJ * D, D, HN, D, D, (bf16*)(ws + WS_VT), T, 1.0f, 0, 0, 1);
        } else launch_mk(a, base + 0, base + 1, grid, stream);
        if (NAIVE & 2) {
            hipLaunchKernelGGL(nk_pool_delta, dim3(T * DPOOL / 256), dim3(256), 0, stream, (const bf16*)(ws + WS_PROJ), (bf16*)(ws + WS_MIX));
            hipLaunchKernelGGL(nk_pool_mm, dim3(T * DPOOL / 256), dim3(256), 0, stream, (const bf16*)(ws + WS_MIX), (const bf16*)(ws + WS_WP) + (size_t)l * 4 * 128 * 128, (const float*)d_in[7] + l * DPOOL, (bf16*)(ws + WS_MIXO));
            hipLaunchKernelGGL(nk_na, dim3(T * NH / 256), dim3(256), 0, stream, (const bf16*)(ws + WS_PROJ), (const bf16*)(ws + WS_VT), (const float*)d_in[8] + (size_t)l * NH * 15 * 31, (bf16*)(ws + WS_MIXO));
        } else launch_mk(a, base + 1, base + 2, grid, stream);
        if (NAIVE & 4) hipLaunchKernelGGL(nk_gemm, dim3(D / 32, T / 32), dim3(64), 0, stream, (const bf16*)(ws + WS_MIXO), D, (const bf16*)(ws + WS_WOUT) + (size_t)l * D * D, D, D, (bf16*)(ws + WS_MIX), D, 1.0f, 0, 0, 0);
        else launch_mk(a, base + 2, base + 3, grid, stream);
        launch_mk(a, base + 3, base + 4, grid, stream);
        if (NAIVE & 24) hipLaunchKernelGGL(nk_blocktab, dim3(1), dim3(64), 0, stream, (const unsigned*)(ws + WS_CTL), (int*)(ws + WS_BTAB), moe);
        const int F_ = moe ? DFFE : DFF, nchunk = moe ? MAXCHUNK : 2;
        for (int c = 0; c < nchunk; ++c) {
            if (NAIVE & 8) hipLaunchKernelGGL(nk_ffn_up, dim3(F_ / 32, CHUNK_BLK * 256 / 32), dim3(64), 0, stream, HN, moe ? (const bf16*)(ws + WS_WGUM) : (const bf16*)(ws + WS_WGU0), moe ? (const int*)(ws + WS_LIST) : (const int*)(ws + WS_LISTID), (const int*)(ws + WS_BTAB), (bf16*)(ws + WS_HFF), c * CHUNK_BLK, F_, moe);
            else launch_mk(a, base + 4 + 2 * c, base + 5 + 2 * c, grid, stream);
            if (NAIVE & 16) hipLaunchKernelGGL(nk_ffn_down, dim3(D / 32, CHUNK_BLK * 256 / 32), dim3(64), 0, stream, (const bf16*)(ws + WS_HFF), moe ? (const bf16*)(ws + WS_WDM) : (const bf16*)(ws + WS_WD0), (const int*)(ws + WS_BTAB), (bf16*)(ws + WS_Y), c * CHUNK_BLK, F_);
            else launch_mk(a, base + 5 + 2 * c, base + 6 + 2 * c, grid, stream);
        }
        launch_mk(a, base + 14, base + 15, grid, stream);
    }
#endif
}
```

```cpp
#include <hip/hip_runtime.h>
#include <cstdio>
#include <cstdint>

#ifndef MODE
#define MODE 3
#endif
#ifndef NAIVE
#define NAIVE 0
#endif
#ifndef I8_DENSE
#define I8_DENSE 1
#endif
#ifndef I8_PROJ
#define I8_PROJ 1
#endif
#ifndef FP6_UP
#define FP6_UP 1
#endif
#ifndef FP8_DDOWN
#define FP8_DDOWN 1
#endif
#ifndef Y8_MOE
#define Y8_MOE 1
#endif
#ifndef FP8_MOE
#define FP8_MOE 1
#endif
#if ((FP8_MOE || I8_DENSE) && (NAIVE & 24) || I8_PROJ && (NAIVE & 1)) && MODE != 3
#error the simple reference FFN kernels are bf16 only: build with -DFP8_MOE=0 to use them
#endif

#define GAS __attribute__((address_space(1)))
#define LAS __attribute__((address_space(3)))
typedef unsigned short bf16;
typedef unsigned v4u __attribute__((ext_vector_type(4)));
typedef unsigned v2u __attribute__((ext_vector_type(2)));
typedef float f32x4 __attribute__((ext_vector_type(4)));
typedef float f32x2 __attribute__((ext_vector_type(2)));
typedef short bf16x8 __attribute__((ext_vector_type(8)));

constexpr int BATCH = 2, SEQ = 16384, T = BATCH * SEQ, D = 1024, DIN = 2048, DPOOL = 512, DATT = 512, NH = 16, HD = 32;
constexpr int GRIDW = 64, GROWS = SEQ / GRIDW, KH = 8, KW = 16;
constexpr int DFF = 4096, NE = 8, DFFE = 3584, DEPTH = 2;
constexpr int UPITCH = 512;
constexpr int NPROJ = 1536;
constexpr float RMS_EPS = 1e-6f;
constexpr float LOG2E = 1.4426950408889634f;
constexpr float QSCALE = 0.17677669529663687f * LOG2E;
__host__ __device__ __forceinline__ size_t vt_index(int ch, int tok) { return (size_t)(tok >> 6) * (DATT * 64) + (size_t)ch * 64 + (tok & 63); }
constexpr float S6A = 1.25f, S6W = 40.0f;
typedef float f32x16 __attribute__((ext_vector_type(16)));
typedef int i32x6 __attribute__((ext_vector_type(6)));
constexpr float W8_UP = 32.0f, W8_DN = 64.0f;
typedef int i32x8 __attribute__((ext_vector_type(8)));
typedef int i32x4 __attribute__((ext_vector_type(4)));
constexpr int CHUNK_BLK = 64;
constexpr int MAXCHUNK = 5;
constexpr int MAXBLK = 264;

constexpr size_t MiB = 1u << 20;
constexpr size_t WS_CTL = 0, CTL_ZERO_BYTES = 1 * MiB;
constexpr size_t WS_LIST = 1 * MiB;
constexpr size_t WS_INFO = 2 * MiB;
constexpr size_t WS_LISTID = 2 * MiB + 512 * 1024;
constexpr size_t WS_SA = 2 * MiB + 640 * 1024;
constexpr size_t WS_SWIN = 2 * MiB + 896 * 1024;
constexpr size_t WS_SW0 = 2 * MiB + 832 * 1024;
constexpr size_t WS_BTAB = 2 * MiB + 768 * 1024;
constexpr size_t WS_WP = 3 * MiB;
constexpr size_t WS_WIN = 4 * MiB;
constexpr size_t WS_WOUT = 12 * MiB;
constexpr size_t WS_WGU0 = 16 * MiB;
constexpr size_t WS_WD0 = 32 * MiB;
constexpr size_t WS_WGUM = 40 * MiB;
constexpr size_t WS_WDM = (FP8_MOE ? 160 : 152) * MiB;
constexpr size_t WS_H16 = 96 * MiB;
constexpr size_t WS_HN = 208 * MiB;
constexpr size_t WS_R = 272 * MiB;
constexpr size_t WS_HFF = WS_R;
constexpr size_t WS_Y = WS_R + 128 * MiB;
constexpr size_t WS_PQ = WS_R + 32 * MiB, WS_PK = WS_R + 64 * MiB;
constexpr size_t WS_PROJ = WS_R;
constexpr size_t WS_VT = WS_R + 96 * MiB;
constexpr size_t WS_MIXO = WS_R + 128 * MiB;
constexpr size_t WS_MIX = WS_R + 192 * MiB;
constexpr size_t WS_END = 532 * MiB;
constexpr float YS = 16.0f;
constexpr int HFF_TILE = 256 * 128;
constexpr int TAILSPLIT = 7, TAILPART_ROWS = 8 * 256;
constexpr size_t WS_TAILPART6 = WS_Y + 68 * MiB;
constexpr size_t WS_TAILPART = WS_WGU0;
static_assert(WS_TAILPART + (size_t)(TAILSPLIT - 1) * TAILPART_ROWS * D * 2 <= WS_WGUM, "tail partials");
static_assert(!FP8_MOE || (WS_WGUM + (size_t)NE * 2 * DFFE * D <= WS_H16 && WS_H16 + (size_t)T * D * 2 <= WS_WDM), "H16 sits in the gap the fp8 expert weights leave");

constexpr int CW_TMO = 0, CW_CODE = 1;
constexpr int CW_BAR = 4096;
constexpr int CW_CNT = 16384;
constexpr int CW_DBG = 20480;

constexpr int RING_BYTES = 131072;
constexpr int TOKBUF_OFF = RING_BYTES;
constexpr int BLK_OFF = TOKBUF_OFF + 9 * 1024;
constexpr int BST_OFF = BLK_OFF + 272 * 4;
constexpr int LCNT_OFF = BST_OFF + 64;
constexpr int MISC_OFF = LCNT_OFF + 64;
constexpr int LDS_BYTES = 147456;
static_assert(MISC_OFF + 64 <= LDS_BYTES, "LDS map");

#define RLX_AGENT __ATOMIC_RELAXED, __HIP_MEMORY_SCOPE_AGENT
#define LDS_WAIT() asm volatile("s_waitcnt lgkmcnt(0)" ::: "memory")
#define VM_WAIT() asm volatile("s_waitcnt vmcnt(0)" ::: "memory")
__device__ __forceinline__ unsigned f2bf(float f) { unsigned u = __builtin_bit_cast(unsigned, f); return (u + 0x7fffu + ((u >> 16) & 1u)) >> 16; }
__device__ __forceinline__ unsigned pk2(float lo, float hi) { return f2bf(lo) | (f2bf(hi) << 16); }
__device__ __forceinline__ float bflo(unsigned w) { return __builtin_bit_cast(float, w << 16); }
__device__ __forceinline__ float bfhi(unsigned w) { return __builtin_bit_cast(float, w & 0xffff0000u); }
__device__ __forceinline__ float bf2f(bf16 v) { return __builtin_bit_cast(float, (unsigned)v << 16); }
__device__ __forceinline__ unsigned cvt_pk_bf16(float lo, float hi) { unsigned r; asm volatile("v_cvt_pk_bf16_f32 %0, %1, %2" : "=v"(r) : "v"(lo), "v"(hi)); return r; }
__device__ __forceinline__ float wave_sum(float v) {
#pragma unroll
    for (int o = 1; o < 64; o <<= 1) v += __shfl_xor(v, o);
    return v;
}

#define XB_TMO      128
#define XB_XCNT(j)  (256  + 64 * (j))
#define XB_XSUB(j)  (1280 + 64 * (j))
#define XB_XGEN(j)  (2304 + 64 * (j))
#define XB_TOP      3328
#define XB_TOPGEN   3392
#define XCD_BAR_WORDS 3456
#define XB_SPIN_CAP (1u << 18)
__device__ __forceinline__ unsigned xb_ld(unsigned* p)              { return __hip_atomic_load(p, __ATOMIC_RELAXED, __HIP_MEMORY_SCOPE_AGENT); }
__device__ __forceinline__ unsigned xb_add(unsigned* p, unsigned v) { return __hip_atomic_fetch_add(p, v, __ATOMIC_RELAXED, __HIP_MEMORY_SCOPE_AGENT); }
__device__ __forceinline__ unsigned xb_xcc_id() { return (unsigned)__builtin_amdgcn_s_getreg((3 << 11) | 20) & 0xFu; }
#define XB_SPIN(cond, bar) do { unsigned _sp = 0; while (cond) { __builtin_amdgcn_s_sleep(1); \
    if ((++_sp & 255u) == 0u) { if (xb_ld(&(bar)[XB_TMO])) break; if (_sp > XB_SPIN_CAP) { atomicAdd(&(bar)[XB_TMO], 1u); break; } } } } while (0)
struct XcdBarrier { unsigned* bar; unsigned x; volatile LAS unsigned* st; };
__device__ __forceinline__ XcdBarrier xcd_barrier_post(unsigned* bar, volatile LAS unsigned* st) {
    XcdBarrier b; b.bar = bar; b.x = xb_xcc_id(); b.st = st;
    if (threadIdx.x == 0) (void)xb_add(&bar[XB_XCNT(b.x)], 1u);
    return b;
}
__device__ __forceinline__ void xcd_barrier_complete(unsigned* bar, unsigned x, unsigned& nloc, unsigned& nx) {
    const unsigned G = gridDim.x * gridDim.y * gridDim.z;
    unsigned sum, cnt, mine, sp = 0u;
    for (;;) {
        sum = 0u; cnt = 0u; mine = 0u;
#pragma unroll
        for (unsigned j = 0; j < 16; ++j) { const unsigned c = xb_ld(&bar[XB_XCNT(j)]); sum += c; cnt += (c > 0u) ? 1u : 0u; mine = (j == x) ? c : mine; }
        if (sum == G) break;
        __builtin_amdgcn_s_sleep(1);
        if ((++sp & 255u) == 0u) { if (xb_ld(&bar[XB_TMO])) break; if (sp > XB_SPIN_CAP) { atomicAdd(&bar[XB_TMO], 1u); break; } }
    }
    nloc = mine > 0u ? mine : 1u; nx = cnt > 0u ? cnt : 1u;
}
__device__ __forceinline__ void xcd_barrier(const XcdBarrier& b) {
    asm volatile("s_waitcnt vmcnt(0)" ::: "memory");
    __syncthreads();
    if (threadIdx.x == 0) {
        unsigned* bar = b.bar;
        __builtin_amdgcn_s_waitcnt(0);
        unsigned nloc = b.st[0], nx = b.st[1];
        if (nloc == 0u) { xcd_barrier_complete(bar, b.x, nloc, nx); b.st[0] = nloc; b.st[1] = nx; }
        const unsigned old = xb_add(&bar[XB_XSUB(b.x)], 1u);
        const unsigned gen = old / nloc;
        if (old + 1u == (gen + 1u) * nloc) {
            __builtin_amdgcn_fence(__ATOMIC_RELEASE, "agent");
            asm volatile("s_waitcnt vmcnt(0)" ::: "memory");
            const unsigned og = xb_add(&bar[XB_TOP], 1u);
            const unsigned tg = og / nx;
            if (og + 1u == (tg + 1u) * nx) xb_add(&bar[XB_TOPGEN], 1u);
            else XB_SPIN(xb_ld(&bar[XB_TOPGEN]) == tg, bar);
            __builtin_amdgcn_fence(__ATOMIC_ACQUIRE, "agent");
            xb_add(&bar[XB_XGEN(b.x)], 1u);
            asm volatile("s_waitcnt vmcnt(0)" ::: "memory");
        } else {
            XB_SPIN(xb_ld(&bar[XB_XGEN(b.x)]) == gen, bar);
            __builtin_amdgcn_fence(__ATOMIC_ACQUIRE, "agent");
            asm volatile("s_waitcnt vmcnt(0)" ::: "memory");
        }
    }
    __syncthreads();
}

namespace pg8 {
constexpr int BM = 256, BK = 64, HALF = 128, HTB = HALF * BK * 2, STAGE_BYTES = 8 * HTB, NXCD = 8, WGM = 8;
__host__ __device__ __forceinline__ int lds_byte(int r, int c) { const int st = (r >> 4) * 2 + (c >> 5), rr = r & 15, cc = c & 31, ob = rr * 64 + cc * 2; return st * 1024 + (ob ^ (((ob >> 9) & 1) << 5)); }
__host__ __device__ __forceinline__ void stage_rc(int b, int& R, int& C) { const int st = b / 1024, sb = b % 1024, swz = sb ^ (((sb >> 9) & 1) << 5); R = (st >> 1) * 16 + swz / 64; C = (st & 1) * 32 + (swz % 64) / 2; }
__host__ __device__ __forceinline__ int perm32(int rho) { const int n = rho >> 4, i = rho & 15; return 8 * (i >> 2) + 4 * n + (i & 3); }

struct Unit { const char* A; const char* B; const void* p0; const float* cs; bf16* obase; int orow, ocol, ldc; float scale; };

__device__ __forceinline__ bool tile_order(int i, int G, int c, int nM, int nN, int& pm, int& pn) {
    const int nwg = nM * nN; const long L = (long)i * G + c; if (L >= nwg) return false;
    int wgid = (int)L; { const int q = nwg / NXCD, r = nwg % NXCD, xcd = wgid % NXCD, off = wgid / NXCD; wgid = (xcd < r ? xcd * (q + 1) : r * (q + 1) + (xcd - r) * q) + off; }
    const int nig = WGM * nN, gid = wgid / nig, fm = gid * WGM, gsz = (nM - fm) < WGM ? (nM - fm) : WGM;
    pm = fm + ((wgid % nig) % gsz); pn = (wgid % nig) / gsz; return true;
}

template <bool VT> struct EpiBf16T {
    static constexpr bool SCL = false;
    __device__ __forceinline__ void operator()(const f32x4 (&acc)[2][2][4][2], const Unit& u, int wr, int wc, int fr, int fq, const LAS int* tok, const LAS float* scl) const {
        const int row0 = u.orow + wr * 64 + fr, col0 = u.ocol + wc * 32 + 8 * fq; const float sc = u.scale;
#pragma unroll
        for (int ai = 0; ai < 2; ++ai)
#pragma unroll
            for (int m = 0; m < 4; ++m) { const int row = row0 + ai * HALF + m * 16; bf16* rowp = u.obase + (size_t)row * u.ldc + col0;
#pragma unroll
                for (int bj = 0; bj < 2; ++bj) { const f32x4 v0 = acc[ai][bj][m][0] * sc, v1 = acc[ai][bj][m][1] * sc;
                    v4u w; w.x = cvt_pk_bf16(v0[0], v0[1]); w.y = cvt_pk_bf16(v0[2], v0[3]); w.z = cvt_pk_bf16(v1[0], v1[1]); w.w = cvt_pk_bf16(v1[2], v1[3]);
                    bf16* p = (VT && u.ldc < 0) ? u.obase + vt_index(row, col0 + bj * HALF) : rowp + bj * HALF;
                    *(v4u*)p = w; } }
    }
};
struct EpiY8 {
    static constexpr bool SCL = false;
    __device__ __forceinline__ void operator()(const f32x4 (&acc)[2][2][4][2], const Unit& u, int wr, int wc, int fr, int fq, const LAS int* tok, const LAS float* scl) const {
        const int row0 = u.orow + wr * 64 + fr, col0 = u.ocol + wc * 32 + 8 * fq; const float sc = u.scale;
#pragma unroll
        for (int ai = 0; ai < 2; ++ai)
#pragma unroll
            for (int m = 0; m < 4; ++m) { unsigned char* rowp = (unsigned char*)u.obase + (size_t)(row0 + ai * HALF + m * 16) * u.ldc + col0;
#pragma unroll
                for (int bj = 0; bj < 2; ++bj) { const f32x4 v0 = acc[ai][bj][m][0] * sc, v1 = acc[ai][bj][m][1] * sc;
                    int w0 = 0, w1 = 0;
                    w0 = __builtin_amdgcn_cvt_pk_fp8_f32(v0[0], v0[1], w0, false); w0 = __builtin_amdgcn_cvt_pk_fp8_f32(v0[2], v0[3], w0, true);
                    w1 = __builtin_amdgcn_cvt_pk_fp8_f32(v1[0], v1[1], w1, false); w1 = __builtin_amdgcn_cvt_pk_fp8_f32(v1[2], v1[3], w1, true);
                    v2u w; w.x = (unsigned)w0; w.y = (unsigned)w1; *(v2u*)(rowp + bj * HALF) = w; } }
    }
};
typedef EpiBf16T<false> EpiBf16;
typedef EpiBf16T<true> EpiProj;
__device__ __forceinline__ float silu_mul(float g, float u) { return g * u * __builtin_amdgcn_rcpf(1.0f + __builtin_amdgcn_exp2f(-LOG2E * g)); }
struct EpiSwiGLU {
    static constexpr bool SCL = false;
    __device__ __forceinline__ void operator()(const f32x4 (&acc)[2][2][4][2], const Unit& u, int wr, int wc, int fr, int fq, const LAS int* tok, const LAS float* scl) const {
        const int row0 = u.orow + wr * 64 + fr, col0 = u.ocol + wc * 32 + 8 * fq;
#pragma unroll
        for (int ai = 0; ai < 2; ++ai)
#pragma unroll
            for (int m = 0; m < 4; ++m) { bf16* rowp = u.obase + (size_t)(row0 + ai * HALF + m * 16) * u.ldc + col0;
                const f32x4 g0 = acc[ai][0][m][0], g1 = acc[ai][0][m][1], u0 = acc[ai][1][m][0], u1 = acc[ai][1][m][1];
                v4u w; w.x = cvt_pk_bf16(silu_mul(g0[0], u0[0]), silu_mul(g0[1], u0[1])); w.y = cvt_pk_bf16(silu_mul(g0[2], u0[2]), silu_mul(g0[3], u0[3]));
                w.z = cvt_pk_bf16(silu_mul(g1[0], u1[0]), silu_mul(g1[1], u1[1])); w.w = cvt_pk_bf16(silu_mul(g1[2], u1[2]), silu_mul(g1[3], u1[3]));
                *(v4u*)rowp = w; }
    }
};

template <bool F6> struct EpiSwiGLU8T {
    static constexpr bool SCL = false;
    static __device__ __forceinline__ f32x2 pair(f32x2 gr, f32x2 ur) {
        const float sc = F6 ? 1.0f / (S6A * S6W) : 1.0f / W8_UP; const f32x2 a = gr * (-LOG2E * sc);
        f32x2 t; t.x = __builtin_amdgcn_exp2f(a.x); t.y = __builtin_amdgcn_exp2f(a.y);
        const f32x2 d = t + 1.0f; f32x2 r; r.x = __builtin_amdgcn_rcpf(d.x); r.y = __builtin_amdgcn_rcpf(d.y);
        return (gr * ur) * (r * (sc * sc));
    }
    __device__ __forceinline__ void operator()(const f32x4 (&acc)[2][2][4][2], const Unit& u, int wr, int wc, int fr, int fq, const LAS int* tok, const LAS float* scl) const {
        const int row0 = u.orow + wr * 64 + fr, col0 = u.ocol + wc * 32 + 8 * fq;
#pragma unroll
        for (int ai = 0; ai < 2; ++ai)
#pragma unroll
            for (int m = 0; m < 4; ++m) { unsigned char* rowp = (unsigned char*)u.obase + (size_t)(row0 + ai * HALF + m * 16) * 128 + col0;
                const f32x4 g0 = acc[ai][0][m][0], g1 = acc[ai][0][m][1], u0 = acc[ai][1][m][0], u1 = acc[ai][1][m][1];
                const f32x2 o0 = pair((f32x2){g0[0], g0[1]}, (f32x2){u0[0], u0[1]}), o1 = pair((f32x2){g0[2], g0[3]}, (f32x2){u0[2], u0[3]});
                const f32x2 o2 = pair((f32x2){g1[0], g1[1]}, (f32x2){u1[0], u1[1]}), o3 = pair((f32x2){g1[2], g1[3]}, (f32x2){u1[2], u1[3]});
                int w0 = 0, w1 = 0;
                w0 = __builtin_amdgcn_cvt_pk_fp8_f32(o0.x, o0.y, w0, false); w0 = __builtin_amdgcn_cvt_pk_fp8_f32(o1.x, o1.y, w0, true);
                w1 = __builtin_amdgcn_cvt_pk_fp8_f32(o2.x, o2.y, w1, false); w1 = __builtin_amdgcn_cvt_pk_fp8_f32(o3.x, o3.y, w1, true);
                v2u w; w.x = (unsigned)w0; w.y = (unsigned)w1; *(v2u*)rowp = w; }
    }
};

typedef EpiSwiGLU8T<false> EpiSwiGLU8;
typedef EpiSwiGLU8T<true> EpiSwiGLU6;
struct EpiProj_I8 {
    static constexpr bool SCL = true;
    __device__ __forceinline__ const float* rs_ptr(const Unit& u) const { return (const float*)u.p0; }
    __device__ __forceinline__ const float* cs_ptr(const Unit& u) const { return u.cs; }
    __device__ __forceinline__ void operator()(const f32x4 (&acc)[2][2][4][2], const Unit& u, int wr, int wc, int fr, int fq, const LAS int* tok, const LAS float* scl) const {
        const int rl0 = wr * 64 + fr, cl0 = wc * 32 + 8 * fq, row0 = u.orow + rl0, col0 = u.ocol + cl0; const float sc = u.scale;
        const bool hm = u.ldc == 0; const size_t rstride = hm ? 32 : (size_t)u.ldc, bstride = hm ? (size_t)4 * T * 32 : (size_t)HALF;
        bf16* lbase = hm ? u.obase + (size_t)((u.ocol >> 5) + wc) * T * 32 + 8 * fq : u.obase + col0;
        f32x4 cv[2][2];
#pragma unroll
        for (int bj = 0; bj < 2; ++bj) { cv[bj][0] = *(const LAS f32x4*)(scl + 256 + cl0 + bj * HALF) * sc; cv[bj][1] = *(const LAS f32x4*)(scl + 256 + cl0 + bj * HALF + 4) * sc; }
#pragma unroll
        for (int ai = 0; ai < 2; ++ai)
#pragma unroll
            for (int m = 0; m < 4; ++m) { const int row = row0 + ai * HALF + m * 16; const float sr = scl[rl0 + ai * HALF + m * 16]; bf16* rowp = lbase + (size_t)row * rstride;
#pragma unroll
                for (int bj = 0; bj < 2; ++bj) { const f32x4 v0 = __builtin_convertvector(__builtin_bit_cast(i32x4, acc[ai][bj][m][0]), f32x4) * cv[bj][0] * sr, v1 = __builtin_convertvector(__builtin_bit_cast(i32x4, acc[ai][bj][m][1]), f32x4) * cv[bj][1] * sr;
                    v4u w; w.x = cvt_pk_bf16(v0[0], v0[1]); w.y = cvt_pk_bf16(v0[2], v0[3]); w.z = cvt_pk_bf16(v1[0], v1[1]); w.w = cvt_pk_bf16(v1[2], v1[3]);
                    bf16* p = (u.ldc < 0) ? u.obase + vt_index(row, col0 + bj * HALF) : rowp + bj * bstride;
                    *(v4u*)p = w; } }
    }
};
template <bool F8OUT> struct EpiSwiGLU_I8T {
    static constexpr bool SCL = true;
    const float* sA; const float* sW; const int* idl;
    __device__ __forceinline__ const float* rs_ptr(const Unit& u) const { return sA + ((const int*)u.p0 - idl); }
    __device__ __forceinline__ const float* cs_ptr(const Unit& u) const { return sW + 2 * u.ocol; }
    static __device__ __forceinline__ f32x2 pair(f32x2 gr, f32x2 ur, f32x2 ka, f32x2 k, float sa) {
        const f32x2 a = (gr * sa) * ka;
        f32x2 t; t.x = __builtin_amdgcn_exp2f(a.x); t.y = __builtin_amdgcn_exp2f(a.y);
        const f32x2 d = t * k + k; f32x2 r; r.x = __builtin_amdgcn_rcpf(d.x); r.y = __builtin_amdgcn_rcpf(d.y);
        return (gr * ur) * r;
    }
    __device__ __forceinline__ void operator()(const f32x4 (&acc)[2][2][4][2], const Unit& u, int wr, int wc, int fr, int fq, const LAS int* tok, const LAS float* scl) const {
        const int rl0 = wr * 64 + fr, row0 = u.orow + rl0, cl0 = wc * 32 + 8 * fq, col0 = u.ocol + cl0;
        f32x2 ka[4], kc[4];
#pragma unroll
        for (int i = 0; i < 4; ++i) { const f32x2 wg = *(const LAS f32x2*)(scl + 256 + cl0 + 2 * i), wu = *(const LAS f32x2*)(scl + 256 + HALF + cl0 + 2 * i); const f32x2 p = wg * wu;
            ka[i] = wg * (-LOG2E); kc[i].x = __builtin_amdgcn_rcpf(p.x); kc[i].y = __builtin_amdgcn_rcpf(p.y); }
#pragma unroll
        for (int ai = 0; ai < 2; ++ai)
#pragma unroll
            for (int m = 0; m < 4; ++m) { const float sa = scl[rl0 + ai * HALF + m * 16], rs2 = __builtin_amdgcn_rcpf(sa * sa);
                bf16* rowp = u.obase + (size_t)(row0 + ai * HALF + m * 16) * u.ldc + col0;
                f32x2 o[4];
#pragma unroll
                for (int i = 0; i < 4; ++i) { const f32x4 ga = acc[ai][0][m][i >> 1], ua = acc[ai][1][m][i >> 1];
                    const float g0 = ga[2 * (i & 1)], g1 = ga[2 * (i & 1) + 1], u0 = ua[2 * (i & 1)], u1 = ua[2 * (i & 1) + 1];
                    const f32x2 gr = (f32x2){(float)__float_as_int(g0), (float)__float_as_int(g1)}, ur = (f32x2){(float)__float_as_int(u0), (float)__float_as_int(u1)};
                    o[i] = pair(gr, ur, ka[i], kc[i] * rs2, sa); }
                if constexpr (F8OUT) { int w0 = 0, w1 = 0;
                    w0 = __builtin_amdgcn_cvt_pk_fp8_f32(o[0].x, o[0].y, w0, false); w0 = __builtin_amdgcn_cvt_pk_fp8_f32(o[1].x, o[1].y, w0, true);
                    w1 = __builtin_amdgcn_cvt_pk_fp8_f32(o[2].x, o[2].y, w1, false); w1 = __builtin_amdgcn_cvt_pk_fp8_f32(o[3].x, o[3].y, w1, true);
                    v2u w; w.x = (unsigned)w0; w.y = (unsigned)w1; *(v2u*)((unsigned char*)u.obase + (size_t)(row0 + ai * HALF + m * 16) * 128 + col0) = w; }
                else { v4u w; w.x = cvt_pk_bf16(o[0].x, o[0].y); w.y = cvt_pk_bf16(o[1].x, o[1].y); w.z = cvt_pk_bf16(o[2].x, o[2].y); w.w = cvt_pk_bf16(o[3].x, o[3].y);
                    *(v4u*)rowp = w; } }
    }
};
typedef EpiSwiGLU_I8T<FP8_DDOWN != 0> EpiSwiGLU_I8;

template <class Epi, class Sched, bool GATHER, int MT = 0  >
__device__ __forceinline__ void gemm_phase(LAS unsigned char* lds, LAS int* tokbuf, const int K, const Sched& S, const Epi& E, const int P_ = 0, const int PA_ = 0, const int KSA_ = 0) {
    const int P = P_ ? P_ : K, PA = PA_ ? PA_ : P;
    const size_t kstepA = KSA_ ? (size_t)KSA_ : (size_t)(BK * 2);
    int tid_ = threadIdx.x; asm volatile("" : "+v"(tid_));
    const int tid = tid_, wid = __builtin_amdgcn_readfirstlane(tid >> 6), lane = tid & 63, wr = wid >> 2, wc = wid & 3, fr = lane & 15, fq = lane >> 4;
    const int nt = K / BK;
    unsigned voffA[2][2], voffB[2]; int rowA[2], colA[2];
#pragma unroll
    for (int i = 0; i < 2; ++i) { int R, C; stage_rc(tid * 16 + i * 8192, R, C); const int Rb = (R & ~31) + perm32(R & 31);
        voffA[0][i] = (unsigned)(R * PA + C) * 2u; voffA[1][i] = (unsigned)((R + HALF) * PA + C) * 2u; voffB[i] = (unsigned)(Rb * P + C) * 2u; rowA[i] = R; colA[i] = C; }
    const size_t kstep = (size_t)(BK * 2);
    const size_t hstep = (size_t)HALF * P * 2, hstepA = (size_t)HALF * PA * 2;
    const unsigned ldsw = (unsigned)wid * 1024u;
    const int aoff = lds_byte(wr * 64 + fr, fq * 8), boff = lds_byte(wc * 32 + fr, fq * 8);
#define PG8_SA(b, h) (((b) * 2 + (h)) * HTB)
#define PG8_SB(b, h) ((4 + (b) * 2 + (h)) * HTB)
#define PG8_STAGE(bufoff, gbase, voff) do { _Pragma("unroll") for (int _i = 0; _i < 2; ++_i) \
        __builtin_amdgcn_global_load_lds((const unsigned*)((const char*)(gbase) + (voff)[_i]), (LAS unsigned*)(lds + (bufoff) + ldsw + _i * 8192), 16, 0, 0); } while (0)
#define PG8_STAGE_A1(bufoff, gbase) do { if constexpr (GATHER) PG8_STAGE(bufoff, gbase, voffA[1]); else PG8_STAGE(bufoff, (gbase) + hstepA, voffA[0]); } while (0)
#define PG8_LDA(dst, b, h) do { _Pragma("unroll") for (int m = 0; m < 4; ++m) _Pragma("unroll") for (int k = 0; k < 2; ++k) dst[m][k] = *(const LAS bf16x8*)(lds + PG8_SA(b, h) + aoff + m * 2048 + k * 1024); } while (0)
#define PG8_LDB(dst, b, h) do { _Pragma("unroll") for (int n = 0; n < 2; ++n) _Pragma("unroll") for (int k = 0; k < 2; ++k) dst[n][k] = *(const LAS bf16x8*)(lds + PG8_SB(b, h) + boff + n * 2048 + k * 1024); } while (0)
#define PG8_CAT8(x) __builtin_shufflevector(__builtin_bit_cast(i32x4, (x)[0]), __builtin_bit_cast(i32x4, (x)[1]), 0, 1, 2, 3, 4, 5, 6, 7)
#define PG8_MMA(ai, bj, At, Bt) do { __builtin_amdgcn_s_setprio(1); _Pragma("unroll") for (int m = 0; m < 4; ++m) _Pragma("unroll") for (int n = 0; n < 2; ++n) { \
        if constexpr (MT == 1) acc[ai][bj][m][n] = __builtin_amdgcn_mfma_scale_f32_16x16x128_f8f6f4(PG8_CAT8(Bt[n]), PG8_CAT8(At[m]), acc[ai][bj][m][n], 0, 0, 0, 0, 0, 0); \
        else if constexpr (MT == 3) acc[ai][bj][m][n] = __builtin_amdgcn_mfma_scale_f32_16x16x128_f8f6f4(PG8_CAT8(Bt[n]), PG8_CAT8(At[m]), acc[ai][bj][m][n], 2, 2, 0, 0, 0, 0); \
        else if constexpr (MT == 2) { _Pragma("unroll") for (int k = 0; k < 2; ++k) acc[ai][bj][m][n] = __builtin_bit_cast(f32x4, __builtin_amdgcn_mfma_i32_16x16x64_i8(__builtin_bit_cast(i32x4, Bt[n][k]), __builtin_bit_cast(i32x4, At[m][k]), __builtin_bit_cast(i32x4, acc[ai][bj][m][n]), 0, 0, 0)); } \
        else { _Pragma("unroll") for (int k = 0; k < 2; ++k) acc[ai][bj][m][n] = __builtin_amdgcn_mfma_f32_16x16x32_bf16(Bt[n][k], At[m][k], acc[ai][bj][m][n], 0, 0, 0); } } \
        __builtin_amdgcn_s_setprio(0); } while (0)
#define PG8_WAIT_V(n) asm volatile("s_waitcnt vmcnt(" #n ")" ::: "memory")
#define PG8_WAIT_L(n) asm volatile("s_waitcnt lgkmcnt(" #n ")" ::: "memory")
#define PG8_BAR __builtin_amdgcn_s_barrier()
#define PG8_SCHED __builtin_amdgcn_sched_barrier(0)
#define PG8_TOKOFF(dst, tb) do { _Pragma("unroll") for (int _h = 0; _h < 2; ++_h) _Pragma("unroll") for (int _i = 0; _i < 2; ++_i) \
        dst[_h][_i] = (unsigned)(tb)[_h * HALF + rowA[_i]] * (unsigned)(PA * 2) + (unsigned)(colA[_i] * 2); } while (0)
#define PG8_TOKDMA(listp, tb) do { if (wid < 4) __builtin_amdgcn_global_load_lds((const unsigned*)((listp) + tid), (LAS unsigned*)((tb) + wid * 64), 4, 0, 0); } while (0)
#define PG8_SCB(u_) ((LAS float*)(tokbuf + 768) + 512 * ((u_) % 3))
#define PG8_SCLDMA(un, u_) do { const float* sp_ = wid < 4 ? E.rs_ptr(un) + tid : E.cs_ptr(un) + (tid - 256); \
        __builtin_amdgcn_global_load_lds((const unsigned*)sp_, (LAS unsigned*)(PG8_SCB(u_) + wid * 64), 4, 0, 0); } while (0)
#define PG8_TB(u_) (tokbuf + 256 * ((u_) % 3))
    Unit cur, nxt; int ui = 0;
    if (!S.next(0, cur)) return;
    f32x4 acc[2][2][4][2];
#pragma unroll
    for (int a = 0; a < 2; ++a)
#pragma unroll
        for (int b = 0; b < 2; ++b)
#pragma unroll
            for (int m = 0; m < 4; ++m)
#pragma unroll
                for (int n = 0; n < 2; ++n) acc[a][b][m][n] = (f32x4){0.f, 0.f, 0.f, 0.f};
    bf16x8 At[4][2], B0[2][2], B1[2][2];
    const char* cA = cur.A; const char* cB = cur.B;
    if constexpr (Epi::SCL) PG8_SCLDMA(cur, 0);
    if constexpr (GATHER) {
        PG8_TOKDMA((const int*)cur.p0, PG8_TB(0)); PG8_WAIT_V(0); PG8_BAR; asm volatile("" ::: "memory");
        PG8_TOKOFF(voffA, PG8_TB(0)); PG8_WAIT_L(0); asm volatile("" ::: "memory");
    } else if constexpr (Epi::SCL) { PG8_WAIT_V(0); PG8_BAR; asm volatile("" ::: "memory"); }
    PG8_STAGE(PG8_SB(0, 0), cB, voffB); PG8_STAGE(PG8_SB(0, 1), cB + hstep, voffB); PG8_STAGE(PG8_SA(0, 0), cA, voffA[0]); PG8_STAGE_A1(PG8_SA(0, 1), cA);
    if (wr == 1) PG8_BAR;
    PG8_WAIT_V(2); PG8_BAR;
    PG8_STAGE(PG8_SB(1, 0), cB + kstep, voffB); PG8_STAGE(PG8_SA(1, 0), cA + kstepA, voffA[0]); PG8_STAGE(PG8_SB(1, 1), cB + hstep + kstep, voffB);
    PG8_WAIT_V(6); PG8_BAR;
    for (;;) {
        const bool has_next = S.next(ui + 1, nxt);
        if constexpr (Epi::SCL) { if (has_next) PG8_SCLDMA(nxt, ui + 1); }
        if constexpr (GATHER) { if (has_next) PG8_TOKDMA((const int*)nxt.p0, PG8_TB(ui + 1)); }
        const char* nA = has_next ? nxt.A : cA; const char* nB = has_next ? nxt.B : cB;
        for (int t = 0; t < nt; t += 2) {
            const bool last = (t == nt - 2);
            const char* a1 = cA + (size_t)(t + 1) * kstepA;
            const char* a2 = last ? nA : cA + (size_t)(t + 2) * kstepA; const char* b2 = last ? nB : cB + (size_t)(t + 2) * kstep;
            const char* a3 = a2 + kstepA; const char* b3 = b2 + kstep;
            PG8_LDB(B0, 0, 0); PG8_LDB(B1, 0, 1); PG8_SCHED; PG8_LDA(At, 0, 0); PG8_STAGE_A1(PG8_SA(1, 1), a1);
            if constexpr (GATHER) { if (last && has_next) { PG8_TOKOFF(voffA, PG8_TB(ui + 1)); } }
            PG8_WAIT_V(8); PG8_WAIT_L(0); PG8_BAR; PG8_MMA(0, 0, At, B0); PG8_MMA(0, 1, At, B1); PG8_BAR; PG8_SCHED;
            PG8_LDA(At, 0, 1); PG8_STAGE(PG8_SB(0, 0), b2, voffB); PG8_STAGE(PG8_SB(0, 1), b2 + hstep, voffB); PG8_STAGE(PG8_SA(0, 0), a2, voffA[0]);
            PG8_WAIT_V(8); PG8_WAIT_L(0); PG8_BAR; PG8_MMA(1, 0, At, B0); PG8_MMA(1, 1, At, B1); PG8_BAR; PG8_SCHED;
            PG8_LDB(B0, 1, 0); PG8_LDB(B1, 1, 1); PG8_SCHED; PG8_LDA(At, 1, 0); PG8_STAGE_A1(PG8_SA(0, 1), a2);
            PG8_WAIT_V(8); PG8_WAIT_L(0); PG8_BAR; PG8_MMA(0, 0, At, B0); PG8_MMA(0, 1, At, B1); PG8_BAR; PG8_SCHED;
            PG8_LDA(At, 1, 1); PG8_STAGE(PG8_SB(1, 0), b3, voffB); PG8_STAGE(PG8_SB(1, 1), b3 + hstep, voffB); PG8_STAGE(PG8_SA(1, 0), a3, voffA[0]);
            PG8_WAIT_V(8); PG8_WAIT_L(0); PG8_BAR; PG8_MMA(1, 0, At, B0); PG8_MMA(1, 1, At, B1); PG8_BAR; PG8_SCHED;
        }
        if (wr == 0) PG8_BAR;
#ifndef EPIX
#define EPIX 1
#endif
        for (int e_ = 0; e_ < EPIX; ++e_) E(acc, cur, wr, wc, fr, fq, PG8_TB(ui), PG8_SCB(ui));
        if (!has_next) break;
#pragma unroll
        for (int a = 0; a < 2; ++a)
#pragma unroll
            for (int b = 0; b < 2; ++b)
#pragma unroll
                for (int m = 0; m < 4; ++m)
#pragma unroll
                    for (int n = 0; n < 2; ++n) acc[a][b][m][n] = (f32x4){0.f, 0.f, 0.f, 0.f};
        cur = nxt; cA = nA; cB = nB; ++ui;
        if (wr == 1) PG8_BAR;
    }
    PG8_WAIT_V(0);
    PG8_BAR;
#undef PG8_SA
#undef PG8_SB
#undef PG8_STAGE
#undef PG8_LDA
#undef PG8_STAGE_A1
#undef PG8_LDB
#undef PG8_MMA
#undef PG8_CAT8
#undef PG8_WAIT_V
#undef PG8_WAIT_L
#undef PG8_BAR
#undef PG8_SCHED
#undef PG8_TOKOFF
#undef PG8_TOKDMA
#undef PG8_TB
#undef PG8_SCB
#undef PG8_SCLDMA
}
}

struct Args { const float* in[17]; float* out; unsigned char* ws; int lo, hi, breg, pad; };
struct Frame {
    LAS unsigned char* lds; volatile LAS unsigned* MISC; unsigned* ctl; int tid, lane, wave, G, bid;
    const float *x, *g_mpre, *g_mpost, *g_fpre, *g_fpost, *w_in, *pool_w, *pool_scale, *rpb, *w_out, *dwg, *dwu, *dwd, *router, *mwg, *mwu, *mwd;
    float* out; unsigned char* ws;
};

__device__ __forceinline__ void p0_transpose_item(const float* W, int K, int N, bf16* WT, int kb, int n0, int row_base, LAS float* scr, int lane) {
    const int k0 = 64 * kb;
#pragma unroll 8
    for (int i = 0; i < 32; ++i) { const int kk = 2 * i + (lane >> 5); scr[kk * 33 + (lane & 31)] = W[(size_t)(k0 + kk) * N + n0 + (lane & 31)]; }
    LDS_WAIT(); asm volatile("" ::: "memory");
    const int c = lane & 7;
#pragma unroll
    for (int j = 0; j < 4; ++j) { const int n = (lane >> 3) + 8 * j; const LAS float* s = scr + (8 * c) * 33 + n;
        v4u o; o.x = pk2(s[0 * 33], s[1 * 33]); o.y = pk2(s[2 * 33], s[3 * 33]); o.z = pk2(s[4 * 33], s[5 * 33]); o.w = pk2(s[6 * 33], s[7 * 33]);
        *(v4u*)(WT + (size_t)(row_base + n) * K + k0 + 8 * c) = o; }
    LDS_WAIT(); asm volatile("" ::: "memory");
}
__device__ __forceinline__ void p0_matrix(const float* W, int K, int N, bf16* WT, int ilv_half, LAS float* scr, int lane, int gw, int NGW, int& base) {
    const int nblk = N / 32, nitems = (K / 64) * nblk;
    int it = gw - (base % NGW); if (it < 0) it += NGW;
    for (; it < nitems; it += NGW) { const int kb = it / nblk, n0 = 32 * (it % nblk);
        const int rb = ilv_half < 0 ? n0 : (n0 / 128) * 256 + (n0 % 128) + 128 * ilv_half;
        p0_transpose_item(W, K, N, WT, kb, n0, rb, scr, lane); }
    base += nitems;
}
__device__ __forceinline__ void p0_transpose_item_fp8(const float* W, int K, int N, unsigned char* WT, int kt, int n0, int row_base, float scale, LAS float* scr, int lane) {
    const int k0 = 128 * kt;
#pragma unroll 8
    for (int i = 0; i < 64; ++i) { const int kk = 2 * i + (lane >> 5); scr[kk * 33 + (lane & 31)] = W[(size_t)(k0 + kk) * N + n0 + (lane & 31)] * scale; }
    LDS_WAIT(); asm volatile("" ::: "memory");
    const int c = lane & 7;
#pragma unroll 1
    for (int pass = 0; pass < 4; ++pass) { const int n = (lane >> 3) + 8 * pass; const LAS float* sp = scr + (16 * c) * 33 + n;
        v4u o;
#pragma unroll
        for (int d = 0; d < 4; ++d) { int w = 0; w = __builtin_amdgcn_cvt_pk_fp8_f32(sp[(4 * d) * 33], sp[(4 * d + 1) * 33], w, false); w = __builtin_amdgcn_cvt_pk_fp8_f32(sp[(4 * d + 2) * 33], sp[(4 * d + 3) * 33], w, true); o[d] = (unsigned)w; }
        *(v4u*)(WT + (size_t)(row_base + n) * K + k0 + 16 * c) = o; }
    LDS_WAIT(); asm volatile("" ::: "memory");
}
__device__ __forceinline__ void p0_transpose_item_fp6(const float* W, int K, int N, unsigned char* WT, int kt, int n0, int row_base, float scale, LAS float* scr, int lane) {
    const int k0 = 128 * kt;
#pragma unroll 8
    for (int i = 0; i < 64; ++i) { const int kk = 2 * i + (lane >> 5); scr[kk * 33 + (lane & 31)] = W[(size_t)(k0 + kk) * N + n0 + (lane & 31)] * scale; }
    LDS_WAIT(); asm volatile("" ::: "memory");
    const int n = lane & 31, g = lane >> 5;
    unsigned char* rp = WT + (size_t)(row_base + n) * K + 128 * kt;
#pragma unroll 1
    for (int h = 0; h < 2; ++h) { const int fq = 2 * h + g; const LAS float* sp = scr + (32 * fq) * 33 + n;
        f32x16 x, y;
#pragma unroll
        for (int i = 0; i < 16; ++i) { x[i] = sp[i * 33]; y[i] = sp[(16 + i) * 33]; }
        const i32x6 o = __builtin_amdgcn_cvt_scalef32_2xpk16_fp6_f32(x, y, 1.0f);
        *(v4u*)(rp + 16 * fq) = (v4u){(unsigned)o[0], (unsigned)o[1], (unsigned)o[2], (unsigned)o[3]};
        *(v4u*)(rp + 64 + 16 * fq) = (v4u){(unsigned)o[4], (unsigned)o[5], 0u, 0u}; }
    LDS_WAIT(); asm volatile("" ::: "memory");
}
__device__ __forceinline__ void p0_matrix_fp6(const float* W, int K, int N, unsigned char* WT, int ilv_half, float scale, LAS float* scr, int lane, int gw, int NGW, int& base) {
    const int nblk = N / 32, nitems = (K / 128) * nblk;
    int it = gw - (base % NGW); if (it < 0) it += NGW;
    for (; it < nitems; it += NGW) { const int kt = it / nblk, n0 = 32 * (it % nblk);
        const int rb = (n0 / 128) * 256 + (n0 % 128) + 128 * ilv_half;
        p0_transpose_item_fp6(W, K, N, WT, kt, n0, rb, scale, scr, lane); }
    base += nitems;
}
__device__ __forceinline__ void p0_matrix_fp8(const float* W, int K, int N, unsigned char* WT, int ilv_half, float scale, LAS float* scr, int lane, int gw, int NGW, int& base) {
    const int nblk = N / 32, nitems = (K / 128) * nblk;
    int it = gw - (base % NGW); if (it < 0) it += NGW;
    for (; it < nitems; it += NGW) { const int kt = it / nblk, n0 = 32 * (it % nblk);
        const int rb = ilv_half < 0 ? n0 : (n0 / 128) * 256 + (n0 % 128) + 128 * ilv_half;
        p0_transpose_item_fp8(W, K, N, WT, kt, n0, rb, scale, scr, lane); }
    base += nitems;
}
__device__ __forceinline__ void rms_row_to_bf16(const float* xrow, const float* g, bf16* orow, int lane) {
    const f32x4* xr = (const f32x4*)xrow + lane; const f32x4* gr = (const f32x4*)g + lane;
    f32x4 v[4]; float s = 0.f;
#pragma unroll
    for (int j = 0; j < 4; ++j) { v[j] = xr[64 * j]; s += (v[j].x * v[j].x + v[j].y * v[j].y) + (v[j].z * v[j].z + v[j].w * v[j].w); }
    const float rstd = 1.0f / sqrtf(wave_sum(s) * (1.f / D) + RMS_EPS);
    v2u* o8 = (v2u*)orow + lane;
#pragma unroll
    for (int j = 0; j < 4; ++j) { const f32x4 gg = gr[64 * j]; v2u w; w.x = pk2(v[j].x * rstd * gg.x, v[j].y * rstd * gg.y); w.y = pk2(v[j].z * rstd * gg.z, v[j].w * rstd * gg.w); o8[64 * j] = w; }
}
__device__ __forceinline__ float wave_max(float v) {
#pragma unroll
    for (int o = 1; o < 64; o <<= 1) v = fmaxf(v, __shfl_xor(v, o));
    return v;
}
__device__ __forceinline__ void p0_colblock_i8(Frame& F, const float* W, int N, int n0, unsigned char* W8, float* sW, int dest0) {
    const int tid = F.tid, lane = F.lane, wid = F.wave, n = lane & 31, kh = lane >> 5;
    LAS float* slab = (LAS float*)F.lds; LAS float* cmax = (LAS float*)(F.lds + RING_BYTES);
    __syncthreads();
    float mx = 0.f;
#pragma unroll 1
    for (int i0 = 0; i0 < 64; i0 += 16) {
        float v[16];
#pragma unroll
        for (int i = 0; i < 16; ++i) v[i] = W[(size_t)(128 * wid + 2 * (i0 + i) + kh) * N + n0 + n];
#pragma unroll
        for (int i = 0; i < 16; ++i) { const int k = 128 * wid + 2 * (i0 + i) + kh; slab[k * 32 + (n ^ (k & 31))] = v[i]; mx = fmaxf(mx, fabsf(v[i])); }
    }
    cmax[wid * 64 + lane] = mx;
    __syncthreads();
    float amax = 0.f;
#pragma unroll
    for (int w = 0; w < 8; ++w) amax = fmaxf(amax, fmaxf(cmax[w * 64 + n], cmax[w * 64 + 32 + n]));
    const float sc = amax > 0.f ? amax * (1.0f / 127.0f) : 1.0f, inv = amax > 0.f ? 127.0f / amax : 0.f;
    const int kc = tid >> 5, dest = dest0 + n;
#pragma unroll 1
    for (int q4 = 0; q4 < 4; ++q4) { v4u o;
#pragma unroll
        for (int d = 0; d < 4; ++d) { unsigned w = 0u;
#pragma unroll
            for (int j = 0; j < 4; ++j) { const int k = 64 * kc + 16 * q4 + 4 * d + j; w |= ((unsigned)__float2int_rn(slab[k * 32 + (n ^ (k & 31))] * inv) & 0xffu) << (8 * j); }
            o[d] = w; }
        *(v4u*)(W8 + (size_t)dest * D + 64 * kc + 16 * q4) = o; }
    if (kc == 0) sW[dest] = sc;
}
__device__ __forceinline__ void p0_i8_weights(Frame& F) {
    constexpr int NB_D = I8_DENSE ? 2 * (DFF / 32) : 0, NB_P = I8_PROJ ? DEPTH * (DIN / 32) : 0;
    for (int cb = F.bid; cb < NB_D + NB_P; cb += F.G) {
        if (cb < NB_D) { const int half = cb / (DFF / 32), n0 = 32 * (cb % (DFF / 32));
            p0_colblock_i8(F, half ? F.dwu : F.dwg, DFF, n0, F.ws + WS_WGU0, (float*)(F.ws + WS_SW0), (n0 / 128) * 256 + (n0 % 128) + 128 * half); }
        else { const int c2 = cb - NB_D, l = c2 / (DIN / 32), n0 = 32 * (c2 % (DIN / 32));
            p0_colblock_i8(F, F.w_in + (size_t)l * D * DIN, DIN, n0, F.ws + WS_WIN + (size_t)l * DIN * D, (float*)(F.ws + WS_SWIN) + l * DIN, n0); }
    }
    __syncthreads();
}
__device__ __forceinline__ void rms_row_to_i8(const float* xrow, const float* g, unsigned char* orow, float* sa, int lane) {
    const f32x4* xr = (const f32x4*)xrow + lane; const f32x4* gr = (const f32x4*)g + lane;
    f32x4 v[4]; float s = 0.f;
#pragma unroll
    for (int j = 0; j < 4; ++j) { v[j] = xr[64 * j]; s += (v[j].x * v[j].x + v[j].y * v[j].y) + (v[j].z * v[j].z + v[j].w * v[j].w); }
    const float rstd = 1.0f / sqrtf(wave_sum(s) * (1.f / D) + RMS_EPS); float am = 0.f;
#pragma unroll
    for (int j = 0; j < 4; ++j) { v[j] = v[j] * rstd * gr[64 * j]; am = fmaxf(fmaxf(am, fmaxf(fabsf(v[j].x), fabsf(v[j].y))), fmaxf(fabsf(v[j].z), fabsf(v[j].w))); }
    am = wave_max(am); const float inv = am > 0.f ? 127.0f / am : 0.f;
#pragma unroll
    for (int j = 0; j < 4; ++j) ((unsigned*)orow + lane)[64 * j] = ((unsigned)__float2int_rn(v[j].x * inv) & 0xffu) | (((unsigned)__float2int_rn(v[j].y * inv) & 0xffu) << 8) | (((unsigned)__float2int_rn(v[j].z * inv) & 0xffu) << 16) | (((unsigned)__float2int_rn(v[j].w * inv) & 0xffu) << 24);
    if (lane == 0) *sa = am > 0.f ? am * (1.0f / 127.0f) : 1.0f;
}
__device__ __forceinline__ void p0_prologue(Frame& F0) {
    Frame F = F0; { int t_ = threadIdx.x; asm volatile("" : "+v"(t_)); F.tid = t_; F.lane = t_ & 63; F.wave = __builtin_amdgcn_readfirstlane(t_ >> 6); }
    LAS float* scr = (LAS float*)(F.lds + F.wave * 16896);
    const int gw = F.bid * 8 + F.wave, NGW = F.G * 8, gt = F.bid * 512 + F.tid, NGT = F.G * 512;
    { v4u z = (v4u){0u, 0u, 0u, 0u}; v4u* L = (v4u*)(F.ws + WS_LIST); for (int i = gt; i < (int)(NE * T / 4); i += NGT) L[i] = z;
      int* id = (int*)(F.ws + WS_LISTID); for (int i = gt; i < T; i += NGT) id[i] = i; }
    int base = 0;
    for (int l = 0; l < DEPTH; ++l) {
#if !I8_PROJ
        p0_matrix(F.w_in + (size_t)l * D * DIN, D, DIN, (bf16*)(F.ws + WS_WIN) + (size_t)l * DIN * D, -1, scr, F.lane, gw, NGW, base);
#endif
        p0_matrix(F.w_out + (size_t)l * D * D, D, D, (bf16*)(F.ws + WS_WOUT) + (size_t)l * D * D, -1, scr, F.lane, gw, NGW, base);
        for (int g = 0; g < 4; ++g) p0_matrix(F.pool_w + (size_t)(l * 4 + g) * 128 * 128, 128, 128, (bf16*)(F.ws + WS_WP) + (size_t)(l * 4 + g) * 128 * 128, -1, scr, F.lane, gw, NGW, base);
    }
#if !I8_DENSE
    p0_matrix(F.dwg, D, DFF, (bf16*)(F.ws + WS_WGU0), 0, scr, F.lane, gw, NGW, base);
    p0_matrix(F.dwu, D, DFF, (bf16*)(F.ws + WS_WGU0), 1, scr, F.lane, gw, NGW, base);
#endif
#if FP8_DDOWN
    p0_matrix_fp8(F.dwd, DFF, D, F.ws + WS_WD0, -1, W8_DN, scr, F.lane, gw, NGW, base);
#else
    p0_matrix(F.dwd, DFF, D, (bf16*)(F.ws + WS_WD0), -1, scr, F.lane, gw, NGW, base);
#endif
    for (int e = 0; e < NE; ++e) {
#if FP8_MOE
#if FP6_UP
        p0_matrix_fp6(F.mwg + (size_t)e * D * DFFE, D, DFFE, F.ws + WS_WGUM + (size_t)e * 2 * DFFE * D, 0, S6W, scr, F.lane, gw, NGW, base);
        p0_matrix_fp6(F.mwu + (size_t)e * D * DFFE, D, DFFE, F.ws + WS_WGUM + (size_t)e * 2 * DFFE * D, 1, S6W, scr, F.lane, gw, NGW, base);
#else
        p0_matrix_fp8(F.mwg + (size_t)e * D * DFFE, D, DFFE, F.ws + WS_WGUM + (size_t)e * 2 * DFFE * D, 0, W8_UP, scr, F.lane, gw, NGW, base);
        p0_matrix_fp8(F.mwu + (size_t)e * D * DFFE, D, DFFE, F.ws + WS_WGUM + (size_t)e * 2 * DFFE * D, 1, W8_UP, scr, F.lane, gw, NGW, base);
#endif
        p0_matrix_fp8(F.mwd + (size_t)e * DFFE * D, DFFE, D, F.ws + WS_WDM + (size_t)e * D * DFFE, -1, W8_DN, scr, F.lane, gw, NGW, base);
#else
        p0_matrix(F.mwg + (size_t)e * D * DFFE, D, DFFE, (bf16*)(F.ws + WS_WGUM) + (size_t)e * 2 * DFFE * D, 0, scr, F.lane, gw, NGW, base);
        p0_matrix(F.mwu + (size_t)e * D * DFFE, D, DFFE, (bf16*)(F.ws + WS_WGUM) + (size_t)e * 2 * DFFE * D, 1, scr, F.lane, gw, NGW, base);
        p0_matrix(F.mwd + (size_t)e * DFFE * D, DFFE, D, (bf16*)(F.ws + WS_WDM) + (size_t)e * D * DFFE, -1, scr, F.lane, gw, NGW, base);
#endif
    }
    bf16* HN = (bf16*)(F.ws + WS_HN);
#if I8_PROJ
    for (int m = gw; m < T; m += NGW) rms_row_to_i8(F.x + (size_t)m * D, F.g_mpre, (unsigned char*)HN + (size_t)m * D, (float*)(F.ws + WS_SA) + m, F.lane);
#else
    for (int m = gw; m < T; m += NGW) rms_row_to_bf16(F.x + (size_t)m * D, F.g_mpre, HN + (size_t)m * D, F.lane);
#endif
#if I8_DENSE || I8_PROJ
    p0_i8_weights(F);
#endif
}

__device__ __forceinline__ unsigned ld_cnt(const unsigned* ctl, int e) { return __hip_atomic_load(ctl + CW_CNT + 64 * e, RLX_AGENT); }

__device__ __forceinline__ void ld_bf16_row(const bf16* row, int lane, f32x4 (&v)[4]) {
    const v2u* p = (const v2u*)row + lane;
#pragma unroll
    for (int j = 0; j < 4; ++j) { const v2u w = p[64 * j]; v[j] = (f32x4){bflo(w.x), bfhi(w.x), bflo(w.y), bfhi(w.y)}; }
}
__device__ __forceinline__ float sumsq16(const f32x4 (&v)[4]) {
    float s = 0.f;
#pragma unroll
    for (int j = 0; j < 4; ++j) s += (v[j].x * v[j].x + v[j].y * v[j].y) + (v[j].z * v[j].z + v[j].w * v[j].w);
    return s;
}
#define H16 FP8_MOE
struct NormRow { v2u a[4]; v2u b[4]; f32x4 hf[4]; v2u hb[4]; float g0, g1; };
template <bool FFN>
__device__ __forceinline__ void norm_phase(Frame& F0, int l) {
    Frame F = F0; { int t_ = threadIdx.x; asm volatile("" : "+v"(t_)); F.tid = t_; F.lane = t_ & 63; F.wave = __builtin_amdgcn_readfirstlane(t_ >> 6); }
    const int lane = F.lane, gw = F.bid * 8 + F.wave, NGW = F.G * 8;
    const bool moe = (l & 1) != 0;
    LAS float* WR = (LAS float*)F.lds;
    LAS unsigned* lcnt = (LAS unsigned*)(F.lds + LCNT_OFF); LAS unsigned* lbase = lcnt + 8;
    LAS int* bst = (LAS int*)(F.lds + BST_OFF);
    LAS float* rowbuf = (LAS float*)(F.lds + 32768 + F.wave * 4352);
    if (!FFN && moe) {
        for (int i = F.tid; i < D * NE; i += 512) { const int d = i >> 3, e = i & 7; WR[e * D + d] = F.router[i]; }
        if (F.tid < 8) lcnt[F.tid] = 0u;
        __syncthreads();
    }
    if (FFN && moe) {
        if (F.tid == 0) { int s = 0; for (int e = 0; e < NE; ++e) { bst[e] = s; s += (int)((ld_cnt(F.ctl, e) + 255u) >> 8); } }
        __syncthreads();
    }
    const float* gA = FFN ? F.g_fpost + l * D : F.g_mpost + l * D;
    const float* gB = FFN ? F.g_mpre + (l + 1) * D : F.g_fpre + l * D;
    const bool haveB = FFN ? (l + 1 < DEPTH) : true;
    const bool last = FFN && (l + 1 == DEPTH);
    const bool I8HN = FFN ? (I8_PROJ != 0) : (I8_DENSE && !moe);
    const bool hold_f32 = (!FFN && l == 0) || !H16;
    const bf16* addsrc = FFN ? (const bf16*)(F.ws + WS_Y) : (const bf16*)(F.ws + WS_MIX);
    const float* hold32 = (!FFN && l == 0) ? F.x : F.out;
    bf16* H = (bf16*)(F.ws + WS_H16);
    bf16* HN = (bf16*)(F.ws + WS_HN);
    const v2u* info = (const v2u*)(F.ws + WS_INFO); const f32x2* ginfo = (const f32x2*)(F.ws + WS_INFO + 256 * 1024);
#define NORM_LOAD(R, m_, nf_, gg_) do { \
        if (FFN && moe) { const int e0_ = (int)((nf_).x >> 16), p0_ = (int)((nf_).x & 0xffffu), e1_ = (int)((nf_).y >> 16), p1_ = (int)((nf_).y & 0xffffu); \
            if (Y8_MOE) { const unsigned* pa_ = (const unsigned*)((const unsigned char*)addsrc + (size_t)(256 * bst[e0_] + p0_) * D) + lane; const unsigned* pb_ = (const unsigned*)((const unsigned char*)addsrc + (size_t)(256 * bst[e1_] + p1_) * D) + lane; \
                _Pragma("unroll") for (int j = 0; j < 4; ++j) { (R).a[j].x = pa_[64 * j]; (R).b[j].x = pb_[64 * j]; } (R).g0 = (gg_).x * (1.0f / YS); (R).g1 = (gg_).y * (1.0f / YS); }   \
            else { const v2u* pa_ = (const v2u*)(addsrc + (size_t)(256 * bst[e0_] + p0_) * D) + lane; const v2u* pb_ = (const v2u*)(addsrc + (size_t)(256 * bst[e1_] + p1_) * D) + lane; \
            _Pragma("unroll") for (int j = 0; j < 4; ++j) { (R).a[j] = pa_[64 * j]; (R).b[j] = pb_[64 * j]; } (R).g0 = (gg_).x; (R).g1 = (gg_).y; } } \
        else { const v2u* pa_ = (const v2u*)(addsrc + (size_t)(m_) * D) + lane; _Pragma("unroll") for (int j = 0; j < 4; ++j) (R).a[j] = pa_[64 * j]; } \
        if (hold_f32) { const f32x4* hp_ = (const f32x4*)(hold32 + (size_t)(m_) * D) + lane; _Pragma("unroll") for (int j = 0; j < 4; ++j) (R).hf[j] = hp_[64 * j]; } \
        else { const v2u* hp_ = (const v2u*)(H + (size_t)(m_) * D) + lane; _Pragma("unroll") for (int j = 0; j < 4; ++j) (R).hb[j] = hp_[64 * j]; } } while (0)
    int sTok = 0, sE0 = 0, sE1 = 0; float sG0 = 0.f, sG1 = 0.f;
    v2u nfL = (v2u){0u, 0u}; f32x2 ggL = (f32x2){0.f, 0.f};
    if (FFN && moe) { const int mi = gw + lane * NGW; if (mi < T) { nfL = info[mi]; ggL = ginfo[mi]; } }
    const int nfLx = (int)nfL.x, nfLy = (int)nfL.y; const float ggLx_ = ggL.x, ggLy_ = ggL.y; const int ggLx = __float_as_int(ggLx_), ggLy = __float_as_int(ggLy_);
#define NORM_INFO(nf_, gg_, it_) do { if (FFN && moe) { const int x_ = __builtin_amdgcn_readlane(nfLx, it_), y_ = __builtin_amdgcn_readlane(nfLy, it_), gx_ = __builtin_amdgcn_readlane(ggLx, it_), gy_ = __builtin_amdgcn_readlane(ggLy, it_); \
        (nf_).x = (unsigned)x_; (nf_).y = (unsigned)y_; (gg_).x = __int_as_float(gx_); (gg_).y = __int_as_float(gy_); } } while (0)
#define NORM_ROW(R, m_, it_) do { \
        f32x4 a[4]; \
        _Pragma("unroll") for (int j = 0; j < 4; ++j) { \
            if (FFN && moe && Y8_MOE) { const int wa_ = (int)(R).a[j].x, wb_ = (int)(R).b[j].x; const f32x2 a01 = __builtin_amdgcn_cvt_pk_f32_fp8(wa_, false), a23 = __builtin_amdgcn_cvt_pk_f32_fp8(wa_, true), b01 = __builtin_amdgcn_cvt_pk_f32_fp8(wb_, false), b23 = __builtin_amdgcn_cvt_pk_f32_fp8(wb_, true); \
                a[j] = (f32x4){a01.x, a01.y, a23.x, a23.y} * (R).g0 + (f32x4){b01.x, b01.y, b23.x, b23.y} * (R).g1; } \
            else { a[j] = (f32x4){bflo((R).a[j].x), bfhi((R).a[j].x), bflo((R).a[j].y), bfhi((R).a[j].y)}; \
            if (FFN && moe) { const f32x4 b = (f32x4){bflo((R).b[j].x), bfhi((R).b[j].x), bflo((R).b[j].y), bfhi((R).b[j].y)}; a[j] = a[j] * (R).g0 + b * (R).g1; } } } \
        const float r1 = 1.0f / sqrtf(wave_sum(sumsq16(a)) * (1.f / D) + RMS_EPS); \
        const f32x4* gAp = (const f32x4*)gA + lane; \
        f32x4 h[4]; \
        _Pragma("unroll") for (int j = 0; j < 4; ++j) { const f32x4 ho = hold_f32 ? (R).hf[j] : (f32x4){bflo((R).hb[j].x), bfhi((R).hb[j].x), bflo((R).hb[j].y), bfhi((R).hb[j].y)}; h[j] = ho + a[j] * r1 * gAp[64 * j]; } \
        if (last || !H16) { f32x4* op = (f32x4*)(F.out + (size_t)(m_) * D) + lane; _Pragma("unroll") for (int j = 0; j < 4; ++j) op[64 * j] = h[j]; } \
        else { v2u* op = (v2u*)(H + (size_t)(m_) * D) + lane; _Pragma("unroll") for (int j = 0; j < 4; ++j) { v2u w; w.x = cvt_pk_bf16(h[j].x, h[j].y); w.y = cvt_pk_bf16(h[j].z, h[j].w); op[64 * j] = w; } } \
        if (haveB) { \
            const float r2 = 1.0f / sqrtf(wave_sum(sumsq16(h)) * (1.f / D) + RMS_EPS); \
            const f32x4* gBp = (const f32x4*)gB + lane; v2u* o8 = (v2u*)(HN + (size_t)(m_) * D) + lane; \
            _Pragma("unroll") for (int j = 0; j < 4; ++j) { h[j] = h[j] * r2 * gBp[64 * j]; \
                if (FP8_MOE && FP6_UP && !FFN && moe) { const int e_ = 256 * j + 4 * lane, ix_ = e_ + (e_ >> 5); rowbuf[ix_] = h[j].x * S6A; rowbuf[ix_ + 1] = h[j].y * S6A; rowbuf[ix_ + 2] = h[j].z * S6A; rowbuf[ix_ + 3] = h[j].w * S6A; } \
                else if (FP8_MOE && !FFN && moe) { int w = 0; w = __builtin_amdgcn_cvt_pk_fp8_f32(h[j].x, h[j].y, w, false); w = __builtin_amdgcn_cvt_pk_fp8_f32(h[j].z, h[j].w, w, true); ((unsigned*)((unsigned char*)HN + (size_t)(m_) * D) + lane)[64 * j] = (unsigned)w; } \
                else if (!I8HN) { v2u w; w.x = cvt_pk_bf16(h[j].x, h[j].y); w.y = cvt_pk_bf16(h[j].z, h[j].w); o8[64 * j] = w; } } \
            if (FP8_MOE && FP6_UP && !FFN && moe) { asm volatile("s_waitcnt lgkmcnt(0)" ::: "memory"); \
                if (lane < 32) { f32x16 x_, y_; _Pragma("unroll") for (int i = 0; i < 16; ++i) { x_[i] = rowbuf[33 * lane + i]; y_[i] = rowbuf[33 * lane + 16 + i]; } \
                    const i32x6 o_ = __builtin_amdgcn_cvt_scalef32_2xpk16_fp6_f32(x_, y_, 1.0f); unsigned char* rp_ = (unsigned char*)HN + (size_t)(m_) * D + 128 * (lane >> 2); \
                    *(v4u*)(rp_ + 16 * (lane & 3)) = (v4u){(unsigned)o_[0], (unsigned)o_[1], (unsigned)o_[2], (unsigned)o_[3]}; *(v4u*)(rp_ + 64 + 16 * (lane & 3)) = (v4u){(unsigned)o_[4], (unsigned)o_[5], 0u, 0u}; } \
                asm volatile("s_waitcnt lgkmcnt(0)" ::: "memory"); } \
            if (I8HN) { float am = 0.f; \
                _Pragma("unroll") for (int j = 0; j < 4; ++j) am = fmaxf(fmaxf(am, fmaxf(fabsf(h[j].x), fabsf(h[j].y))), fmaxf(fabsf(h[j].z), fabsf(h[j].w))); \
                am = wave_max(am); const float sa_ = am > 0.f ? am * (1.0f / 127.0f) : 1.0f, inv_ = am > 0.f ? 127.0f / am : 0.f; \
                _Pragma("unroll") for (int j = 0; j < 4; ++j) { const unsigned w = ((unsigned)__float2int_rn(h[j].x * inv_) & 0xffu) | (((unsigned)__float2int_rn(h[j].y * inv_) & 0xffu) << 8) | (((unsigned)__float2int_rn(h[j].z * inv_) & 0xffu) << 16) | (((unsigned)__float2int_rn(h[j].w * inv_) & 0xffu) << 24); \
                    ((unsigned*)((unsigned char*)HN + (size_t)(m_) * D) + lane)[64 * j] = w; } \
                if (lane == 0) ((float*)(F.ws + WS_SA))[(m_)] = sa_; } \
            if (!FFN && moe) { \
                float lg[NE]; \
                _Pragma("unroll") for (int e = 0; e < NE; ++e) { float s_ = 0.f; \
                    _Pragma("unroll") for (int j = 0; j < 4; ++j) { const f32x4 w = *(const LAS f32x4*)(WR + e * D + 256 * j + 4 * lane); s_ += (h[j].x * w.x + h[j].y * w.y) + (h[j].z * w.z + h[j].w * w.w); } \
                    lg[e] = wave_sum(s_); } \
                int e0 = 0; float l0 = lg[0]; \
                _Pragma("unroll") for (int e = 1; e < NE; ++e) if (lg[e] > l0) { l0 = lg[e]; e0 = e; } \
                int e1 = -1; float l1 = -INFINITY; \
                _Pragma("unroll") for (int e = 0; e < NE; ++e) if (e != e0 && lg[e] > l1) { l1 = lg[e]; e1 = e; } \
                const float g0 = 1.0f / (1.0f + __expf(l1 - l0)), g1 = 1.0f - g0; \
                if (lane == (it_)) { sTok = (m_); sE0 = e0; sE1 = e1; sG0 = g0; sG1 = g1; } \
            } \
        } } while (0)
    int it = 0;
    NormRow c0, c1; v2u nf = (v2u){0u, 0u}; f32x2 gg = (f32x2){0.f, 0.f};
    if (gw < T) { NORM_INFO(nf, gg, 0); NORM_LOAD(c0, gw, nf, gg); }
    if (gw + NGW < T) { NORM_INFO(nf, gg, 1); NORM_LOAD(c1, gw + NGW, nf, gg); }
    for (int m = gw; m < T; m += 2 * NGW, it += 2) {
        const int m1 = m + NGW, m2 = m + 2 * NGW, m3 = m + 3 * NGW;
        NormRow n0, n1;
        if (m2 < T) { NORM_INFO(nf, gg, it + 2); NORM_LOAD(n0, m2, nf, gg); }
        if (m3 < T) { NORM_INFO(nf, gg, it + 3); NORM_LOAD(n1, m3, nf, gg); }
        NORM_ROW(c0, m, it);
        if (m1 < T) NORM_ROW(c1, m1, it + 1);
        c0 = n0; c1 = n1;
    }
    it = (T - gw + NGW - 1) / NGW; if (it < 0) it = 0;
#undef NORM_ROW
#undef NORM_INFO
#undef NORM_LOAD
    if (!FFN && moe) {
        unsigned loc0 = 0u, loc1 = 0u;
        if (lane < it) { loc0 = __hip_atomic_fetch_add(lcnt + sE0, 1u, __ATOMIC_RELAXED, __HIP_MEMORY_SCOPE_WORKGROUP); loc1 = __hip_atomic_fetch_add(lcnt + sE1, 1u, __ATOMIC_RELAXED, __HIP_MEMORY_SCOPE_WORKGROUP); }
        __syncthreads();
        if (F.tid < 8) lbase[F.tid] = __hip_atomic_fetch_add(F.ctl + CW_CNT + 64 * F.tid, lcnt[F.tid], RLX_AGENT);
        __syncthreads();
        if (lane < it) {
            const unsigned p0 = lbase[sE0] + loc0, p1 = lbase[sE1] + loc1;
            int* list = (int*)(F.ws + WS_LIST);
            list[(size_t)sE0 * T + p0] = sTok; list[(size_t)sE1 * T + p1] = sTok;
            v2u nf; nf.x = ((unsigned)sE0 << 16) | p0; nf.y = ((unsigned)sE1 << 16) | p1;
            ((v2u*)(F.ws + WS_INFO))[sTok] = nf; ((f32x2*)(F.ws + WS_INFO + 256 * 1024))[sTok] = (f32x2){sG0, sG1};
        }
    }
}

__device__ __forceinline__ size_t mixo_index(size_t tok, int ch) { return ((tok >> 8) * 16 + (size_t)(ch >> 6)) * (256 * 64) + (tok & 255) * 64 + (ch & 63); }
constexpr int U_PITCH = 1040, U_ROWS = 80, BIAS_OFF = U_PITCH * U_ROWS;
typedef __bf16 bf16x2_t __attribute__((ext_vector_type(2)));
template <int HW>
__device__ __forceinline__ void pool_frags(bf16x8 (&dfr)[2][4], const LAS unsigned char* cb, const float (&inv)[2]) {
    unsigned one_lo_ = 0x00003f80u, one_hi_ = 0x3f800000u; asm volatile("" : "+v"(one_lo_), "+v"(one_hi_));
    const bf16x2_t ONE_LO = __builtin_bit_cast(bf16x2_t, one_lo_), ONE_HI = __builtin_bit_cast(bf16x2_t, one_hi_);
#pragma unroll
    for (int mt = 0; mt < 2; ++mt)
#pragma unroll
        for (int ks = 0; ks < 4; ++ks) {
            const LAS unsigned char* cp = cb + mt * 16 * U_PITCH + ks * 64;
            float s0 = 0.f, s1 = 0.f, s2 = 0.f, s3 = 0.f, s4 = 0.f, s5 = 0.f, s6 = 0.f, s7 = 0.f;
#pragma unroll
            for (int d = -HW; d < HW; ++d) { const v4u v = *(const LAS v4u*)(cp + d * U_PITCH); const unsigned vx = v.x, vy = v.y, vz = v.z, vw = v.w;
                const bf16x2_t px = __builtin_bit_cast(bf16x2_t, vx), py = __builtin_bit_cast(bf16x2_t, vy), pz = __builtin_bit_cast(bf16x2_t, vz), pw = __builtin_bit_cast(bf16x2_t, vw);
                s0 = __builtin_amdgcn_fdot2_f32_bf16(px, ONE_LO, s0, false); s1 = __builtin_amdgcn_fdot2_f32_bf16(px, ONE_HI, s1, false);
                s2 = __builtin_amdgcn_fdot2_f32_bf16(py, ONE_LO, s2, false); s3 = __builtin_amdgcn_fdot2_f32_bf16(py, ONE_HI, s3, false);
                s4 = __builtin_amdgcn_fdot2_f32_bf16(pz, ONE_LO, s4, false); s5 = __builtin_amdgcn_fdot2_f32_bf16(pz, ONE_HI, s5, false);
                s6 = __builtin_amdgcn_fdot2_f32_bf16(pw, ONE_LO, s6, false); s7 = __builtin_amdgcn_fdot2_f32_bf16(pw, ONE_HI, s7, false); }
            const v4u c = *(const LAS v4u*)cp; const float iv = inv[mt];
            v4u p; p.x = cvt_pk_bf16(s0 * iv - bflo(c.x), s1 * iv - bfhi(c.x)); p.y = cvt_pk_bf16(s2 * iv - bflo(c.y), s3 * iv - bfhi(c.y));
            p.z = cvt_pk_bf16(s4 * iv - bflo(c.z), s5 * iv - bfhi(c.z)); p.w = cvt_pk_bf16(s6 * iv - bflo(c.w), s7 * iv - bfhi(c.w));
            dfr[mt][ks] = __builtin_bit_cast(bf16x8, p);
        }
}
__device__ __forceinline__ void mixer_phase(Frame& F0, int l) {
    Frame F = F0; { int t_ = threadIdx.x; asm volatile("" : "+v"(t_)); F.tid = t_; F.lane = t_ & 63; F.wave = __builtin_amdgcn_readfirstlane(t_ >> 6); }
    const int tid = F.tid, lane = F.lane, wid = F.wave, fr = lane & 15, fq = lane >> 4;
    const bf16* proj = (const bf16*)(F.ws + WS_PROJ); bf16* mixo = (bf16*)(F.ws + WS_MIXO);
    const bf16* Wp = (const bf16*)(F.ws + WS_WP) + (size_t)l * 4 * 128 * 128; const float* pscale = F.pool_scale + l * DPOOL;
    const int vcu = (F.G % 8 == 0) ? (F.bid % 8) * (F.G / 8) + F.bid / 8 : F.bid;
    for (int unit = vcu; unit < BATCH * GROWS; unit += F.G) {
        const int b = unit / GROWS, r = unit % GROWS, tb0 = b * SEQ, trow0 = 64 * r - 8;
        __syncthreads();
        { v4u uv[10];
#pragma unroll
          for (int k = 0; k < 10; ++k) { const int idx = tid + 512 * k, row = idx >> 6, pc = idx & 63, t = trow0 + row; uv[k] = (v4u){0u, 0u, 0u, 0u}; if (t >= 0 && t < SEQ) uv[k] = *(const v4u*)(proj + (size_t)(tb0 + t) * UPITCH + pc * 8); }
#pragma unroll
          for (int k = 0; k < 10; ++k) { const int idx = tid + 512 * k, row = idx >> 6, pc = idx & 63; *(LAS v4u*)(F.lds + row * U_PITCH + pc * 16) = uv[k]; } }
        __syncthreads();
#ifndef REP_POOL
#define REP_POOL 1
#endif
        for (int rep_ = 0; rep_ < REP_POOL; ++rep_) {
            const int g = wid >> 1, half = wid & 1, hw = 1 << g;
            const bf16* Wg = Wp + (size_t)g * 128 * 128;
            bf16x8 wnext[4];
#pragma unroll
            for (int ks = 0; ks < 4; ++ks) wnext[ks] = *(const bf16x8*)(Wg + (size_t)fr * 128 + 32 * ks + 8 * fq);
            bf16x8 dfr[2][4];
            { const LAS unsigned char* cb = F.lds + (8 + 32 * half + fr) * U_PITCH + (128 * g + 8 * fq) * 2;
              float inv[2];
#pragma unroll
              for (int mt = 0; mt < 2; ++mt) { const int t = 64 * r + 32 * half + 16 * mt + fr; inv[mt] = 1.0f / (float)(min(t + hw, SEQ) - max(t - hw, 0)); }
              switch (g) { case 0: pool_frags<1>(dfr, cb, inv); break; case 1: pool_frags<2>(dfr, cb, inv); break; case 2: pool_frags<4>(dfr, cb, inv); break; default: pool_frags<8>(dfr, cb, inv); break; } }
#pragma unroll
            for (int nt = 0; nt < 8; ++nt) {
                bf16x8 wf[4];
#pragma unroll
                for (int ks = 0; ks < 4; ++ks) wf[ks] = wnext[ks];
                if (nt + 1 < 8) {
#pragma unroll
                    for (int ks = 0; ks < 4; ++ks) wnext[ks] = *(const bf16x8*)(Wg + (size_t)(16 * (nt + 1) + fr) * 128 + 32 * ks + 8 * fq); }
                const f32x4 sc = *(const f32x4*)(pscale + 128 * g + 16 * nt + 4 * fq);
#pragma unroll
                for (int mt = 0; mt < 2; ++mt) {
                    f32x4 acc = (f32x4){0.f, 0.f, 0.f, 0.f};
#pragma unroll
                    for (int ks = 0; ks < 4; ++ks) acc = __builtin_amdgcn_mfma_f32_16x16x32_bf16(wf[ks], dfr[mt][ks], acc, 0, 0, 0);
                    acc = acc * sc;
                    v2u w; w.x = cvt_pk_bf16(acc[0], acc[1]); w.y = cvt_pk_bf16(acc[2], acc[3]);
                    *(v2u*)(mixo + mixo_index((size_t)(tb0 + 64 * r + 32 * half + 16 * mt + fr), 128 * g + 16 * nt + 4 * fq)) = w;
                }
            }
        }
    }
    __syncthreads();
}

constexpr int NA_KTOK = 80, NA_KROW = 64 * NA_KTOK, NA_VD = 144, NA_VROW = 32 * NA_VD, NA_NKR = 11, NA_NPC = NA_NKR * 256;
constexpr int NA_K_OFF = 0, NA_V_OFF = NA_NKR * NA_KROW, NA_B_OFF = NA_V_OFF + NA_NKR * NA_VROW;
static_assert(NA_B_OFF + 15 * 128 <= RING_BYTES, "NA LDS map");
#ifndef REP_NA
#define REP_NA 1
#endif
__device__ __forceinline__ void na_phase(Frame& F0, int l) {
    Frame F = F0; { int t_ = threadIdx.x; asm volatile("" : "+v"(t_)); F.tid = t_; F.lane = t_ & 63; F.wave = __builtin_amdgcn_readfirstlane(t_ >> 6); }
    const int tid = F.tid, lane = F.lane, wid = F.wave, fr = lane & 15, fq = lane >> 4;
    const bf16* projq = (const bf16*)(F.ws + WS_PQ); const bf16* projk = (const bf16*)(F.ws + WS_PK); const bf16* Vt = (const bf16*)(F.ws + WS_VT); bf16* mixo = (bf16*)(F.ws + WS_MIXO);
    const float* rpb = F.rpb + (size_t)l * NH * 15 * 31;
    const int vcu = (F.G % 8 == 0) ? (F.bid % 8) * (F.G / 8) + F.bid / 8 : F.bid;
    constexpr int NU = BATCH * NH * (GROWS / 4);
    const int upc = (NU + F.G - 1) / F.G, u0 = vcu * upc, u1 = min(u0 + upc, NU);
    v4u kreg[6], vreg[6];
    int w_hi = -1, w_bh = -1;
#define NA_UNIT(u, b, h, sg, krlo, nrows) const int b = (u) / (NH * 64), h = ((u) / 64) % NH, sg = (u) % 64, krlo = min(max(4 * sg - 4, 0), GROWS - KH), nrows = min(NA_NKR, GROWS - krlo)
#define NA_PLAN(u, newlo, nnew) NA_UNIT(u, pb_, ph_, psg_, pkrlo_, pnrows_); const bool keep_ = ((u) / 64 == w_bh) && pkrlo_ <= w_hi && pkrlo_ + NA_NKR > w_hi - 1; \
        const int newlo = keep_ ? max(pkrlo_, w_hi) : pkrlo_, nnew = pkrlo_ + pnrows_ - newlo; (void)psg_
#define NA_LOAD(newlo, nnew, b_, h_) do { const size_t tb_ = (size_t)(b_) * SEQ + 64 * (newlo); \
        _Pragma("unroll") for (int k = 0; k < 6; ++k) { const int p = tid + 512 * k, row = p >> 8, rem = p & 255; \
            if (row < (nnew)) { kreg[k] = *(const v4u*)(projk + ((size_t)(h_) * T + tb_ + 64 * row + (rem >> 2)) * 32 + 8 * (rem & 3)); \
                vreg[k] = *(const v4u*)(Vt + vt_index(32 * (h_) + (rem >> 3), (int)tb_ + 64 * row) + 8 * (rem & 7)); } } } while (0)
    int c_newlo = 0, c_nnew = 0;
    if (u0 < u1) { NA_PLAN(u0, nl_, nn_); c_newlo = nl_; c_nnew = nn_; NA_LOAD(nl_, nn_, pb_, ph_); }
    for (int u = u0; u < u1; ++u) {
        NA_UNIT(u, b, h, sg, krlo, nrows);
        __syncthreads();
#pragma unroll
        for (int k = 0; k < 6; ++k) { const int p = tid + 512 * k, row = p >> 8, rem = p & 255;
            if (row < c_nnew) { const int slot = (c_newlo + row) % NA_NKR;
                *(LAS v4u*)(F.lds + NA_K_OFF + slot * NA_KROW + (rem >> 2) * NA_KTOK + 16 * (rem & 3)) = kreg[k];
                *(LAS v4u*)(F.lds + NA_V_OFF + slot * NA_VROW + (rem >> 3) * NA_VD + 16 * (rem & 7)) = vreg[k]; } }
        if (tid < 15 * 32) { const int col = tid & 31, row = tid >> 5; *(LAS float*)(F.lds + NA_B_OFF + tid * 4) = col < 31 ? rpb[(h * 15 + row) * 31 + col] * LOG2E : -INFINITY; }
        __syncthreads();
        w_hi = krlo + nrows; w_bh = u / 64;
        if (u + 1 < u1) { NA_PLAN(u + 1, nl_, nn_); c_newlo = nl_; c_nnew = nn_; NA_LOAD(nl_, nn_, pb_, ph_); }
        const size_t tb0 = (size_t)b * SEQ;
#pragma unroll 1
        for (int tt = 0; tt < 2; ++tt) {
            const int t = wid + 8 * tt, j = t >> 2, qb = t & 3, r = 4 * sg + j, r0 = min(max(r - KH / 2, 0), GROWS - KH);
            const int cs = qb == 0 ? 0 : (qb == 1 ? 8 : (qb == 2 ? 24 : 32));
            const int c = 16 * qb + fr, c0 = min(max(c - KW / 2, 0), GRIDW - KW);
            const int th = c0 - cs;
            bool vq[4]; int boff[4];
#pragma unroll
            for (int q = 0; q < 4; ++q) { vq[q] = (4 * fq + q) >= th; boff[q] = (cs + 4 * fq + q + (vq[q] ? 0 : 16) - c + KW - 1) * 4; }
            const unsigned M0 = (vq[0] ? 0xffffu : 0u) | (vq[1] ? 0xffff0000u : 0u), M1 = (vq[2] ? 0xffffu : 0u) | (vq[3] ? 0xffff0000u : 0u), N0 = ~M0, N1 = ~M1;
            const size_t qtok = tb0 + 64 * r + 16 * qb + fr;
            const bf16x8 qf = *(const bf16x8*)(projq + ((size_t)h * T + qtok) * 32 + 8 * fq);
            int slot[KH];
#pragma unroll
            for (int kr = 0; kr < KH; ++kr) slot[kr] = (r0 + kr) % NA_NKR;
            const LAS unsigned char* kb = F.lds + NA_K_OFF + (cs + fr) * NA_KTOK + 16 * fq;
            const LAS unsigned char* bb = F.lds + NA_B_OFF + (r0 - r + KH - 1) * 128;
            f32x2 sv[KH][2];
            float mx = -INFINITY;
#pragma unroll
            for (int kr = 0; kr < KH; ++kr) {
                f32x4 bv;
#pragma unroll
                for (int q = 0; q < 4; ++q) bv[q] = *(const LAS float*)(bb + boff[q] + kr * 128);
                const f32x4 s0 = __builtin_amdgcn_mfma_f32_16x16x32_bf16(*(const LAS bf16x8*)(kb + slot[kr] * NA_KROW), qf, bv, 0, 0, 0);
                const f32x4 s1 = __builtin_amdgcn_mfma_f32_16x16x32_bf16(*(const LAS bf16x8*)(kb + slot[kr] * NA_KROW + 16 * NA_KTOK), qf, bv, 0, 0, 0);
                const float e0 = vq[0] ? s0[0] : s1[0], e1 = vq[1] ? s0[1] : s1[1], e2 = vq[2] ? s0[2] : s1[2], e3 = vq[3] ? s0[3] : s1[3];
                sv[kr][0] = (f32x2){e0, e1}; sv[kr][1] = (f32x2){e2, e3};
                mx = fmaxf(fmaxf(mx, e0), e1); mx = fmaxf(fmaxf(mx, e2), e3);
            }
            mx = fmaxf(mx, __shfl_xor(mx, 16)); mx = fmaxf(mx, __shfl_xor(mx, 32));
            const f32x2 mx2 = (f32x2){mx, mx};
            f32x2 sum2 = (f32x2){0.f, 0.f};
#pragma unroll
            for (int kr = 0; kr < KH; ++kr)
#pragma unroll
                for (int hh = 0; hh < 2; ++hh) { const f32x2 dlt = sv[kr][hh] - mx2; f32x2 p; p.x = __builtin_amdgcn_exp2f(dlt.x); p.y = __builtin_amdgcn_exp2f(dlt.y); sv[kr][hh] = p; sum2 += p; }
            float sum = sum2.x + sum2.y;
            sum += __shfl_xor(sum, 16); sum += __shfl_xor(sum, 32);
            const LAS unsigned char* vb = F.lds + NA_V_OFF + fr * NA_VD + (cs + 4 * fq) * 2;
            f32x4 o[2] = {(f32x4){0.f, 0.f, 0.f, 0.f}, (f32x4){0.f, 0.f, 0.f, 0.f}};
#pragma unroll
            for (int kr = 0; kr < KH; ++kr) {
                const unsigned u01 = cvt_pk_bf16(sv[kr][0].x, sv[kr][0].y), u23 = cvt_pk_bf16(sv[kr][1].x, sv[kr][1].y);
                v4u pw; pw.x = u01 & M0; pw.y = u23 & M1; pw.z = u01 & N0; pw.w = u23 & N1;
                const bf16x8 pf = __builtin_bit_cast(bf16x8, pw);
#pragma unroll
                for (int dt = 0; dt < 2; ++dt) {
                    const LAS unsigned char* vp = vb + slot[kr] * NA_VROW + 16 * dt * NA_VD;
                    const v2u lo = *(const LAS v2u*)vp, hi = *(const LAS v2u*)(vp + 32);
                    v4u vw; vw.x = lo.x; vw.y = lo.y; vw.z = hi.x; vw.w = hi.y;
                    o[dt] = __builtin_amdgcn_mfma_f32_16x16x32_bf16(__builtin_bit_cast(bf16x8, vw), pf, o[dt], 0, 0, 0);
                }
            }
            const float inv = __builtin_amdgcn_rcpf(sum);
            bf16* orow = mixo + mixo_index(qtok, DPOOL + 32 * h + 4 * fq);
#pragma unroll
            for (int dt = 0; dt < 2; ++dt) { v2u w; w.x = cvt_pk_bf16(o[dt][0] * inv, o[dt][1] * inv); w.y = cvt_pk_bf16(o[dt][2] * inv, o[dt][3] * inv); *(v2u*)(orow + 16 * dt) = w; }
        }
    }
    __syncthreads();
#undef NA_UNIT
#undef NA_PLAN
#undef NA_LOAD
}

struct SchedProj {
    const char* hn; const char* win; bf16* proj; bf16* vt; int G, c, esz; const float* sa; const float* sw;
    __device__ __forceinline__ bool next(int i, pg8::Unit& u) const {
        int pm, pn; if (!pg8::tile_order(i, G, c, T / 256, 8, pm, pn)) return false;
        const size_t tstep = (size_t)256 * D * esz;
        if (pn < 6) { u.A = hn + pm * tstep; u.B = win + pn * tstep; u.orow = 256 * pm;
            if (pn < 2) { u.obase = proj; u.ocol = 256 * pn; u.ldc = UPITCH; } else { u.obase = proj + (size_t)(pn >> 1) * T * 512; u.ocol = 256 * (pn & 1); u.ldc = 0; }
            u.scale = (pn == 2 || pn == 3) ? QSCALE : 1.0f; u.p0 = sa + 256 * pm; u.cs = sw + 256 * pn; }
        else { u.A = win + pn * tstep; u.B = hn + pm * tstep; u.obase = vt; u.orow = 256 * (pn - 6); u.ocol = 256 * pm; u.ldc = -1; u.scale = 1.0f; u.p0 = sw + 256 * pn; u.cs = sa + 256 * pm; }
        return true;
    }
};
struct SchedOut {
    const char* a; const char* w; bf16* o; int G, c;
    __device__ __forceinline__ bool next(int i, pg8::Unit& u) const {
        int pm, pn; if (!pg8::tile_order(i, G, c, T / 256, 4, pm, pn)) return false;
        const size_t tstep = (size_t)256 * D * 2; u.p0 = nullptr; u.cs = nullptr;
        u.A = a + pm * tstep; u.B = w + pn * tstep; u.obase = o; u.orow = 256 * pm; u.ocol = 256 * pn; u.ldc = D; u.scale = 1.0f; return true;
    }
};
__device__ __forceinline__ void ffn_table(Frame& F0, bool moe) {
    Frame F = F0; { int t_ = threadIdx.x; asm volatile("" : "+v"(t_)); F.tid = t_; F.lane = t_ & 63; F.wave = __builtin_amdgcn_readfirstlane(t_ >> 6); }
    LAS int* blk = (LAS int*)(F.lds + BLK_OFF); LAS int* bst = (LAS int*)(F.lds + BST_OFF);
    __syncthreads();
    if (F.tid == 0) { int s = 0; for (int e = 0; e < NE; ++e) { bst[e] = s; s += moe ? (int)((ld_cnt(F.ctl, e) + 255u) >> 8) : (e == 0 ? T / 256 : 0); } bst[8] = s; }
    __syncthreads();
    for (int b = F.tid; b < MAXBLK + 8; b += 512) { int e = 0; for (int k = 1; k < NE; ++k) if (b >= bst[k]) e = k; blk[b] = e; }
    __syncthreads();
}
__device__ __forceinline__ bool tail_reduce(Frame& F0) {
    int t_ = threadIdx.x; asm volatile("" : "+v"(t_));
    const int lane = t_ & 63, gw = F0.bid * 8 + __builtin_amdgcn_readfirstlane(t_ >> 6), NGW = F0.G * 8;
    int nb = 0;
    for (int e = 0; e < NE; ++e) nb += (int)((ld_cnt(F0.ctl, e) + 255u) >> 8);
    const int nrows = (nb - 256) * 256;
    if (nrows <= 0) return false;
    const bf16* part = (const bf16*)(F0.ws + WS_TAILPART);
#if Y8_MOE
    unsigned char* y8 = F0.ws + WS_Y + (size_t)256 * 256 * D; const bf16* part6 = (const bf16*)(F0.ws + WS_TAILPART6);
    for (int r = gw; r < nrows; r += NGW) {
        v4u w[TAILSPLIT][2];
#pragma unroll
        for (int h = 0; h < 2; ++h) {
#pragma unroll
            for (int p = 0; p < TAILSPLIT; ++p) w[p][h] = *((const v4u*)((p < 6 ? part + ((size_t)p * TAILPART_ROWS + r) * D : part6 + (size_t)r * D)) + lane + 64 * h); }
#pragma unroll
        for (int h = 0; h < 2; ++h) { float v[8];
#pragma unroll
            for (int j = 0; j < 4; ++j) { float lo = 0.f, hi = 0.f;
#pragma unroll
                for (int p = 0; p < TAILSPLIT; ++p) { lo += bflo(w[p][h][j]); hi += bfhi(w[p][h][j]); }
                v[2 * j] = lo * YS; v[2 * j + 1] = hi * YS; }
            int w0 = 0, w1 = 0;
            w0 = __builtin_amdgcn_cvt_pk_fp8_f32(v[0], v[1], w0, false); w0 = __builtin_amdgcn_cvt_pk_fp8_f32(v[2], v[3], w0, true);
            w1 = __builtin_amdgcn_cvt_pk_fp8_f32(v[4], v[5], w1, false); w1 = __builtin_amdgcn_cvt_pk_fp8_f32(v[6], v[7], w1, true);
            v2u o; o.x = (unsigned)w0; o.y = (unsigned)w1;
            *((v2u*)(y8 + (size_t)r * D) + lane + 64 * h) = o; }
    }
#else
    bf16* y = (bf16*)(F0.ws + WS_Y) + (size_t)256 * 256 * D;
    for (int r = gw; r < nrows; r += NGW) {
        v4u w[TAILSPLIT][2];
#pragma unroll
        for (int h = 0; h < 2; ++h) { w[0][h] = *((const v4u*)(y + (size_t)r * D) + lane + 64 * h);
#pragma unroll
            for (int p = 1; p < TAILSPLIT; ++p) w[p][h] = *((const v4u*)(part + ((size_t)(p - 1) * TAILPART_ROWS + r) * D) + lane + 64 * h); }
#pragma unroll
        for (int h = 0; h < 2; ++h) { v4u o;
#pragma unroll
            for (int j = 0; j < 4; ++j) { float lo = 0.f, hi = 0.f;
#pragma unroll
                for (int p = 0; p < TAILSPLIT; ++p) { lo += bflo(w[p][h][j]); hi += bfhi(w[p][h][j]); }
                o[j] = cvt_pk_bf16(lo, hi); }
            *((v4u*)(y + (size_t)r * D) + lane + 64 * h) = o; }
    }
#endif
    return true;
}
template <bool TILED> struct SchedUpT {
    const char* hn; const char* wgu; const int* lists; bf16* hff; LAS int* blk; LAS int* bst; int G, c, cstart, nblk, nN, F_, moe, esz;
    __device__ __forceinline__ bool next(int i, pg8::Unit& u) const {
        int pm, pn; if (!pg8::tile_order(i, G, c, nblk, nN, pm, pn)) return false;
        const int b = cstart + pm, e = __builtin_amdgcn_readfirstlane(blk[b]), lb = b - __builtin_amdgcn_readfirstlane(bst[e]);
        u.A = hn; u.p0 = lists + (moe ? (size_t)e * T + 256 * lb : (size_t)256 * b); u.cs = nullptr;
        u.B = wgu + ((size_t)e * 2 * F_ + 256 * pn) * D * esz; u.obase = hff; u.orow = 256 * pm; u.ocol = 128 * pn; u.ldc = F_; u.scale = 1.0f;
        if constexpr (TILED) { u.obase = (bf16*)((char*)hff + ((size_t)pm * nN + pn) * HFF_TILE - 128 * pn - (size_t)256 * pm * 128); }
        return true;
    }
};
template <bool TILED, bool Y8 = false> struct SchedDownT {
    const char* hff; const char* wd; bf16* y; LAS int* blk; int G, c, cstart, nblk, F_, esz; float scale; const int* idl; int pm0, split;
    __device__ __forceinline__ bool next(int i, pg8::Unit& u) const {
        int pm, pn; if (!pg8::tile_order(i, G, c, nblk, 4 * split, pm, pn)) return false;
        const int p = pn >> 2; pn &= 3;
        const int b = cstart + pm, e = __builtin_amdgcn_readfirstlane(blk[b]); u.p0 = idl; u.cs = nullptr;
        const size_t koff = (size_t)p * (F_ / split) * esz;
        u.A = hff + (size_t)(pm0 + pm) * 256 * F_ * esz + (TILED ? (size_t)p * (F_ / split / 128) * HFF_TILE : koff); u.B = wd + ((size_t)e * D + 256 * pn) * F_ * esz + koff;
        const int img = Y8 ? p : p - 1;
        const long long poff = (split == 1 || img < 0) ? 0ll : (img < 6 ? ((long long)WS_TAILPART - (long long)WS_Y) / 2 + (long long)img * TAILPART_ROWS * D : ((long long)WS_TAILPART6 - (long long)WS_Y) / 2);
        u.obase = y + poff; u.orow = (split == 1 || img < 0) ? 256 * b : 256 * pm; u.ocol = 256 * pn; u.ldc = D; u.scale = scale; return true;
    }
};

constexpr int STEPS_PER_LAYER = 16, NSTEPS = 1 + DEPTH * STEPS_PER_LAYER;
#define RUN(s) (lo <= (s) && (s) < hi)
#ifndef BARX
#define BARX 1
#endif
#define SEAM(s) do { if (RUN(s) && RUN((s) + 1)) { for (int b_ = 0; b_ < BARX; ++b_) xcd_barrier(bar); } } while (0)
template <int L>
__device__ __forceinline__ void run_layer(Frame& F, const XcdBarrier& bar, const int lo, const int hi) {
    constexpr int l = L, base = 1 + STEPS_PER_LAYER * L; constexpr bool moe = (L & 1) != 0, f8 = FP8_MOE && moe, i8 = I8_DENSE && !moe; constexpr bool h8 = f8 || (FP8_DDOWN && !moe);
    LAS int* tokbuf = (LAS int*)(F.lds + TOKBUF_OFF); LAS int* blk = (LAS int*)(F.lds + BLK_OFF); LAS int* bst = (LAS int*)(F.lds + BST_OFF);
    const char* HN = (const char*)(F.ws + WS_HN);
#ifndef NO_P1
    if (RUN(base + 0)) {
        SchedProj S{HN, (const char*)(F.ws + WS_WIN) + (size_t)l * DIN * D * (I8_PROJ ? 1 : 2), (bf16*)(F.ws + WS_PROJ), (bf16*)(F.ws + WS_VT), F.G, F.bid, I8_PROJ ? 1 : 2, (const float*)(F.ws + WS_SA), (const float*)(F.ws + WS_SWIN) + l * DIN};
        if constexpr (I8_PROJ != 0) pg8::gemm_phase<pg8::EpiProj_I8, SchedProj, false, 2>(F.lds, tokbuf, D / 2, S, pg8::EpiProj_I8{});
        else pg8::gemm_phase<pg8::EpiProj, SchedProj, false>(F.lds, tokbuf, D, S, pg8::EpiProj{});
    } SEAM(base + 0);
#endif
#ifndef NO_P2
#ifndef NA_CALLS
#define NA_CALLS 1
#endif
#ifndef POOL_CALLS
#define POOL_CALLS 1
#endif
    if (RUN(base + 1)) { for (int i_ = 0; i_ < POOL_CALLS; ++i_) mixer_phase(F, l); for (int i_ = 0; i_ < NA_CALLS; ++i_) na_phase(F, l); } SEAM(base + 1);
#endif
#ifndef NO_P3
    if (RUN(base + 2)) {
        SchedOut S{(const char*)(F.ws + WS_MIXO), (const char*)(F.ws + WS_WOUT) + (size_t)l * D * D * 2, (bf16*)(F.ws + WS_MIX), F.G, F.bid};
        pg8::gemm_phase<pg8::EpiBf16, SchedOut, false>(F.lds, tokbuf, D, S, pg8::EpiBf16{}, D, 64, 256 * 128);
    } SEAM(base + 2);
#endif
#ifndef NO_P4
    if (RUN(base + 3)) { norm_phase<false>(F, l); } SEAM(base + 3);
#endif
    constexpr int F_ = moe ? DFFE : DFF, cblk = h8 ? 2 * CHUNK_BLK : CHUNK_BLK;
    bool table = false; int NB = 0;
    for (int c = 0; c < MAXCHUNK; ++c) {
        const int s5 = base + 4 + 2 * c, s6 = s5 + 1;
        if (!(RUN(s5) || RUN(s6))) continue;
        if (!table) { ffn_table(F, moe); NB = __builtin_amdgcn_readfirstlane(bst[8]); table = true; }
        const int cstart = c * cblk; int nblk = min(NB - cstart, cblk);
        if constexpr (f8) { if (c == 1) nblk = NB - cstart; else if (c > 1) continue; }
        if (nblk <= 0) continue;
#ifndef NO_P5
        if (RUN(s5)) {
            typedef SchedUpT<h8> SchedUp; SchedUp S{HN, moe ? (const char*)(F.ws + WS_WGUM) : (const char*)(F.ws + WS_WGU0), moe ? (const int*)(F.ws + WS_LIST) : (const int*)(F.ws + WS_LISTID), (bf16*)(F.ws + WS_HFF), blk, bst, F.G, F.bid, cstart, nblk, F_ / 128, F_, moe ? 1 : 0, (f8 || i8) ? 1 : 2};
            if constexpr (f8 && FP6_UP) pg8::gemm_phase<pg8::EpiSwiGLU6, SchedUp, true, 3>(F.lds, tokbuf, D / 2, S, pg8::EpiSwiGLU6{});
            else if constexpr (f8) pg8::gemm_phase<pg8::EpiSwiGLU8, SchedUp, true, 1>(F.lds, tokbuf, D / 2, S, pg8::EpiSwiGLU8{});
            else if constexpr (i8) pg8::gemm_phase<pg8::EpiSwiGLU_I8, SchedUp, true, 2>(F.lds, tokbuf, D / 2, S, pg8::EpiSwiGLU_I8{(const float*)(F.ws + WS_SA), (const float*)(F.ws + WS_SW0), (const int*)(F.ws + WS_LISTID)});
            else pg8::gemm_phase<pg8::EpiSwiGLU, SchedUp, true>(F.lds, tokbuf, D, S, pg8::EpiSwiGLU{});
        } SEAM(s5);
#endif
#ifndef NO_P6
        if (RUN(s6)) {
            const int nfull = h8 ? min(nblk, cblk) : nblk;
            constexpr bool y8 = Y8_MOE && f8;
            typedef SchedDownT<h8, y8> SchedDown; SchedDown S{(const char*)(F.ws + WS_HFF), moe ? (const char*)(F.ws + WS_WDM) : (const char*)(F.ws + WS_WD0), (bf16*)(F.ws + WS_Y), blk, F.G, F.bid, cstart, nfull, F_, h8 ? 1 : 2, (h8 ? 1.0f / W8_DN : 1.0f) * (y8 ? YS : 1.0f), (const int*)(F.ws + WS_LISTID), 0, 1};
            if constexpr (h8) {
                const int npass = (f8 && nblk > nfull) ? 2 : 1;
                if constexpr (y8) {
                    pg8::gemm_phase<pg8::EpiY8, SchedDown, true, 1>(F.lds, tokbuf, F_ / 2, S, pg8::EpiY8{}, F_ / 2, 64, HFF_TILE);
                    if (npass > 1) { const SchedDown S2{(const char*)(F.ws + WS_HFF), (const char*)(F.ws + WS_WDM), (bf16*)(F.ws + WS_Y), blk, F.G, F.bid, cstart + nfull, nblk - nfull, F_, 1, 1.0f / W8_DN, (const int*)(F.ws + WS_LISTID), nfull, TAILSPLIT};
                        int ksplit = F_ / 2 / TAILSPLIT; asm volatile("" : "+s"(ksplit));
                        pg8::gemm_phase<pg8::EpiBf16, SchedDown, true, 1>(F.lds, tokbuf, ksplit, S2, pg8::EpiBf16{}, F_ / 2, 64, HFF_TILE); }
                } else {
#pragma clang loop unroll(disable)
                for (int pass = 0; pass < npass; ++pass) {
                    if (pass == 1) { S.cstart = cstart + nfull; S.nblk = nblk - nfull; S.pm0 = nfull; S.split = TAILSPLIT; }
                    pg8::gemm_phase<pg8::EpiBf16, SchedDown, true, 1>(F.lds, tokbuf, pass == 0 ? F_ / 2 : F_ / 2 / TAILSPLIT, S, pg8::EpiBf16{}, F_ / 2, 64, HFF_TILE);
                }
                }
            }
            else pg8::gemm_phase<pg8::EpiBf16, SchedDown, false>(F.lds, tokbuf, F_, S, pg8::EpiBf16{});
        } SEAM(s6);
#endif
    }
#ifndef NO_P7
    if (RUN(base + 14)) { if constexpr (f8) { if (tail_reduce(F)) xcd_barrier(bar); } norm_phase<true>(F, l); }
#endif
    if (l + 1 < DEPTH) { if (RUN(base + 14) && RUN(base + 16)) xcd_barrier(bar); }
}
__global__ void __launch_bounds__(512, 2) mk_fwd(Args args) {
    extern __shared__ __attribute__((aligned(16))) unsigned char lds_raw[];
    Frame F;
    F.lds = (LAS unsigned char*)lds_raw; F.MISC = (volatile LAS unsigned*)(F.lds + MISC_OFF);
    F.tid = threadIdx.x; F.lane = F.tid & 63; F.wave = __builtin_amdgcn_readfirstlane(F.tid >> 6); F.G = gridDim.x; F.bid = blockIdx.x;
    F.ws = args.ws; F.ctl = (unsigned*)(args.ws + WS_CTL); F.out = args.out;
    F.x = args.in[0]; F.g_mpre = args.in[1]; F.g_mpost = args.in[2]; F.g_fpre = args.in[3]; F.g_fpost = args.in[4]; F.w_in = args.in[5]; F.pool_w = args.in[6]; F.pool_scale = args.in[7];
    F.rpb = args.in[8]; F.w_out = args.in[9]; F.dwg = args.in[10]; F.dwu = args.in[11]; F.dwd = args.in[12]; F.router = args.in[13]; F.mwg = args.in[14]; F.mwu = args.in[15]; F.mwd = args.in[16];
    if (F.tid < 16) F.MISC[F.tid] = 0u;
    __syncthreads();
    const int lo = args.lo, hi = args.hi;
    XcdBarrier bar; bar.bar = F.ctl + CW_BAR + args.breg * XCD_BAR_WORDS; bar.x = 0; bar.st = F.MISC;
    if (hi - lo > 1) bar = xcd_barrier_post(F.ctl + CW_BAR + args.breg * XCD_BAR_WORDS, F.MISC);
#ifndef NO_P0
#ifndef REP_P0
#define REP_P0 1
#endif
    if (RUN(0)) { for (int r_ = 0; r_ < REP_P0; ++r_) p0_prologue(F); } SEAM(0);
#endif
    run_layer<0>(F, bar, lo, hi);
    run_layer<1>(F, bar, lo, hi);
}
#undef RUN
#undef SEAM

__global__ void __launch_bounds__(64) nk_gemm(const bf16* A, int lda, const bf16* Bt, int ldb, int K, bf16* O, int ldo, float scale, int sc_lo, int sc_hi, int vt) {
    const int m0 = 32 * blockIdx.y, n0 = 32 * blockIdx.x, lane = threadIdx.x, fr = lane & 15, fq = lane >> 4;
    f32x4 acc[2][2];
#pragma unroll
    for (int a = 0; a < 2; ++a)
#pragma unroll
        for (int b = 0; b < 2; ++b) acc[a][b] = (f32x4){0.f, 0.f, 0.f, 0.f};
    for (int k0 = 0; k0 < K; k0 += 32) {
        bf16x8 a[2], b[2];
#pragma unroll
        for (int i = 0; i < 2; ++i) { a[i] = *(const bf16x8*)(A + (size_t)(m0 + 16 * i + fr) * lda + k0 + 8 * fq); b[i] = *(const bf16x8*)(Bt + (size_t)(n0 + 16 * i + fr) * ldb + k0 + 8 * fq); }
#pragma unroll
        for (int mt = 0; mt < 2; ++mt)
#pragma unroll
            for (int nt = 0; nt < 2; ++nt) acc[mt][nt] = __builtin_amdgcn_mfma_f32_16x16x32_bf16(a[mt], b[nt], acc[mt][nt], 0, 0, 0);
    }
#pragma unroll
    for (int mt = 0; mt < 2; ++mt)
#pragma unroll
        for (int nt = 0; nt < 2; ++nt)
#pragma unroll
            for (int q = 0; q < 4; ++q) { const int m = m0 + 16 * mt + 4 * fq + q, n = n0 + 16 * nt + fr; const float sc = (n >= sc_lo && n < sc_hi) ? scale : 1.0f;
                O[vt ? vt_index(m, n) : (size_t)m * ldo + n] = (bf16)f2bf(acc[mt][nt][q] * sc); }
}
__global__ void nk_blocktab(const unsigned* ctl, int* btab, int moe) {
    if (threadIdx.x != 0 || blockIdx.x != 0) return;
    int b = 0;
    for (int e = 0; e < NE; ++e) { const int nb = moe ? (int)((ctl[CW_CNT + 64 * e] + 255u) >> 8) : (e == 0 ? T / 256 : 0); for (int k = 0; k < nb; ++k) btab[b++] = e | (k << 8); }
    btab[MAXBLK] = b;
}
__global__ void __launch_bounds__(64) nk_ffn_up(const bf16* hn, const bf16* wgu, const int* lists, const int* btab, bf16* hff, int cstart, int F_, int moe) {
    const int m0 = 32 * blockIdx.y, f0 = 32 * blockIdx.x, lane = threadIdx.x, fr = lane & 15, fq = lane >> 4;
    const int b = cstart + m0 / 256; if (b >= btab[MAXBLK]) return;
    const int e = btab[b] & 0xff, lb = btab[b] >> 8;
    const int* list = lists + (moe ? (size_t)e * T + 256 * lb : (size_t)256 * b) + (m0 % 256);
    const bf16* W = wgu + (size_t)e * 2 * F_ * D; const int rg = (f0 / 128) * 256 + (f0 % 128);
    const bf16* arow[2]; arow[0] = hn + (size_t)list[fr] * D; arow[1] = hn + (size_t)list[16 + fr] * D;
    f32x4 ag[2][2], au[2][2];
#pragma unroll
    for (int a = 0; a < 2; ++a)
#pragma unroll
        for (int c = 0; c < 2; ++c) { ag[a][c] = (f32x4){0.f, 0.f, 0.f, 0.f}; au[a][c] = (f32x4){0.f, 0.f, 0.f, 0.f}; }
    for (int k0 = 0; k0 < D; k0 += 32) {
        bf16x8 a[2], bg[2], bu[2];
#pragma unroll
        for (int i = 0; i < 2; ++i) { a[i] = *(const bf16x8*)(arow[i] + k0 + 8 * fq); bg[i] = *(const bf16x8*)(W + (size_t)(rg + 16 * i + fr) * D + k0 + 8 * fq); bu[i] = *(const bf16x8*)(W + (size_t)(rg + 128 + 16 * i + fr) * D + k0 + 8 * fq); }
#pragma unroll
        for (int mt = 0; mt < 2; ++mt)
#pragma unroll
            for (int nt = 0; nt < 2; ++nt) { ag[mt][nt] = __builtin_amdgcn_mfma_f32_16x16x32_bf16(a[mt], bg[nt], ag[mt][nt], 0, 0, 0); au[mt][nt] = __builtin_amdgcn_mfma_f32_16x16x32_bf16(a[mt], bu[nt], au[mt][nt], 0, 0, 0); }
    }
#pragma unroll
    for (int mt = 0; mt < 2; ++mt)
#pragma unroll
        for (int nt = 0; nt < 2; ++nt)
#pragma unroll
            for (int q = 0; q < 4; ++q) { const float g = ag[mt][nt][q], u = au[mt][nt][q]; const float v = g * u / (1.0f + __expf(-g));
                hff[(size_t)(m0 + 16 * mt + 4 * fq + q) * F_ + f0 + 16 * nt + fr] = (bf16)f2bf(v); }
}
__global__ void __launch_bounds__(64) nk_ffn_down(const bf16* hff, const bf16* wd, const int* btab, bf16* y, int cstart, int F_) {
    const int m0 = 32 * blockIdx.y, n0 = 32 * blockIdx.x, lane = threadIdx.x, fr = lane & 15, fq = lane >> 4;
    const int b = cstart + m0 / 256; if (b >= btab[MAXBLK]) return;
    const int e = btab[b] & 0xff; const bf16* W = wd + (size_t)e * D * F_;
    f32x4 acc[2][2];
#pragma unroll
    for (int a = 0; a < 2; ++a)
#pragma unroll
        for (int c = 0; c < 2; ++c) acc[a][c] = (f32x4){0.f, 0.f, 0.f, 0.f};
    for (int k0 = 0; k0 < F_; k0 += 32) {
        bf16x8 a[2], bb[2];
#pragma unroll
        for (int i = 0; i < 2; ++i) { a[i] = *(const bf16x8*)(hff + (size_t)(m0 + 16 * i + fr) * F_ + k0 + 8 * fq); bb[i] = *(const bf16x8*)(W + (size_t)(n0 + 16 * i + fr) * F_ + k0 + 8 * fq); }
#pragma unroll
        for (int mt = 0; mt < 2; ++mt)
#pragma unroll
            for (int nt = 0; nt < 2; ++nt) acc[mt][nt] = __builtin_amdgcn_mfma_f32_16x16x32_bf16(a[mt], bb[nt], acc[mt][nt], 0, 0, 0);
    }
#pragma unroll
    for (int mt = 0; mt < 2; ++mt)
#pragma unroll
        for (int nt = 0; nt < 2; ++nt)
#pragma unroll
            for (int q = 0; q < 4; ++q) y[(size_t)(256 * cstart + m0 + 16 * mt + 4 * fq + q) * D + n0 + 16 * nt + fr] = (bf16)f2bf(acc[mt][nt][q]);
}
__global__ void nk_pool_delta(const bf16* proj, bf16* delta) {
    const int idx = blockIdx.x * 256 + threadIdx.x, tok = idx / DPOOL, ch = idx % DPOOL, b = tok / SEQ, t = tok % SEQ, g = ch / 128, hw = 1 << g;
    const int lo = max(t - hw, 0), hi = min(t + hw, SEQ); float s = 0.f;
    for (int tt = lo; tt < hi; ++tt) s += bf2f(proj[(size_t)(b * SEQ + tt) * NPROJ + ch]);
    delta[(size_t)tok * DPOOL + ch] = (bf16)f2bf(s / (float)(hi - lo) - bf2f(proj[(size_t)tok * NPROJ + ch]));
}
__global__ void nk_pool_mm(const bf16* delta, const bf16* Wp, const float* pscale, bf16* mixo) {
    const int idx = blockIdx.x * 256 + threadIdx.x, tok = idx / DPOOL, dd = idx % DPOOL, g = dd / 128, d = dd % 128; float s = 0.f;
    for (int c = 0; c < 128; ++c) s += bf2f(delta[(size_t)tok * DPOOL + 128 * g + c]) * bf2f(Wp[(size_t)(g * 128 + d) * 128 + c]);
    mixo[(size_t)tok * D + dd] = (bf16)f2bf(s * pscale[dd]);
}
__global__ void nk_na(const bf16* proj, const bf16* Vt, const float* rpb, bf16* mixo) {
    const int idx = blockIdx.x * 256 + threadIdx.x, tok = idx / NH, h = idx % NH, b = tok / SEQ, t = tok % SEQ, r = t / GRIDW, c = t % GRIDW;
    const int r0 = min(max(r - KH / 2, 0), GROWS - KH), c0 = min(max(c - KW / 2, 0), GRIDW - KW);
    float q[HD];
#pragma unroll
    for (int d = 0; d < HD; ++d) q[d] = bf2f(proj[(size_t)tok * NPROJ + 512 + HD * h + d]);
    float mx = -INFINITY;
    for (int i = 0; i < KH; ++i) for (int j = 0; j < KW; ++j) {
        const size_t kt = (size_t)(b * SEQ + (r0 + i) * GRIDW + c0 + j); float s = 0.f;
#pragma unroll
        for (int d = 0; d < HD; ++d) s += q[d] * bf2f(proj[kt * NPROJ + 1024 + HD * h + d]);
        s += rpb[(h * 15 + (r0 + i - r + KH - 1)) * 31 + (c0 + j - c + KW - 1)] * LOG2E; mx = fmaxf(mx, s);
    }
    float o[HD], sum = 0.f;
#pragma unroll
    for (int d = 0; d < HD; ++d) o[d] = 0.f;
    for (int i = 0; i < KH; ++i) for (int j = 0; j < KW; ++j) {
        const size_t kt = (size_t)(b * SEQ + (r0 + i) * GRIDW + c0 + j); float s = 0.f;
#pragma unroll
        for (int d = 0; d < HD; ++d) s += q[d] * bf2f(proj[kt * NPROJ + 1024 + HD * h + d]);
        s += rpb[(h * 15 + (r0 + i - r + KH - 1)) * 31 + (c0 + j - c + KW - 1)] * LOG2E;
        const float p = exp2f(s - mx); sum += p; const float pb = __builtin_bit_cast(float, f2bf(p) << 16);
#pragma unroll
        for (int d = 0; d < HD; ++d) o[d] += pb * bf2f(Vt[vt_index(HD * h + d, (int)kt)]);
    }
#pragma unroll
    for (int d = 0; d < HD; ++d) mixo[(size_t)tok * D + DPOOL + HD * h + d] = (bf16)f2bf(o[d] / sum);
}

static void launch_mk(const Args& a0, int lo, int hi, int grid, hipStream_t stream, int breg = 0) {
    Args a = a0; a.lo = lo; a.hi = hi; a.breg = breg; a.pad = 0;
    hipLaunchKernelGGL(mk_fwd, dim3(grid), dim3(512), LDS_BYTES, stream, a);
}
extern "C" void kernel_launch(void* const* d_in, const int* in_sizes, int n_in, void* d_out, int out_size, void* d_ws, size_t ws_size, hipStream_t stream) {
    static int grid = 0;
    if (grid == 0) {
        if (n_in != 17 || out_size != T * D || ws_size < WS_END) { fprintf(stderr, "kernel_launch: unexpected problem (n_in %d, out %d, ws %zu)\n", n_in, out_size, ws_size); grid = -1; return; }
        int dev = 0, cus = 0;
        if (hipGetDevice(&dev) != hipSuccess || hipDeviceGetAttribute(&cus, hipDeviceAttributeMultiprocessorCount, dev) != hipSuccess) { grid = -1; return; }
        if (hipFuncSetAttribute((const void*)mk_fwd, hipFuncAttributeMaxDynamicSharedMemorySize, LDS_BYTES) != hipSuccess) { grid = -1; return; }
        int per_cu = 0;
        if (hipOccupancyMaxActiveBlocksPerMultiprocessor(&per_cu, (const void*)mk_fwd, 512, LDS_BYTES) != hipSuccess || per_cu < 1) { fprintf(stderr, "kernel_launch: occupancy query says %d\n", per_cu); }
        (void)hipGetLastError();
        grid = cus;
    }
    if (grid < 0) return;
    hipMemsetAsync((char*)d_ws + WS_CTL, 0, CTL_ZERO_BYTES, stream);
    Args a{};
    for (int i = 0; i < 17; ++i) a.in[i] = (const float*)d_in[i];
    a.out = (float*)d_out; a.ws = (unsigned char*)d_ws; a.lo = 0; a.hi = 0;
    unsigned char* ws = (unsigned char*)d_ws;
#if MODE == 3
#if defined(REPSTEP)
    launch_mk(a, 0, REPSTEP + 1, grid, stream, 0); launch_mk(a, REPSTEP, REPSTEP + 1, grid, stream, 1); launch_mk(a, REPSTEP + 1, NSTEPS, grid, stream, 2);
#else
    launch_mk(a, 0, NSTEPS, grid, stream);
#endif
#else
    launch_mk(a, 0, 1, grid, stream);
    const bf16* HN = (const bf16*)(ws + WS_HN);
    for (int l = 0; l < DEPTH; ++l) {
        const int base = 1 + STEPS_PER_LAYER * l; const int moe = l & 1;
        const bf16* win = (const bf16*)(ws + WS_WIN) + (size_t)l * DIN * D;
        if (NAIVE & 1) {
            hipLaunchKernelGGL(nk_gemm, dim3(NPROJ / 32, T / 32), dim3(64), 0, stream, HN, D, win, D, D, (bf16*)(ws + WS_PROJ), NPROJ, QSCALE, 512, 1024, 0);
            hipLaunchKernelGGL(nk_gemm, dim3(T / 32, DATT / 32), dim3(64), 0, stream, win + (size_t)NPROJ * D, D, HN, D, D, (bf16*)(ws + WS_VT), T, 1.0f, 0, 0, 1);
        } else launch_mk(a, base + 0, base + 1, grid, stream);
        if (NAIVE & 2) {
            hipLaunchKernelGGL(nk_pool_delta, dim3(T * DPOOL / 256), dim3(256), 0, stream, (const bf16*)(ws + WS_PROJ), (bf16*)(ws + WS_MIX));
            hipLaunchKernelGGL(nk_pool_mm, dim3(T * DPOOL / 256), dim3(256), 0, stream, (const bf16*)(ws + WS_MIX), (const bf16*)(ws + WS_WP) + (size_t)l * 4 * 128 * 128, (const float*)d_in[7] + l * DPOOL, (bf16*)(ws + WS_MIXO));
            hipLaunchKernelGGL(nk_na, dim3(T * NH / 256), dim3(256), 0, stream, (const bf16*)(ws + WS_PROJ), (const bf16*)(ws + WS_VT), (const float*)d_in[8] + (size_t)l * NH * 15 * 31, (bf16*)(ws + WS_MIXO));
        } else launch_mk(a, base + 1, base + 2, grid, stream);
        if (NAIVE & 4) hipLaunchKernelGGL(nk_gemm, dim3(D / 32, T / 32), dim3(64), 0, stream, (const bf16*)(ws + WS_MIXO), D, (const bf16*)(ws + WS_WOUT) + (size_t)l * D * D, D, D, (bf16*)(ws + WS_MIX), D, 1.0f, 0, 0, 0);
        else launch_mk(a, base + 2, base + 3, grid, stream);
        launch_mk(a, base + 3, base + 4, grid, stream);
        if (NAIVE & 24) hipLaunchKernelGGL(nk_blocktab, dim3(1), dim3(64), 0, stream, (const unsigned*)(ws + WS_CTL), (int*)(ws + WS_BTAB), moe);
        const int F_ = moe ? DFFE : DFF, nchunk = moe ? MAXCHUNK : 2;
        for (int c = 0; c < nchunk; ++c) {
            if (NAIVE & 8) hipLaunchKernelGGL(nk_ffn_up, dim3(F_ / 32, CHUNK_BLK * 256 / 32), dim3(64), 0, stream, HN, moe ? (const bf16*)(ws + WS_WGUM) : (const bf16*)(ws + WS_WGU0), moe ? (const int*)(ws + WS_LIST) : (const int*)(ws + WS_LISTID), (const int*)(ws + WS_BTAB), (bf16*)(ws + WS_HFF), c * CHUNK_BLK, F_, moe);
            else launch_mk(a, base + 4 + 2 * c, base + 5 + 2 * c, grid, stream);
            if (NAIVE & 16) hipLaunchKernelGGL(nk_ffn_down, dim3(D / 32, CHUNK_BLK * 256 / 32), dim3(64), 0, stream, (const bf16*)(ws + WS_HFF), moe ? (const bf16*)(ws + WS_WDM) : (const bf16*)(ws + WS_WD0), (const int*)(ws + WS_BTAB), (bf16*)(ws + WS_Y), c * CHUNK_BLK, F_);
            else launch_mk(a, base + 5 + 2 * c, base + 6 + 2 * c, grid, stream);
        }
        launch_mk(a, base + 14, base + 15, grid, stream);
    }
#endif
}
```

```cpp
#include <hip/hip_runtime.h>
#include <cstdio>
#include <cstdint>

#ifndef MODE
#define MODE 3
#endif
#ifndef NAIVE
#define NAIVE 0
#endif
#ifndef I8_DENSE
#define I8_DENSE 1
#endif
#ifndef I8_PROJ
#define I8_PROJ 1
#endif
#ifndef FP6_UP
#define FP6_UP 1
#endif
#ifndef FP8_DDOWN
#define FP8_DDOWN 1
#endif
#ifndef Y8_MOE
#define Y8_MOE 1
#endif
#ifndef FP8_MOE
#define FP8_MOE 1
#endif
#if ((FP8_MOE || I8_DENSE) && (NAIVE & 24) || I8_PROJ && (NAIVE & 1)) && MODE != 3
#error the simple reference FFN kernels are bf16 only: build with -DFP8_MOE=0 to use them
#endif

#define GAS __attribute__((address_space(1)))
#define LAS __attribute__((address_space(3)))
typedef unsigned short bf16;
typedef unsigned v4u __attribute__((ext_vector_type(4)));
typedef unsigned v2u __attribute__((ext_vector_type(2)));
typedef float f32x4 __attribute__((ext_vector_type(4)));
typedef float f32x2 __attribute__((ext_vector_type(2)));
typedef short bf16x8 __attribute__((ext_vector_type(8)));

constexpr int BATCH = 2, SEQ = 16384, T = BATCH * SEQ, D = 1024, DIN = 2048, DPOOL = 512, DATT = 512, NH = 16, HD = 32;
constexpr int GRIDW = 64, GROWS = SEQ / GRIDW, KH = 8, KW = 16;
constexpr int DFF = 4096, NE = 8, DFFE = 3584, DEPTH = 2;
constexpr int UPITCH = 512;
constexpr int NPROJ = 1536;
constexpr float RMS_EPS = 1e-6f;
constexpr float LOG2E = 1.4426950408889634f;
constexpr float QSCALE = 0.17677669529663687f * LOG2E;
__host__ __device__ __forceinline__ size_t vt_index(int ch, int tok) { return (size_t)(tok >> 6) * (DATT * 64) + (size_t)ch * 64 + (tok & 63); }
constexpr float S6A = 1.25f, S6W = 40.0f;
typedef float f32x16 __attribute__((ext_vector_type(16)));
typedef int i32x6 __attribute__((ext_vector_type(6)));
constexpr float W8_UP = 32.0f, W8_DN = 64.0f;
typedef int i32x8 __attribute__((ext_vector_type(8)));
typedef int i32x4 __attribute__((ext_vector_type(4)));
constexpr int CHUNK_BLK = 64;
constexpr int MAXCHUNK = 5;
constexpr int MAXBLK = 264;

constexpr size_t MiB = 1u << 20;
constexpr size_t WS_CTL = 0, CTL_ZERO_BYTES = 1 * MiB;
constexpr size_t WS_LIST = 1 * MiB;
constexpr size_t WS_INFO = 2 * MiB;
constexpr size_t WS_LISTID = 2 * MiB + 512 * 1024;
constexpr size_t WS_SA = 2 * MiB + 640 * 1024;
constexpr size_t WS_SWIN = 2 * MiB + 896 * 1024;
constexpr size_t WS_SW0 = 2 * MiB + 832 * 1024;
constexpr size_t WS_BTAB = 2 * MiB + 768 * 1024;
constexpr size_t WS_WP = 3 * MiB;
constexpr size_t WS_WIN = 4 * MiB;
constexpr size_t WS_WOUT = 12 * MiB;
constexpr size_t WS_WGU0 = 16 * MiB;
constexpr size_t WS_WD0 = 32 * MiB;
constexpr size_t WS_WGUM = 40 * MiB;
constexpr size_t WS_WDM = (FP8_MOE ? 160 : 152) * MiB;
constexpr size_t WS_H16 = 96 * MiB;
constexpr size_t WS_HN = 208 * MiB;
constexpr size_t WS_R = 272 * MiB;
constexpr size_t WS_HFF = WS_R;
constexpr size_t WS_Y = WS_R + 128 * MiB;
constexpr size_t WS_PQ = WS_R + 32 * MiB, WS_PK = WS_R + 64 * MiB;
constexpr size_t WS_PROJ = WS_R;
constexpr size_t WS_VT = WS_R + 96 * MiB;
constexpr size_t WS_MIXO = WS_R + 128 * MiB;
constexpr size_t WS_MIX = WS_R + 192 * MiB;
constexpr size_t WS_END = 532 * MiB;
constexpr float YS = 16.0f;
constexpr int HFF_TILE = 256 * 128;
constexpr int TAILSPLIT = 7, TAILPART_ROWS = 8 * 256;
constexpr size_t WS_TAILPART6 = WS_Y + 68 * MiB;
constexpr size_t WS_TAILPART = WS_WGU0;
static_assert(WS_TAILPART + (size_t)(TAILSPLIT - 1) * TAILPART_ROWS * D * 2 <= WS_WGUM, "tail partials");
static_assert(!FP8_MOE || (WS_WGUM + (size_t)NE * 2 * DFFE * D <= WS_H16 && WS_H16 + (size_t)T * D * 2 <= WS_WDM), "H16 sits in the gap the fp8 expert weights leave");

constexpr int CW_TMO = 0, CW_CODE = 1;
constexpr int CW_BAR = 4096;
constexpr int CW_CNT = 16384;
constexpr int CW_DBG = 20480;

constexpr int RING_BYTES = 131072;
constexpr int TOKBUF_OFF = RING_BYTES;
constexpr int BLK_OFF = TOKBUF_OFF + 9 * 1024;
constexpr int BST_OFF = BLK_OFF + 272 * 4;
constexpr int LCNT_OFF = BST_OFF + 64;
constexpr int MISC_OFF = LCNT_OFF + 64;
constexpr int LDS_BYTES = 147456;
static_assert(MISC_OFF + 64 <= LDS_BYTES, "LDS map");

#define RLX_AGENT __ATOMIC_RELAXED, __HIP_MEMORY_SCOPE_AGENT
#define LDS_WAIT() asm volatile("s_waitcnt lgkmcnt(0)" ::: "memory")
#define VM_WAIT() asm volatile("s_waitcnt vmcnt(0)" ::: "memory")
__device__ __forceinline__ unsigned f2bf(float f) { unsigned u = __builtin_bit_cast(unsigned, f); return (u + 0x7fffu + ((u >> 16) & 1u)) >> 16; }
__device__ __forceinline__ unsigned pk2(float lo, float hi) { return f2bf(lo) | (f2bf(hi) << 16); }
__device__ __forceinline__ float bflo(unsigned w) { return __builtin_bit_cast(float, w << 16); }
__device__ __forceinline__ float bfhi(unsigned w) { return __builtin_bit_cast(float, w & 0xffff0000u); }
__device__ __forceinline__ float bf2f(bf16 v) { return __builtin_bit_cast(float, (unsigned)v << 16); }
__device__ __forceinline__ unsigned cvt_pk_bf16(float lo, float hi) { unsigned r; asm volatile("v_cvt_pk_bf16_f32 %0, %1, %2" : "=v"(r) : "v"(lo), "v"(hi)); return r; }
__device__ __forceinline__ float wave_sum(float v) {
#pragma unroll
    for (int o = 1; o < 64; o <<= 1) v += __shfl_xor(v, o);
    return v;
}

#define XB_TMO      128
#define XB_XCNT(j)  (256  + 64 * (j))
#define XB_XSUB(j)  (1280 + 64 * (j))
#define XB_XGEN(j)  (2304 + 64 * (j))
#define XB_TOP      3328
#define XB_TOPGEN   3392
#define XCD_BAR_WORDS 3456
#define XB_SPIN_CAP (1u << 18)
__device__ __forceinline__ unsigned xb_ld(unsigned* p)              { return __hip_atomic_load(p, __ATOMIC_RELAXED, __HIP_MEMORY_SCOPE_AGENT); }
__device__ __forceinline__ unsigned xb_add(unsigned* p, unsigned v) { return __hip_atomic_fetch_add(p, v, __ATOMIC_RELAXED, __HIP_MEMORY_SCOPE_AGENT); }
__device__ __forceinline__ unsigned xb_xcc_id() { return (unsigned)__builtin_amdgcn_s_getreg((3 << 11) | 20) & 0xFu; }
#define XB_SPIN(cond, bar) do { unsigned _sp = 0; while (cond) { __builtin_amdgcn_s_sleep(1); \
    if ((++_sp & 255u) == 0u) { if (xb_ld(&(bar)[XB_TMO])) break; if (_sp > XB_SPIN_CAP) { atomicAdd(&(bar)[XB_TMO], 1u); break; } } } } while (0)
struct XcdBarrier { unsigned* bar; unsigned x; volatile LAS unsigned* st; };
__device__ __forceinline__ XcdBarrier xcd_barrier_post(unsigned* bar, volatile LAS unsigned* st) {
    XcdBarrier b; b.bar = bar; b.x = xb_xcc_id(); b.st = st;
    if (threadIdx.x == 0) (void)xb_add(&bar[XB_XCNT(b.x)], 1u);
    return b;
}
__device__ __forceinline__ void xcd_barrier_complete(unsigned* bar, unsigned x, unsigned& nloc, unsigned& nx) {
    const unsigned G = gridDim.x * gridDim.y * gridDim.z;
    unsigned sum, cnt, mine, sp = 0u;
    for (;;) {
        sum = 0u; cnt = 0u; mine = 0u;
#pragma unroll
        for (unsigned j = 0; j < 16; ++j) { const unsigned c = xb_ld(&bar[XB_XCNT(j)]); sum += c; cnt += (c > 0u) ? 1u : 0u; mine = (j == x) ? c : mine; }
        if (sum == G) break;
        __builtin_amdgcn_s_sleep(1);
        if ((++sp & 255u) == 0u) { if (xb_ld(&bar[XB_TMO])) break; if (sp > XB_SPIN_CAP) { atomicAdd(&bar[XB_TMO], 1u); break; } }
    }
    nloc = mine > 0u ? mine : 1u; nx = cnt > 0u ? cnt : 1u;
}
__device__ __forceinline__ void xcd_barrier(const XcdBarrier& b) {
    asm volatile("s_waitcnt vmcnt(0)" ::: "memory");
    __syncthreads();
    if (threadIdx.x == 0) {
        unsigned* bar = b.bar;
        __builtin_amdgcn_s_waitcnt(0);
        unsigned nloc = b.st[0], nx = b.st[1];
        if (nloc == 0u) { xcd_barrier_complete(bar, b.x, nloc, nx); b.st[0] = nloc; b.st[1] = nx; }
        const unsigned old = xb_add(&bar[XB_XSUB(b.x)], 1u);
        const unsigned gen = old / nloc;
        if (old + 1u == (gen + 1u) * nloc) {
            __builtin_amdgcn_fence(__ATOMIC_RELEASE, "agent");
            asm volatile("s_waitcnt vmcnt(0)" ::: "memory");
            const unsigned og = xb_add(&bar[XB_TOP], 1u);
            const unsigned tg = og / nx;
            if (og + 1u == (tg + 1u) * nx) xb_add(&bar[XB_TOPGEN], 1u);
            else XB_SPIN(xb_ld(&bar[XB_TOPGEN]) == tg, bar);
            __builtin_amdgcn_fence(__ATOMIC_ACQUIRE, "agent");
            xb_add(&bar[XB_XGEN(b.x)], 1u);
            asm volatile("s_waitcnt vmcnt(0)" ::: "memory");
        } else {
            XB_SPIN(xb_ld(&bar[XB_XGEN(b.x)]) == gen, bar);
            __builtin_amdgcn_fence(__ATOMIC_ACQUIRE, "agent");
            asm volatile("s_waitcnt vmcnt(0)" ::: "memory");
        }
    }
    __syncthreads();
}

namespace pg8 {
constexpr int BM = 256, BK = 64, HALF = 128, HTB = HALF * BK * 2, STAGE_BYTES = 8 * HTB, NXCD = 8, WGM = 8;
__host__ __device__ __forceinline__ int lds_byte(int r, int c) { const int st = (r >> 4) * 2 + (c >> 5), rr = r & 15, cc = c & 31, ob = rr * 64 + cc * 2; return st * 1024 + (ob ^ (((ob >> 9) & 1) << 5)); }
__host__ __device__ __forceinline__ void stage_rc(int b, int& R, int& C) { const int st = b / 1024, sb = b % 1024, swz = sb ^ (((sb >> 9) & 1) << 5); R = (st >> 1) * 16 + swz / 64; C = (st & 1) * 32 + (swz % 64) / 2; }
__host__ __device__ __forceinline__ int perm32(int rho) { const int n = rho >> 4, i = rho & 15; return 8 * (i >> 2) + 4 * n + (i & 3); }

struct Unit { const char* A; const char* B; const void* p0; const float* cs; bf16* obase; int orow, ocol, ldc; float scale; };

__device__ __forceinline__ bool tile_order(int i, int G, int c, int nM, int nN, int& pm, int& pn) {
    const int nwg = nM * nN; const long L = (long)i * G + c; if (L >= nwg) return false;
    int wgid = (int)L; { const int q = nwg / NXCD, r = nwg % NXCD, xcd = wgid % NXCD, off = wgid / NXCD; wgid = (xcd < r ? xcd * (q + 1) : r * (q + 1) + (xcd - r) * q) + off; }
    const int nig = WGM * nN, gid = wgid / nig, fm = gid * WGM, gsz = (nM - fm) < WGM ? (nM - fm) : WGM;
    pm = fm + ((wgid % nig) % gsz); pn = (wgid % nig) / gsz; return true;
}

template <bool VT> struct EpiBf16T {
    static constexpr bool SCL = false;
    __device__ __forceinline__ void operator()(const f32x4 (&acc)[2][2][4][2], const Unit& u, int wr, int wc, int fr, int fq, const LAS int* tok, const LAS float* scl) const {
        const int row0 = u.orow + wr * 64 + fr, col0 = u.ocol + wc * 32 + 8 * fq; const float sc = u.scale;
#pragma unroll
        for (int ai = 0; ai < 2; ++ai)
#pragma unroll
            for (int m = 0; m < 4; ++m) { const int row = row0 + ai * HALF + m * 16; bf16* rowp = u.obase + (size_t)row * u.ldc + col0;
#pragma unroll
                for (int bj = 0; bj < 2; ++bj) { const f32x4 v0 = acc[ai][bj][m][0] * sc, v1 = acc[ai][bj][m][1] * sc;
                    v4u w; w.x = cvt_pk_bf16(v0[0], v0[1]); w.y = cvt_pk_bf16(v0[2], v0[3]); w.z = cvt_pk_bf16(v1[0], v1[1]); w.w = cvt_pk_bf16(v1[2], v1[3]);
                    bf16* p = (VT && u.ldc < 0) ? u.obase + vt_index(row, col0 + bj * HALF) : rowp + bj * HALF;
                    *(v4u*)p = w; } }
    }
};
struct EpiY8 {
    static constexpr bool SCL = false;
    __device__ __forceinline__ void operator()(const f32x4 (&acc)[2][2][4][2], const Unit& u, int wr, int wc, int fr, int fq, const LAS int* tok, const LAS float* scl) const {
        const int row0 = u.orow + wr * 64 + fr, col0 = u.ocol + wc * 32 + 8 * fq; const float sc = u.scale;
#pragma unroll
        for (int ai = 0; ai < 2; ++ai)
#pragma unroll
            for (int m = 0; m < 4; ++m) { unsigned char* rowp = (unsigned char*)u.obase + (size_t)(row0 + ai * HALF + m * 16) * u.ldc + col0;
#pragma unroll
                for (int bj = 0; bj < 2; ++bj) { const f32x4 v0 = acc[ai][bj][m][0] * sc, v1 = acc[ai][bj][m][1] * sc;
                    int w0 = 0, w1 = 0;
                    w0 = __builtin_amdgcn_cvt_pk_fp8_f32(v0[0], v0[1], w0, false); w0 = __builtin_amdgcn_cvt_pk_fp8_f32(v0[2], v0[3], w0, true);
                    w1 = __builtin_amdgcn_cvt_pk_fp8_f32(v1[0], v1[1], w1, false); w1 = __builtin_amdgcn_cvt_pk_fp8_f32(v1[2], v1[3], w1, true);
                    v2u w; w.x = (unsigned)w0; w.y = (unsigned)w1; *(v2u*)(rowp + bj * HALF) = w; } }
    }
};
typedef EpiBf16T<false> EpiBf16;
typedef EpiBf16T<true> EpiProj;
__device__ __forceinline__ float silu_mul(float g, float u) { return g * u * __builtin_amdgcn_rcpf(1.0f + __builtin_amdgcn_exp2f(-LOG2E * g)); }
struct EpiSwiGLU {
    static constexpr bool SCL = false;
    __device__ __forceinline__ void operator()(const f32x4 (&acc)[2][2][4][2], const Unit& u, int wr, int wc, int fr, int fq, const LAS int* tok, const LAS float* scl) const {
        const int row0 = u.orow + wr * 64 + fr, col0 = u.ocol + wc * 32 + 8 * fq;
#pragma unroll
        for (int ai = 0; ai < 2; ++ai)
#pragma unroll
            for (int m = 0; m < 4; ++m) { bf16* rowp = u.obase + (size_t)(row0 + ai * HALF + m * 16) * u.ldc + col0;
                const f32x4 g0 = acc[ai][0][m][0], g1 = acc[ai][0][m][1], u0 = acc[ai][1][m][0], u1 = acc[ai][1][m][1];
                v4u w; w.x = cvt_pk_bf16(silu_mul(g0[0], u0[0]), silu_mul(g0[1], u0[1])); w.y = cvt_pk_bf16(silu_mul(g0[2], u0[2]), silu_mul(g0[3], u0[3]));
                w.z = cvt_pk_bf16(silu_mul(g1[0], u1[0]), silu_mul(g1[1], u1[1])); w.w = cvt_pk_bf16(silu_mul(g1[2], u1[2]), silu_mul(g1[3], u1[3]));
                *(v4u*)rowp = w; }
    }
};

template <bool F6> struct EpiSwiGLU8T {
    static constexpr bool SCL = false;
    static __device__ __forceinline__ f32x2 pair(f32x2 gr, f32x2 ur) {
        const float sc = F6 ? 1.0f / (S6A * S6W) : 1.0f / W8_UP; const f32x2 a = gr * (-LOG2E * sc);
        f32x2 t; t.x = __builtin_amdgcn_exp2f(a.x); t.y = __builtin_amdgcn_exp2f(a.y);
        const f32x2 d = t + 1.0f; f32x2 r; r.x = __builtin_amdgcn_rcpf(d.x); r.y = __builtin_amdgcn_rcpf(d.y);
        return (gr * ur) * (r * (sc * sc));
    }
    __device__ __forceinline__ void operator()(const f32x4 (&acc)[2][2][4][2], const Unit& u, int wr, int wc, int fr, int fq, const LAS int* tok, const LAS float* scl) const {
        const int row0 = u.orow + wr * 64 + fr, col0 = u.ocol + wc * 32 + 8 * fq;
#pragma unroll
        for (int ai = 0; ai < 2; ++ai)
#pragma unroll
            for (int m = 0; m < 4; ++m) { unsigned char* rowp = (unsigned char*)u.obase + (size_t)(row0 + ai * HALF + m * 16) * 128 + col0;
                const f32x4 g0 = acc[ai][0][m][0], g1 = acc[ai][0][m][1], u0 = acc[ai][1][m][0], u1 = acc[ai][1][m][1];
                const f32x2 o0 = pair((f32x2){g0[0], g0[1]}, (f32x2){u0[0], u0[1]}), o1 = pair((f32x2){g0[2], g0[3]}, (f32x2){u0[2], u0[3]});
                const f32x2 o2 = pair((f32x2){g1[0], g1[1]}, (f32x2){u1[0], u1[1]}), o3 = pair((f32x2){g1[2], g1[3]}, (f32x2){u1[2], u1[3]});
                int w0 = 0, w1 = 0;
                w0 = __builtin_amdgcn_cvt_pk_fp8_f32(o0.x, o0.y, w0, false); w0 = __builtin_amdgcn_cvt_pk_fp8_f32(o1.x, o1.y, w0, true);
                w1 = __builtin_amdgcn_cvt_pk_fp8_f32(o2.x, o2.y, w1, false); w1 = __builtin_amdgcn_cvt_pk_fp8_f32(o3.x, o3.y, w1, true);
                v2u w; w.x = (unsigned)w0; w.y = (unsigned)w1; *(v2u*)rowp = w; }
    }
};

typedef EpiSwiGLU8T<false> EpiSwiGLU8;
typedef EpiSwiGLU8T<true> EpiSwiGLU6;
struct EpiProj_I8 {
    static constexpr bool SCL = true;
    __device__ __forceinline__ const float* rs_ptr(const Unit& u) const { return (const float*)u.p0; }
    __device__ __forceinline__ const float* cs_ptr(const Unit& u) const { return u.cs; }
    __device__ __forceinline__ void operator()(const f32x4 (&acc)[2][2][4][2], const Unit& u, int wr, int wc, int fr, int fq, const LAS int* tok, const LAS float* scl) const {
        const int rl0 = wr * 64 + fr, cl0 = wc * 32 + 8 * fq, row0 = u.orow + rl0, col0 = u.ocol + cl0; const float sc = u.scale;
        const bool hm = u.ldc == 0; const size_t rstride = hm ? 32 : (size_t)u.ldc, bstride = hm ? (size_t)4 * T * 32 : (size_t)HALF;
        bf16* lbase = hm ? u.obase + (size_t)((u.ocol >> 5) + wc) * T * 32 + 8 * fq : u.obase + col0;
        f32x4 cv[2][2];
#pragma unroll
        for (int bj = 0; bj < 2; ++bj) { cv[bj][0] = *(const LAS f32x4*)(scl + 256 + cl0 + bj * HALF) * sc; cv[bj][1] = *(const LAS f32x4*)(scl + 256 + cl0 + bj * HALF + 4) * sc; }
#pragma unroll
        for (int ai = 0; ai < 2; ++ai)
#pragma unroll
            for (int m = 0; m < 4; ++m) { const int row = row0 + ai * HALF + m * 16; const float sr = scl[rl0 + ai * HALF + m * 16]; bf16* rowp = lbase + (size_t)row * rstride;
#pragma unroll
                for (int bj = 0; bj < 2; ++bj) { const f32x4 v0 = __builtin_convertvector(__builtin_bit_cast(i32x4, acc[ai][bj][m][0]), f32x4) * cv[bj][0] * sr, v1 = __builtin_convertvector(__builtin_bit_cast(i32x4, acc[ai][bj][m][1]), f32x4) * cv[bj][1] * sr;
                    v4u w; w.x = cvt_pk_bf16(v0[0], v0[1]); w.y = cvt_pk_bf16(v0[2], v0[3]); w.z = cvt_pk_bf16(v1[0], v1[1]); w.w = cvt_pk_bf16(v1[2], v1[3]);
                    bf16* p = (u.ldc < 0) ? u.obase + vt_index(row, col0 + bj * HALF) : rowp + bj * bstride;
                    *(v4u*)p = w; } }
    }
};
template <bool F8OUT> struct EpiSwiGLU_I8T {
    static constexpr bool SCL = true;
    const float* sA; const float* sW; const int* idl;
    __device__ __forceinline__ const float* rs_ptr(const Unit& u) const { return sA + ((const int*)u.p0 - idl); }
    __device__ __forceinline__ const float* cs_ptr(const Unit& u) const { return sW + 2 * u.ocol; }
    static __device__ __forceinline__ f32x2 pair(f32x2 gr, f32x2 ur, f32x2 ka, f32x2 k, float sa) {
        const f32x2 a = (gr * sa) * ka;
        f32x2 t; t.x = __builtin_amdgcn_exp2f(a.x); t.y = __builtin_amdgcn_exp2f(a.y);
        const f32x2 d = t * k + k; f32x2 r; r.x = __builtin_amdgcn_rcpf(d.x); r.y = __builtin_amdgcn_rcpf(d.y);
        return (gr * ur) * r;
    }
    __device__ __forceinline__ void operator()(const f32x4 (&acc)[2][2][4][2], const Unit& u, int wr, int wc, int fr, int fq, const LAS int* tok, const LAS float* scl) const {
        const int rl0 = wr * 64 + fr, row0 = u.orow + rl0, cl0 = wc * 32 + 8 * fq, col0 = u.ocol + cl0;
        f32x2 ka[4], kc[4];
#pragma unroll
        for (int i = 0; i < 4; ++i) { const f32x2 wg = *(const LAS f32x2*)(scl + 256 + cl0 + 2 * i), wu = *(const LAS f32x2*)(scl + 256 + HALF + cl0 + 2 * i); const f32x2 p = wg * wu;
            ka[i] = wg * (-LOG2E); kc[i].x = __builtin_amdgcn_rcpf(p.x); kc[i].y = __builtin_amdgcn_rcpf(p.y); }
#pragma unroll
        for (int ai = 0; ai < 2; ++ai)
#pragma unroll
            for (int m = 0; m < 4; ++m) { const float sa = scl[rl0 + ai * HALF + m * 16], rs2 = __builtin_amdgcn_rcpf(sa * sa);
                bf16* rowp = u.obase + (size_t)(row0 + ai * HALF + m * 16) * u.ldc + col0;
                f32x2 o[4];
#pragma unroll
                for (int i = 0; i < 4; ++i) { const f32x4 ga = acc[ai][0][m][i >> 1], ua = acc[ai][1][m][i >> 1];
                    const float g0 = ga[2 * (i & 1)], g1 = ga[2 * (i & 1) + 1], u0 = ua[2 * (i & 1)], u1 = ua[2 * (i & 1) + 1];
                    const f32x2 gr = (f32x2){(float)__float_as_int(g0), (float)__float_as_int(g1)}, ur = (f32x2){(float)__float_as_int(u0), (float)__float_as_int(u1)};
                    o[i] = pair(gr, ur, ka[i], kc[i] * rs2, sa); }
                if constexpr (F8OUT) { int w0 = 0, w1 = 0;
                    w0 = __builtin_amdgcn_cvt_pk_fp8_f32(o[0].x, o[0].y, w0, false); w0 = __builtin_amdgcn_cvt_pk_fp8_f32(o[1].x, o[1].y, w0, true);
                    w1 = __builtin_amdgcn_cvt_pk_fp8_f32(o[2].x, o[2].y, w1, false); w1 = __builtin_amdgcn_cvt_pk_fp8_f32(o[3].x, o[3].y, w1, true);
                    v2u w; w.x = (unsigned)w0; w.y = (unsigned)w1; *(v2u*)((unsigned char*)u.obase + (size_t)(row0 + ai * HALF + m * 16) * 128 + col0) = w; }
                else { v4u w; w.x = cvt_pk_bf16(o[0].x, o[0].y); w.y = cvt_pk_bf16(o[1].x, o[1].y); w.z = cvt_pk_bf16(o[2].x, o[2].y); w.w = cvt_pk_bf16(o[3].x, o[3].y);
                    *(v4u*)rowp = w; } }
    }
};
typedef EpiSwiGLU_I8T<FP8_DDOWN != 0> EpiSwiGLU_I8;

template <class Epi, class Sched, bool GATHER, int MT = 0  >
__device__ __forceinline__ void gemm_phase(LAS unsigned char* lds, LAS int* tokbuf, const int K, const Sched& S, const Epi& E, const int P_ = 0, const int PA_ = 0, const int KSA_ = 0) {
    const int P = P_ ? P_ : K, PA = PA_ ? PA_ : P;
    const size_t kstepA = KSA_ ? (size_t)KSA_ : (size_t)(BK * 2);
    int tid_ = threadIdx.x; asm volatile("" : "+v"(tid_));
    const int tid = tid_, wid = __builtin_amdgcn_readfirstlane(tid >> 6), lane = tid & 63, wr = wid >> 2, wc = wid & 3, fr = lane & 15, fq = lane >> 4;
    const int nt = K / BK;
    unsigned voffA[2][2], voffB[2]; int rowA[2], colA[2];
#pragma unroll
    for (int i = 0; i < 2; ++i) { int R, C; stage_rc(tid * 16 + i * 8192, R, C); const int Rb = (R & ~31) + perm32(R & 31);
        voffA[0][i] = (unsigned)(R * PA + C) * 2u; voffA[1][i] = (unsigned)((R + HALF) * PA + C) * 2u; voffB[i] = (unsigned)(Rb * P + C) * 2u; rowA[i] = R; colA[i] = C; }
    const size_t kstep = (size_t)(BK * 2);
    const size_t hstep = (size_t)HALF * P * 2, hstepA = (size_t)HALF * PA * 2;
    const unsigned ldsw = (unsigned)wid * 1024u;
    const int aoff = lds_byte(wr * 64 + fr, fq * 8), boff = lds_byte(wc * 32 + fr, fq * 8);
#define PG8_SA(b, h) (((b) * 2 + (h)) * HTB)
#define PG8_SB(b, h) ((4 + (b) * 2 + (h)) * HTB)
#define PG8_STAGE(bufoff, gbase, voff) do { _Pragma("unroll") for (int _i = 0; _i < 2; ++_i) \
        __builtin_amdgcn_global_load_lds((const unsigned*)((const char*)(gbase) + (voff)[_i]), (LAS unsigned*)(lds + (bufoff) + ldsw + _i * 8192), 16, 0, 0); } while (0)
#define PG8_STAGE_A1(bufoff, gbase) do { if constexpr (GATHER) PG8_STAGE(bufoff, gbase, voffA[1]); else PG8_STAGE(bufoff, (gbase) + hstepA, voffA[0]); } while (0)
#define PG8_LDA(dst, b, h) do { _Pragma("unroll") for (int m = 0; m < 4; ++m) _Pragma("unroll") for (int k = 0; k < 2; ++k) dst[m][k] = *(const LAS bf16x8*)(lds + PG8_SA(b, h) + aoff + m * 2048 + k * 1024); } while (0)
#define PG8_LDB(dst, b, h) do { _Pragma("unroll") for (int n = 0; n < 2; ++n) _Pragma("unroll") for (int k = 0; k < 2; ++k) dst[n][k] = *(const LAS bf16x8*)(lds + PG8_SB(b, h) + boff + n * 2048 + k * 1024); } while (0)
#define PG8_CAT8(x) __builtin_shufflevector(__builtin_bit_cast(i32x4, (x)[0]), __builtin_bit_cast(i32x4, (x)[1]), 0, 1, 2, 3, 4, 5, 6, 7)
#define PG8_MMA(ai, bj, At, Bt) do { __builtin_amdgcn_s_setprio(1); _Pragma("unroll") for (int m = 0; m < 4; ++m) _Pragma("unroll") for (int n = 0; n < 2; ++n) { \
        if constexpr (MT == 1) acc[ai][bj][m][n] = __builtin_amdgcn_mfma_scale_f32_16x16x128_f8f6f4(PG8_CAT8(Bt[n]), PG8_CAT8(At[m]), acc[ai][bj][m][n], 0, 0, 0, 0, 0, 0); \
        else if constexpr (MT == 3) acc[ai][bj][m][n] = __builtin_amdgcn_mfma_scale_f32_16x16x128_f8f6f4(PG8_CAT8(Bt[n]), PG8_CAT8(At[m]), acc[ai][bj][m][n], 2, 2, 0, 0, 0, 0); \
        else if constexpr (MT == 2) { _Pragma("unroll") for (int k = 0; k < 2; ++k) acc[ai][bj][m][n] = __builtin_bit_cast(f32x4, __builtin_amdgcn_mfma_i32_16x16x64_i8(__builtin_bit_cast(i32x4, Bt[n][k]), __builtin_bit_cast(i32x4, At[m][k]), __builtin_bit_cast(i32x4, acc[ai][bj][m][n]), 0, 0, 0)); } \
        else { _Pragma("unroll") for (int k = 0; k < 2; ++k) acc[ai][bj][m][n] = __builtin_amdgcn_mfma_f32_16x16x32_bf16(Bt[n][k], At[m][k], acc[ai][bj][m][n], 0, 0, 0); } } \
        __builtin_amdgcn_s_setprio(0); } while (0)
#define PG8_WAIT_V(n) asm volatile("s_waitcnt vmcnt(" #n ")" ::: "memory")
#define PG8_WAIT_L(n) asm volatile("s_waitcnt lgkmcnt(" #n ")" ::: "memory")
#define PG8_BAR __builtin_amdgcn_s_barrier()
#define PG8_SCHED __builtin_amdgcn_sched_barrier(0)
#define PG8_TOKOFF(dst, tb) do { _Pragma("unroll") for (int _h = 0; _h < 2; ++_h) _Pragma("unroll") for (int _i = 0; _i < 2; ++_i) \
        dst[_h][_i] = (unsigned)(tb)[_h * HALF + rowA[_i]] * (unsigned)(PA * 2) + (unsigned)(colA[_i] * 2); } while (0)
#define PG8_TOKDMA(listp, tb) do { if (wid < 4) __builtin_amdgcn_global_load_lds((const unsigned*)((listp) + tid), (LAS unsigned*)((tb) + wid * 64), 4, 0, 0); } while (0)
#define PG8_SCB(u_) ((LAS float*)(tokbuf + 768) + 512 * ((u_) % 3))
#define PG8_SCLDMA(un, u_) do { const float* sp_ = wid < 4 ? E.rs_ptr(un) + tid : E.cs_ptr(un) + (tid - 256); \
        __builtin_amdgcn_global_load_lds((const unsigned*)sp_, (LAS unsigned*)(PG8_SCB(u_) + wid * 64), 4, 0, 0); } while (0)
#define PG8_TB(u_) (tokbuf + 256 * ((u_) % 3))
    Unit cur, nxt; int ui = 0;
    if (!S.next(0, cur)) return;
    f32x4 acc[2][2][4][2];
#pragma unroll
    for (int a = 0; a < 2; ++a)
#pragma unroll
        for (int b = 0; b < 2; ++b)
#pragma unroll
            for (int m = 0; m < 4; ++m)
#pragma unroll
                for (int n = 0; n < 2; ++n) acc[a][b][m][n] = (f32x4){0.f, 0.f, 0.f, 0.f};
    bf16x8 At[4][2], B0[2][2], B1[2][2];
    const char* cA = cur.A; const char* cB = cur.B;
    if constexpr (Epi::SCL) PG8_SCLDMA(cur, 0);
    if constexpr (GATHER) {
        PG8_TOKDMA((const int*)cur.p0, PG8_TB(0)); PG8_WAIT_V(0); PG8_BAR; asm volatile("" ::: "memory");
        PG8_TOKOFF(voffA, PG8_TB(0)); PG8_WAIT_L(0); asm volatile("" ::: "memory");
    } else if constexpr (Epi::SCL) { PG8_WAIT_V(0); PG8_BAR; asm volatile("" ::: "memory"); }
    PG8_STAGE(PG8_SB(0, 0), cB, voffB); PG8_STAGE(PG8_SB(0, 1), cB + hstep, voffB); PG8_STAGE(PG8_SA(0, 0), cA, voffA[0]); PG8_STAGE_A1(PG8_SA(0, 1), cA);
    if (wr == 1) PG8_BAR;
    PG8_WAIT_V(2); PG8_BAR;
    PG8_STAGE(PG8_SB(1, 0), cB + kstep, voffB); PG8_STAGE(PG8_SA(1, 0), cA + kstepA, voffA[0]); PG8_STAGE(PG8_SB(1, 1), cB + hstep + kstep, voffB);
    PG8_WAIT_V(6); PG8_BAR;
    for (;;) {
        const bool has_next = S.next(ui + 1, nxt);
        if constexpr (Epi::SCL) { if (has_next) PG8_SCLDMA(nxt, ui + 1); }
        if constexpr (GATHER) { if (has_next) PG8_TOKDMA((const int*)nxt.p0, PG8_TB(ui + 1)); }
        const char* nA = has_next ? nxt.A : cA; const char* nB = has_next ? nxt.B : cB;
        for (int t = 0; t < nt; t += 2) {
            const bool last = (t == nt - 2);
            const char* a1 = cA + (size_t)(t + 1) * kstepA;
            const char* a2 = last ? nA : cA + (size_t)(t + 2) * kstepA; const char* b2 = last ? nB : cB + (size_t)(t + 2) * kstep;
            const char* a3 = a2 + kstepA; const char* b3 = b2 + kstep;
            if constexpr (MT == 3) {
            PG8_LDB(B0, 0, 0); PG8_LDB(B1, 0, 1); PG8_SCHED; PG8_LDA(At, 0, 0);
            PG8_WAIT_V(6); PG8_WAIT_L(0); PG8_BAR; PG8_MMA(0, 0, At, B0); PG8_SCHED; PG8_STAGE_A1(PG8_SA(1, 1), a1); PG8_SCHED; PG8_MMA(0, 1, At, B1); PG8_BAR; PG8_SCHED;
            if constexpr (GATHER) { if (last && has_next) { PG8_TOKOFF(voffA, PG8_TB(ui + 1)); } }
            PG8_LDA(At, 0, 1);
            PG8_WAIT_V(2); PG8_WAIT_L(0); PG8_BAR; PG8_STAGE(PG8_SB(0, 0), b2, voffB); PG8_SCHED; PG8_MMA(1, 0, At, B0); PG8_SCHED; PG8_STAGE(PG8_SB(0, 1), b2 + hstep, voffB); PG8_SCHED; PG8_MMA(1, 1, At, B1); PG8_SCHED; PG8_STAGE(PG8_SA(0, 0), a2, voffA[0]); PG8_BAR; PG8_SCHED;
            PG8_LDB(B0, 1, 0); PG8_LDB(B1, 1, 1); PG8_SCHED; PG8_LDA(At, 1, 0);
            PG8_WAIT_V(6); PG8_WAIT_L(0); PG8_BAR; PG8_MMA(0, 0, At, B0); PG8_SCHED; PG8_STAGE_A1(PG8_SA(0, 1), a2); PG8_SCHED; PG8_MMA(0, 1, At, B1); PG8_BAR; PG8_SCHED;
            PG8_LDA(At, 1, 1);
            PG8_WAIT_V(2); PG8_WAIT_L(0); PG8_BAR; PG8_STAGE(PG8_SB(1, 0), b3, voffB); PG8_SCHED; PG8_MMA(1, 0, At, B0); PG8_SCHED; PG8_STAGE(PG8_SB(1, 1), b3 + hstep, voffB); PG8_SCHED; PG8_MMA(1, 1, At, B1); PG8_SCHED; PG8_STAGE(PG8_SA(1, 0), a3, voffA[0]); PG8_BAR; PG8_SCHED;
            } else {
            PG8_LDB(B0, 0, 0); PG8_LDB(B1, 0, 1); PG8_SCHED; PG8_LDA(At, 0, 0); PG8_STAGE_A1(PG8_SA(1, 1), a1);
            if constexpr (GATHER) { if (last && has_next) { PG8_TOKOFF(voffA, PG8_TB(ui + 1)); } }
            PG8_WAIT_V(8); PG8_WAIT_L(0); PG8_BAR; PG8_MMA(0, 0, At, B0); PG8_MMA(0, 1, At, B1); PG8_BAR; PG8_SCHED;
            PG8_LDA(At, 0, 1); PG8_STAGE(PG8_SB(0, 0), b2, voffB); PG8_STAGE(PG8_SB(0, 1), b2 + hstep, voffB); PG8_STAGE(PG8_SA(0, 0), a2, voffA[0]);
            PG8_WAIT_V(8); PG8_WAIT_L(0); PG8_BAR; PG8_MMA(1, 0, At, B0); PG8_MMA(1, 1, At, B1); PG8_BAR; PG8_SCHED;
            PG8_LDB(B0, 1, 0); PG8_LDB(B1, 1, 1); PG8_SCHED; PG8_LDA(At, 1, 0); PG8_STAGE_A1(PG8_SA(0, 1), a2);
            PG8_WAIT_V(8); PG8_WAIT_L(0); PG8_BAR; PG8_MMA(0, 0, At, B0); PG8_MMA(0, 1, At, B1); PG8_BAR; PG8_SCHED;
            PG8_LDA(At, 1, 1); PG8_STAGE(PG8_SB(1, 0), b3, voffB); PG8_STAGE(PG8_SB(1, 1), b3 + hstep, voffB); PG8_STAGE(PG8_SA(1, 0), a3, voffA[0]);
            PG8_WAIT_V(8); PG8_WAIT_L(0); PG8_BAR; PG8_MMA(1, 0, At, B0); PG8_MMA(1, 1, At, B1); PG8_BAR; PG8_SCHED;
                    }
        }
        if (wr == 0) PG8_BAR;
#ifndef EPIX
#define EPIX 1
#endif
        for (int e_ = 0; e_ < EPIX; ++e_) E(acc, cur, wr, wc, fr, fq, PG8_TB(ui), PG8_SCB(ui));
        if (!has_next) break;
#pragma unroll
        for (int a = 0; a < 2; ++a)
#pragma unroll
            for (int b = 0; b < 2; ++b)
#pragma unroll
                for (int m = 0; m < 4; ++m)
#pragma unroll
                    for (int n = 0; n < 2; ++n) acc[a][b][m][n] = (f32x4){0.f, 0.f, 0.f, 0.f};
        cur = nxt; cA = nA; cB = nB; ++ui;
        if (wr == 1) PG8_BAR;
    }
    PG8_WAIT_V(0);
    PG8_BAR;
#undef PG8_SA
#undef PG8_SB
#undef PG8_STAGE
#undef PG8_LDA
#undef PG8_STAGE_A1
#undef PG8_LDB
#undef PG8_MMA
#undef PG8_CAT8
#undef PG8_WAIT_V
#undef PG8_WAIT_L
#undef PG8_BAR
#undef PG8_SCHED
#undef PG8_TOKOFF
#undef PG8_TOKDMA
#undef PG8_TB
#undef PG8_SCB
#undef PG8_SCLDMA
}
}

struct Args { const float* in[17]; float* out; unsigned char* ws; int lo, hi, breg, pad; };
struct Frame {
    LAS unsigned char* lds; volatile LAS unsigned* MISC; unsigned* ctl; int tid, lane, wave, G, bid;
    const float *x, *g_mpre, *g_mpost, *g_fpre, *g_fpost, *w_in, *pool_w, *pool_scale, *rpb, *w_out, *dwg, *dwu, *dwd, *router, *mwg, *mwu, *mwd;
    float* out; unsigned char* ws;
};

__device__ __forceinline__ void p0_transpose_item(const float* W, int K, int N, bf16* WT, int kb, int n0, int row_base, LAS float* scr, int lane) {
    const int k0 = 64 * kb;
#pragma unroll 8
    for (int i = 0; i < 32; ++i) { const int kk = 2 * i + (lane >> 5); scr[kk * 33 + (lane & 31)] = W[(size_t)(k0 + kk) * N + n0 + (lane & 31)]; }
    LDS_WAIT(); asm volatile("" ::: "memory");
    const int c = lane & 7;
#pragma unroll
    for (int j = 0; j < 4; ++j) { const int n = (lane >> 3) + 8 * j; const LAS float* s = scr + (8 * c) * 33 + n;
        v4u o; o.x = pk2(s[0 * 33], s[1 * 33]); o.y = pk2(s[2 * 33], s[3 * 33]); o.z = pk2(s[4 * 33], s[5 * 33]); o.w = pk2(s[6 * 33], s[7 * 33]);
        *(v4u*)(WT + (size_t)(row_base + n) * K + k0 + 8 * c) = o; }
    LDS_WAIT(); asm volatile("" ::: "memory");
}
__device__ __forceinline__ void p0_matrix(const float* W, int K, int N, bf16* WT, int ilv_half, LAS float* scr, int lane, int gw, int NGW, int& base) {
    const int nblk = N / 32, nitems = (K / 64) * nblk;
    int it = gw - (base % NGW); if (it < 0) it += NGW;
    for (; it < nitems; it += NGW) { const int kb = it / nblk, n0 = 32 * (it % nblk);
        const int rb = ilv_half < 0 ? n0 : (n0 / 128) * 256 + (n0 % 128) + 128 * ilv_half;
        p0_transpose_item(W, K, N, WT, kb, n0, rb, scr, lane); }
    base += nitems;
}
__device__ __forceinline__ void p0_transpose_item_fp8(const float* W, int K, int N, unsigned char* WT, int kt, int n0, int row_base, float scale, LAS float* scr, int lane) {
    const int k0 = 128 * kt;
#pragma unroll 8
    for (int i = 0; i < 64; ++i) { const int kk = 2 * i + (lane >> 5); scr[kk * 33 + (lane & 31)] = W[(size_t)(k0 + kk) * N + n0 + (lane & 31)] * scale; }
    LDS_WAIT(); asm volatile("" ::: "memory");
    const int c = lane & 7;
#pragma unroll 1
    for (int pass = 0; pass < 4; ++pass) { const int n = (lane >> 3) + 8 * pass; const LAS float* sp = scr + (16 * c) * 33 + n;
        v4u o;
#pragma unroll
        for (int d = 0; d < 4; ++d) { int w = 0; w = __builtin_amdgcn_cvt_pk_fp8_f32(sp[(4 * d) * 33], sp[(4 * d + 1) * 33], w, false); w = __builtin_amdgcn_cvt_pk_fp8_f32(sp[(4 * d + 2) * 33], sp[(4 * d + 3) * 33], w, true); o[d] = (unsigned)w; }
        *(v4u*)(WT + (size_t)(row_base + n) * K + k0 + 16 * c) = o; }
    LDS_WAIT(); asm volatile("" ::: "memory");
}
__device__ __forceinline__ void p0_transpose_item_fp6(const float* W, int K, int N, unsigned char* WT, int kt, int n0, int row_base, float scale, LAS float* scr, int lane) {
    const int k0 = 128 * kt;
#pragma unroll 8
    for (int i = 0; i < 64; ++i) { const int kk = 2 * i + (lane >> 5); scr[kk * 33 + (lane & 31)] = W[(size_t)(k0 + kk) * N + n0 + (lane & 31)] * scale; }
    LDS_WAIT(); asm volatile("" ::: "memory");
    const int n = lane & 31, g = lane >> 5;
    unsigned char* rp = WT + (size_t)(row_base + n) * K + 128 * kt;
#pragma unroll 1
    for (int h = 0; h < 2; ++h) { const int fq = 2 * h + g; const LAS float* sp = scr + (32 * fq) * 33 + n;
        f32x16 x, y;
#pragma unroll
        for (int i = 0; i < 16; ++i) { x[i] = sp[i * 33]; y[i] = sp[(16 + i) * 33]; }
        const i32x6 o = __builtin_amdgcn_cvt_scalef32_2xpk16_fp6_f32(x, y, 1.0f);
        *(v4u*)(rp + 16 * fq) = (v4u){(unsigned)o[0], (unsigned)o[1], (unsigned)o[2], (unsigned)o[3]};
        *(v4u*)(rp + 64 + 16 * fq) = (v4u){(unsigned)o[4], (unsigned)o[5], 0u, 0u}; }
    LDS_WAIT(); asm volatile("" ::: "memory");
}
__device__ __forceinline__ void p0_matrix_fp6(const float* W, int K, int N, unsigned char* WT, int ilv_half, float scale, LAS float* scr, int lane, int gw, int NGW, int& base) {
    const int nblk = N / 32, nitems = (K / 128) * nblk;
    int it = gw - (base % NGW); if (it < 0) it += NGW;
    for (; it < nitems; it += NGW) { const int kt = it / nblk, n0 = 32 * (it % nblk);
        const int rb = (n0 / 128) * 256 + (n0 % 128) + 128 * ilv_half;
        p0_transpose_item_fp6(W, K, N, WT, kt, n0, rb, scale, scr, lane); }
    base += nitems;
}
__device__ __forceinline__ void p0_matrix_fp8(const float* W, int K, int N, unsigned char* WT, int ilv_half, float scale, LAS float* scr, int lane, int gw, int NGW, int& base) {
    const int nblk = N / 32, nitems = (K / 128) * nblk;
    int it = gw - (base % NGW); if (it < 0) it += NGW;
    for (; it < nitems; it += NGW) { const int kt = it / nblk, n0 = 32 * (it % nblk);
        const int rb = ilv_half < 0 ? n0 : (n0 / 128) * 256 + (n0 % 128) + 128 * ilv_half;
        p0_transpose_item_fp8(W, K, N, WT, kt, n0, rb, scale, scr, lane); }
    base += nitems;
}
__device__ __forceinline__ void rms_row_to_bf16(const float* xrow, const float* g, bf16* orow, int lane) {
    const f32x4* xr = (const f32x4*)xrow + lane; const f32x4* gr = (const f32x4*)g + lane;
    f32x4 v[4]; float s = 0.f;
#pragma unroll
    for (int j = 0; j < 4; ++j) { v[j] = xr[64 * j]; s += (v[j].x * v[j].x + v[j].y * v[j].y) + (v[j].z * v[j].z + v[j].w * v[j].w); }
    const float rstd = 1.0f / sqrtf(wave_sum(s) * (1.f / D) + RMS_EPS);
    v2u* o8 = (v2u*)orow + lane;
#pragma unroll
    for (int j = 0; j < 4; ++j) { const f32x4 gg = gr[64 * j]; v2u w; w.x = pk2(v[j].x * rstd * gg.x, v[j].y * rstd * gg.y); w.y = pk2(v[j].z * rstd * gg.z, v[j].w * rstd * gg.w); o8[64 * j] = w; }
}
__device__ __forceinline__ float wave_max(float v) {
#pragma unroll
    for (int o = 1; o < 64; o <<= 1) v = fmaxf(v, __shfl_xor(v, o));
    return v;
}
__device__ __forceinline__ void p0_colblock_i8(Frame& F, const float* W, int N, int n0, unsigned char* W8, float* sW, int dest0) {
    const int tid = F.tid, lane = F.lane, wid = F.wave, n = lane & 31, kh = lane >> 5;
    LAS float* slab = (LAS float*)F.lds; LAS float* cmax = (LAS float*)(F.lds + RING_BYTES);
    __syncthreads();
    float mx = 0.f;
#pragma unroll 1
    for (int i0 = 0; i0 < 64; i0 += 16) {
        float v[16];
#pragma unroll
        for (int i = 0; i < 16; ++i) v[i] = W[(size_t)(128 * wid + 2 * (i0 + i) + kh) * N + n0 + n];
#pragma unroll
        for (int i = 0; i < 16; ++i) { const int k = 128 * wid + 2 * (i0 + i) + kh; slab[k * 32 + (n ^ (k & 31))] = v[i]; mx = fmaxf(mx, fabsf(v[i])); }
    }
    cmax[wid * 64 + lane] = mx;
    __syncthreads();
    float amax = 0.f;
#pragma unroll
    for (int w = 0; w < 8; ++w) amax = fmaxf(amax, fmaxf(cmax[w * 64 + n], cmax[w * 64 + 32 + n]));
    const float sc = amax > 0.f ? amax * (1.0f / 127.0f) : 1.0f, inv = amax > 0.f ? 127.0f / amax : 0.f;
    const int kc = tid >> 5, dest = dest0 + n;
#pragma unroll 1
    for (int q4 = 0; q4 < 4; ++q4) { v4u o;
#pragma unroll
        for (int d = 0; d < 4; ++d) { unsigned w = 0u;
#pragma unroll
            for (int j = 0; j < 4; ++j) { const int k = 64 * kc + 16 * q4 + 4 * d + j; w |= ((unsigned)__float2int_rn(slab[k * 32 + (n ^ (k & 31))] * inv) & 0xffu) << (8 * j); }
            o[d] = w; }
        *(v4u*)(W8 + (size_t)dest * D + 64 * kc + 16 * q4) = o; }
    if (kc == 0) sW[dest] = sc;
}
__device__ __forceinline__ void p0_i8_weights(Frame& F) {
    constexpr int NB_D = I8_DENSE ? 2 * (DFF / 32) : 0, NB_P = I8_PROJ ? DEPTH * (DIN / 32) : 0;
    for (int cb = F.bid; cb < NB_D + NB_P; cb += F.G) {
        if (cb < NB_D) { const int half = cb / (DFF / 32), n0 = 32 * (cb % (DFF / 32));
            p0_colblock_i8(F, half ? F.dwu : F.dwg, DFF, n0, F.ws + WS_WGU0, (float*)(F.ws + WS_SW0), (n0 / 128) * 256 + (n0 % 128) + 128 * half); }
        else { const int c2 = cb - NB_D, l = c2 / (DIN / 32), n0 = 32 * (c2 % (DIN / 32));
            p0_colblock_i8(F, F.w_in + (size_t)l * D * DIN, DIN, n0, F.ws + WS_WIN + (size_t)l * DIN * D, (float*)(F.ws + WS_SWIN) + l * DIN, n0); }
    }
    __syncthreads();
}
__device__ __forceinline__ void rms_row_to_i8(const float* xrow, const float* g, unsigned char* orow, float* sa, int lane) {
    const f32x4* xr = (const f32x4*)xrow + lane; const f32x4* gr = (const f32x4*)g + lane;
    f32x4 v[4]; float s = 0.f;
#pragma unroll
    for (int j = 0; j < 4; ++j) { v[j] = xr[64 * j]; s += (v[j].x * v[j].x + v[j].y * v[j].y) + (v[j].z * v[j].z + v[j].w * v[j].w); }
    const float rstd = 1.0f / sqrtf(wave_sum(s) * (1.f / D) + RMS_EPS); float am = 0.f;
#pragma unroll
    for (int j = 0; j < 4; ++j) { v[j] = v[j] * rstd * gr[64 * j]; am = fmaxf(fmaxf(am, fmaxf(fabsf(v[j].x), fabsf(v[j].y))), fmaxf(fabsf(v[j].z), fabsf(v[j].w))); }
    am = wave_max(am); const float inv = am > 0.f ? 127.0f / am : 0.f;
#pragma unroll
    for (int j = 0; j < 4; ++j) ((unsigned*)orow + lane)[64 * j] = ((unsigned)__float2int_rn(v[j].x * inv) & 0xffu) | (((unsigned)__float2int_rn(v[j].y * inv) & 0xffu) << 8) | (((unsigned)__float2int_rn(v[j].z * inv) & 0xffu) << 16) | (((unsigned)__float2int_rn(v[j].w * inv) & 0xffu) << 24);
    if (lane == 0) *sa = am > 0.f ? am * (1.0f / 127.0f) : 1.0f;
}
__device__ __forceinline__ void p0_prologue(Frame& F0) {
    Frame F = F0; { int t_ = threadIdx.x; asm volatile("" : "+v"(t_)); F.tid = t_; F.lane = t_ & 63; F.wave = __builtin_amdgcn_readfirstlane(t_ >> 6); }
    LAS float* scr = (LAS float*)(F.lds + F.wave * 16896);
    const int gw = F.bid * 8 + F.wave, NGW = F.G * 8, gt = F.bid * 512 + F.tid, NGT = F.G * 512;
    { v4u z = (v4u){0u, 0u, 0u, 0u}; v4u* L = (v4u*)(F.ws + WS_LIST); for (int i = gt; i < (int)(NE * T / 4); i += NGT) L[i] = z;
      int* id = (int*)(F.ws + WS_LISTID); for (int i = gt; i < T; i += NGT) id[i] = i; }
    int base = 0;
    for (int l = 0; l < DEPTH; ++l) {
#if !I8_PROJ
        p0_matrix(F.w_in + (size_t)l * D * DIN, D, DIN, (bf16*)(F.ws + WS_WIN) + (size_t)l * DIN * D, -1, scr, F.lane, gw, NGW, base);
#endif
        p0_matrix(F.w_out + (size_t)l * D * D, D, D, (bf16*)(F.ws + WS_WOUT) + (size_t)l * D * D, -1, scr, F.lane, gw, NGW, base);
        for (int g = 0; g < 4; ++g) p0_matrix(F.pool_w + (size_t)(l * 4 + g) * 128 * 128, 128, 128, (bf16*)(F.ws + WS_WP) + (size_t)(l * 4 + g) * 128 * 128, -1, scr, F.lane, gw, NGW, base);
    }
#if !I8_DENSE
    p0_matrix(F.dwg, D, DFF, (bf16*)(F.ws + WS_WGU0), 0, scr, F.lane, gw, NGW, base);
    p0_matrix(F.dwu, D, DFF, (bf16*)(F.ws + WS_WGU0), 1, scr, F.lane, gw, NGW, base);
#endif
#if FP8_DDOWN
    p0_matrix_fp8(F.dwd, DFF, D, F.ws + WS_WD0, -1, W8_DN, scr, F.lane, gw, NGW, base);
#else
    p0_matrix(F.dwd, DFF, D, (bf16*)(F.ws + WS_WD0), -1, scr, F.lane, gw, NGW, base);
#endif
    for (int e = 0; e < NE; ++e) {
#if FP8_MOE
#if FP6_UP
        p0_matrix_fp6(F.mwg + (size_t)e * D * DFFE, D, DFFE, F.ws + WS_WGUM + (size_t)e * 2 * DFFE * D, 0, S6W, scr, F.lane, gw, NGW, base);
        p0_matrix_fp6(F.mwu + (size_t)e * D * DFFE, D, DFFE, F.ws + WS_WGUM + (size_t)e * 2 * DFFE * D, 1, S6W, scr, F.lane, gw, NGW, base);
#else
        p0_matrix_fp8(F.mwg + (size_t)e * D * DFFE, D, DFFE, F.ws + WS_WGUM + (size_t)e * 2 * DFFE * D, 0, W8_UP, scr, F.lane, gw, NGW, base);
        p0_matrix_fp8(F.mwu + (size_t)e * D * DFFE, D, DFFE, F.ws + WS_WGUM + (size_t)e * 2 * DFFE * D, 1, W8_UP, scr, F.lane, gw, NGW, base);
#endif
        p0_matrix_fp8(F.mwd + (size_t)e * DFFE * D, DFFE, D, F.ws + WS_WDM + (size_t)e * D * DFFE, -1, W8_DN, scr, F.lane, gw, NGW, base);
#else
        p0_matrix(F.mwg + (size_t)e * D * DFFE, D, DFFE, (bf16*)(F.ws + WS_WGUM) + (size_t)e * 2 * DFFE * D, 0, scr, F.lane, gw, NGW, base);
        p0_matrix(F.mwu + (size_t)e * D * DFFE, D, DFFE, (bf16*)(F.ws + WS_WGUM) + (size_t)e * 2 * DFFE * D, 1, scr, F.lane, gw, NGW, base);
        p0_matrix(F.mwd + (size_t)e * DFFE * D, DFFE, D, (bf16*)(F.ws + WS_WDM) + (size_t)e * D * DFFE, -1, scr, F.lane, gw, NGW, base);
#endif
    }
    bf16* HN = (bf16*)(F.ws + WS_HN);
#if I8_PROJ
    for (int m = gw; m < T; m += NGW) rms_row_to_i8(F.x + (size_t)m * D, F.g_mpre, (unsigned char*)HN + (size_t)m * D, (float*)(F.ws + WS_SA) + m, F.lane);
#else
    for (int m = gw; m < T; m += NGW) rms_row_to_bf16(F.x + (size_t)m * D, F.g_mpre, HN + (size_t)m * D, F.lane);
#endif
#if I8_DENSE || I8_PROJ
    p0_i8_weights(F);
#endif
}

__device__ __forceinline__ unsigned ld_cnt(const unsigned* ctl, int e) { return __hip_atomic_load(ctl + CW_CNT + 64 * e, RLX_AGENT); }

__device__ __forceinline__ void ld_bf16_row(const bf16* row, int lane, f32x4 (&v)[4]) {
    const v2u* p = (const v2u*)row + lane;
#pragma unroll
    for (int j = 0; j < 4; ++j) { const v2u w = p[64 * j]; v[j] = (f32x4){bflo(w.x), bfhi(w.x), bflo(w.y), bfhi(w.y)}; }
}
__device__ __forceinline__ float sumsq16(const f32x4 (&v)[4]) {
    float s = 0.f;
#pragma unroll
    for (int j = 0; j < 4; ++j) s += (v[j].x * v[j].x + v[j].y * v[j].y) + (v[j].z * v[j].z + v[j].w * v[j].w);
    return s;
}
#define H16 FP8_MOE
struct NormRow { v2u a[4]; v2u b[4]; f32x4 hf[4]; v2u hb[4]; float g0, g1; };
template <bool FFN>
__device__ __forceinline__ void norm_phase(Frame& F0, int l) {
    Frame F = F0; { int t_ = threadIdx.x; asm volatile("" : "+v"(t_)); F.tid = t_; F.lane = t_ & 63; F.wave = __builtin_amdgcn_readfirstlane(t_ >> 6); }
    const int lane = F.lane, gw = F.bid * 8 + F.wave, NGW = F.G * 8;
    const bool moe = (l & 1) != 0;
    LAS float* WR = (LAS float*)F.lds;
    LAS unsigned* lcnt = (LAS unsigned*)(F.lds + LCNT_OFF); LAS unsigned* lbase = lcnt + 8;
    LAS int* bst = (LAS int*)(F.lds + BST_OFF);
    LAS float* rowbuf = (LAS float*)(F.lds + 32768 + F.wave * 4352);
    if (!FFN && moe) {
        for (int i = F.tid; i < D * NE; i += 512) { const int d = i >> 3, e = i & 7; WR[e * D + d] = F.router[i]; }
        if (F.tid < 8) lcnt[F.tid] = 0u;
        __syncthreads();
    }
    if (FFN && moe) {
        if (F.tid == 0) { int s = 0; for (int e = 0; e < NE; ++e) { bst[e] = s; s += (int)((ld_cnt(F.ctl, e) + 255u) >> 8); } }
        __syncthreads();
    }
    const float* gA = FFN ? F.g_fpost + l * D : F.g_mpost + l * D;
    const float* gB = FFN ? F.g_mpre + (l + 1) * D : F.g_fpre + l * D;
    const bool haveB = FFN ? (l + 1 < DEPTH) : true;
    const bool last = FFN && (l + 1 == DEPTH);
    const bool I8HN = FFN ? (I8_PROJ != 0) : (I8_DENSE && !moe);
    const bool hold_f32 = (!FFN && l == 0) || !H16;
    const bf16* addsrc = FFN ? (const bf16*)(F.ws + WS_Y) : (const bf16*)(F.ws + WS_MIX);
    const float* hold32 = (!FFN && l == 0) ? F.x : F.out;
    bf16* H = (bf16*)(F.ws + WS_H16);
    bf16* HN = (bf16*)(F.ws + WS_HN);
    const v2u* info = (const v2u*)(F.ws + WS_INFO); const f32x2* ginfo = (const f32x2*)(F.ws + WS_INFO + 256 * 1024);
#define NORM_LOAD(R, m_, nf_, gg_) do { \
        if (FFN && moe) { const int e0_ = (int)((nf_).x >> 16), p0_ = (int)((nf_).x & 0xffffu), e1_ = (int)((nf_).y >> 16), p1_ = (int)((nf_).y & 0xffffu); \
            if (Y8_MOE) { const unsigned* pa_ = (const unsigned*)((const unsigned char*)addsrc + (size_t)(256 * bst[e0_] + p0_) * D) + lane; const unsigned* pb_ = (const unsigned*)((const unsigned char*)addsrc + (size_t)(256 * bst[e1_] + p1_) * D) + lane; \
                _Pragma("unroll") for (int j = 0; j < 4; ++j) { (R).a[j].x = pa_[64 * j]; (R).b[j].x = pb_[64 * j]; } (R).g0 = (gg_).x * (1.0f / YS); (R).g1 = (gg_).y * (1.0f / YS); }   \
            else { const v2u* pa_ = (const v2u*)(addsrc + (size_t)(256 * bst[e0_] + p0_) * D) + lane; const v2u* pb_ = (const v2u*)(addsrc + (size_t)(256 * bst[e1_] + p1_) * D) + lane; \
            _Pragma("unroll") for (int j = 0; j < 4; ++j) { (R).a[j] = pa_[64 * j]; (R).b[j] = pb_[64 * j]; } (R).g0 = (gg_).x; (R).g1 = (gg_).y; } } \
        else { const v2u* pa_ = (const v2u*)(addsrc + (size_t)(m_) * D) + lane; _Pragma("unroll") for (int j = 0; j < 4; ++j) (R).a[j] = pa_[64 * j]; } \
        if (hold_f32) { const f32x4* hp_ = (const f32x4*)(hold32 + (size_t)(m_) * D) + lane; _Pragma("unroll") for (int j = 0; j < 4; ++j) (R).hf[j] = hp_[64 * j]; } \
        else { const v2u* hp_ = (const v2u*)(H + (size_t)(m_) * D) + lane; _Pragma("unroll") for (int j = 0; j < 4; ++j) (R).hb[j] = hp_[64 * j]; } } while (0)
    int sTok = 0, sE0 = 0, sE1 = 0; float sG0 = 0.f, sG1 = 0.f;
    v2u nfL = (v2u){0u, 0u}; f32x2 ggL = (f32x2){0.f, 0.f};
    if (FFN && moe) { const int mi = gw + lane * NGW; if (mi < T) { nfL = info[mi]; ggL = ginfo[mi]; } }
    const int nfLx = (int)nfL.x, nfLy = (int)nfL.y; const float ggLx_ = ggL.x, ggLy_ = ggL.y; const int ggLx = __float_as_int(ggLx_), ggLy = __float_as_int(ggLy_);
#define NORM_INFO(nf_, gg_, it_) do { if (FFN && moe) { const int x_ = __builtin_amdgcn_readlane(nfLx, it_), y_ = __builtin_amdgcn_readlane(nfLy, it_), gx_ = __builtin_amdgcn_readlane(ggLx, it_), gy_ = __builtin_amdgcn_readlane(ggLy, it_); \
        (nf_).x = (unsigned)x_; (nf_).y = (unsigned)y_; (gg_).x = __int_as_float(gx_); (gg_).y = __int_as_float(gy_); } } while (0)
#define NORM_ROW(R, m_, it_) do { \
        f32x4 a[4]; \
        _Pragma("unroll") for (int j = 0; j < 4; ++j) { \
            if (FFN && moe && Y8_MOE) { const int wa_ = (int)(R).a[j].x, wb_ = (int)(R).b[j].x; const f32x2 a01 = __builtin_amdgcn_cvt_pk_f32_fp8(wa_, false), a23 = __builtin_amdgcn_cvt_pk_f32_fp8(wa_, true), b01 = __builtin_amdgcn_cvt_pk_f32_fp8(wb_, false), b23 = __builtin_amdgcn_cvt_pk_f32_fp8(wb_, true); \
                a[j] = (f32x4){a01.x, a01.y, a23.x, a23.y} * (R).g0 + (f32x4){b01.x, b01.y, b23.x, b23.y} * (R).g1; } \
            else { a[j] = (f32x4){bflo((R).a[j].x), bfhi((R).a[j].x), bflo((R).a[j].y), bfhi((R).a[j].y)}; \
            if (FFN && moe) { const f32x4 b = (f32x4){bflo((R).b[j].x), bfhi((R).b[j].x), bflo((R).b[j].y), bfhi((R).b[j].y)}; a[j] = a[j] * (R).g0 + b * (R).g1; } } } \
        const float r1 = 1.0f / sqrtf(wave_sum(sumsq16(a)) * (1.f / D) + RMS_EPS); \
        const f32x4* gAp = (const f32x4*)gA + lane; \
        f32x4 h[4]; \
        _Pragma("unroll") for (int j = 0; j < 4; ++j) { const f32x4 ho = hold_f32 ? (R).hf[j] : (f32x4){bflo((R).hb[j].x), bfhi((R).hb[j].x), bflo((R).hb[j].y), bfhi((R).hb[j].y)}; h[j] = ho + a[j] * r1 * gAp[64 * j]; } \
        if (last || !H16) { f32x4* op = (f32x4*)(F.out + (size_t)(m_) * D) + lane; _Pragma("unroll") for (int j = 0; j < 4; ++j) op[64 * j] = h[j]; } \
        else { v2u* op = (v2u*)(H + (size_t)(m_) * D) + lane; _Pragma("unroll") for (int j = 0; j < 4; ++j) { v2u w; w.x = cvt_pk_bf16(h[j].x, h[j].y); w.y = cvt_pk_bf16(h[j].z, h[j].w); op[64 * j] = w; } } \
        if (haveB) { \
            const float r2 = 1.0f / sqrtf(wave_sum(sumsq16(h)) * (1.f / D) + RMS_EPS); \
            const f32x4* gBp = (const f32x4*)gB + lane; v2u* o8 = (v2u*)(HN + (size_t)(m_) * D) + lane; \
            _Pragma("unroll") for (int j = 0; j < 4; ++j) { h[j] = h[j] * r2 * gBp[64 * j]; \
                if (FP8_MOE && FP6_UP && !FFN && moe) { const int e_ = 256 * j + 4 * lane, ix_ = e_ + (e_ >> 5); rowbuf[ix_] = h[j].x * S6A; rowbuf[ix_ + 1] = h[j].y * S6A; rowbuf[ix_ + 2] = h[j].z * S6A; rowbuf[ix_ + 3] = h[j].w * S6A; } \
                else if (FP8_MOE && !FFN && moe) { int w = 0; w = __builtin_amdgcn_cvt_pk_fp8_f32(h[j].x, h[j].y, w, false); w = __builtin_amdgcn_cvt_pk_fp8_f32(h[j].z, h[j].w, w, true); ((unsigned*)((unsigned char*)HN + (size_t)(m_) * D) + lane)[64 * j] = (unsigned)w; } \
                else if (!I8HN) { v2u w; w.x = cvt_pk_bf16(h[j].x, h[j].y); w.y = cvt_pk_bf16(h[j].z, h[j].w); o8[64 * j] = w; } } \
            if (FP8_MOE && FP6_UP && !FFN && moe) { asm volatile("s_waitcnt lgkmcnt(0)" ::: "memory"); \
                if (lane < 32) { f32x16 x_, y_; _Pragma("unroll") for (int i = 0; i < 16; ++i) { x_[i] = rowbuf[33 * lane + i]; y_[i] = rowbuf[33 * lane + 16 + i]; } \
                    const i32x6 o_ = __builtin_amdgcn_cvt_scalef32_2xpk16_fp6_f32(x_, y_, 1.0f); unsigned char* rp_ = (unsigned char*)HN + (size_t)(m_) * D + 128 * (lane >> 2); \
                    *(v4u*)(rp_ + 16 * (lane & 3)) = (v4u){(unsigned)o_[0], (unsigned)o_[1], (unsigned)o_[2], (unsigned)o_[3]}; *(v4u*)(rp_ + 64 + 16 * (lane & 3)) = (v4u){(unsigned)o_[4], (unsigned)o_[5], 0u, 0u}; } \
                asm volatile("s_waitcnt lgkmcnt(0)" ::: "memory"); } \
            if (I8HN) { float am = 0.f; \
                _Pragma("unroll") for (int j = 0; j < 4; ++j) am = fmaxf(fmaxf(am, fmaxf(fabsf(h[j].x), fabsf(h[j].y))), fmaxf(fabsf(h[j].z), fabsf(h[j].w))); \
                am = wave_max(am); const float sa_ = am > 0.f ? am * (1.0f / 127.0f) : 1.0f, inv_ = am > 0.f ? 127.0f / am : 0.f; \
                _Pragma("unroll") for (int j = 0; j < 4; ++j) { const unsigned w = ((unsigned)__float2int_rn(h[j].x * inv_) & 0xffu) | (((unsigned)__float2int_rn(h[j].y * inv_) & 0xffu) << 8) | (((unsigned)__float2int_rn(h[j].z * inv_) & 0xffu) << 16) | (((unsigned)__float2int_rn(h[j].w * inv_) & 0xffu) << 24); \
                    ((unsigned*)((unsigned char*)HN + (size_t)(m_) * D) + lane)[64 * j] = w; } \
                if (lane == 0) ((float*)(F.ws + WS_SA))[(m_)] = sa_; } \
            if (!FFN && moe) { \
                float lg[NE]; \
                _Pragma("unroll") for (int e = 0; e < NE; ++e) { float s_ = 0.f; \
                    _Pragma("unroll") for (int j = 0; j < 4; ++j) { const f32x4 w = *(const LAS f32x4*)(WR + e * D + 256 * j + 4 * lane); s_ += (h[j].x * w.x + h[j].y * w.y) + (h[j].z * w.z + h[j].w * w.w); } \
                    lg[e] = wave_sum(s_); } \
                int e0 = 0; float l0 = lg[0]; \
                _Pragma("unroll") for (int e = 1; e < NE; ++e) if (lg[e] > l0) { l0 = lg[e]; e0 = e; } \
                int e1 = -1; float l1 = -INFINITY; \
                _Pragma("unroll") for (int e = 0; e < NE; ++e) if (e != e0 && lg[e] > l1) { l1 = lg[e]; e1 = e; } \
                const float g0 = 1.0f / (1.0f + __expf(l1 - l0)), g1 = 1.0f - g0; \
                if (lane == (it_)) { sTok = (m_); sE0 = e0; sE1 = e1; sG0 = g0; sG1 = g1; } \
            } \
        } } while (0)
    int it = 0;
    NormRow c0, c1; v2u nf = (v2u){0u, 0u}; f32x2 gg = (f32x2){0.f, 0.f};
    if (gw < T) { NORM_INFO(nf, gg, 0); NORM_LOAD(c0, gw, nf, gg); }
    if (gw + NGW < T) { NORM_INFO(nf, gg, 1); NORM_LOAD(c1, gw + NGW, nf, gg); }
    for (int m = gw; m < T; m += 2 * NGW, it += 2) {
        const int m1 = m + NGW, m2 = m + 2 * NGW, m3 = m + 3 * NGW;
        NormRow n0, n1;
        if (m2 < T) { NORM_INFO(nf, gg, it + 2); NORM_LOAD(n0, m2, nf, gg); }
        if (m3 < T) { NORM_INFO(nf, gg, it + 3); NORM_LOAD(n1, m3, nf, gg); }
        NORM_ROW(c0, m, it);
        if (m1 < T) NORM_ROW(c1, m1, it + 1);
        c0 = n0; c1 = n1;
    }
    it = (T - gw + NGW - 1) / NGW; if (it < 0) it = 0;
#undef NORM_ROW
#undef NORM_INFO
#undef NORM_LOAD
    if (!FFN && moe) {
        unsigned loc0 = 0u, loc1 = 0u;
        if (lane < it) { loc0 = __hip_atomic_fetch_add(lcnt + sE0, 1u, __ATOMIC_RELAXED, __HIP_MEMORY_SCOPE_WORKGROUP); loc1 = __hip_atomic_fetch_add(lcnt + sE1, 1u, __ATOMIC_RELAXED, __HIP_MEMORY_SCOPE_WORKGROUP); }
        __syncthreads();
        if (F.tid < 8) lbase[F.tid] = __hip_atomic_fetch_add(F.ctl + CW_CNT + 64 * F.tid, lcnt[F.tid], RLX_AGENT);
        __syncthreads();
        if (lane < it) {
            const unsigned p0 = lbase[sE0] + loc0, p1 = lbase[sE1] + loc1;
            int* list = (int*)(F.ws + WS_LIST);
            list[(size_t)sE0 * T + p0] = sTok; list[(size_t)sE1 * T + p1] = sTok;
            v2u nf; nf.x = ((unsigned)sE0 << 16) | p0; nf.y = ((unsigned)sE1 << 16) | p1;
            ((v2u*)(F.ws + WS_INFO))[sTok] = nf; ((f32x2*)(F.ws + WS_INFO + 256 * 1024))[sTok] = (f32x2){sG0, sG1};
        }
    }
}

__device__ __forceinline__ size_t mixo_index(size_t tok, int ch) { return ((tok >> 8) * 16 + (size_t)(ch >> 6)) * (256 * 64) + (tok & 255) * 64 + (ch & 63); }
constexpr int U_PITCH = 1040, U_ROWS = 80, BIAS_OFF = U_PITCH * U_ROWS;
typedef __bf16 bf16x2_t __attribute__((ext_vector_type(2)));
template <int HW>
__device__ __forceinline__ void pool_frags(bf16x8 (&dfr)[2][4], const LAS unsigned char* cb, const float (&inv)[2]) {
    unsigned one_lo_ = 0x00003f80u, one_hi_ = 0x3f800000u; asm volatile("" : "+v"(one_lo_), "+v"(one_hi_));
    const bf16x2_t ONE_LO = __builtin_bit_cast(bf16x2_t, one_lo_), ONE_HI = __builtin_bit_cast(bf16x2_t, one_hi_);
#pragma unroll
    for (int mt = 0; mt < 2; ++mt)
#pragma unroll
        for (int ks = 0; ks < 4; ++ks) {
            const LAS unsigned char* cp = cb + mt * 16 * U_PITCH + ks * 64;
            float s0 = 0.f, s1 = 0.f, s2 = 0.f, s3 = 0.f, s4 = 0.f, s5 = 0.f, s6 = 0.f, s7 = 0.f;
#pragma unroll
            for (int d = -HW; d < HW; ++d) { const v4u v = *(const LAS v4u*)(cp + d * U_PITCH); const unsigned vx = v.x, vy = v.y, vz = v.z, vw = v.w;
                const bf16x2_t px = __builtin_bit_cast(bf16x2_t, vx), py = __builtin_bit_cast(bf16x2_t, vy), pz = __builtin_bit_cast(bf16x2_t, vz), pw = __builtin_bit_cast(bf16x2_t, vw);
                s0 = __builtin_amdgcn_fdot2_f32_bf16(px, ONE_LO, s0, false); s1 = __builtin_amdgcn_fdot2_f32_bf16(px, ONE_HI, s1, false);
                s2 = __builtin_amdgcn_fdot2_f32_bf16(py, ONE_LO, s2, false); s3 = __builtin_amdgcn_fdot2_f32_bf16(py, ONE_HI, s3, false);
                s4 = __builtin_amdgcn_fdot2_f32_bf16(pz, ONE_LO, s4, false); s5 = __builtin_amdgcn_fdot2_f32_bf16(pz, ONE_HI, s5, false);
                s6 = __builtin_amdgcn_fdot2_f32_bf16(pw, ONE_LO, s6, false); s7 = __builtin_amdgcn_fdot2_f32_bf16(pw, ONE_HI, s7, false); }
            const v4u c = *(const LAS v4u*)cp; const float iv = inv[mt];
            v4u p; p.x = cvt_pk_bf16(s0 * iv - bflo(c.x), s1 * iv - bfhi(c.x)); p.y = cvt_pk_bf16(s2 * iv - bflo(c.y), s3 * iv - bfhi(c.y));
            p.z = cvt_pk_bf16(s4 * iv - bflo(c.z), s5 * iv - bfhi(c.z)); p.w = cvt_pk_bf16(s6 * iv - bflo(c.w), s7 * iv - bfhi(c.w));
            dfr[mt][ks] = __builtin_bit_cast(bf16x8, p);
        }
}
__device__ __forceinline__ void mixer_phase(Frame& F0, int l) {
    Frame F = F0; { int t_ = threadIdx.x; asm volatile("" : "+v"(t_)); F.tid = t_; F.lane = t_ & 63; F.wave = __builtin_amdgcn_readfirstlane(t_ >> 6); }
    const int tid = F.tid, lane = F.lane, wid = F.wave, fr = lane & 15, fq = lane >> 4;
    const bf16* proj = (const bf16*)(F.ws + WS_PROJ); bf16* mixo = (bf16*)(F.ws + WS_MIXO);
    const bf16* Wp = (const bf16*)(F.ws + WS_WP) + (size_t)l * 4 * 128 * 128; const float* pscale = F.pool_scale + l * DPOOL;
    const int vcu = (F.G % 8 == 0) ? (F.bid % 8) * (F.G / 8) + F.bid / 8 : F.bid;
    for (int unit = vcu; unit < BATCH * GROWS; unit += F.G) {
        const int b = unit / GROWS, r = unit % GROWS, tb0 = b * SEQ, trow0 = 64 * r - 8;
        __syncthreads();
        { v4u uv[10];
#pragma unroll
          for (int k = 0; k < 10; ++k) { const int idx = tid + 512 * k, row = idx >> 6, pc = idx & 63, t = trow0 + row; uv[k] = (v4u){0u, 0u, 0u, 0u}; if (t >= 0 && t < SEQ) uv[k] = *(const v4u*)(proj + (size_t)(tb0 + t) * UPITCH + pc * 8); }
#pragma unroll
          for (int k = 0; k < 10; ++k) { const int idx = tid + 512 * k, row = idx >> 6, pc = idx & 63; *(LAS v4u*)(F.lds + row * U_PITCH + pc * 16) = uv[k]; } }
        __syncthreads();
#ifndef REP_POOL
#define REP_POOL 1
#endif
        for (int rep_ = 0; rep_ < REP_POOL; ++rep_) {
            const int g = wid >> 1, half = wid & 1, hw = 1 << g;
            const bf16* Wg = Wp + (size_t)g * 128 * 128;
            bf16x8 wnext[4];
#pragma unroll
            for (int ks = 0; ks < 4; ++ks) wnext[ks] = *(const bf16x8*)(Wg + (size_t)fr * 128 + 32 * ks + 8 * fq);
            bf16x8 dfr[2][4];
            { const LAS unsigned char* cb = F.lds + (8 + 32 * half + fr) * U_PITCH + (128 * g + 8 * fq) * 2;
              float inv[2];
#pragma unroll
              for (int mt = 0; mt < 2; ++mt) { const int t = 64 * r + 32 * half + 16 * mt + fr; inv[mt] = 1.0f / (float)(min(t + hw, SEQ) - max(t - hw, 0)); }
              switch (g) { case 0: pool_frags<1>(dfr, cb, inv); break; case 1: pool_frags<2>(dfr, cb, inv); break; case 2: pool_frags<4>(dfr, cb, inv); break; default: pool_frags<8>(dfr, cb, inv); break; } }
#pragma unroll
            for (int nt = 0; nt < 8; ++nt) {
                bf16x8 wf[4];
#pragma unroll
                for (int ks = 0; ks < 4; ++ks) wf[ks] = wnext[ks];
                if (nt + 1 < 8) {
#pragma unroll
                    for (int ks = 0; ks < 4; ++ks) wnext[ks] = *(const bf16x8*)(Wg + (size_t)(16 * (nt + 1) + fr) * 128 + 32 * ks + 8 * fq); }
                const f32x4 sc = *(const f32x4*)(pscale + 128 * g + 16 * nt + 4 * fq);
#pragma unroll
                for (int mt = 0; mt < 2; ++mt) {
                    f32x4 acc = (f32x4){0.f, 0.f, 0.f, 0.f};
#pragma unroll
                    for (int ks = 0; ks < 4; ++ks) acc = __builtin_amdgcn_mfma_f32_16x16x32_bf16(wf[ks], dfr[mt][ks], acc, 0, 0, 0);
                    acc = acc * sc;
                    v2u w; w.x = cvt_pk_bf16(acc[0], acc[1]); w.y = cvt_pk_bf16(acc[2], acc[3]);
                    *(v2u*)(mixo + mixo_index((size_t)(tb0 + 64 * r + 32 * half + 16 * mt + fr), 128 * g + 16 * nt + 4 * fq)) = w;
                }
            }
        }
    }
    __syncthreads();
}

constexpr int NA_KTOK = 80, NA_KROW = 64 * NA_KTOK, NA_VD = 144, NA_VROW = 32 * NA_VD, NA_NKR = 11, NA_NPC = NA_NKR * 256;
constexpr int NA_K_OFF = 0, NA_V_OFF = NA_NKR * NA_KROW, NA_B_OFF = NA_V_OFF + NA_NKR * NA_VROW;
static_assert(NA_B_OFF + 15 * 128 <= RING_BYTES, "NA LDS map");
#ifndef REP_NA
#define REP_NA 1
#endif
__device__ __forceinline__ void na_phase(Frame& F0, int l) {
    Frame F = F0; { int t_ = threadIdx.x; asm volatile("" : "+v"(t_)); F.tid = t_; F.lane = t_ & 63; F.wave = __builtin_amdgcn_readfirstlane(t_ >> 6); }
    const int tid = F.tid, lane = F.lane, wid = F.wave, fr = lane & 15, fq = lane >> 4;
    const bf16* projq = (const bf16*)(F.ws + WS_PQ); const bf16* projk = (const bf16*)(F.ws + WS_PK); const bf16* Vt = (const bf16*)(F.ws + WS_VT); bf16* mixo = (bf16*)(F.ws + WS_MIXO);
    const float* rpb = F.rpb + (size_t)l * NH * 15 * 31;
    const int vcu = (F.G % 8 == 0) ? (F.bid % 8) * (F.G / 8) + F.bid / 8 : F.bid;
    constexpr int NU = BATCH * NH * (GROWS / 4);
    const int upc = (NU + F.G - 1) / F.G, u0 = vcu * upc, u1 = min(u0 + upc, NU);
    v4u kreg[6], vreg[6];
    int w_hi = -1, w_bh = -1;
#define NA_UNIT(u, b, h, sg, krlo, nrows) const int b = (u) / (NH * 64), h = ((u) / 64) % NH, sg = (u) % 64, krlo = min(max(4 * sg - 4, 0), GROWS - KH), nrows = min(NA_NKR, GROWS - krlo)
#define NA_PLAN(u, newlo, nnew) NA_UNIT(u, pb_, ph_, psg_, pkrlo_, pnrows_); const bool keep_ = ((u) / 64 == w_bh) && pkrlo_ <= w_hi && pkrlo_ + NA_NKR > w_hi - 1; \
        const int newlo = keep_ ? max(pkrlo_, w_hi) : pkrlo_, nnew = pkrlo_ + pnrows_ - newlo; (void)psg_
#define NA_LOAD(newlo, nnew, b_, h_) do { const size_t tb_ = (size_t)(b_) * SEQ + 64 * (newlo); \
        _Pragma("unroll") for (int k = 0; k < 6; ++k) { const int p = tid + 512 * k, row = p >> 8, rem = p & 255; \
            if (row < (nnew)) { kreg[k] = *(const v4u*)(projk + ((size_t)(h_) * T + tb_ + 64 * row + (rem >> 2)) * 32 + 8 * (rem & 3)); \
                vreg[k] = *(const v4u*)(Vt + vt_index(32 * (h_) + (rem >> 3), (int)tb_ + 64 * row) + 8 * (rem & 7)); } } } while (0)
    int c_newlo = 0, c_nnew = 0;
    if (u0 < u1) { NA_PLAN(u0, nl_, nn_); c_newlo = nl_; c_nnew = nn_; NA_LOAD(nl_, nn_, pb_, ph_); }
    for (int u = u0; u < u1; ++u) {
        NA_UNIT(u, b, h, sg, krlo, nrows);
        __syncthreads();
#pragma unroll
        for (int k = 0; k < 6; ++k) { const int p = tid + 512 * k, row = p >> 8, rem = p & 255;
            if (row < c_nnew) { const int slot = (c_newlo + row) % NA_NKR;
                *(LAS v4u*)(F.lds + NA_K_OFF + slot * NA_KROW + (rem >> 2) * NA_KTOK + 16 * (rem & 3)) = kreg[k];
                *(LAS v4u*)(F.lds + NA_V_OFF + slot * NA_VROW + (rem >> 3) * NA_VD + 16 * (rem & 7)) = vreg[k]; } }
        if (tid < 15 * 32) { const int col = tid & 31, row = tid >> 5; *(LAS float*)(F.lds + NA_B_OFF + tid * 4) = col < 31 ? rpb[(h * 15 + row) * 31 + col] * LOG2E : -INFINITY; }
        __syncthreads();
        w_hi = krlo + nrows; w_bh = u / 64;
        if (u + 1 < u1) { NA_PLAN(u + 1, nl_, nn_); c_newlo = nl_; c_nnew = nn_; NA_LOAD(nl_, nn_, pb_, ph_); }
        const size_t tb0 = (size_t)b * SEQ;
#pragma unroll 1
        for (int tt = 0; tt < 2; ++tt) {
            const int t = wid + 8 * tt, j = t >> 2, qb = t & 3, r = 4 * sg + j, r0 = min(max(r - KH / 2, 0), GROWS - KH);
            const int cs = qb == 0 ? 0 : (qb == 1 ? 8 : (qb == 2 ? 24 : 32));
            const int c = 16 * qb + fr, c0 = min(max(c - KW / 2, 0), GRIDW - KW);
            const int th = c0 - cs;
            bool vq[4]; int boff[4];
#pragma unroll
            for (int q = 0; q < 4; ++q) { vq[q] = (4 * fq + q) >= th; boff[q] = (cs + 4 * fq + q + (vq[q] ? 0 : 16) - c + KW - 1) * 4; }
            const unsigned M0 = (vq[0] ? 0xffffu : 0u) | (vq[1] ? 0xffff0000u : 0u), M1 = (vq[2] ? 0xffffu : 0u) | (vq[3] ? 0xffff0000u : 0u), N0 = ~M0, N1 = ~M1;
            const size_t qtok = tb0 + 64 * r + 16 * qb + fr;
            const bf16x8 qf = *(const bf16x8*)(projq + ((size_t)h * T + qtok) * 32 + 8 * fq);
            int slot[KH];
#pragma unroll
            for (int kr = 0; kr < KH; ++kr) slot[kr] = (r0 + kr) % NA_NKR;
            const LAS unsigned char* kb = F.lds + NA_K_OFF + (cs + fr) * NA_KTOK + 16 * fq;
            const LAS unsigned char* bb = F.lds + NA_B_OFF + (r0 - r + KH - 1) * 128;
            f32x2 sv[KH][2];
            float mx = -INFINITY;
#pragma unroll
            for (int kr = 0; kr < KH; ++kr) {
                f32x4 bv;
#pragma unroll
                for (int q = 0; q < 4; ++q) bv[q] = *(const LAS float*)(bb + boff[q] + kr * 128);
                const f32x4 s0 = __builtin_amdgcn_mfma_f32_16x16x32_bf16(*(const LAS bf16x8*)(kb + slot[kr] * NA_KROW), qf, bv, 0, 0, 0);
                const f32x4 s1 = __builtin_amdgcn_mfma_f32_16x16x32_bf16(*(const LAS bf16x8*)(kb + slot[kr] * NA_KROW + 16 * NA_KTOK), qf, bv, 0, 0, 0);
                const float e0 = vq[0] ? s0[0] : s1[0], e1 = vq[1] ? s0[1] : s1[1], e2 = vq[2] ? s0[2] : s1[2], e3 = vq[3] ? s0[3] : s1[3];
                sv[kr][0] = (f32x2){e0, e1}; sv[kr][1] = (f32x2){e2, e3};
                mx = fmaxf(fmaxf(mx, e0), e1); mx = fmaxf(fmaxf(mx, e2), e3);
            }
            mx = fmaxf(mx, __shfl_xor(mx, 16)); mx = fmaxf(mx, __shfl_xor(mx, 32));
            const f32x2 mx2 = (f32x2){mx, mx};
            f32x2 sum2 = (f32x2){0.f, 0.f};
#pragma unroll
            for (int kr = 0; kr < KH; ++kr)
#pragma unroll
                for (int hh = 0; hh < 2; ++hh) { const f32x2 dlt = sv[kr][hh] - mx2; f32x2 p; p.x = __builtin_amdgcn_exp2f(dlt.x); p.y = __builtin_amdgcn_exp2f(dlt.y); sv[kr][hh] = p; sum2 += p; }
            float sum = sum2.x + sum2.y;
            sum += __shfl_xor(sum, 16); sum += __shfl_xor(sum, 32);
            const LAS unsigned char* vb = F.lds + NA_V_OFF + fr * NA_VD + (cs + 4 * fq) * 2;
            f32x4 o[2] = {(f32x4){0.f, 0.f, 0.f, 0.f}, (f32x4){0.f, 0.f, 0.f, 0.f}};
#pragma unroll
            for (int kr = 0; kr < KH; ++kr) {
                const unsigned u01 = cvt_pk_bf16(sv[kr][0].x, sv[kr][0].y), u23 = cvt_pk_bf16(sv[kr][1].x, sv[kr][1].y);
                v4u pw; pw.x = u01 & M0; pw.y = u23 & M1; pw.z = u01 & N0; pw.w = u23 & N1;
                const bf16x8 pf = __builtin_bit_cast(bf16x8, pw);
#pragma unroll
                for (int dt = 0; dt < 2; ++dt) {
                    const LAS unsigned char* vp = vb + slot[kr] * NA_VROW + 16 * dt * NA_VD;
                    const v2u lo = *(const LAS v2u*)vp, hi = *(const LAS v2u*)(vp + 32);
                    v4u vw; vw.x = lo.x; vw.y = lo.y; vw.z = hi.x; vw.w = hi.y;
                    o[dt] = __builtin_amdgcn_mfma_f32_16x16x32_bf16(__builtin_bit_cast(bf16x8, vw), pf, o[dt], 0, 0, 0);
                }
            }
            const float inv = __builtin_amdgcn_rcpf(sum);
            bf16* orow = mixo + mixo_index(qtok, DPOOL + 32 * h + 4 * fq);
#pragma unroll
            for (int dt = 0; dt < 2; ++dt) { v2u w; w.x = cvt_pk_bf16(o[dt][0] * inv, o[dt][1] * inv); w.y = cvt_pk_bf16(o[dt][2] * inv, o[dt][3] * inv); *(v2u*)(orow + 16 * dt) = w; }
        }
    }
    __syncthreads();
#undef NA_UNIT
#undef NA_PLAN
#undef NA_LOAD
}

struct SchedProj {
    const char* hn; const char* win; bf16* proj; bf16* vt; int G, c, esz; const float* sa; const float* sw;
    __device__ __forceinline__ bool next(int i, pg8::Unit& u) const {
        int pm, pn; if (!pg8::tile_order(i, G, c, T / 256, 8, pm, pn)) return false;
        const size_t tstep = (size_t)256 * D * esz;
        if (pn < 6) { u.A = hn + pm * tstep; u.B = win + pn * tstep; u.orow = 256 * pm;
            if (pn < 2) { u.obase = proj; u.ocol = 256 * pn; u.ldc = UPITCH; } else { u.obase = proj + (size_t)(pn >> 1) * T * 512; u.ocol = 256 * (pn & 1); u.ldc = 0; }
            u.scale = (pn == 2 || pn == 3) ? QSCALE : 1.0f; u.p0 = sa + 256 * pm; u.cs = sw + 256 * pn; }
        else { u.A = win + pn * tstep; u.B = hn + pm * tstep; u.obase = vt; u.orow = 256 * (pn - 6); u.ocol = 256 * pm; u.ldc = -1; u.scale = 1.0f; u.p0 = sw + 256 * pn; u.cs = sa + 256 * pm; }
        return true;
    }
};
struct SchedOut {
    const char* a; const char* w; bf16* o; int G, c;
    __device__ __forceinline__ bool next(int i, pg8::Unit& u) const {
        int pm, pn; if (!pg8::tile_order(i, G, c, T / 256, 4, pm, pn)) return false;
        const size_t tstep = (size_t)256 * D * 2; u.p0 = nullptr; u.cs = nullptr;
        u.A = a + pm * tstep; u.B = w + pn * tstep; u.obase = o; u.orow = 256 * pm; u.ocol = 256 * pn; u.ldc = D; u.scale = 1.0f; return true;
    }
};
__device__ __forceinline__ void ffn_table(Frame& F0, bool moe) {
    Frame F = F0; { int t_ = threadIdx.x; asm volatile("" : "+v"(t_)); F.tid = t_; F.lane = t_ & 63; F.wave = __builtin_amdgcn_readfirstlane(t_ >> 6); }
    LAS int* blk = (LAS int*)(F.lds + BLK_OFF); LAS int* bst = (LAS int*)(F.lds + BST_OFF);
    __syncthreads();
    if (F.tid == 0) { int s = 0; for (int e = 0; e < NE; ++e) { bst[e] = s; s += moe ? (int)((ld_cnt(F.ctl, e) + 255u) >> 8) : (e == 0 ? T / 256 : 0); } bst[8] = s; }
    __syncthreads();
    for (int b = F.tid; b < MAXBLK + 8; b += 512) { int e = 0; for (int k = 1; k < NE; ++k) if (b >= bst[k]) e = k; blk[b] = e; }
    __syncthreads();
}
__device__ __forceinline__ bool tail_reduce(Frame& F0) {
    int t_ = threadIdx.x; asm volatile("" : "+v"(t_));
    const int lane = t_ & 63, gw = F0.bid * 8 + __builtin_amdgcn_readfirstlane(t_ >> 6), NGW = F0.G * 8;
    int nb = 0;
    for (int e = 0; e < NE; ++e) nb += (int)((ld_cnt(F0.ctl, e) + 255u) >> 8);
    const int nrows = (nb - 256) * 256;
    if (nrows <= 0) return false;
    const bf16* part = (const bf16*)(F0.ws + WS_TAILPART);
#if Y8_MOE
    unsigned char* y8 = F0.ws + WS_Y + (size_t)256 * 256 * D; const bf16* part6 = (const bf16*)(F0.ws + WS_TAILPART6);
    for (int r = gw; r < nrows; r += NGW) {
        v4u w[TAILSPLIT][2];
#pragma unroll
        for (int h = 0; h < 2; ++h) {
#pragma unroll
            for (int p = 0; p < TAILSPLIT; ++p) w[p][h] = *((const v4u*)((p < 6 ? part + ((size_t)p * TAILPART_ROWS + r) * D : part6 + (size_t)r * D)) + lane + 64 * h); }
#pragma unroll
        for (int h = 0; h < 2; ++h) { float v[8];
#pragma unroll
            for (int j = 0; j < 4; ++j) { float lo = 0.f, hi = 0.f;
#pragma unroll
                for (int p = 0; p < TAILSPLIT; ++p) { lo += bflo(w[p][h][j]); hi += bfhi(w[p][h][j]); }
                v[2 * j] = lo * YS; v[2 * j + 1] = hi * YS; }
            int w0 = 0, w1 = 0;
            w0 = __builtin_amdgcn_cvt_pk_fp8_f32(v[0], v[1], w0, false); w0 = __builtin_amdgcn_cvt_pk_fp8_f32(v[2], v[3], w0, true);
            w1 = __builtin_amdgcn_cvt_pk_fp8_f32(v[4], v[5], w1, false); w1 = __builtin_amdgcn_cvt_pk_fp8_f32(v[6], v[7], w1, true);
            v2u o; o.x = (unsigned)w0; o.y = (unsigned)w1;
            *((v2u*)(y8 + (size_t)r * D) + lane + 64 * h) = o; }
    }
#else
    bf16* y = (bf16*)(F0.ws + WS_Y) + (size_t)256 * 256 * D;
    for (int r = gw; r < nrows; r += NGW) {
        v4u w[TAILSPLIT][2];
#pragma unroll
        for (int h = 0; h < 2; ++h) { w[0][h] = *((const v4u*)(y + (size_t)r * D) + lane + 64 * h);
#pragma unroll
            for (int p = 1; p < TAILSPLIT; ++p) w[p][h] = *((const v4u*)(part + ((size_t)(p - 1) * TAILPART_ROWS + r) * D) + lane + 64 * h); }
#pragma unroll
        for (int h = 0; h < 2; ++h) { v4u o;
#pragma unroll
            for (int j = 0; j < 4; ++j) { float lo = 0.f, hi = 0.f;
#pragma unroll
                for (int p = 0; p < TAILSPLIT; ++p) { lo += bflo(w[p][h][j]); hi += bfhi(w[p][h][j]); }
                o[j] = cvt_pk_bf16(lo, hi); }
            *((v4u*)(y + (size_t)r * D) + lane + 64 * h) = o; }
    }
#endif
    return true;
}
template <bool TILED> struct SchedUpT {
    const char* hn; const char* wgu; const int* lists; bf16* hff; LAS int* blk; LAS int* bst; int G, c, cstart, nblk, nN, F_, moe, esz;
    __device__ __forceinline__ bool next(int i, pg8::Unit& u) const {
        int pm, pn; if (!pg8::tile_order(i, G, c, nblk, nN, pm, pn)) return false;
        const int b = cstart + pm, e = __builtin_amdgcn_readfirstlane(blk[b]), lb = b - __builtin_amdgcn_readfirstlane(bst[e]);
        u.A = hn; u.p0 = lists + (moe ? (size_t)e * T + 256 * lb : (size_t)256 * b); u.cs = nullptr;
        u.B = wgu + ((size_t)e * 2 * F_ + 256 * pn) * D * esz; u.obase = hff; u.orow = 256 * pm; u.ocol = 128 * pn; u.ldc = F_; u.scale = 1.0f;
        if constexpr (TILED) { u.obase = (bf16*)((char*)hff + ((size_t)pm * nN + pn) * HFF_TILE - 128 * pn - (size_t)256 * pm * 128); }
        return true;
    }
};
template <bool TILED, bool Y8 = false> struct SchedDownT {
    const char* hff; const char* wd; bf16* y; LAS int* blk; int G, c, cstart, nblk, F_, esz; float scale; const int* idl; int pm0, split;
    __device__ __forceinline__ bool next(int i, pg8::Unit& u) const {
        int pm, pn; if (!pg8::tile_order(i, G, c, nblk, 4 * split, pm, pn)) return false;
        const int p = pn >> 2; pn &= 3;
        const int b = cstart + pm, e = __builtin_amdgcn_readfirstlane(blk[b]); u.p0 = idl; u.cs = nullptr;
        const size_t koff = (size_t)p * (F_ / split) * esz;
        u.A = hff + (size_t)(pm0 + pm) * 256 * F_ * esz + (TILED ? (size_t)p * (F_ / split / 128) * HFF_TILE : koff); u.B = wd + ((size_t)e * D + 256 * pn) * F_ * esz + koff;
        const int img = Y8 ? p : p - 1;
        const long long poff = (split == 1 || img < 0) ? 0ll : (img < 6 ? ((long long)WS_TAILPART - (long long)WS_Y) / 2 + (long long)img * TAILPART_ROWS * D : ((long long)WS_TAILPART6 - (long long)WS_Y) / 2);
        u.obase = y + poff; u.orow = (split == 1 || img < 0) ? 256 * b : 256 * pm; u.ocol = 256 * pn; u.ldc = D; u.scale = scale; return true;
    }
};

constexpr int STEPS_PER_LAYER = 16, NSTEPS = 1 + DEPTH * STEPS_PER_LAYER;
#define RUN(s) (lo <= (s) && (s) < hi)
#ifndef BARX
#define BARX 1
#endif
#define SEAM(s) do { if (RUN(s) && RUN((s) + 1)) { for (int b_ = 0; b_ < BARX; ++b_) xcd_barrier(bar); } } while (0)
template <int L>
__device__ __forceinline__ void run_layer(Frame& F, const XcdBarrier& bar, const int lo, const int hi) {
    constexpr int l = L, base = 1 + STEPS_PER_LAYER * L; constexpr bool moe = (L & 1) != 0, f8 = FP8_MOE && moe, i8 = I8_DENSE && !moe; constexpr bool h8 = f8 || (FP8_DDOWN && !moe);
    LAS int* tokbuf = (LAS int*)(F.lds + TOKBUF_OFF); LAS int* blk = (LAS int*)(F.lds + BLK_OFF); LAS int* bst = (LAS int*)(F.lds + BST_OFF);
    const char* HN = (const char*)(F.ws + WS_HN);
#ifndef NO_P1
    if (RUN(base + 0)) {
        SchedProj S{HN, (const char*)(F.ws + WS_WIN) + (size_t)l * DIN * D * (I8_PROJ ? 1 : 2), (bf16*)(F.ws + WS_PROJ), (bf16*)(F.ws + WS_VT), F.G, F.bid, I8_PROJ ? 1 : 2, (const float*)(F.ws + WS_SA), (const float*)(F.ws + WS_SWIN) + l * DIN};
        if constexpr (I8_PROJ != 0) pg8::gemm_phase<pg8::EpiProj_I8, SchedProj, false, 2>(F.lds, tokbuf, D / 2, S, pg8::EpiProj_I8{});
        else pg8::gemm_phase<pg8::EpiProj, SchedProj, false>(F.lds, tokbuf, D, S, pg8::EpiProj{});
    } SEAM(base + 0);
#endif
#ifndef NO_P2
#ifndef NA_CALLS
#define NA_CALLS 1
#endif
#ifndef POOL_CALLS
#define POOL_CALLS 1
#endif
    if (RUN(base + 1)) { for (int i_ = 0; i_ < POOL_CALLS; ++i_) mixer_phase(F, l); for (int i_ = 0; i_ < NA_CALLS; ++i_) na_phase(F, l); } SEAM(base + 1);
#endif
#ifndef NO_P3
    if (RUN(base + 2)) {
        SchedOut S{(const char*)(F.ws + WS_MIXO), (const char*)(F.ws + WS_WOUT) + (size_t)l * D * D * 2, (bf16*)(F.ws + WS_MIX), F.G, F.bid};
        pg8::gemm_phase<pg8::EpiBf16, SchedOut, false>(F.lds, tokbuf, D, S, pg8::EpiBf16{}, D, 64, 256 * 128);
    } SEAM(base + 2);
#endif
#ifndef NO_P4
    if (RUN(base + 3)) { norm_phase<false>(F, l); } SEAM(base + 3);
#endif
    constexpr int F_ = moe ? DFFE : DFF, cblk = h8 ? 2 * CHUNK_BLK : CHUNK_BLK;
    bool table = false; int NB = 0;
    for (int c = 0; c < MAXCHUNK; ++c) {
        const int s5 = base + 4 + 2 * c, s6 = s5 + 1;
        if (!(RUN(s5) || RUN(s6))) continue;
        if (!table) { ffn_table(F, moe); NB = __builtin_amdgcn_readfirstlane(bst[8]); table = true; }
        const int cstart = c * cblk; int nblk = min(NB - cstart, cblk);
        if constexpr (f8) { if (c == 1) nblk = NB - cstart; else if (c > 1) continue; }
        if (nblk <= 0) continue;
#ifndef NO_P5
        if (RUN(s5)) {
            typedef SchedUpT<h8> SchedUp; SchedUp S{HN, moe ? (const char*)(F.ws + WS_WGUM) : (const char*)(F.ws + WS_WGU0), moe ? (const int*)(F.ws + WS_LIST) : (const int*)(F.ws + WS_LISTID), (bf16*)(F.ws + WS_HFF), blk, bst, F.G, F.bid, cstart, nblk, F_ / 128, F_, moe ? 1 : 0, (f8 || i8) ? 1 : 2};
            if constexpr (f8 && FP6_UP) pg8::gemm_phase<pg8::EpiSwiGLU6, SchedUp, true, 3>(F.lds, tokbuf, D / 2, S, pg8::EpiSwiGLU6{});
            else if constexpr (f8) pg8::gemm_phase<pg8::EpiSwiGLU8, SchedUp, true, 1>(F.lds, tokbuf, D / 2, S, pg8::EpiSwiGLU8{});
            else if constexpr (i8) pg8::gemm_phase<pg8::EpiSwiGLU_I8, SchedUp, true, 2>(F.lds, tokbuf, D / 2, S, pg8::EpiSwiGLU_I8{(const float*)(F.ws + WS_SA), (const float*)(F.ws + WS_SW0), (const int*)(F.ws + WS_LISTID)});
            else pg8::gemm_phase<pg8::EpiSwiGLU, SchedUp, true>(F.lds, tokbuf, D, S, pg8::EpiSwiGLU{});
        } SEAM(s5);
#endif
#ifndef NO_P6
        if (RUN(s6)) {
            const int nfull = h8 ? min(nblk, cblk) : nblk;
            constexpr bool y8 = Y8_MOE && f8;
            typedef SchedDownT<h8, y8> SchedDown; SchedDown S{(const char*)(F.ws + WS_HFF), moe ? (const char*)(F.ws + WS_WDM) : (const char*)(F.ws + WS_WD0), (bf16*)(F.ws + WS_Y), blk, F.G, F.bid, cstart, nfull, F_, h8 ? 1 : 2, (h8 ? 1.0f / W8_DN : 1.0f) * (y8 ? YS : 1.0f), (const int*)(F.ws + WS_LISTID), 0, 1};
            if constexpr (h8) {
                const int npass = (f8 && nblk > nfull) ? 2 : 1;
                if constexpr (y8) {
                    pg8::gemm_phase<pg8::EpiY8, SchedDown, true, 1>(F.lds, tokbuf, F_ / 2, S, pg8::EpiY8{}, F_ / 2, 64, HFF_TILE);
                    if (npass > 1) { const SchedDown S2{(const char*)(F.ws + WS_HFF), (const char*)(F.ws + WS_WDM), (bf16*)(F.ws + WS_Y), blk, F.G, F.bid, cstart + nfull, nblk - nfull, F_, 1, 1.0f / W8_DN, (const int*)(F.ws + WS_LISTID), nfull, TAILSPLIT};
                        int ksplit = F_ / 2 / TAILSPLIT; asm volatile("" : "+s"(ksplit));
                        pg8::gemm_phase<pg8::EpiBf16, SchedDown, true, 1>(F.lds, tokbuf, ksplit, S2, pg8::EpiBf16{}, F_ / 2, 64, HFF_TILE); }
                } else {
#pragma clang loop unroll(disable)
                for (int pass = 0; pass < npass; ++pass) {
                    if (pass == 1) { S.cstart = cstart + nfull; S.nblk = nblk - nfull; S.pm0 = nfull; S.split = TAILSPLIT; }
                    pg8::gemm_phase<pg8::EpiBf16, SchedDown, true, 1>(F.lds, tokbuf, pass == 0 ? F_ / 2 : F_ / 2 / TAILSPLIT, S, pg8::EpiBf16{}, F_ / 2, 64, HFF_TILE);
                }
                }
            }
            else pg8::gemm_phase<pg8::EpiBf16, SchedDown, false>(F.lds, tokbuf, F_, S, pg8::EpiBf16{});
        } SEAM(s6);
#endif
    }
#ifndef NO_P7
    if (RUN(base + 14)) { if constexpr (f8) { if (tail_reduce(F)) xcd_barrier(bar); } norm_phase<true>(F, l); }
#endif
    if (l + 1 < DEPTH) { if (RUN(base + 14) && RUN(base + 16)) xcd_barrier(bar); }
}
__global__ void __launch_bounds__(512, 2) mk_fwd(Args args) {
    extern __shared__ __attribute__((aligned(16))) unsigned char lds_raw[];
    Frame F;
    F.lds = (LAS unsigned char*)lds_raw; F.MISC = (volatile LAS unsigned*)(F.lds + MISC_OFF);
    F.tid = threadIdx.x; F.lane = F.tid & 63; F.wave = __builtin_amdgcn_readfirstlane(F.tid >> 6); F.G = gridDim.x; F.bid = blockIdx.x;
    F.ws = args.ws; F.ctl = (unsigned*)(args.ws + WS_CTL); F.out = args.out;
    F.x = args.in[0]; F.g_mpre = args.in[1]; F.g_mpost = args.in[2]; F.g_fpre = args.in[3]; F.g_fpost = args.in[4]; F.w_in = args.in[5]; F.pool_w = args.in[6]; F.pool_scale = args.in[7];
    F.rpb = args.in[8]; F.w_out = args.in[9]; F.dwg = args.in[10]; F.dwu = args.in[11]; F.dwd = args.in[12]; F.router = args.in[13]; F.mwg = args.in[14]; F.mwu = args.in[15]; F.mwd = args.in[16];
    if (F.tid < 16) F.MISC[F.tid] = 0u;
    __syncthreads();
    const int lo = args.lo, hi = args.hi;
    XcdBarrier bar; bar.bar = F.ctl + CW_BAR + args.breg * XCD_BAR_WORDS; bar.x = 0; bar.st = F.MISC;
    if (hi - lo > 1) bar = xcd_barrier_post(F.ctl + CW_BAR + args.breg * XCD_BAR_WORDS, F.MISC);
#ifndef NO_P0
#ifndef REP_P0
#define REP_P0 1
#endif
    if (RUN(0)) { for (int r_ = 0; r_ < REP_P0; ++r_) p0_prologue(F); } SEAM(0);
#endif
    run_layer<0>(F, bar, lo, hi);
    run_layer<1>(F, bar, lo, hi);
}
#undef RUN
#undef SEAM

__global__ void __launch_bounds__(64) nk_gemm(const bf16* A, int lda, const bf16* Bt, int ldb, int K, bf16* O, int ldo, float scale, int sc_lo, int sc_hi, int vt) {
    const int m0 = 32 * blockIdx.y, n0 = 32 * blockIdx.x, lane = threadIdx.x, fr = lane & 15, fq = lane >> 4;
    f32x4 acc[2][2];
#pragma unroll
    for (int a = 0; a < 2; ++a)
#pragma unroll
        for (int b = 0; b < 2; ++b) acc[a][b] = (f32x4){0.f, 0.f, 0.f, 0.f};
    for (int k0 = 0; k0 < K; k0 += 32) {
        bf16x8 a[2], b[2];
#pragma unroll
        for (int i = 0; i < 2; ++i) { a[i] = *(const bf16x8*)(A + (size_t)(m0 + 16 * i + fr) * lda + k0 + 8 * fq); b[i] = *(const bf16x8*)(Bt + (size_t)(n0 + 16 * i + fr) * ldb + k0 + 8 * fq); }
#pragma unroll
        for (int mt = 0; mt < 2; ++mt)
#pragma unroll
            for (int nt = 0; nt < 2; ++nt) acc[mt][nt] = __builtin_amdgcn_mfma_f32_16x16x32_bf16(a[mt], b[nt], acc[mt][nt], 0, 0, 0);
    }
#pragma unroll
    for (int mt = 0; mt < 2; ++mt)
#pragma unroll
        for (int nt = 0; nt < 2; ++nt)
#pragma unroll
            for (int q = 0; q < 4; ++q) { const int m = m0 + 16 * mt + 4 * fq + q, n = n0 + 16 * nt + fr; const float sc = (n >= sc_lo && n < sc_hi) ? scale : 1.0f;
                O[vt ? vt_index(m, n) : (size_t)m * ldo + n] = (bf16)f2bf(acc[mt][nt][q] * sc); }
}
__global__ void nk_blocktab(const unsigned* ctl, int* btab, int moe) {
    if (threadIdx.x != 0 || blockIdx.x != 0) return;
    int b = 0;
    for (int e = 0; e < NE; ++e) { const int nb = moe ? (int)((ctl[CW_CNT + 64 * e] + 255u) >> 8) : (e == 0 ? T / 256 : 0); for (int k = 0; k < nb; ++k) btab[b++] = e | (k << 8); }
    btab[MAXBLK] = b;
}
__global__ void __launch_bounds__(64) nk_ffn_up(const bf16* hn, const bf16* wgu, const int* lists, const int* btab, bf16* hff, int cstart, int F_, int moe) {
    const int m0 = 32 * blockIdx.y, f0 = 32 * blockIdx.x, lane = threadIdx.x, fr = lane & 15, fq = lane >> 4;
    const int b = cstart + m0 / 256; if (b >= btab[MAXBLK]) return;
    const int e = btab[b] & 0xff, lb = btab[b] >> 8;
    const int* list = lists + (moe ? (size_t)e * T + 256 * lb : (size_t)256 * b) + (m0 % 256);
    const bf16* W = wgu + (size_t)e * 2 * F_ * D; const int rg = (f0 / 128) * 256 + (f0 % 128);
    const bf16* arow[2]; arow[0] = hn + (size_t)list[fr] * D; arow[1] = hn + (size_t)list[16 + fr] * D;
    f32x4 ag[2][2], au[2][2];
#pragma unroll
    for (int a = 0; a < 2; ++a)
#pragma unroll
        for (int c = 0; c < 2; ++c) { ag[a][c] = (f32x4){0.f, 0.f, 0.f, 0.f}; au[a][c] = (f32x4){0.f, 0.f, 0.f, 0.f}; }
    for (int k0 = 0; k0 < D; k0 += 32) {
        bf16x8 a[2], bg[2], bu[2];
#pragma unroll
        for (int i = 0; i < 2; ++i) { a[i] = *(const bf16x8*)(arow[i] + k0 + 8 * fq); bg[i] = *(const bf16x8*)(W + (size_t)(rg + 16 * i + fr) * D + k0 + 8 * fq); bu[i] = *(const bf16x8*)(W + (size_t)(rg + 128 + 16 * i + fr) * D + k0 + 8 * fq); }
#pragma unroll
        for (int mt = 0; mt < 2; ++mt)
#pragma unroll
            for (int nt = 0; nt < 2; ++nt) { ag[mt][nt] = __builtin_amdgcn_mfma_f32_16x16x32_bf16(a[mt], bg[nt], ag[mt][nt], 0, 0, 0); au[mt][nt] = __builtin_amdgcn_mfma_f32_16x16x32_bf16(a[mt], bu[nt], au[mt][nt], 0, 0, 0); }
    }
#pragma unroll
    for (int mt = 0; mt < 2; ++mt)
#pragma unroll
        for (int nt = 0; nt < 2; ++nt)
#pragma unroll
            for (int q = 0; q < 4; ++q) { const float g = ag[mt][nt][q], u = au[mt][nt][q]; const float v = g * u / (1.0f + __expf(-g));
                hff[(size_t)(m0 + 16 * mt + 4 * fq + q) * F_ + f0 + 16 * nt + fr] = (bf16)f2bf(v); }
}
__global__ void __launch_bounds__(64) nk_ffn_down(const bf16* hff, const bf16* wd, const int* btab, bf16* y, int cstart, int F_) {
    const int m0 = 32 * blockIdx.y, n0 = 32 * blockIdx.x, lane = threadIdx.x, fr = lane & 15, fq = lane >> 4;
    const int b = cstart + m0 / 256; if (b >= btab[MAXBLK]) return;
    const int e = btab[b] & 0xff; const bf16* W = wd + (size_t)e * D * F_;
    f32x4 acc[2][2];
#pragma unroll
    for (int a = 0; a < 2; ++a)
#pragma unroll
        for (int c = 0; c < 2; ++c) acc[a][c] = (f32x4){0.f, 0.f, 0.f, 0.f};
    for (int k0 = 0; k0 < F_; k0 += 32) {
        bf16x8 a[2], bb[2];
#pragma unroll
        for (int i = 0; i < 2; ++i) { a[i] = *(const bf16x8*)(hff + (size_t)(m0 + 16 * i + fr) * F_ + k0 + 8 * fq); bb[i] = *(const bf16x8*)(W + (size_t)(n0 + 16 * i + fr) * F_ + k0 + 8 * fq); }
#pragma unroll
        for (int mt = 0; mt < 2; ++mt)
#pragma unroll
            for (int nt = 0; nt < 2; ++nt) acc[mt][nt] = __builtin_amdgcn_mfma_f32_16x16x32_bf16(a[mt], bb[nt], acc[mt][nt], 0, 0, 0);
    }
#pragma unroll
    for (int mt = 0; mt < 2; ++mt)
#pragma unroll
        for (int nt = 0; nt < 2; ++nt)
#pragma unroll
            for (int q = 0; q < 4; ++q) y[(size_t)(256 * cstart + m0 + 16 * mt + 4 * fq + q) * D + n0 + 16 * nt + fr] = (bf16)f2bf(acc[mt][nt][q]);
}
__global__ void nk_pool_delta(const bf16* proj, bf16* delta) {
    const int idx = blockIdx.x * 256 + threadIdx.x, tok = idx / DPOOL, ch = idx % DPOOL, b = tok / SEQ, t = tok % SEQ, g = ch / 128, hw = 1 << g;
    const int lo = max(t - hw, 0), hi = min(t + hw, SEQ); float s = 0.f;
    for (int tt = lo; tt < hi; ++tt) s += bf2f(proj[(size_t)(b * SEQ + tt) * NPROJ + ch]);
    delta[(size_t)tok * DPOOL + ch] = (bf16)f2bf(s / (float)(hi - lo) - bf2f(proj[(size_t)tok * NPROJ + ch]));
}
__global__ void nk_pool_mm(const bf16* delta, const bf16* Wp, const float* pscale, bf16* mixo) {
    const int idx = blockIdx.x * 256 + threadIdx.x, tok = idx / DPOOL, dd = idx % DPOOL, g = dd / 128, d = dd % 128; float s = 0.f;
    for (int c = 0; c < 128; ++c) s += bf2f(delta[(size_t)tok * DPOOL + 128 * g + c]) * bf2f(Wp[(size_t)(g * 128 + d) * 128 + c]);
    mixo[(size_t)tok * D + dd] = (bf16)f2bf(s * pscale[dd]);
}
__global__ void nk_na(const bf16* proj, const bf16* Vt, const float* rpb, bf16* mixo) {
    const int idx = blockIdx.x * 256 + threadIdx.x, tok = idx / NH, h = idx % NH, b = tok / SEQ, t = tok % SEQ, r = t / GRIDW, c = t % GRIDW;
    const int r0 = min(max(r - KH / 2, 0), GROWS - KH), c0 = min(max(c - KW / 2, 0), GRIDW - KW);
    float q[HD];
#pragma unroll
    for (int d = 0; d < HD; ++d) q[d] = bf2f(proj[(size_t)tok * NPROJ + 512 + HD * h + d]);
    float mx = -INFINITY;
    for (int i = 0; i < KH; ++i) for (int j = 0; j < KW; ++j) {
        const size_t kt = (size_t)(b * SEQ + (r0 + i) * GRIDW + c0 + j); float s = 0.f;
#pragma unroll
        for (int d = 0; d < HD; ++d) s += q[d] * bf2f(proj[kt * NPROJ + 1024 + HD * h + d]);
        s += rpb[(h * 15 + (r0 + i - r + KH - 1)) * 31 + (c0 + j - c + KW - 1)] * LOG2E; mx = fmaxf(mx, s);
    }
    float o[HD], sum = 0.f;
#pragma unroll
    for (int d = 0; d < HD; ++d) o[d] = 0.f;
    for (int i = 0; i < KH; ++i) for (int j = 0; j < KW; ++j) {
        const size_t kt = (size_t)(b * SEQ + (r0 + i) * GRIDW + c0 + j); float s = 0.f;
#pragma unroll
        for (int d = 0; d < HD; ++d) s += q[d] * bf2f(proj[kt * NPROJ + 1024 + HD * h + d]);
        s += rpb[(h * 15 + (r0 + i - r + KH - 1)) * 31 + (c0 + j - c + KW - 1)] * LOG2E;
        const float p = exp2f(s - mx); sum += p; const float pb = __builtin_bit_cast(float, f2bf(p) << 16);
#pragma unroll
        for (int d = 0; d < HD; ++d) o[d] += pb * bf2f(Vt[vt_index(HD * h + d, (int)kt)]);
    }
#pragma unroll
    for (int d = 0; d < HD; ++d) mixo[(size_t)tok * D + DPOOL + HD * h + d] = (bf16)f2bf(o[d] / sum);
}

static void launch_mk(const Args& a0, int lo, int hi, int grid, hipStream_t stream, int breg = 0) {
    Args a = a0; a.lo = lo; a.hi = hi; a.breg = breg; a.pad = 0;
    hipLaunchKernelGGL(mk_fwd, dim3(grid), dim3(512), LDS_BYTES, stream, a);
}
extern "C" void kernel_launch(void* const* d_in, const int* in_sizes, int n_in, void* d_out, int out_size, void* d_ws, size_t ws_size, hipStream_t stream) {
    static int grid = 0;
    if (grid == 0) {
        if (n_in != 17 || out_size != T * D || ws_size < WS_END) { fprintf(stderr, "kernel_launch: unexpected problem (n_in %d, out %d, ws %zu)\n", n_in, out_size, ws_size); grid = -1; return; }
        int dev = 0, cus = 0;
        if (hipGetDevice(&dev) != hipSuccess || hipDeviceGetAttribute(&cus, hipDeviceAttributeMultiprocessorCount, dev) != hipSuccess) { grid = -1; return; }
        if (hipFuncSetAttribute((const void*)mk_fwd, hipFuncAttributeMaxDynamicSharedMemorySize, LDS_BYTES) != hipSuccess) { grid = -1; return; }
        int per_cu = 0;
        if (hipOccupancyMaxActiveBlocksPerMultiprocessor(&per_cu, (const void*)mk_fwd, 512, LDS_BYTES) != hipSuccess || per_cu < 1) { fprintf(stderr, "kernel_launch: occupancy query says %d\n", per_cu); }
        (void)hipGetLastError();
        grid = cus;
    }
    if (grid < 0) return;
    hipMemsetAsync((char*)d_ws + WS_CTL, 0, CTL_ZERO_BYTES, stream);
    Args a{};
    for (int i = 0; i < 17; ++i) a.in[i] = (const float*)d_in[i];
    a.out = (float*)d_out; a.ws = (unsigned char*)d_ws; a.lo = 0; a.hi = 0;
    unsigned char* ws = (unsigned char*)d_ws;
#if MODE == 3
#if defined(REPSTEP)
    launch_mk(a, 0, REPSTEP + 1, grid, stream, 0); launch_mk(a, REPSTEP, REPSTEP + 1, grid, stream, 1); launch_mk(a, REPSTEP + 1, NSTEPS, grid, stream, 2);
#else
    launch_mk(a, 0, NSTEPS, grid, stream);
#endif
#else
    launch_mk(a, 0, 1, grid, stream);
    const bf16* HN = (const bf16*)(ws + WS_HN);
    for (int l = 0; l < DEPTH; ++l) {
        const int base = 1 + STEPS_PER_LAYER * l; const int moe = l & 1;
        const bf16* win = (const bf16*)(ws + WS_WIN) + (size_t)l * DIN * D;
        if (NAIVE & 1) {
            hipLaunchKernelGGL(nk_gemm, dim3(NPROJ / 32, T / 32), dim3(64), 0, stream, HN, D, win, D, D, (bf16*)(ws + WS_PROJ), NPROJ, QSCALE, 512, 1024, 0);
            hipLaunchKernelGGL(nk_gemm, dim3(T / 32, DATT / 32), dim3(64), 0, stream, win + (size_t)NPROJ * D, D, HN, D, D, (bf16*)(ws + WS_VT), T, 1.0f, 0, 0, 1);
        } else launch_mk(a, base + 0, base + 1, grid, stream);
        if (NAIVE & 2) {
            hipLaunchKernelGGL(nk_pool_delta, dim3(T * DPOOL / 256), dim3(256), 0, stream, (const bf16*)(ws + WS_PROJ), (bf16*)(ws + WS_MIX));
            hipLaunchKernelGGL(nk_pool_mm, dim3(T * DPOOL / 256), dim3(256), 0, stream, (const bf16*)(ws + WS_MIX), (const bf16*)(ws + WS_WP) + (size_t)l * 4 * 128 * 128, (const float*)d_in[7] + l * DPOOL, (bf16*)(ws + WS_MIXO));
            hipLaunchKernelGGL(nk_na, dim3(T * NH / 256), dim3(256), 0, stream, (const bf16*)(ws + WS_PROJ), (const bf16*)(ws + WS_VT), (const float*)d_in[8] + (size_t)l * NH * 15 * 31, (bf16*)(ws + WS_MIXO));
        } else launch_mk(a, base + 1, base + 2, grid, stream);
        if (NAIVE & 4) hipLaunchKernelGGL(nk_gemm, dim3(D / 32, T / 32), dim3(64), 0, stream, (const bf16*)(ws + WS_MIXO), D, (const bf16*)(ws + WS_WOUT) + (size_t)l * D * D, D, D, (bf16*)(ws + WS_MIX), D, 1.0f, 0, 0, 0);
        else launch_mk(a, base + 2, base + 3, grid, stream);
        launch_mk(a, base + 3, base + 4, grid, stream);
        if (NAIVE & 24) hipLaunchKernelGGL(nk_blocktab, dim3(1), dim3(64), 0, stream, (const unsigned*)(ws + WS_CTL), (int*)(ws + WS_BTAB), moe);
        const int F_ = moe ? DFFE : DFF, nchunk = moe ? MAXCHUNK : 2;
        for (int c = 0; c < nchunk; ++c) {
            if (NAIVE & 8) hipLaunchKernelGGL(nk_ffn_up, dim3(F_ / 32, CHUNK_BLK * 256 / 32), dim3(64), 0, stream, HN, moe ? (const bf16*)(ws + WS_WGUM) : (const bf16*)(ws + WS_WGU0), moe ? (const int*)(ws + WS_LIST) : (const int*)(ws + WS_LISTID), (const int*)(ws + WS_BTAB), (bf16*)(ws + WS_HFF), c * CHUNK_BLK, F_, moe);
            else launch_mk(a, base + 4 + 2 * c, base + 5 + 2 * c, grid, stream);
            if (NAIVE & 16) hipLaunchKernelGGL(nk_ffn_down, dim3(D / 32, CHUNK_BLK * 256 / 32), dim3(64), 0, stream, (const bf16*)(ws + WS_HFF), moe ? (const bf16*)(ws + WS_WDM) : (const bf16*)(ws + WS_WD0), (const int*)(ws + WS_BTAB), (bf16*)(ws + WS_Y), c * CHUNK_BLK, F_);
            else launch_mk(a, base + 5 + 2 * c, base + 6 + 2 * c, grid, stream);
        }
        launch_mk(a, base + 14, base + 15, grid, stream);
    }
#endif
}
```

```cpp
#include <hip/hip_runtime.h>
#include <cstdio>
#include <cstdint>

#ifndef MODE
#define MODE 3
#endif
#ifndef NAIVE
#define NAIVE 0
#endif
#ifndef I8_DENSE
#define I8_DENSE 1
#endif
#ifndef I8_PROJ
#define I8_PROJ 1
#endif
#ifndef FP6_UP
#define FP6_UP 1
#endif
#ifndef FP8_DDOWN
#define FP8_DDOWN 1
#endif
#ifndef Y8_MOE
#define Y8_MOE 1
#endif
#ifndef FP8_MOE
#define FP8_MOE 1
#endif
#if ((FP8_MOE || I8_DENSE) && (NAIVE & 24) || I8_PROJ && (NAIVE & 1)) && MODE != 3
#error the simple reference FFN kernels are bf16 only: build with -DFP8_MOE=0 to use them
#endif

#define GAS __attribute__((address_space(1)))
#define LAS __attribute__((address_space(3)))
typedef unsigned short bf16;
typedef unsigned v4u __attribute__((ext_vector_type(4)));
typedef unsigned v2u __attribute__((ext_vector_type(2)));
typedef float f32x4 __attribute__((ext_vector_type(4)));
typedef float f32x2 __attribute__((ext_vector_type(2)));
typedef short bf16x8 __attribute__((ext_vector_type(8)));

constexpr int BATCH = 2, SEQ = 16384, T = BATCH * SEQ, D = 1024, DIN = 2048, DPOOL = 512, DATT = 512, NH = 16, HD = 32;
constexpr int GRIDW = 64, GROWS = SEQ / GRIDW, KH = 8, KW = 16;
constexpr int DFF = 4096, NE = 8, DFFE = 3584, DEPTH = 2;
constexpr int UPITCH = 512;
constexpr int NPROJ = 1536;
constexpr float RMS_EPS = 1e-6f;
constexpr float LOG2E = 1.4426950408889634f;
constexpr float QSCALE = 0.17677669529663687f * LOG2E;
__host__ __device__ __forceinline__ size_t vt_index(int ch, int tok) { return (size_t)(tok >> 6) * (DATT * 64) + (size_t)ch * 64 + (tok & 63); }
constexpr float S6A = 1.25f, S6W = 40.0f;
typedef float f32x16 __attribute__((ext_vector_type(16)));
typedef int i32x6 __attribute__((ext_vector_type(6)));
constexpr float W8_UP = 32.0f, W8_DN = 64.0f;
typedef int i32x8 __attribute__((ext_vector_type(8)));
typedef int i32x4 __attribute__((ext_vector_type(4)));
constexpr int CHUNK_BLK = 64;
constexpr int MAXCHUNK = 5;
constexpr int MAXBLK = 264;

constexpr size_t MiB = 1u << 20;
constexpr size_t WS_CTL = 0, CTL_ZERO_BYTES = 1 * MiB;
constexpr size_t WS_LIST = 1 * MiB;
constexpr size_t WS_INFO = 2 * MiB;
constexpr size_t WS_LISTID = 2 * MiB + 512 * 1024;
constexpr size_t WS_SA = 2 * MiB + 640 * 1024;
constexpr size_t WS_SWIN = 2 * MiB + 896 * 1024;
constexpr size_t WS_SW0 = 2 * MiB + 832 * 1024;
constexpr size_t WS_BTAB = 2 * MiB + 768 * 1024;
constexpr size_t WS_WP = 3 * MiB;
constexpr size_t WS_WIN = 4 * MiB;
constexpr size_t WS_WOUT = 12 * MiB;
constexpr size_t WS_WGU0 = 16 * MiB;
constexpr size_t WS_WD0 = 32 * MiB;
constexpr size_t WS_WGUM = 40 * MiB;
constexpr size_t WS_WDM = (FP8_MOE ? 160 : 152) * MiB;
constexpr size_t WS_H16 = 96 * MiB;
constexpr size_t WS_HN = 208 * MiB;
constexpr size_t WS_R = 272 * MiB;
constexpr size_t WS_HFF = WS_R;
constexpr size_t WS_Y = WS_R + 128 * MiB;
constexpr size_t WS_PQ = WS_R + 32 * MiB, WS_PK = WS_R + 64 * MiB;
constexpr size_t WS_PROJ = WS_R;
constexpr size_t WS_VT = WS_R + 96 * MiB;
constexpr size_t WS_MIXO = WS_R + 128 * MiB;
constexpr size_t WS_MIX = WS_R + 192 * MiB;
constexpr size_t WS_END = 532 * MiB;
constexpr float YS = 16.0f;
constexpr int HFF_TILE = 256 * 128;
constexpr int TAILSPLIT = 7, TAILPART_ROWS = 8 * 256;
constexpr size_t WS_TAILPART6 = WS_Y + 68 * MiB;
constexpr size_t WS_TAILPART = WS_WGU0;
static_assert(WS_TAILPART + (size_t)(TAILSPLIT - 1) * TAILPART_ROWS * D * 2 <= WS_WGUM, "tail partials");
static_assert(!FP8_MOE || (WS_WGUM + (size_t)NE * 2 * DFFE * D <= WS_H16 && WS_H16 + (size_t)T * D * 2 <= WS_WDM), "H16 sits in the gap the fp8 expert weights leave");

constexpr int CW_TMO = 0, CW_CODE = 1;
constexpr int CW_BAR = 4096;
constexpr int CW_CNT = 16384;
constexpr int CW_DBG = 20480;

constexpr int RING_BYTES = 131072;
constexpr int TOKBUF_OFF = RING_BYTES;
constexpr int BLK_OFF = TOKBUF_OFF + 9 * 1024;
constexpr int BST_OFF = BLK_OFF + 272 * 4;
constexpr int LCNT_OFF = BST_OFF + 64;
constexpr int MISC_OFF = LCNT_OFF + 64;
constexpr int LDS_BYTES = 147456;
static_assert(MISC_OFF + 64 <= LDS_BYTES, "LDS map");

#define RLX_AGENT __ATOMIC_RELAXED, __HIP_MEMORY_SCOPE_AGENT
#define LDS_WAIT() asm volatile("s_waitcnt lgkmcnt(0)" ::: "memory")
#define VM_WAIT() asm volatile("s_waitcnt vmcnt(0)" ::: "memory")
__device__ __forceinline__ unsigned f2bf(float f) { unsigned u = __builtin_bit_cast(unsigned, f); return (u + 0x7fffu + ((u >> 16) & 1u)) >> 16; }
__device__ __forceinline__ unsigned pk2(float lo, float hi) { return f2bf(lo) | (f2bf(hi) << 16); }
__device__ __forceinline__ float bflo(unsigned w) { return __builtin_bit_cast(float, w << 16); }
__device__ __forceinline__ float bfhi(unsigned w) { return __builtin_bit_cast(float, w & 0xffff0000u); }
__device__ __forceinline__ float bf2f(bf16 v) { return __builtin_bit_cast(float, (unsigned)v << 16); }
__device__ __forceinline__ unsigned cvt_pk_bf16(float lo, float hi) { unsigned r; asm volatile("v_cvt_pk_bf16_f32 %0, %1, %2" : "=v"(r) : "v"(lo), "v"(hi)); return r; }
__device__ __forceinline__ float wave_sum(float v) {
#pragma unroll
    for (int o = 1; o < 64; o <<= 1) v += __shfl_xor(v, o);
    return v;
}

#define XB_TMO      128
#define XB_XCNT(j)  (256  + 64 * (j))
#define XB_XSUB(j)  (1280 + 64 * (j))
#define XB_XGEN(j)  (2304 + 64 * (j))
#define XB_TOP      3328
#define XB_TOPGEN   3392
#define XCD_BAR_WORDS 3456
#define XB_SPIN_CAP (1u << 18)
__device__ __forceinline__ unsigned xb_ld(unsigned* p)              { return __hip_atomic_load(p, __ATOMIC_RELAXED, __HIP_MEMORY_SCOPE_AGENT); }
__device__ __forceinline__ unsigned xb_add(unsigned* p, unsigned v) { return __hip_atomic_fetch_add(p, v, __ATOMIC_RELAXED, __HIP_MEMORY_SCOPE_AGENT); }
__device__ __forceinline__ unsigned xb_xcc_id() { return (unsigned)__builtin_amdgcn_s_getreg((3 << 11) | 20) & 0xFu; }
#define XB_SPIN(cond, bar) do { unsigned _sp = 0; while (cond) { __builtin_amdgcn_s_sleep(1); \
    if ((++_sp & 255u) == 0u) { if (xb_ld(&(bar)[XB_TMO])) break; if (_sp > XB_SPIN_CAP) { atomicAdd(&(bar)[XB_TMO], 1u); break; } } } } while (0)
struct XcdBarrier { unsigned* bar; unsigned x; volatile LAS unsigned* st; };
__device__ __forceinline__ XcdBarrier xcd_barrier_post(unsigned* bar, volatile LAS unsigned* st) {
    XcdBarrier b; b.bar = bar; b.x = xb_xcc_id(); b.st = st;
    if (threadIdx.x == 0) (void)xb_add(&bar[XB_XCNT(b.x)], 1u);
    return b;
}
__device__ __forceinline__ void xcd_barrier_complete(unsigned* bar, unsigned x, unsigned& nloc, unsigned& nx) {
    const unsigned G = gridDim.x * gridDim.y * gridDim.z;
    unsigned sum, cnt, mine, sp = 0u;
    for (;;) {
        sum = 0u; cnt = 0u; mine = 0u;
#pragma unroll
        for (unsigned j = 0; j < 16; ++j) { const unsigned c = xb_ld(&bar[XB_XCNT(j)]); sum += c; cnt += (c > 0u) ? 1u : 0u; mine = (j == x) ? c : mine; }
        if (sum == G) break;
        __builtin_amdgcn_s_sleep(1);
        if ((++sp & 255u) == 0u) { if (xb_ld(&bar[XB_TMO])) break; if (sp > XB_SPIN_CAP) { atomicAdd(&bar[XB_TMO], 1u); break; } }
    }
    nloc = mine > 0u ? mine : 1u; nx = cnt > 0u ? cnt : 1u;
}
__device__ __forceinline__ void xcd_barrier(const XcdBarrier& b) {
    asm volatile("s_waitcnt vmcnt(0)" ::: "memory");
    __syncthreads();
    if (threadIdx.x == 0) {
        unsigned* bar = b.bar;
        __builtin_amdgcn_s_waitcnt(0);
        unsigned nloc = b.st[0], nx = b.st[1];
        if (nloc == 0u) { xcd_barrier_complete(bar, b.x, nloc, nx); b.st[0] = nloc; b.st[1] = nx; }
        const unsigned old = xb_add(&bar[XB_XSUB(b.x)], 1u);
        const unsigned gen = old / nloc;
        if (old + 1u == (gen + 1u) * nloc) {
            __builtin_amdgcn_fence(__ATOMIC_RELEASE, "agent");
            asm volatile("s_waitcnt vmcnt(0)" ::: "memory");
            const unsigned og = xb_add(&bar[XB_TOP], 1u);
            const unsigned tg = og / nx;
            if (og + 1u == (tg + 1u) * nx) xb_add(&bar[XB_TOPGEN], 1u);
            else XB_SPIN(xb_ld(&bar[XB_TOPGEN]) == tg, bar);
            __builtin_amdgcn_fence(__ATOMIC_ACQUIRE, "agent");
            xb_add(&bar[XB_XGEN(b.x)], 1u);
            asm volatile("s_waitcnt vmcnt(0)" ::: "memory");
        } else {
            XB_SPIN(xb_ld(&bar[XB_XGEN(b.x)]) == gen, bar);
            __builtin_amdgcn_fence(__ATOMIC_ACQUIRE, "agent");
            asm volatile("s_waitcnt vmcnt(0)" ::: "memory");
        }
    }
    __syncthreads();
}

namespace pg8 {
constexpr int BM = 256, BK = 64, HALF = 128, HTB = HALF * BK * 2, STAGE_BYTES = 8 * HTB, NXCD = 8, WGM = 8;
__host__ __device__ __forceinline__ int lds_byte(int r, int c) { const int st = (r >> 4) * 2 + (c >> 5), rr = r & 15, cc = c & 31, ob = rr * 64 + cc * 2; return st * 1024 + (ob ^ (((ob >> 9) & 1) << 5)); }
__host__ __device__ __forceinline__ void stage_rc(int b, int& R, int& C) { const int st = b / 1024, sb = b % 1024, swz = sb ^ (((sb >> 9) & 1) << 5); R = (st >> 1) * 16 + swz / 64; C = (st & 1) * 32 + (swz % 64) / 2; }
__host__ __device__ __forceinline__ int perm32(int rho) { const int n = rho >> 4, i = rho & 15; return 8 * (i >> 2) + 4 * n + (i & 3); }

struct Unit { const char* A; const char* B; const void* p0; const float* cs; bf16* obase; int orow, ocol, ldc; float scale; };

__device__ __forceinline__ bool tile_order(int i, int G, int c, int nM, int nN, int& pm, int& pn) {
    const int nwg = nM * nN; const long L = (long)i * G + c; if (L >= nwg) return false;
    int wgid = (int)L; { const int q = nwg / NXCD, r = nwg % NXCD, xcd = wgid % NXCD, off = wgid / NXCD; wgid = (xcd < r ? xcd * (q + 1) : r * (q + 1) + (xcd - r) * q) + off; }
    const int nig = WGM * nN, gid = wgid / nig, fm = gid * WGM, gsz = (nM - fm) < WGM ? (nM - fm) : WGM;
    pm = fm + ((wgid % nig) % gsz); pn = (wgid % nig) / gsz; return true;
}

template <bool VT> struct EpiBf16T {
    static constexpr bool SCL = false;
    __device__ __forceinline__ void operator()(const f32x4 (&acc)[2][2][4][2], const Unit& u, int wr, int wc, int fr, int fq, const LAS int* tok, const LAS float* scl) const {
        const int row0 = u.orow + wr * 64 + fr, col0 = u.ocol + wc * 32 + 8 * fq; const float sc = u.scale;
#pragma unroll
        for (int ai = 0; ai < 2; ++ai)
#pragma unroll
            for (int m = 0; m < 4; ++m) { const int row = row0 + ai * HALF + m * 16; bf16* rowp = u.obase + (size_t)row * u.ldc + col0;
#pragma unroll
                for (int bj = 0; bj < 2; ++bj) { const f32x4 v0 = acc[ai][bj][m][0] * sc, v1 = acc[ai][bj][m][1] * sc;
                    v4u w; w.x = cvt_pk_bf16(v0[0], v0[1]); w.y = cvt_pk_bf16(v0[2], v0[3]); w.z = cvt_pk_bf16(v1[0], v1[1]); w.w = cvt_pk_bf16(v1[2], v1[3]);
                    bf16* p = (VT && u.ldc < 0) ? u.obase + vt_index(row, col0 + bj * HALF) : rowp + bj * HALF;
                    *(v4u*)p = w; } }
    }
};
struct EpiY8 {
    static constexpr bool SCL = false;
    __device__ __forceinline__ void operator()(const f32x4 (&acc)[2][2][4][2], const Unit& u, int wr, int wc, int fr, int fq, const LAS int* tok, const LAS float* scl) const {
        const int row0 = u.orow + wr * 64 + fr, col0 = u.ocol + wc * 32 + 8 * fq; const float sc = u.scale;
#pragma unroll
        for (int ai = 0; ai < 2; ++ai)
#pragma unroll
            for (int m = 0; m < 4; ++m) { unsigned char* rowp = (unsigned char*)u.obase + (size_t)(row0 + ai * HALF + m * 16) * u.ldc + col0;
#pragma unroll
                for (int bj = 0; bj < 2; ++bj) { const f32x4 v0 = acc[ai][bj][m][0] * sc, v1 = acc[ai][bj][m][1] * sc;
                    int w0 = 0, w1 = 0;
                    w0 = __builtin_amdgcn_cvt_pk_fp8_f32(v0[0], v0[1], w0, false); w0 = __builtin_amdgcn_cvt_pk_fp8_f32(v0[2], v0[3], w0, true);
                    w1 = __builtin_amdgcn_cvt_pk_fp8_f32(v1[0], v1[1], w1, false); w1 = __builtin_amdgcn_cvt_pk_fp8_f32(v1[2], v1[3], w1, true);
                    v2u w; w.x = (unsigned)w0; w.y = (unsigned)w1; *(v2u*)(rowp + bj * HALF) = w; } }
    }
};
typedef EpiBf16T<false> EpiBf16;
typedef EpiBf16T<true> EpiProj;
__device__ __forceinline__ float silu_mul(float g, float u) { return g * u * __builtin_amdgcn_rcpf(1.0f + __builtin_amdgcn_exp2f(-LOG2E * g)); }
struct EpiSwiGLU {
    static constexpr bool SCL = false;
    __device__ __forceinline__ void operator()(const f32x4 (&acc)[2][2][4][2], const Unit& u, int wr, int wc, int fr, int fq, const LAS int* tok, const LAS float* scl) const {
        const int row0 = u.orow + wr * 64 + fr, col0 = u.ocol + wc * 32 + 8 * fq;
#pragma unroll
        for (int ai = 0; ai < 2; ++ai)
#pragma unroll
            for (int m = 0; m < 4; ++m) { bf16* rowp = u.obase + (size_t)(row0 + ai * HALF + m * 16) * u.ldc + col0;
                const f32x4 g0 = acc[ai][0][m][0], g1 = acc[ai][0][m][1], u0 = acc[ai][1][m][0], u1 = acc[ai][1][m][1];
                v4u w; w.x = cvt_pk_bf16(silu_mul(g0[0], u0[0]), silu_mul(g0[1], u0[1])); w.y = cvt_pk_bf16(silu_mul(g0[2], u0[2]), silu_mul(g0[3], u0[3]));
                w.z = cvt_pk_bf16(silu_mul(g1[0], u1[0]), silu_mul(g1[1], u1[1])); w.w = cvt_pk_bf16(silu_mul(g1[2], u1[2]), silu_mul(g1[3], u1[3]));
                *(v4u*)rowp = w; }
    }
};

template <bool F6> struct EpiSwiGLU8T {
    static constexpr bool SCL = false;
    static __device__ __forceinline__ f32x2 pair(f32x2 gr, f32x2 ur) {
        const float sc = F6 ? 1.0f / (S6A * S6W) : 1.0f / W8_UP; const f32x2 a = gr * (-LOG2E * sc);
        f32x2 t; t.x = __builtin_amdgcn_exp2f(a.x); t.y = __builtin_amdgcn_exp2f(a.y);
        const f32x2 d = t + 1.0f; f32x2 r; r.x = __builtin_amdgcn_rcpf(d.x); r.y = __builtin_amdgcn_rcpf(d.y);
        return (gr * ur) * (r * (sc * sc));
    }
    __device__ __forceinline__ void operator()(const f32x4 (&acc)[2][2][4][2], const Unit& u, int wr, int wc, int fr, int fq, const LAS int* tok, const LAS float* scl) const {
        const int row0 = u.orow + wr * 64 + fr, col0 = u.ocol + wc * 32 + 8 * fq;
#pragma unroll
        for (int ai = 0; ai < 2; ++ai)
#pragma unroll
            for (int m = 0; m < 4; ++m) { unsigned char* rowp = (unsigned char*)u.obase + (size_t)(row0 + ai * HALF + m * 16) * 128 + col0;
                const f32x4 g0 = acc[ai][0][m][0], g1 = acc[ai][0][m][1], u0 = acc[ai][1][m][0], u1 = acc[ai][1][m][1];
                const f32x2 o0 = pair((f32x2){g0[0], g0[1]}, (f32x2){u0[0], u0[1]}), o1 = pair((f32x2){g0[2], g0[3]}, (f32x2){u0[2], u0[3]});
                const f32x2 o2 = pair((f32x2){g1[0], g1[1]}, (f32x2){u1[0], u1[1]}), o3 = pair((f32x2){g1[2], g1[3]}, (f32x2){u1[2], u1[3]});
                int w0 = 0, w1 = 0;
                w0 = __builtin_amdgcn_cvt_pk_fp8_f32(o0.x, o0.y, w0, false); w0 = __builtin_amdgcn_cvt_pk_fp8_f32(o1.x, o1.y, w0, true);
                w1 = __builtin_amdgcn_cvt_pk_fp8_f32(o2.x, o2.y, w1, false); w1 = __builtin_amdgcn_cvt_pk_fp8_f32(o3.x, o3.y, w1, true);
                v2u w; w.x = (unsigned)w0; w.y = (unsigned)w1; *(v2u*)rowp = w; }
    }
};

typedef EpiSwiGLU8T<false> EpiSwiGLU8;
typedef EpiSwiGLU8T<true> EpiSwiGLU6;
struct EpiProj_I8 {
    static constexpr bool SCL = true;
    __device__ __forceinline__ const float* rs_ptr(const Unit& u) const { return (const float*)u.p0; }
    __device__ __forceinline__ const float* cs_ptr(const Unit& u) const { return u.cs; }
    __device__ __forceinline__ void operator()(const f32x4 (&acc)[2][2][4][2], const Unit& u, int wr, int wc, int fr, int fq, const LAS int* tok, const LAS float* scl) const {
        const int rl0 = wr * 64 + fr, cl0 = wc * 32 + 8 * fq, row0 = u.orow + rl0, col0 = u.ocol + cl0; const float sc = u.scale;
        const bool hm = u.ldc == 0; const size_t rstride = hm ? 32 : (size_t)u.ldc, bstride = hm ? (size_t)4 * T * 32 : (size_t)HALF;
        bf16* lbase = hm ? u.obase + (size_t)((u.ocol >> 5) + wc) * T * 32 + 8 * fq : u.obase + col0;
        f32x4 cv[2][2];
#pragma unroll
        for (int bj = 0; bj < 2; ++bj) { cv[bj][0] = *(const LAS f32x4*)(scl + 256 + cl0 + bj * HALF) * sc; cv[bj][1] = *(const LAS f32x4*)(scl + 256 + cl0 + bj * HALF + 4) * sc; }
#pragma unroll
        for (int ai = 0; ai < 2; ++ai)
#pragma unroll
            for (int m = 0; m < 4; ++m) { const int row = row0 + ai * HALF + m * 16; const float sr = scl[rl0 + ai * HALF + m * 16]; bf16* rowp = lbase + (size_t)row * rstride;
#pragma unroll
                for (int bj = 0; bj < 2; ++bj) { const f32x4 v0 = __builtin_convertvector(__builtin_bit_cast(i32x4, acc[ai][bj][m][0]), f32x4) * cv[bj][0] * sr, v1 = __builtin_convertvector(__builtin_bit_cast(i32x4, acc[ai][bj][m][1]), f32x4) * cv[bj][1] * sr;
                    v4u w; w.x = cvt_pk_bf16(v0[0], v0[1]); w.y = cvt_pk_bf16(v0[2], v0[3]); w.z = cvt_pk_bf16(v1[0], v1[1]); w.w = cvt_pk_bf16(v1[2], v1[3]);
                    bf16* p = (u.ldc < 0) ? u.obase + vt_index(row, col0 + bj * HALF) : rowp + bj * bstride;
                    *(v4u*)p = w; } }
    }
};
template <bool F8OUT> struct EpiSwiGLU_I8T {
    static constexpr bool SCL = true;
    const float* sA; const float* sW; const int* idl;
    __device__ __forceinline__ const float* rs_ptr(const Unit& u) const { return sA + ((const int*)u.p0 - idl); }
    __device__ __forceinline__ const float* cs_ptr(const Unit& u) const { return sW + 2 * u.ocol; }
    static __device__ __forceinline__ f32x2 pair(f32x2 gr, f32x2 ur, f32x2 ka, f32x2 k, float sa) {
        const f32x2 a = (gr * sa) * ka;
        f32x2 t; t.x = __builtin_amdgcn_exp2f(a.x); t.y = __builtin_amdgcn_exp2f(a.y);
        const f32x2 d = t * k + k; f32x2 r; r.x = __builtin_amdgcn_rcpf(d.x); r.y = __builtin_amdgcn_rcpf(d.y);
        return (gr * ur) * r;
    }
    __device__ __forceinline__ void operator()(const f32x4 (&acc)[2][2][4][2], const Unit& u, int wr, int wc, int fr, int fq, const LAS int* tok, const LAS float* scl) const {
        const int rl0 = wr * 64 + fr, row0 = u.orow + rl0, cl0 = wc * 32 + 8 * fq, col0 = u.ocol + cl0;
        f32x2 ka[4], kc[4];
#pragma unroll
        for (int i = 0; i < 4; ++i) { const f32x2 wg = *(const LAS f32x2*)(scl + 256 + cl0 + 2 * i), wu = *(const LAS f32x2*)(scl + 256 + HALF + cl0 + 2 * i); const f32x2 p = wg * wu;
            ka[i] = wg * (-LOG2E); kc[i].x = __builtin_amdgcn_rcpf(p.x); kc[i].y = __builtin_amdgcn_rcpf(p.y); }
#pragma unroll
        for (int ai = 0; ai < 2; ++ai)
#pragma unroll
            for (int m = 0; m < 4; ++m) { const float sa = scl[rl0 + ai * HALF + m * 16], rs2 = __builtin_amdgcn_rcpf(sa * sa);
                bf16* rowp = u.obase + (size_t)(row0 + ai * HALF + m * 16) * u.ldc + col0;
                f32x2 o[4];
#pragma unroll
                for (int i = 0; i < 4; ++i) { const f32x4 ga = acc[ai][0][m][i >> 1], ua = acc[ai][1][m][i >> 1];
                    const float g0 = ga[2 * (i & 1)], g1 = ga[2 * (i & 1) + 1], u0 = ua[2 * (i & 1)], u1 = ua[2 * (i & 1) + 1];
                    const f32x2 gr = (f32x2){(float)__float_as_int(g0), (float)__float_as_int(g1)}, ur = (f32x2){(float)__float_as_int(u0), (float)__float_as_int(u1)};
                    o[i] = pair(gr, ur, ka[i], kc[i] * rs2, sa); }
                if constexpr (F8OUT) { int w0 = 0, w1 = 0;
                    w0 = __builtin_amdgcn_cvt_pk_fp8_f32(o[0].x, o[0].y, w0, false); w0 = __builtin_amdgcn_cvt_pk_fp8_f32(o[1].x, o[1].y, w0, true);
                    w1 = __builtin_amdgcn_cvt_pk_fp8_f32(o[2].x, o[2].y, w1, false); w1 = __builtin_amdgcn_cvt_pk_fp8_f32(o[3].x, o[3].y, w1, true);
                    v2u w; w.x = (unsigned)w0; w.y = (unsigned)w1; *(v2u*)((unsigned char*)u.obase + (size_t)(row0 + ai * HALF + m * 16) * 128 + col0) = w; }
                else { v4u w; w.x = cvt_pk_bf16(o[0].x, o[0].y); w.y = cvt_pk_bf16(o[1].x, o[1].y); w.z = cvt_pk_bf16(o[2].x, o[2].y); w.w = cvt_pk_bf16(o[3].x, o[3].y);
                    *(v4u*)rowp = w; } }
    }
};
typedef EpiSwiGLU_I8T<FP8_DDOWN != 0> EpiSwiGLU_I8;

template <class Epi, class Sched, bool GATHER, int MT = 0  >
__device__ __forceinline__ void gemm_phase(LAS unsigned char* lds, LAS int* tokbuf, const int K, const Sched& S, const Epi& E, const int P_ = 0, const int PA_ = 0, const int KSA_ = 0) {
    const int P = P_ ? P_ : K, PA = PA_ ? PA_ : P;
    const size_t kstepA = KSA_ ? (size_t)KSA_ : (size_t)(BK * 2);
    int tid_ = threadIdx.x; asm volatile("" : "+v"(tid_));
    const int tid = tid_, wid = __builtin_amdgcn_readfirstlane(tid >> 6), lane = tid & 63, wr = wid >> 2, wc = wid & 3, fr = lane & 15, fq = lane >> 4;
    const int nt = K / BK;
    unsigned voffA[2][2], voffB[2]; int rowA[2], colA[2];
#pragma unroll
    for (int i = 0; i < 2; ++i) { int R, C; stage_rc(tid * 16 + i * 8192, R, C); const int Rb = (R & ~31) + perm32(R & 31);
        voffA[0][i] = (unsigned)(R * PA + C) * 2u; voffA[1][i] = (unsigned)((R + HALF) * PA + C) * 2u; voffB[i] = (unsigned)(Rb * P + C) * 2u; rowA[i] = R; colA[i] = C; }
    const size_t kstep = (size_t)(BK * 2);
    const size_t hstep = (size_t)HALF * P * 2, hstepA = (size_t)HALF * PA * 2;
    const unsigned ldsw = (unsigned)wid * 1024u;
    const int aoff = lds_byte(wr * 64 + fr, fq * 8), boff = lds_byte(wc * 32 + fr, fq * 8);
#define PG8_SA(b, h) (((b) * 2 + (h)) * HTB)
#define PG8_SB(b, h) ((4 + (b) * 2 + (h)) * HTB)
#define PG8_STAGE(bufoff, gbase, voff) do { _Pragma("unroll") for (int _i = 0; _i < 2; ++_i) \
        __builtin_amdgcn_global_load_lds((const unsigned*)((const char*)(gbase) + (voff)[_i]), (LAS unsigned*)(lds + (bufoff) + ldsw + _i * 8192), 16, 0, 0); } while (0)
#define PG8_STAGE_A1(bufoff, gbase) do { if constexpr (GATHER) PG8_STAGE(bufoff, gbase, voffA[1]); else PG8_STAGE(bufoff, (gbase) + hstepA, voffA[0]); } while (0)
#define PG8_LDA(dst, b, h) do { _Pragma("unroll") for (int m = 0; m < 4; ++m) _Pragma("unroll") for (int k = 0; k < 2; ++k) dst[m][k] = *(const LAS bf16x8*)(lds + PG8_SA(b, h) + aoff + m * 2048 + k * 1024); } while (0)
#define PG8_LDB(dst, b, h) do { _Pragma("unroll") for (int n = 0; n < 2; ++n) _Pragma("unroll") for (int k = 0; k < 2; ++k) dst[n][k] = *(const LAS bf16x8*)(lds + PG8_SB(b, h) + boff + n * 2048 + k * 1024); } while (0)
#define PG8_CAT8(x) __builtin_shufflevector(__builtin_bit_cast(i32x4, (x)[0]), __builtin_bit_cast(i32x4, (x)[1]), 0, 1, 2, 3, 4, 5, 6, 7)
#define PG8_MMA(ai, bj, At, Bt) do { __builtin_amdgcn_s_setprio(1); _Pragma("unroll") for (int m = 0; m < 4; ++m) _Pragma("unroll") for (int n = 0; n < 2; ++n) { \
        if constexpr (MT == 1) acc[ai][bj][m][n] = __builtin_amdgcn_mfma_scale_f32_16x16x128_f8f6f4(PG8_CAT8(Bt[n]), PG8_CAT8(At[m]), acc[ai][bj][m][n], 0, 0, 0, 0, 0, 0); \
        else if constexpr (MT == 3) acc[ai][bj][m][n] = __builtin_amdgcn_mfma_scale_f32_16x16x128_f8f6f4(PG8_CAT8(Bt[n]), PG8_CAT8(At[m]), acc[ai][bj][m][n], 2, 2, 0, 0, 0, 0); \
        else if constexpr (MT == 2) { _Pragma("unroll") for (int k = 0; k < 2; ++k) acc[ai][bj][m][n] = __builtin_bit_cast(f32x4, __builtin_amdgcn_mfma_i32_16x16x64_i8(__builtin_bit_cast(i32x4, Bt[n][k]), __builtin_bit_cast(i32x4, At[m][k]), __builtin_bit_cast(i32x4, acc[ai][bj][m][n]), 0, 0, 0)); } \
        else { _Pragma("unroll") for (int k = 0; k < 2; ++k) acc[ai][bj][m][n] = __builtin_amdgcn_mfma_f32_16x16x32_bf16(Bt[n][k], At[m][k], acc[ai][bj][m][n], 0, 0, 0); } } \
        __builtin_amdgcn_s_setprio(0); } while (0)
#define PG8_WAIT_V(n) asm volatile("s_waitcnt vmcnt(" #n ")" ::: "memory")
#define PG8_WAIT_L(n) asm volatile("s_waitcnt lgkmcnt(" #n ")" ::: "memory")
#define PG8_BAR __builtin_amdgcn_s_barrier()
#define PG8_SCHED __builtin_amdgcn_sched_barrier(0)
#define PG8_TOKOFF(dst, tb) do { _Pragma("unroll") for (int _h = 0; _h < 2; ++_h) _Pragma("unroll") for (int _i = 0; _i < 2; ++_i) \
        dst[_h][_i] = (unsigned)(tb)[_h * HALF + rowA[_i]] * (unsigned)(PA * 2) + (unsigned)(colA[_i] * 2); } while (0)
#define PG8_TOKDMA(listp, tb) do { if (wid < 4) __builtin_amdgcn_global_load_lds((const unsigned*)((listp) + tid), (LAS unsigned*)((tb) + wid * 64), 4, 0, 0); } while (0)
#define PG8_SCB(u_) ((LAS float*)(tokbuf + 768) + 512 * ((u_) % 3))
#define PG8_SCLDMA(un, u_) do { const float* sp_ = wid < 4 ? E.rs_ptr(un) + tid : E.cs_ptr(un) + (tid - 256); \
        __builtin_amdgcn_global_load_lds((const unsigned*)sp_, (LAS unsigned*)(PG8_SCB(u_) + wid * 64), 4, 0, 0); } while (0)
#define PG8_TB(u_) (tokbuf + 256 * ((u_) % 3))
    Unit cur, nxt; int ui = 0;
    if (!S.next(0, cur)) return;
    f32x4 acc[2][2][4][2];
#pragma unroll
    for (int a = 0; a < 2; ++a)
#pragma unroll
        for (int b = 0; b < 2; ++b)
#pragma unroll
            for (int m = 0; m < 4; ++m)
#pragma unroll
                for (int n = 0; n < 2; ++n) acc[a][b][m][n] = (f32x4){0.f, 0.f, 0.f, 0.f};
    bf16x8 At[4][2], B0[2][2], B1[2][2];
    const char* cA = cur.A; const char* cB = cur.B;
    if constexpr (Epi::SCL) PG8_SCLDMA(cur, 0);
    if constexpr (GATHER) {
        PG8_TOKDMA((const int*)cur.p0, PG8_TB(0)); PG8_WAIT_V(0); PG8_BAR; asm volatile("" ::: "memory");
        PG8_TOKOFF(voffA, PG8_TB(0)); PG8_WAIT_L(0); asm volatile("" ::: "memory");
    } else if constexpr (Epi::SCL) { PG8_WAIT_V(0); PG8_BAR; asm volatile("" ::: "memory"); }
    PG8_STAGE(PG8_SB(0, 0), cB, voffB); PG8_STAGE(PG8_SB(0, 1), cB + hstep, voffB); PG8_STAGE(PG8_SA(0, 0), cA, voffA[0]); PG8_STAGE_A1(PG8_SA(0, 1), cA);
    if (wr == 1) PG8_BAR;
    PG8_WAIT_V(2); PG8_BAR;
    PG8_STAGE(PG8_SB(1, 0), cB + kstep, voffB); PG8_STAGE(PG8_SA(1, 0), cA + kstepA, voffA[0]); PG8_STAGE(PG8_SB(1, 1), cB + hstep + kstep, voffB);
    PG8_WAIT_V(6); PG8_BAR;
    for (;;) {
        const bool has_next = S.next(ui + 1, nxt);
        if constexpr (Epi::SCL) { if (has_next) PG8_SCLDMA(nxt, ui + 1); }
        if constexpr (GATHER) { if (has_next) PG8_TOKDMA((const int*)nxt.p0, PG8_TB(ui + 1)); }
        const char* nA = has_next ? nxt.A : cA; const char* nB = has_next ? nxt.B : cB;
        for (int t = 0; t < nt; t += 2) {
            const bool last = (t == nt - 2);
            const char* a1 = cA + (size_t)(t + 1) * kstepA;
            const char* a2 = last ? nA : cA + (size_t)(t + 2) * kstepA; const char* b2 = last ? nB : cB + (size_t)(t + 2) * kstep;
            const char* a3 = a2 + kstepA; const char* b3 = b2 + kstep;
            PG8_LDB(B0, 0, 0); PG8_LDB(B1, 0, 1); PG8_SCHED; PG8_LDA(At, 0, 0); PG8_STAGE_A1(PG8_SA(1, 1), a1);
            if constexpr (GATHER) { if (last && has_next) { PG8_TOKOFF(voffA, PG8_TB(ui + 1)); } }
            PG8_WAIT_V(8); PG8_WAIT_L(0); PG8_BAR; PG8_MMA(0, 0, At, B0); PG8_MMA(0, 1, At, B1); PG8_BAR; PG8_SCHED;
            PG8_LDA(At, 0, 1); PG8_STAGE(PG8_SB(0, 0), b2, voffB); PG8_STAGE(PG8_SB(0, 1), b2 + hstep, voffB); PG8_STAGE(PG8_SA(0, 0), a2, voffA[0]);
            PG8_WAIT_V(8); PG8_WAIT_L(0); PG8_BAR; PG8_MMA(1, 0, At, B0); PG8_MMA(1, 1, At, B1); PG8_BAR; PG8_SCHED;
            PG8_LDB(B0, 1, 0); PG8_LDB(B1, 1, 1); PG8_SCHED; PG8_LDA(At, 1, 0); PG8_STAGE_A1(PG8_SA(0, 1), a2);
            PG8_WAIT_V(8); PG8_WAIT_L(0); PG8_BAR; PG8_MMA(0, 0, At, B0); PG8_MMA(0, 1, At, B1); PG8_BAR; PG8_SCHED;
            PG8_LDA(At, 1, 1); PG8_STAGE(PG8_SB(1, 0), b3, voffB); PG8_STAGE(PG8_SB(1, 1), b3 + hstep, voffB); PG8_STAGE(PG8_SA(1, 0), a3, voffA[0]);
            PG8_WAIT_V(8); PG8_WAIT_L(0); PG8_BAR; PG8_MMA(1, 0, At, B0); PG8_MMA(1, 1, At, B1); PG8_BAR; PG8_SCHED;
        }
        if (wr == 0) PG8_BAR;
#ifndef EPIX
#define EPIX 1
#endif
        for (int e_ = 0; e_ < EPIX; ++e_) E(acc, cur, wr, wc, fr, fq, PG8_TB(ui), PG8_SCB(ui));
        if (!has_next) break;
#pragma unroll
        for (int a = 0; a < 2; ++a)
#pragma unroll
            for (int b = 0; b < 2; ++b)
#pragma unroll
                for (int m = 0; m < 4; ++m)
#pragma unroll
                    for (int n = 0; n < 2; ++n) acc[a][b][m][n] = (f32x4){0.f, 0.f, 0.f, 0.f};
        cur = nxt; cA = nA; cB = nB; ++ui;
        if (wr == 1) PG8_BAR;
    }
    PG8_WAIT_V(0);
    PG8_BAR;
#undef PG8_SA
#undef PG8_SB
#undef PG8_STAGE
#undef PG8_LDA
#undef PG8_STAGE_A1
#undef PG8_LDB
#undef PG8_MMA
#undef PG8_CAT8
#undef PG8_WAIT_V
#undef PG8_WAIT_L
#undef PG8_BAR
#undef PG8_SCHED
#undef PG8_TOKOFF
#undef PG8_TOKDMA
#undef PG8_TB
#undef PG8_SCB
#undef PG8_SCLDMA
}
}

struct Args { const float* in[17]; float* out; unsigned char* ws; int lo, hi, breg, pad; };
struct Frame {
    LAS unsigned char* lds; volatile LAS unsigned* MISC; unsigned* ctl; int tid, lane, wave, G, bid;
    const float *x, *g_mpre, *g_mpost, *g_fpre, *g_fpost, *w_in, *pool_w, *pool_scale, *rpb, *w_out, *dwg, *dwu, *dwd, *router, *mwg, *mwu, *mwd;
    float* out; unsigned char* ws;
};

__device__ __forceinline__ void p0_transpose_item(const float* W, int K, int N, bf16* WT, int kb, int n0, int row_base, LAS float* scr, int lane) {
    const int k0 = 64 * kb;
#pragma unroll 8
    for (int i = 0; i < 32; ++i) { const int kk = 2 * i + (lane >> 5); scr[kk * 33 + (lane & 31)] = __builtin_nontemporal_load(W + (size_t)(k0 + kk) * N + n0 + (lane & 31)); }
    LDS_WAIT(); asm volatile("" ::: "memory");
    const int c = lane & 7;
#pragma unroll
    for (int j = 0; j < 4; ++j) { const int n = (lane >> 3) + 8 * j; const LAS float* s = scr + (8 * c) * 33 + n;
        v4u o; o.x = pk2(s[0 * 33], s[1 * 33]); o.y = pk2(s[2 * 33], s[3 * 33]); o.z = pk2(s[4 * 33], s[5 * 33]); o.w = pk2(s[6 * 33], s[7 * 33]);
        *(v4u*)(WT + (size_t)(row_base + n) * K + k0 + 8 * c) = o; }
    LDS_WAIT(); asm volatile("" ::: "memory");
}
__device__ __forceinline__ void p0_matrix(const float* W, int K, int N, bf16* WT, int ilv_half, LAS float* scr, int lane, int gw, int NGW, int& base) {
    const int nblk = N / 32, nitems = (K / 64) * nblk;
    int it = gw - (base % NGW); if (it < 0) it += NGW;
    for (; it < nitems; it += NGW) { const int kb = it / nblk, n0 = 32 * (it % nblk);
        const int rb = ilv_half < 0 ? n0 : (n0 / 128) * 256 + (n0 % 128) + 128 * ilv_half;
        p0_transpose_item(W, K, N, WT, kb, n0, rb, scr, lane); }
    base += nitems;
}
__device__ __forceinline__ void p0_transpose_item_fp8(const float* W, int K, int N, unsigned char* WT, int kt, int n0, int row_base, float scale, LAS float* scr, int lane) {
    const int k0 = 128 * kt;
#pragma unroll 8
    for (int i = 0; i < 64; ++i) { const int kk = 2 * i + (lane >> 5); scr[kk * 33 + (lane & 31)] = __builtin_nontemporal_load(W + (size_t)(k0 + kk) * N + n0 + (lane & 31)) * scale; }
    LDS_WAIT(); asm volatile("" ::: "memory");
    const int c = lane & 7;
#pragma unroll 1
    for (int pass = 0; pass < 4; ++pass) { const int n = (lane >> 3) + 8 * pass; const LAS float* sp = scr + (16 * c) * 33 + n;
        v4u o;
#pragma unroll
        for (int d = 0; d < 4; ++d) { int w = 0; w = __builtin_amdgcn_cvt_pk_fp8_f32(sp[(4 * d) * 33], sp[(4 * d + 1) * 33], w, false); w = __builtin_amdgcn_cvt_pk_fp8_f32(sp[(4 * d + 2) * 33], sp[(4 * d + 3) * 33], w, true); o[d] = (unsigned)w; }
        *(v4u*)(WT + (size_t)(row_base + n) * K + k0 + 16 * c) = o; }
    LDS_WAIT(); asm volatile("" ::: "memory");
}
__device__ __forceinline__ void p0_transpose_item_fp6(const float* W, int K, int N, unsigned char* WT, int kt, int n0, int row_base, float scale, LAS float* scr, int lane) {
    const int k0 = 128 * kt;
#pragma unroll 8
    for (int i = 0; i < 64; ++i) { const int kk = 2 * i + (lane >> 5); scr[kk * 33 + (lane & 31)] = __builtin_nontemporal_load(W + (size_t)(k0 + kk) * N + n0 + (lane & 31)) * scale; }
    LDS_WAIT(); asm volatile("" ::: "memory");
    const int n = lane & 31, g = lane >> 5;
    unsigned char* rp = WT + (size_t)(row_base + n) * K + 128 * kt;
#pragma unroll 1
    for (int h = 0; h < 2; ++h) { const int fq = 2 * h + g; const LAS float* sp = scr + (32 * fq) * 33 + n;
        f32x16 x, y;
#pragma unroll
        for (int i = 0; i < 16; ++i) { x[i] = sp[i * 33]; y[i] = sp[(16 + i) * 33]; }
        const i32x6 o = __builtin_amdgcn_cvt_scalef32_2xpk16_fp6_f32(x, y, 1.0f);
        *(v4u*)(rp + 16 * fq) = (v4u){(unsigned)o[0], (unsigned)o[1], (unsigned)o[2], (unsigned)o[3]};
        *(v4u*)(rp + 64 + 16 * fq) = (v4u){(unsigned)o[4], (unsigned)o[5], 0u, 0u}; }
    LDS_WAIT(); asm volatile("" ::: "memory");
}
__device__ __forceinline__ void p0_matrix_fp6(const float* W, int K, int N, unsigned char* WT, int ilv_half, float scale, LAS float* scr, int lane, int gw, int NGW, int& base) {
    const int nblk = N / 32, nitems = (K / 128) * nblk;
    int it = gw - (base % NGW); if (it < 0) it += NGW;
    for (; it < nitems; it += NGW) { const int kt = it / nblk, n0 = 32 * (it % nblk);
        const int rb = (n0 / 128) * 256 + (n0 % 128) + 128 * ilv_half;
        p0_transpose_item_fp6(W, K, N, WT, kt, n0, rb, scale, scr, lane); }
    base += nitems;
}
__device__ __forceinline__ void p0_matrix_fp8(const float* W, int K, int N, unsigned char* WT, int ilv_half, float scale, LAS float* scr, int lane, int gw, int NGW, int& base) {
    const int nblk = N / 32, nitems = (K / 128) * nblk;
    int it = gw - (base % NGW); if (it < 0) it += NGW;
    for (; it < nitems; it += NGW) { const int kt = it / nblk, n0 = 32 * (it % nblk);
        const int rb = ilv_half < 0 ? n0 : (n0 / 128) * 256 + (n0 % 128) + 128 * ilv_half;
        p0_transpose_item_fp8(W, K, N, WT, kt, n0, rb, scale, scr, lane); }
    base += nitems;
}
__device__ __forceinline__ void rms_row_to_bf16(const float* xrow, const float* g, bf16* orow, int lane) {
    const f32x4* xr = (const f32x4*)xrow + lane; const f32x4* gr = (const f32x4*)g + lane;
    f32x4 v[4]; float s = 0.f;
#pragma unroll
    for (int j = 0; j < 4; ++j) { v[j] = __builtin_nontemporal_load(xr + 64 * j); s += (v[j].x * v[j].x + v[j].y * v[j].y) + (v[j].z * v[j].z + v[j].w * v[j].w); }
    const float rstd = 1.0f / sqrtf(wave_sum(s) * (1.f / D) + RMS_EPS);
    v2u* o8 = (v2u*)orow + lane;
#pragma unroll
    for (int j = 0; j < 4; ++j) { const f32x4 gg = gr[64 * j]; v2u w; w.x = pk2(v[j].x * rstd * gg.x, v[j].y * rstd * gg.y); w.y = pk2(v[j].z * rstd * gg.z, v[j].w * rstd * gg.w); o8[64 * j] = w; }
}
__device__ __forceinline__ float wave_max(float v) {
#pragma unroll
    for (int o = 1; o < 64; o <<= 1) v = fmaxf(v, __shfl_xor(v, o));
    return v;
}
__device__ __forceinline__ void p0_colblock_i8(Frame& F, const float* W, int N, int n0, unsigned char* W8, float* sW, int dest0) {
    const int tid = F.tid, lane = F.lane, wid = F.wave, n = lane & 31, kh = lane >> 5;
    LAS float* slab = (LAS float*)F.lds; LAS float* cmax = (LAS float*)(F.lds + RING_BYTES);
    __syncthreads();
    float mx = 0.f;
#pragma unroll 1
    for (int i0 = 0; i0 < 64; i0 += 16) {
        float v[16];
#pragma unroll
        for (int i = 0; i < 16; ++i) v[i] = __builtin_nontemporal_load(W + (size_t)(128 * wid + 2 * (i0 + i) + kh) * N + n0 + n);
#pragma unroll
        for (int i = 0; i < 16; ++i) { const int k = 128 * wid + 2 * (i0 + i) + kh; slab[k * 32 + (n ^ (k & 31))] = v[i]; mx = fmaxf(mx, fabsf(v[i])); }
    }
    cmax[wid * 64 + lane] = mx;
    __syncthreads();
    float amax = 0.f;
#pragma unroll
    for (int w = 0; w < 8; ++w) amax = fmaxf(amax, fmaxf(cmax[w * 64 + n], cmax[w * 64 + 32 + n]));
    const float sc = amax > 0.f ? amax * (1.0f / 127.0f) : 1.0f, inv = amax > 0.f ? 127.0f / amax : 0.f;
    const int kc = tid >> 5, dest = dest0 + n;
#pragma unroll 1
    for (int q4 = 0; q4 < 4; ++q4) { v4u o;
#pragma unroll
        for (int d = 0; d < 4; ++d) { unsigned w = 0u;
#pragma unroll
            for (int j = 0; j < 4; ++j) { const int k = 64 * kc + 16 * q4 + 4 * d + j; w |= ((unsigned)__float2int_rn(slab[k * 32 + (n ^ (k & 31))] * inv) & 0xffu) << (8 * j); }
            o[d] = w; }
        *(v4u*)(W8 + (size_t)dest * D + 64 * kc + 16 * q4) = o; }
    if (kc == 0) sW[dest] = sc;
}
__device__ __forceinline__ void p0_i8_weights(Frame& F) {
    constexpr int NB_D = I8_DENSE ? 2 * (DFF / 32) : 0, NB_P = I8_PROJ ? DEPTH * (DIN / 32) : 0;
    for (int cb = F.bid; cb < NB_D + NB_P; cb += F.G) {
        if (cb < NB_D) { const int half = cb / (DFF / 32), n0 = 32 * (cb % (DFF / 32));
            p0_colblock_i8(F, half ? F.dwu : F.dwg, DFF, n0, F.ws + WS_WGU0, (float*)(F.ws + WS_SW0), (n0 / 128) * 256 + (n0 % 128) + 128 * half); }
        else { const int c2 = cb - NB_D, l = c2 / (DIN / 32), n0 = 32 * (c2 % (DIN / 32));
            p0_colblock_i8(F, F.w_in + (size_t)l * D * DIN, DIN, n0, F.ws + WS_WIN + (size_t)l * DIN * D, (float*)(F.ws + WS_SWIN) + l * DIN, n0); }
    }
    __syncthreads();
}
__device__ __forceinline__ void rms_row_to_i8(const float* xrow, const float* g, unsigned char* orow, float* sa, int lane) {
    const f32x4* xr = (const f32x4*)xrow + lane; const f32x4* gr = (const f32x4*)g + lane;
    f32x4 v[4]; float s = 0.f;
#pragma unroll
    for (int j = 0; j < 4; ++j) { v[j] = __builtin_nontemporal_load(xr + 64 * j); s += (v[j].x * v[j].x + v[j].y * v[j].y) + (v[j].z * v[j].z + v[j].w * v[j].w); }
    const float rstd = 1.0f / sqrtf(wave_sum(s) * (1.f / D) + RMS_EPS); float am = 0.f;
#pragma unroll
    for (int j = 0; j < 4; ++j) { v[j] = v[j] * rstd * gr[64 * j]; am = fmaxf(fmaxf(am, fmaxf(fabsf(v[j].x), fabsf(v[j].y))), fmaxf(fabsf(v[j].z), fabsf(v[j].w))); }
    am = wave_max(am); const float inv = am > 0.f ? 127.0f / am : 0.f;
#pragma unroll
    for (int j = 0; j < 4; ++j) ((unsigned*)orow + lane)[64 * j] = ((unsigned)__float2int_rn(v[j].x * inv) & 0xffu) | (((unsigned)__float2int_rn(v[j].y * inv) & 0xffu) << 8) | (((unsigned)__float2int_rn(v[j].z * inv) & 0xffu) << 16) | (((unsigned)__float2int_rn(v[j].w * inv) & 0xffu) << 24);
    if (lane == 0) *sa = am > 0.f ? am * (1.0f / 127.0f) : 1.0f;
}
__device__ __forceinline__ void p0_prologue(Frame& F0) {
    Frame F = F0; { int t_ = threadIdx.x; asm volatile("" : "+v"(t_)); F.tid = t_; F.lane = t_ & 63; F.wave = __builtin_amdgcn_readfirstlane(t_ >> 6); }
    LAS float* scr = (LAS float*)(F.lds + F.wave * 16896);
    const int gw = F.bid * 8 + F.wave, NGW = F.G * 8, gt = F.bid * 512 + F.tid, NGT = F.G * 512;
    { v4u z = (v4u){0u, 0u, 0u, 0u}; v4u* L = (v4u*)(F.ws + WS_LIST); for (int i = gt; i < (int)(NE * T / 4); i += NGT) L[i] = z;
      int* id = (int*)(F.ws + WS_LISTID); for (int i = gt; i < T; i += NGT) id[i] = i; }
    int base = 0;
    for (int l = 0; l < DEPTH; ++l) {
#if !I8_PROJ
        p0_matrix(F.w_in + (size_t)l * D * DIN, D, DIN, (bf16*)(F.ws + WS_WIN) + (size_t)l * DIN * D, -1, scr, F.lane, gw, NGW, base);
#endif
        p0_matrix(F.w_out + (size_t)l * D * D, D, D, (bf16*)(F.ws + WS_WOUT) + (size_t)l * D * D, -1, scr, F.lane, gw, NGW, base);
        for (int g = 0; g < 4; ++g) p0_matrix(F.pool_w + (size_t)(l * 4 + g) * 128 * 128, 128, 128, (bf16*)(F.ws + WS_WP) + (size_t)(l * 4 + g) * 128 * 128, -1, scr, F.lane, gw, NGW, base);
    }
#if !I8_DENSE
    p0_matrix(F.dwg, D, DFF, (bf16*)(F.ws + WS_WGU0), 0, scr, F.lane, gw, NGW, base);
    p0_matrix(F.dwu, D, DFF, (bf16*)(F.ws + WS_WGU0), 1, scr, F.lane, gw, NGW, base);
#endif
#if FP8_DDOWN
    p0_matrix_fp8(F.dwd, DFF, D, F.ws + WS_WD0, -1, W8_DN, scr, F.lane, gw, NGW, base);
#else
    p0_matrix(F.dwd, DFF, D, (bf16*)(F.ws + WS_WD0), -1, scr, F.lane, gw, NGW, base);
#endif
    for (int e = 0; e < NE; ++e) {
#if FP8_MOE
#if FP6_UP
        p0_matrix_fp6(F.mwg + (size_t)e * D * DFFE, D, DFFE, F.ws + WS_WGUM + (size_t)e * 2 * DFFE * D, 0, S6W, scr, F.lane, gw, NGW, base);
        p0_matrix_fp6(F.mwu + (size_t)e * D * DFFE, D, DFFE, F.ws + WS_WGUM + (size_t)e * 2 * DFFE * D, 1, S6W, scr, F.lane, gw, NGW, base);
#else
        p0_matrix_fp8(F.mwg + (size_t)e * D * DFFE, D, DFFE, F.ws + WS_WGUM + (size_t)e * 2 * DFFE * D, 0, W8_UP, scr, F.lane, gw, NGW, base);
        p0_matrix_fp8(F.mwu + (size_t)e * D * DFFE, D, DFFE, F.ws + WS_WGUM + (size_t)e * 2 * DFFE * D, 1, W8_UP, scr, F.lane, gw, NGW, base);
#endif
        p0_matrix_fp8(F.mwd + (size_t)e * DFFE * D, DFFE, D, F.ws + WS_WDM + (size_t)e * D * DFFE, -1, W8_DN, scr, F.lane, gw, NGW, base);
#else
        p0_matrix(F.mwg + (size_t)e * D * DFFE, D, DFFE, (bf16*)(F.ws + WS_WGUM) + (size_t)e * 2 * DFFE * D, 0, scr, F.lane, gw, NGW, base);
        p0_matrix(F.mwu + (size_t)e * D * DFFE, D, DFFE, (bf16*)(F.ws + WS_WGUM) + (size_t)e * 2 * DFFE * D, 1, scr, F.lane, gw, NGW, base);
        p0_matrix(F.mwd + (size_t)e * DFFE * D, DFFE, D, (bf16*)(F.ws + WS_WDM) + (size_t)e * D * DFFE, -1, scr, F.lane, gw, NGW, base);
#endif
    }
    bf16* HN = (bf16*)(F.ws + WS_HN);
#if I8_PROJ
    for (int m = gw; m < T; m += NGW) rms_row_to_i8(F.x + (size_t)m * D, F.g_mpre, (unsigned char*)HN + (size_t)m * D, (float*)(F.ws + WS_SA) + m, F.lane);
#else
    for (int m = gw; m < T; m += NGW) rms_row_to_bf16(F.x + (size_t)m * D, F.g_mpre, HN + (size_t)m * D, F.lane);
#endif
#if I8_DENSE || I8_PROJ
    p0_i8_weights(F);
#endif
}

__device__ __forceinline__ unsigned ld_cnt(const unsigned* ctl, int e) { return __hip_atomic_load(ctl + CW_CNT + 64 * e, RLX_AGENT); }

__device__ __forceinline__ void ld_bf16_row(const bf16* row, int lane, f32x4 (&v)[4]) {
    const v2u* p = (const v2u*)row + lane;
#pragma unroll
    for (int j = 0; j < 4; ++j) { const v2u w = p[64 * j]; v[j] = (f32x4){bflo(w.x), bfhi(w.x), bflo(w.y), bfhi(w.y)}; }
}
__device__ __forceinline__ float sumsq16(const f32x4 (&v)[4]) {
    float s = 0.f;
#pragma unroll
    for (int j = 0; j < 4; ++j) s += (v[j].x * v[j].x + v[j].y * v[j].y) + (v[j].z * v[j].z + v[j].w * v[j].w);
    return s;
}
#define H16 FP8_MOE
struct NormRow { v2u a[4]; v2u b[4]; f32x4 hf[4]; v2u hb[4]; float g0, g1; };
template <bool FFN>
__device__ __forceinline__ void norm_phase(Frame& F0, int l) {
    Frame F = F0; { int t_ = threadIdx.x; asm volatile("" : "+v"(t_)); F.tid = t_; F.lane = t_ & 63; F.wave = __builtin_amdgcn_readfirstlane(t_ >> 6); }
    const int lane = F.lane, gw = F.bid * 8 + F.wave, NGW = F.G * 8;
    const bool moe = (l & 1) != 0;
    LAS float* WR = (LAS float*)F.lds;
    LAS unsigned* lcnt = (LAS unsigned*)(F.lds + LCNT_OFF); LAS unsigned* lbase = lcnt + 8;
    LAS int* bst = (LAS int*)(F.lds + BST_OFF);
    LAS float* rowbuf = (LAS float*)(F.lds + 32768 + F.wave * 4352);
    if (!FFN && moe) {
        for (int i = F.tid; i < D * NE; i += 512) { const int d = i >> 3, e = i & 7; WR[e * D + d] = F.router[i]; }
        if (F.tid < 8) lcnt[F.tid] = 0u;
        __syncthreads();
    }
    if (FFN && moe) {
        if (F.tid == 0) { int s = 0; for (int e = 0; e < NE; ++e) { bst[e] = s; s += (int)((ld_cnt(F.ctl, e) + 255u) >> 8); } }
        __syncthreads();
    }
    const float* gA = FFN ? F.g_fpost + l * D : F.g_mpost + l * D;
    const float* gB = FFN ? F.g_mpre + (l + 1) * D : F.g_fpre + l * D;
    const bool haveB = FFN ? (l + 1 < DEPTH) : true;
    const bool last = FFN && (l + 1 == DEPTH);
    const bool I8HN = FFN ? (I8_PROJ != 0) : (I8_DENSE && !moe);
    const bool hold_f32 = (!FFN && l == 0) || !H16;
    const bf16* addsrc = FFN ? (const bf16*)(F.ws + WS_Y) : (const bf16*)(F.ws + WS_MIX);
    const float* hold32 = (!FFN && l == 0) ? F.x : F.out;
    bf16* H = (bf16*)(F.ws + WS_H16);
    bf16* HN = (bf16*)(F.ws + WS_HN);
    const v2u* info = (const v2u*)(F.ws + WS_INFO); const f32x2* ginfo = (const f32x2*)(F.ws + WS_INFO + 256 * 1024);
#define NT_LD(p) __builtin_nontemporal_load(p)
#define NORM_LOAD(R, m_, nf_, gg_) do { \
        if (FFN && moe) { const int e0_ = (int)((nf_).x >> 16), p0_ = (int)((nf_).x & 0xffffu), e1_ = (int)((nf_).y >> 16), p1_ = (int)((nf_).y & 0xffffu); \
            if (Y8_MOE) { const unsigned* pa_ = (const unsigned*)((const unsigned char*)addsrc + (size_t)(256 * bst[e0_] + p0_) * D) + lane; const unsigned* pb_ = (const unsigned*)((const unsigned char*)addsrc + (size_t)(256 * bst[e1_] + p1_) * D) + lane; \
                _Pragma("unroll") for (int j = 0; j < 4; ++j) { (R).a[j].x = NT_LD(pa_ + 64 * j); (R).b[j].x = NT_LD(pb_ + 64 * j); } (R).g0 = (gg_).x * (1.0f / YS); (R).g1 = (gg_).y * (1.0f / YS); }   \
            else { const v2u* pa_ = (const v2u*)(addsrc + (size_t)(256 * bst[e0_] + p0_) * D) + lane; const v2u* pb_ = (const v2u*)(addsrc + (size_t)(256 * bst[e1_] + p1_) * D) + lane; \
            _Pragma("unroll") for (int j = 0; j < 4; ++j) { (R).a[j] = NT_LD(pa_ + 64 * j); (R).b[j] = NT_LD(pb_ + 64 * j); } (R).g0 = (gg_).x; (R).g1 = (gg_).y; } } \
        else { const v2u* pa_ = (const v2u*)(addsrc + (size_t)(m_) * D) + lane; _Pragma("unroll") for (int j = 0; j < 4; ++j) (R).a[j] = NT_LD(pa_ + 64 * j); } \
        if (hold_f32) { const f32x4* hp_ = (const f32x4*)(hold32 + (size_t)(m_) * D) + lane; _Pragma("unroll") for (int j = 0; j < 4; ++j) (R).hf[j] = NT_LD(hp_ + 64 * j); } \
        else { const v2u* hp_ = (const v2u*)(H + (size_t)(m_) * D) + lane; _Pragma("unroll") for (int j = 0; j < 4; ++j) (R).hb[j] = NT_LD(hp_ + 64 * j); } } while (0)
    int sTok = 0, sE0 = 0, sE1 = 0; float sG0 = 0.f, sG1 = 0.f;
    v2u nfL = (v2u){0u, 0u}; f32x2 ggL = (f32x2){0.f, 0.f};
    if (FFN && moe) { const int mi = gw + lane * NGW; if (mi < T) { nfL = info[mi]; ggL = ginfo[mi]; } }
    const int nfLx = (int)nfL.x, nfLy = (int)nfL.y; const float ggLx_ = ggL.x, ggLy_ = ggL.y; const int ggLx = __float_as_int(ggLx_), ggLy = __float_as_int(ggLy_);
#define NORM_INFO(nf_, gg_, it_) do { if (FFN && moe) { const int x_ = __builtin_amdgcn_readlane(nfLx, it_), y_ = __builtin_amdgcn_readlane(nfLy, it_), gx_ = __builtin_amdgcn_readlane(ggLx, it_), gy_ = __builtin_amdgcn_readlane(ggLy, it_); \
        (nf_).x = (unsigned)x_; (nf_).y = (unsigned)y_; (gg_).x = __int_as_float(gx_); (gg_).y = __int_as_float(gy_); } } while (0)
#define NORM_ROW(R, m_, it_) do { \
        f32x4 a[4]; \
        _Pragma("unroll") for (int j = 0; j < 4; ++j) { \
            if (FFN && moe && Y8_MOE) { const int wa_ = (int)(R).a[j].x, wb_ = (int)(R).b[j].x; const f32x2 a01 = __builtin_amdgcn_cvt_pk_f32_fp8(wa_, false), a23 = __builtin_amdgcn_cvt_pk_f32_fp8(wa_, true), b01 = __builtin_amdgcn_cvt_pk_f32_fp8(wb_, false), b23 = __builtin_amdgcn_cvt_pk_f32_fp8(wb_, true); \
                a[j] = (f32x4){a01.x, a01.y, a23.x, a23.y} * (R).g0 + (f32x4){b01.x, b01.y, b23.x, b23.y} * (R).g1; } \
            else { a[j] = (f32x4){bflo((R).a[j].x), bfhi((R).a[j].x), bflo((R).a[j].y), bfhi((R).a[j].y)}; \
            if (FFN && moe) { const f32x4 b = (f32x4){bflo((R).b[j].x), bfhi((R).b[j].x), bflo((R).b[j].y), bfhi((R).b[j].y)}; a[j] = a[j] * (R).g0 + b * (R).g1; } } } \
        const float r1 = 1.0f / sqrtf(wave_sum(sumsq16(a)) * (1.f / D) + RMS_EPS); \
        const f32x4* gAp = (const f32x4*)gA + lane; \
        f32x4 h[4]; \
        _Pragma("unroll") for (int j = 0; j < 4; ++j) { const f32x4 ho = hold_f32 ? (R).hf[j] : (f32x4){bflo((R).hb[j].x), bfhi((R).hb[j].x), bflo((R).hb[j].y), bfhi((R).hb[j].y)}; h[j] = ho + a[j] * r1 * gAp[64 * j]; } \
        if (last || !H16) { f32x4* op = (f32x4*)(F.out + (size_t)(m_) * D) + lane; _Pragma("unroll") for (int j = 0; j < 4; ++j) op[64 * j] = h[j]; } \
        else { v2u* op = (v2u*)(H + (size_t)(m_) * D) + lane; _Pragma("unroll") for (int j = 0; j < 4; ++j) { v2u w; w.x = cvt_pk_bf16(h[j].x, h[j].y); w.y = cvt_pk_bf16(h[j].z, h[j].w); op[64 * j] = w; } } \
        if (haveB) { \
            const float r2 = 1.0f / sqrtf(wave_sum(sumsq16(h)) * (1.f / D) + RMS_EPS); \
            const f32x4* gBp = (const f32x4*)gB + lane; v2u* o8 = (v2u*)(HN + (size_t)(m_) * D) + lane; \
            _Pragma("unroll") for (int j = 0; j < 4; ++j) { h[j] = h[j] * r2 * gBp[64 * j]; \
                if (FP8_MOE && FP6_UP && !FFN && moe) { const int e_ = 256 * j + 4 * lane, ix_ = e_ + (e_ >> 5); rowbuf[ix_] = h[j].x * S6A; rowbuf[ix_ + 1] = h[j].y * S6A; rowbuf[ix_ + 2] = h[j].z * S6A; rowbuf[ix_ + 3] = h[j].w * S6A; } \
                else if (FP8_MOE && !FFN && moe) { int w = 0; w = __builtin_amdgcn_cvt_pk_fp8_f32(h[j].x, h[j].y, w, false); w = __builtin_amdgcn_cvt_pk_fp8_f32(h[j].z, h[j].w, w, true); ((unsigned*)((unsigned char*)HN + (size_t)(m_) * D) + lane)[64 * j] = (unsigned)w; } \
                else if (!I8HN) { v2u w; w.x = cvt_pk_bf16(h[j].x, h[j].y); w.y = cvt_pk_bf16(h[j].z, h[j].w); o8[64 * j] = w; } } \
            if (FP8_MOE && FP6_UP && !FFN && moe) { asm volatile("s_waitcnt lgkmcnt(0)" ::: "memory"); \
                if (lane < 32) { f32x16 x_, y_; _Pragma("unroll") for (int i = 0; i < 16; ++i) { x_[i] = rowbuf[33 * lane + i]; y_[i] = rowbuf[33 * lane + 16 + i]; } \
                    const i32x6 o_ = __builtin_amdgcn_cvt_scalef32_2xpk16_fp6_f32(x_, y_, 1.0f); unsigned char* rp_ = (unsigned char*)HN + (size_t)(m_) * D + 128 * (lane >> 2); \
                    *(v4u*)(rp_ + 16 * (lane & 3)) = (v4u){(unsigned)o_[0], (unsigned)o_[1], (unsigned)o_[2], (unsigned)o_[3]}; *(v4u*)(rp_ + 64 + 16 * (lane & 3)) = (v4u){(unsigned)o_[4], (unsigned)o_[5], 0u, 0u}; } \
                asm volatile("s_waitcnt lgkmcnt(0)" ::: "memory"); } \
            if (I8HN) { float am = 0.f; \
                _Pragma("unroll") for (int j = 0; j < 4; ++j) am = fmaxf(fmaxf(am, fmaxf(fabsf(h[j].x), fabsf(h[j].y))), fmaxf(fabsf(h[j].z), fabsf(h[j].w))); \
                am = wave_max(am); const float sa_ = am > 0.f ? am * (1.0f / 127.0f) : 1.0f, inv_ = am > 0.f ? 127.0f / am : 0.f; \
                _Pragma("unroll") for (int j = 0; j < 4; ++j) { const unsigned w = ((unsigned)__float2int_rn(h[j].x * inv_) & 0xffu) | (((unsigned)__float2int_rn(h[j].y * inv_) & 0xffu) << 8) | (((unsigned)__float2int_rn(h[j].z * inv_) & 0xffu) << 16) | (((unsigned)__float2int_rn(h[j].w * inv_) & 0xffu) << 24); \
                    ((unsigned*)((unsigned char*)HN + (size_t)(m_) * D) + lane)[64 * j] = w; } \
                if (lane == 0) ((float*)(F.ws + WS_SA))[(m_)] = sa_; } \
            if (!FFN && moe) { \
                float lg[NE]; \
                _Pragma("unroll") for (int e = 0; e < NE; ++e) { float s_ = 0.f; \
                    _Pragma("unroll") for (int j = 0; j < 4; ++j) { const f32x4 w = *(const LAS f32x4*)(WR + e * D + 256 * j + 4 * lane); s_ += (h[j].x * w.x + h[j].y * w.y) + (h[j].z * w.z + h[j].w * w.w); } \
                    lg[e] = wave_sum(s_); } \
                int e0 = 0; float l0 = lg[0]; \
                _Pragma("unroll") for (int e = 1; e < NE; ++e) if (lg[e] > l0) { l0 = lg[e]; e0 = e; } \
                int e1 = -1; float l1 = -INFINITY; \
                _Pragma("unroll") for (int e = 0; e < NE; ++e) if (e != e0 && lg[e] > l1) { l1 = lg[e]; e1 = e; } \
                const float g0 = 1.0f / (1.0f + __expf(l1 - l0)), g1 = 1.0f - g0; \
                if (lane == (it_)) { sTok = (m_); sE0 = e0; sE1 = e1; sG0 = g0; sG1 = g1; } \
            } \
        } } while (0)
    int it = 0;
    NormRow c0, c1; v2u nf = (v2u){0u, 0u}; f32x2 gg = (f32x2){0.f, 0.f};
    if (gw < T) { NORM_INFO(nf, gg, 0); NORM_LOAD(c0, gw, nf, gg); }
    if (gw + NGW < T) { NORM_INFO(nf, gg, 1); NORM_LOAD(c1, gw + NGW, nf, gg); }
    for (int m = gw; m < T; m += 2 * NGW, it += 2) {
        const int m1 = m + NGW, m2 = m + 2 * NGW, m3 = m + 3 * NGW;
        NormRow n0, n1;
        if (m2 < T) { NORM_INFO(nf, gg, it + 2); NORM_LOAD(n0, m2, nf, gg); }
        if (m3 < T) { NORM_INFO(nf, gg, it + 3); NORM_LOAD(n1, m3, nf, gg); }
        NORM_ROW(c0, m, it);
        if (m1 < T) NORM_ROW(c1, m1, it + 1);
        c0 = n0; c1 = n1;
    }
    it = (T - gw + NGW - 1) / NGW; if (it < 0) it = 0;
#undef NORM_ROW
#undef NORM_INFO
#undef NORM_LOAD
    if (!FFN && moe) {
        unsigned loc0 = 0u, loc1 = 0u;
        if (lane < it) { loc0 = __hip_atomic_fetch_add(lcnt + sE0, 1u, __ATOMIC_RELAXED, __HIP_MEMORY_SCOPE_WORKGROUP); loc1 = __hip_atomic_fetch_add(lcnt + sE1, 1u, __ATOMIC_RELAXED, __HIP_MEMORY_SCOPE_WORKGROUP); }
        __syncthreads();
        if (F.tid < 8) lbase[F.tid] = __hip_atomic_fetch_add(F.ctl + CW_CNT + 64 * F.tid, lcnt[F.tid], RLX_AGENT);
        __syncthreads();
        if (lane < it) {
            const unsigned p0 = lbase[sE0] + loc0, p1 = lbase[sE1] + loc1;
            int* list = (int*)(F.ws + WS_LIST);
            list[(size_t)sE0 * T + p0] = sTok; list[(size_t)sE1 * T + p1] = sTok;
            v2u nf; nf.x = ((unsigned)sE0 << 16) | p0; nf.y = ((unsigned)sE1 << 16) | p1;
            ((v2u*)(F.ws + WS_INFO))[sTok] = nf; ((f32x2*)(F.ws + WS_INFO + 256 * 1024))[sTok] = (f32x2){sG0, sG1};
        }
    }
}

__device__ __forceinline__ size_t mixo_index(size_t tok, int ch) { return ((tok >> 8) * 16 + (size_t)(ch >> 6)) * (256 * 64) + (tok & 255) * 64 + (ch & 63); }
constexpr int U_PITCH = 1040, U_ROWS = 80, BIAS_OFF = U_PITCH * U_ROWS;
typedef __bf16 bf16x2_t __attribute__((ext_vector_type(2)));
template <int HW>
__device__ __forceinline__ void pool_frags(bf16x8 (&dfr)[2][4], const LAS unsigned char* cb, const float (&inv)[2]) {
    unsigned one_lo_ = 0x00003f80u, one_hi_ = 0x3f800000u; asm volatile("" : "+v"(one_lo_), "+v"(one_hi_));
    const bf16x2_t ONE_LO = __builtin_bit_cast(bf16x2_t, one_lo_), ONE_HI = __builtin_bit_cast(bf16x2_t, one_hi_);
#pragma unroll
    for (int mt = 0; mt < 2; ++mt)
#pragma unroll
        for (int ks = 0; ks < 4; ++ks) {
            const LAS unsigned char* cp = cb + mt * 16 * U_PITCH + ks * 64;
            float s0 = 0.f, s1 = 0.f, s2 = 0.f, s3 = 0.f, s4 = 0.f, s5 = 0.f, s6 = 0.f, s7 = 0.f;
#pragma unroll
            for (int d = -HW; d < HW; ++d) { const v4u v = *(const LAS v4u*)(cp + d * U_PITCH); const unsigned vx = v.x, vy = v.y, vz = v.z, vw = v.w;
                const bf16x2_t px = __builtin_bit_cast(bf16x2_t, vx), py = __builtin_bit_cast(bf16x2_t, vy), pz = __builtin_bit_cast(bf16x2_t, vz), pw = __builtin_bit_cast(bf16x2_t, vw);
                s0 = __builtin_amdgcn_fdot2_f32_bf16(px, ONE_LO, s0, false); s1 = __builtin_amdgcn_fdot2_f32_bf16(px, ONE_HI, s1, false);
                s2 = __builtin_amdgcn_fdot2_f32_bf16(py, ONE_LO, s2, false); s3 = __builtin_amdgcn_fdot2_f32_bf16(py, ONE_HI, s3, false);
                s4 = __builtin_amdgcn_fdot2_f32_bf16(pz, ONE_LO, s4, false); s5 = __builtin_amdgcn_fdot2_f32_bf16(pz, ONE_HI, s5, false);
                s6 = __builtin_amdgcn_fdot2_f32_bf16(pw, ONE_LO, s6, false); s7 = __builtin_amdgcn_fdot2_f32_bf16(pw, ONE_HI, s7, false); }
            const v4u c = *(const LAS v4u*)cp; const float iv = inv[mt];
            v4u p; p.x = cvt_pk_bf16(s0 * iv - bflo(c.x), s1 * iv - bfhi(c.x)); p.y = cvt_pk_bf16(s2 * iv - bflo(c.y), s3 * iv - bfhi(c.y));
            p.z = cvt_pk_bf16(s4 * iv - bflo(c.z), s5 * iv - bfhi(c.z)); p.w = cvt_pk_bf16(s6 * iv - bflo(c.w), s7 * iv - bfhi(c.w));
            dfr[mt][ks] = __builtin_bit_cast(bf16x8, p);
        }
}
__device__ __forceinline__ void mixer_phase(Frame& F0, int l) {
    Frame F = F0; { int t_ = threadIdx.x; asm volatile("" : "+v"(t_)); F.tid = t_; F.lane = t_ & 63; F.wave = __builtin_amdgcn_readfirstlane(t_ >> 6); }
    const int tid = F.tid, lane = F.lane, wid = F.wave, fr = lane & 15, fq = lane >> 4;
    const bf16* proj = (const bf16*)(F.ws + WS_PROJ); bf16* mixo = (bf16*)(F.ws + WS_MIXO);
    const bf16* Wp = (const bf16*)(F.ws + WS_WP) + (size_t)l * 4 * 128 * 128; const float* pscale = F.pool_scale + l * DPOOL;
    const int vcu = (F.G % 8 == 0) ? (F.bid % 8) * (F.G / 8) + F.bid / 8 : F.bid;
    for (int unit = vcu; unit < BATCH * GROWS; unit += F.G) {
        const int b = unit / GROWS, r = unit % GROWS, tb0 = b * SEQ, trow0 = 64 * r - 8;
        __syncthreads();
        { v4u uv[10];
#pragma unroll
          for (int k = 0; k < 10; ++k) { const int idx = tid + 512 * k, row = idx >> 6, pc = idx & 63, t = trow0 + row; uv[k] = (v4u){0u, 0u, 0u, 0u}; if (t >= 0 && t < SEQ) uv[k] = __builtin_nontemporal_load((const v4u*)(proj + (size_t)(tb0 + t) * UPITCH + pc * 8)); }
#pragma unroll
          for (int k = 0; k < 10; ++k) { const int idx = tid + 512 * k, row = idx >> 6, pc = idx & 63; *(LAS v4u*)(F.lds + row * U_PITCH + pc * 16) = uv[k]; } }
        __syncthreads();
#ifndef REP_POOL
#define REP_POOL 1
#endif
        for (int rep_ = 0; rep_ < REP_POOL; ++rep_) {
            const int g = wid >> 1, half = wid & 1, hw = 1 << g;
            const bf16* Wg = Wp + (size_t)g * 128 * 128;
            bf16x8 wnext[4];
#pragma unroll
            for (int ks = 0; ks < 4; ++ks) wnext[ks] = *(const bf16x8*)(Wg + (size_t)fr * 128 + 32 * ks + 8 * fq);
            bf16x8 dfr[2][4];
            { const LAS unsigned char* cb = F.lds + (8 + 32 * half + fr) * U_PITCH + (128 * g + 8 * fq) * 2;
              float inv[2];
#pragma unroll
              for (int mt = 0; mt < 2; ++mt) { const int t = 64 * r + 32 * half + 16 * mt + fr; inv[mt] = 1.0f / (float)(min(t + hw, SEQ) - max(t - hw, 0)); }
              switch (g) { case 0: pool_frags<1>(dfr, cb, inv); break; case 1: pool_frags<2>(dfr, cb, inv); break; case 2: pool_frags<4>(dfr, cb, inv); break; default: pool_frags<8>(dfr, cb, inv); break; } }
#pragma unroll
            for (int nt = 0; nt < 8; ++nt) {
                bf16x8 wf[4];
#pragma unroll
                for (int ks = 0; ks < 4; ++ks) wf[ks] = wnext[ks];
                if (nt + 1 < 8) {
#pragma unroll
                    for (int ks = 0; ks < 4; ++ks) wnext[ks] = *(const bf16x8*)(Wg + (size_t)(16 * (nt + 1) + fr) * 128 + 32 * ks + 8 * fq); }
                const f32x4 sc = *(const f32x4*)(pscale + 128 * g + 16 * nt + 4 * fq);
#pragma unroll
                for (int mt = 0; mt < 2; ++mt) {
                    f32x4 acc = (f32x4){0.f, 0.f, 0.f, 0.f};
#pragma unroll
                    for (int ks = 0; ks < 4; ++ks) acc = __builtin_amdgcn_mfma_f32_16x16x32_bf16(wf[ks], dfr[mt][ks], acc, 0, 0, 0);
                    acc = acc * sc;
                    v2u w; w.x = cvt_pk_bf16(acc[0], acc[1]); w.y = cvt_pk_bf16(acc[2], acc[3]);
                    *(v2u*)(mixo + mixo_index((size_t)(tb0 + 64 * r + 32 * half + 16 * mt + fr), 128 * g + 16 * nt + 4 * fq)) = w;
                }
            }
        }
    }
    __syncthreads();
}

constexpr int NA_KTOK = 80, NA_KROW = 64 * NA_KTOK, NA_VD = 144, NA_VROW = 32 * NA_VD, NA_NKR = 11, NA_NPC = NA_NKR * 256;
constexpr int NA_K_OFF = 0, NA_V_OFF = NA_NKR * NA_KROW, NA_B_OFF = NA_V_OFF + NA_NKR * NA_VROW;
static_assert(NA_B_OFF + 15 * 128 <= RING_BYTES, "NA LDS map");
#ifndef REP_NA
#define REP_NA 1
#endif
__device__ __forceinline__ void na_phase(Frame& F0, int l) {
    Frame F = F0; { int t_ = threadIdx.x; asm volatile("" : "+v"(t_)); F.tid = t_; F.lane = t_ & 63; F.wave = __builtin_amdgcn_readfirstlane(t_ >> 6); }
    const int tid = F.tid, lane = F.lane, wid = F.wave, fr = lane & 15, fq = lane >> 4;
    const bf16* projq = (const bf16*)(F.ws + WS_PQ); const bf16* projk = (const bf16*)(F.ws + WS_PK); const bf16* Vt = (const bf16*)(F.ws + WS_VT); bf16* mixo = (bf16*)(F.ws + WS_MIXO);
    const float* rpb = F.rpb + (size_t)l * NH * 15 * 31;
    const int vcu = (F.G % 8 == 0) ? (F.bid % 8) * (F.G / 8) + F.bid / 8 : F.bid;
    constexpr int NU = BATCH * NH * (GROWS / 4);
    const int upc = (NU + F.G - 1) / F.G, u0 = vcu * upc, u1 = min(u0 + upc, NU);
    v4u kreg[6], vreg[6];
    int w_hi = -1, w_bh = -1;
#define NA_UNIT(u, b, h, sg, krlo, nrows) const int b = (u) / (NH * 64), h = ((u) / 64) % NH, sg = (u) % 64, krlo = min(max(4 * sg - 4, 0), GROWS - KH), nrows = min(NA_NKR, GROWS - krlo)
#define NA_PLAN(u, newlo, nnew) NA_UNIT(u, pb_, ph_, psg_, pkrlo_, pnrows_); const bool keep_ = ((u) / 64 == w_bh) && pkrlo_ <= w_hi && pkrlo_ + NA_NKR > w_hi - 1; \
        const int newlo = keep_ ? max(pkrlo_, w_hi) : pkrlo_, nnew = pkrlo_ + pnrows_ - newlo; (void)psg_
#define NA_LOAD(newlo, nnew, b_, h_) do { const size_t tb_ = (size_t)(b_) * SEQ + 64 * (newlo); \
        _Pragma("unroll") for (int k = 0; k < 6; ++k) { const int p = tid + 512 * k, row = p >> 8, rem = p & 255; \
            if (row < (nnew)) { kreg[k] = __builtin_nontemporal_load((const v4u*)(projk + ((size_t)(h_) * T + tb_ + 64 * row + (rem >> 2)) * 32 + 8 * (rem & 3))); \
                vreg[k] = __builtin_nontemporal_load((const v4u*)(Vt + vt_index(32 * (h_) + (rem >> 3), (int)tb_ + 64 * row) + 8 * (rem & 7))); } } } while (0)
    int c_newlo = 0, c_nnew = 0;
    if (u0 < u1) { NA_PLAN(u0, nl_, nn_); c_newlo = nl_; c_nnew = nn_; NA_LOAD(nl_, nn_, pb_, ph_); }
    for (int u = u0; u < u1; ++u) {
        NA_UNIT(u, b, h, sg, krlo, nrows);
        __syncthreads();
#pragma unroll
        for (int k = 0; k < 6; ++k) { const int p = tid + 512 * k, row = p >> 8, rem = p & 255;
            if (row < c_nnew) { const int slot = (c_newlo + row) % NA_NKR;
                *(LAS v4u*)(F.lds + NA_K_OFF + slot * NA_KROW + (rem >> 2) * NA_KTOK + 16 * (rem & 3)) = kreg[k];
                *(LAS v4u*)(F.lds + NA_V_OFF + slot * NA_VROW + (rem >> 3) * NA_VD + 16 * (rem & 7)) = vreg[k]; } }
        if (tid < 15 * 32) { const int col = tid & 31, row = tid >> 5; *(LAS float*)(F.lds + NA_B_OFF + tid * 4) = col < 31 ? rpb[(h * 15 + row) * 31 + col] * LOG2E : -INFINITY; }
        __syncthreads();
        w_hi = krlo + nrows; w_bh = u / 64;
        if (u + 1 < u1) { NA_PLAN(u + 1, nl_, nn_); c_newlo = nl_; c_nnew = nn_; NA_LOAD(nl_, nn_, pb_, ph_); }
        const size_t tb0 = (size_t)b * SEQ;
#pragma unroll 1
        for (int tt = 0; tt < 2; ++tt) {
            const int t = wid + 8 * tt, j = t >> 2, qb = t & 3, r = 4 * sg + j, r0 = min(max(r - KH / 2, 0), GROWS - KH);
            const int cs = qb == 0 ? 0 : (qb == 1 ? 8 : (qb == 2 ? 24 : 32));
            const int c = 16 * qb + fr, c0 = min(max(c - KW / 2, 0), GRIDW - KW);
            const int th = c0 - cs;
            bool vq[4]; int boff[4];
#pragma unroll
            for (int q = 0; q < 4; ++q) { vq[q] = (4 * fq + q) >= th; boff[q] = (cs + 4 * fq + q + (vq[q] ? 0 : 16) - c + KW - 1) * 4; }
            const unsigned M0 = (vq[0] ? 0xffffu : 0u) | (vq[1] ? 0xffff0000u : 0u), M1 = (vq[2] ? 0xffffu : 0u) | (vq[3] ? 0xffff0000u : 0u), N0 = ~M0, N1 = ~M1;
            const size_t qtok = tb0 + 64 * r + 16 * qb + fr;
            const bf16x8 qf = __builtin_nontemporal_load((const bf16x8*)(projq + ((size_t)h * T + qtok) * 32 + 8 * fq));
            int slot[KH];
#pragma unroll
            for (int kr = 0; kr < KH; ++kr) slot[kr] = (r0 + kr) % NA_NKR;
            const LAS unsigned char* kb = F.lds + NA_K_OFF + (cs + fr) * NA_KTOK + 16 * fq;
            const LAS unsigned char* bb = F.lds + NA_B_OFF + (r0 - r + KH - 1) * 128;
            f32x2 sv[KH][2];
            float mx = -INFINITY;
#pragma unroll
            for (int kr = 0; kr < KH; ++kr) {
                f32x4 bv;
#pragma unroll
                for (int q = 0; q < 4; ++q) bv[q] = *(const LAS float*)(bb + boff[q] + kr * 128);
                const f32x4 s0 = __builtin_amdgcn_mfma_f32_16x16x32_bf16(*(const LAS bf16x8*)(kb + slot[kr] * NA_KROW), qf, bv, 0, 0, 0);
                const f32x4 s1 = __builtin_amdgcn_mfma_f32_16x16x32_bf16(*(const LAS bf16x8*)(kb + slot[kr] * NA_KROW + 16 * NA_KTOK), qf, bv, 0, 0, 0);
                const float e0 = vq[0] ? s0[0] : s1[0], e1 = vq[1] ? s0[1] : s1[1], e2 = vq[2] ? s0[2] : s1[2], e3 = vq[3] ? s0[3] : s1[3];
                sv[kr][0] = (f32x2){e0, e1}; sv[kr][1] = (f32x2){e2, e3};
                mx = fmaxf(fmaxf(mx, e0), e1); mx = fmaxf(fmaxf(mx, e2), e3);
            }
            mx = fmaxf(mx, __shfl_xor(mx, 16)); mx = fmaxf(mx, __shfl_xor(mx, 32));
            const f32x2 mx2 = (f32x2){mx, mx};
            f32x2 sum2 = (f32x2){0.f, 0.f};
#pragma unroll
            for (int kr = 0; kr < KH; ++kr)
#pragma unroll
                for (int hh = 0; hh < 2; ++hh) { const f32x2 dlt = sv[kr][hh] - mx2; f32x2 p; p.x = __builtin_amdgcn_exp2f(dlt.x); p.y = __builtin_amdgcn_exp2f(dlt.y); sv[kr][hh] = p; sum2 += p; }
            float sum = sum2.x + sum2.y;
            sum += __shfl_xor(sum, 16); sum += __shfl_xor(sum, 32);
            const LAS unsigned char* vb = F.lds + NA_V_OFF + fr * NA_VD + (cs + 4 * fq) * 2;
            f32x4 o[2] = {(f32x4){0.f, 0.f, 0.f, 0.f}, (f32x4){0.f, 0.f, 0.f, 0.f}};
#pragma unroll
            for (int kr = 0; kr < KH; ++kr) {
                const unsigned u01 = cvt_pk_bf16(sv[kr][0].x, sv[kr][0].y), u23 = cvt_pk_bf16(sv[kr][1].x, sv[kr][1].y);
                v4u pw; pw.x = u01 & M0; pw.y = u23 & M1; pw.z = u01 & N0; pw.w = u23 & N1;
                const bf16x8 pf = __builtin_bit_cast(bf16x8, pw);
#pragma unroll
                for (int dt = 0; dt < 2; ++dt) {
                    const LAS unsigned char* vp = vb + slot[kr] * NA_VROW + 16 * dt * NA_VD;
                    const v2u lo = *(const LAS v2u*)vp, hi = *(const LAS v2u*)(vp + 32);
                    v4u vw; vw.x = lo.x; vw.y = lo.y; vw.z = hi.x; vw.w = hi.y;
                    o[dt] = __builtin_amdgcn_mfma_f32_16x16x32_bf16(__builtin_bit_cast(bf16x8, vw), pf, o[dt], 0, 0, 0);
                }
            }
            const float inv = __builtin_amdgcn_rcpf(sum);
            bf16* orow = mixo + mixo_index(qtok, DPOOL + 32 * h + 4 * fq);
#pragma unroll
            for (int dt = 0; dt < 2; ++dt) { v2u w; w.x = cvt_pk_bf16(o[dt][0] * inv, o[dt][1] * inv); w.y = cvt_pk_bf16(o[dt][2] * inv, o[dt][3] * inv); *(v2u*)(orow + 16 * dt) = w; }
        }
    }
    __syncthreads();
#undef NA_UNIT
#undef NA_PLAN
#undef NA_LOAD
}

struct SchedProj {
    const char* hn; const char* win; bf16* proj; bf16* vt; int G, c, esz; const float* sa; const float* sw;
    __device__ __forceinline__ bool next(int i, pg8::Unit& u) const {
        int pm, pn; if (!pg8::tile_order(i, G, c, T / 256, 8, pm, pn)) return false;
        const size_t tstep = (size_t)256 * D * esz;
        if (pn < 6) { u.A = hn + pm * tstep; u.B = win + pn * tstep; u.orow = 256 * pm;
            if (pn < 2) { u.obase = proj; u.ocol = 256 * pn; u.ldc = UPITCH; } else { u.obase = proj + (size_t)(pn >> 1) * T * 512; u.ocol = 256 * (pn & 1); u.ldc = 0; }
            u.scale = (pn == 2 || pn == 3) ? QSCALE : 1.0f; u.p0 = sa + 256 * pm; u.cs = sw + 256 * pn; }
        else { u.A = win + pn * tstep; u.B = hn + pm * tstep; u.obase = vt; u.orow = 256 * (pn - 6); u.ocol = 256 * pm; u.ldc = -1; u.scale = 1.0f; u.p0 = sw + 256 * pn; u.cs = sa + 256 * pm; }
        return true;
    }
};
struct SchedOut {
    const char* a; const char* w; bf16* o; int G, c;
    __device__ __forceinline__ bool next(int i, pg8::Unit& u) const {
        int pm, pn; if (!pg8::tile_order(i, G, c, T / 256, 4, pm, pn)) return false;
        const size_t tstep = (size_t)256 * D * 2; u.p0 = nullptr; u.cs = nullptr;
        u.A = a + pm * tstep; u.B = w + pn * tstep; u.obase = o; u.orow = 256 * pm; u.ocol = 256 * pn; u.ldc = D; u.scale = 1.0f; return true;
    }
};
__device__ __forceinline__ void ffn_table(Frame& F0, bool moe) {
    Frame F = F0; { int t_ = threadIdx.x; asm volatile("" : "+v"(t_)); F.tid = t_; F.lane = t_ & 63; F.wave = __builtin_amdgcn_readfirstlane(t_ >> 6); }
    LAS int* blk = (LAS int*)(F.lds + BLK_OFF); LAS int* bst = (LAS int*)(F.lds + BST_OFF);
    __syncthreads();
    if (F.tid == 0) { int s = 0; for (int e = 0; e < NE; ++e) { bst[e] = s; s += moe ? (int)((ld_cnt(F.ctl, e) + 255u) >> 8) : (e == 0 ? T / 256 : 0); } bst[8] = s; }
    __syncthreads();
    for (int b = F.tid; b < MAXBLK + 8; b += 512) { int e = 0; for (int k = 1; k < NE; ++k) if (b >= bst[k]) e = k; blk[b] = e; }
    __syncthreads();
}
__device__ __forceinline__ bool tail_reduce(Frame& F0) {
    int t_ = threadIdx.x; asm volatile("" : "+v"(t_));
    const int lane = t_ & 63, gw = F0.bid * 8 + __builtin_amdgcn_readfirstlane(t_ >> 6), NGW = F0.G * 8;
    int nb = 0;
    for (int e = 0; e < NE; ++e) nb += (int)((ld_cnt(F0.ctl, e) + 255u) >> 8);
    const int nrows = (nb - 256) * 256;
    if (nrows <= 0) return false;
    const bf16* part = (const bf16*)(F0.ws + WS_TAILPART);
#if Y8_MOE
    unsigned char* y8 = F0.ws + WS_Y + (size_t)256 * 256 * D; const bf16* part6 = (const bf16*)(F0.ws + WS_TAILPART6);
    for (int r = gw; r < nrows; r += NGW) {
        v4u w[TAILSPLIT][2];
#pragma unroll
        for (int h = 0; h < 2; ++h) {
#pragma unroll
            for (int p = 0; p < TAILSPLIT; ++p) w[p][h] = *((const v4u*)((p < 6 ? part + ((size_t)p * TAILPART_ROWS + r) * D : part6 + (size_t)r * D)) + lane + 64 * h); }
#pragma unroll
        for (int h = 0; h < 2; ++h) { float v[8];
#pragma unroll
            for (int j = 0; j < 4; ++j) { float lo = 0.f, hi = 0.f;
#pragma unroll
                for (int p = 0; p < TAILSPLIT; ++p) { lo += bflo(w[p][h][j]); hi += bfhi(w[p][h][j]); }
                v[2 * j] = lo * YS; v[2 * j + 1] = hi * YS; }
            int w0 = 0, w1 = 0;
            w0 = __builtin_amdgcn_cvt_pk_fp8_f32(v[0], v[1], w0, false); w0 = __builtin_amdgcn_cvt_pk_fp8_f32(v[2], v[3], w0, true);
            w1 = __builtin_amdgcn_cvt_pk_fp8_f32(v[4], v[5], w1, false); w1 = __builtin_amdgcn_cvt_pk_fp8_f32(v[6], v[7], w1, true);
            v2u o; o.x = (unsigned)w0; o.y = (unsigned)w1;
            *((v2u*)(y8 + (size_t)r * D) + lane + 64 * h) = o; }
    }
#else
    bf16* y = (bf16*)(F0.ws + WS_Y) + (size_t)256 * 256 * D;
    for (int r = gw; r < nrows; r += NGW) {
        v4u w[TAILSPLIT][2];
#pragma unroll
        for (int h = 0; h < 2; ++h) { w[0][h] = *((const v4u*)(y + (size_t)r * D) + lane + 64 * h);
#pragma unroll
            for (int p = 1; p < TAILSPLIT; ++p) w[p][h] = *((const v4u*)(part + ((size_t)(p - 1) * TAILPART_ROWS + r) * D) + lane + 64 * h); }
#pragma unroll
        for (int h = 0; h < 2; ++h) { v4u o;
#pragma unroll
            for (int j = 0; j < 4; ++j) { float lo = 0.f, hi = 0.f;
#pragma unroll
                for (int p = 0; p < TAILSPLIT; ++p) { lo += bflo(w[p][h][j]); hi += bfhi(w[p][h][j]); }
                o[j] = cvt_pk_bf16(lo, hi); }
            *((v4u*)(y + (size_t)r * D) + lane + 64 * h) = o; }
    }
#endif
    return true;
}
template <bool TILED> struct SchedUpT {
    const char* hn; const char* wgu; const int* lists; bf16* hff; LAS int* blk; LAS int* bst; int G, c, cstart, nblk, nN, F_, moe, esz;
    __device__ __forceinline__ bool next(int i, pg8::Unit& u) const {
        int pm, pn; if (!pg8::tile_order(i, G, c, nblk, nN, pm, pn)) return false;
        const int b = cstart + pm, e = __builtin_amdgcn_readfirstlane(blk[b]), lb = b - __builtin_amdgcn_readfirstlane(bst[e]);
        u.A = hn; u.p0 = lists + (moe ? (size_t)e * T + 256 * lb : (size_t)256 * b); u.cs = nullptr;
        u.B = wgu + ((size_t)e * 2 * F_ + 256 * pn) * D * esz; u.obase = hff; u.orow = 256 * pm; u.ocol = 128 * pn; u.ldc = F_; u.scale = 1.0f;
        if constexpr (TILED) { u.obase = (bf16*)((char*)hff + ((size_t)pm * nN + pn) * HFF_TILE - 128 * pn - (size_t)256 * pm * 128); }
        return true;
    }
};
template <bool TILED, bool Y8 = false> struct SchedDownT {
    const char* hff; const char* wd; bf16* y; LAS int* blk; int G, c, cstart, nblk, F_, esz; float scale; const int* idl; int pm0, split;
    __device__ __forceinline__ bool next(int i, pg8::Unit& u) const {
        int pm, pn; if (!pg8::tile_order(i, G, c, nblk, 4 * split, pm, pn)) return false;
        const int p = pn >> 2; pn &= 3;
        const int b = cstart + pm, e = __builtin_amdgcn_readfirstlane(blk[b]); u.p0 = idl; u.cs = nullptr;
        const size_t koff = (size_t)p * (F_ / split) * esz;
        u.A = hff + (size_t)(pm0 + pm) * 256 * F_ * esz + (TILED ? (size_t)p * (F_ / split / 128) * HFF_TILE : koff); u.B = wd + ((size_t)e * D + 256 * pn) * F_ * esz + koff;
        const int img = Y8 ? p : p - 1;
        const long long poff = (split == 1 || img < 0) ? 0ll : (img < 6 ? ((long long)WS_TAILPART - (long long)WS_Y) / 2 + (long long)img * TAILPART_ROWS * D : ((long long)WS_TAILPART6 - (long long)WS_Y) / 2);
        u.obase = y + poff; u.orow = (split == 1 || img < 0) ? 256 * b : 256 * pm; u.ocol = 256 * pn; u.ldc = D; u.scale = scale; return true;
    }
};

constexpr int STEPS_PER_LAYER = 16, NSTEPS = 1 + DEPTH * STEPS_PER_LAYER;
#define RUN(s) (lo <= (s) && (s) < hi)
#ifndef BARX
#define BARX 1
#endif
#define SEAM(s) do { if (RUN(s) && RUN((s) + 1)) { for (int b_ = 0; b_ < BARX; ++b_) xcd_barrier(bar); } } while (0)
template <int L>
__device__ __forceinline__ void run_layer(Frame& F, const XcdBarrier& bar, const int lo, const int hi) {
    constexpr int l = L, base = 1 + STEPS_PER_LAYER * L; constexpr bool moe = (L & 1) != 0, f8 = FP8_MOE && moe, i8 = I8_DENSE && !moe; constexpr bool h8 = f8 || (FP8_DDOWN && !moe);
    LAS int* tokbuf = (LAS int*)(F.lds + TOKBUF_OFF); LAS int* blk = (LAS int*)(F.lds + BLK_OFF); LAS int* bst = (LAS int*)(F.lds + BST_OFF);
    const char* HN = (const char*)(F.ws + WS_HN);
#ifndef NO_P1
    if (RUN(base + 0)) {
        SchedProj S{HN, (const char*)(F.ws + WS_WIN) + (size_t)l * DIN * D * (I8_PROJ ? 1 : 2), (bf16*)(F.ws + WS_PROJ), (bf16*)(F.ws + WS_VT), F.G, F.bid, I8_PROJ ? 1 : 2, (const float*)(F.ws + WS_SA), (const float*)(F.ws + WS_SWIN) + l * DIN};
        if constexpr (I8_PROJ != 0) pg8::gemm_phase<pg8::EpiProj_I8, SchedProj, false, 2>(F.lds, tokbuf, D / 2, S, pg8::EpiProj_I8{});
        else pg8::gemm_phase<pg8::EpiProj, SchedProj, false>(F.lds, tokbuf, D, S, pg8::EpiProj{});
    } SEAM(base + 0);
#endif
#ifndef NO_P2
#ifndef NA_CALLS
#define NA_CALLS 1
#endif
#ifndef POOL_CALLS
#define POOL_CALLS 1
#endif
    if (RUN(base + 1)) { for (int i_ = 0; i_ < POOL_CALLS; ++i_) mixer_phase(F, l); for (int i_ = 0; i_ < NA_CALLS; ++i_) na_phase(F, l); } SEAM(base + 1);
#endif
#ifndef NO_P3
    if (RUN(base + 2)) {
        SchedOut S{(const char*)(F.ws + WS_MIXO), (const char*)(F.ws + WS_WOUT) + (size_t)l * D * D * 2, (bf16*)(F.ws + WS_MIX), F.G, F.bid};
        pg8::gemm_phase<pg8::EpiBf16, SchedOut, false>(F.lds, tokbuf, D, S, pg8::EpiBf16{}, D, 64, 256 * 128);
    } SEAM(base + 2);
#endif
#ifndef NO_P4
    if (RUN(base + 3)) { norm_phase<false>(F, l); } SEAM(base + 3);
#endif
    constexpr int F_ = moe ? DFFE : DFF, cblk = h8 ? 2 * CHUNK_BLK : CHUNK_BLK;
    bool table = false; int NB = 0;
    for (int c = 0; c < MAXCHUNK; ++c) {
        const int s5 = base + 4 + 2 * c, s6 = s5 + 1;
        if (!(RUN(s5) || RUN(s6))) continue;
        if (!table) { ffn_table(F, moe); NB = __builtin_amdgcn_readfirstlane(bst[8]); table = true; }
        const int cstart = c * cblk; int nblk = min(NB - cstart, cblk);
        if constexpr (f8) { if (c == 1) nblk = NB - cstart; else if (c > 1) continue; }
        if (nblk <= 0) continue;
#ifndef NO_P5
        if (RUN(s5)) {
            typedef SchedUpT<h8> SchedUp; SchedUp S{HN, moe ? (const char*)(F.ws + WS_WGUM) : (const char*)(F.ws + WS_WGU0), moe ? (const int*)(F.ws + WS_LIST) : (const int*)(F.ws + WS_LISTID), (bf16*)(F.ws + WS_HFF), blk, bst, F.G, F.bid, cstart, nblk, F_ / 128, F_, moe ? 1 : 0, (f8 || i8) ? 1 : 2};
            if constexpr (f8 && FP6_UP) pg8::gemm_phase<pg8::EpiSwiGLU6, SchedUp, true, 3>(F.lds, tokbuf, D / 2, S, pg8::EpiSwiGLU6{});
            else if constexpr (f8) pg8::gemm_phase<pg8::EpiSwiGLU8, SchedUp, true, 1>(F.lds, tokbuf, D / 2, S, pg8::EpiSwiGLU8{});
            else if constexpr (i8) pg8::gemm_phase<pg8::EpiSwiGLU_I8, SchedUp, true, 2>(F.lds, tokbuf, D / 2, S, pg8::EpiSwiGLU_I8{(const float*)(F.ws + WS_SA), (const float*)(F.ws + WS_SW0), (const int*)(F.ws + WS_LISTID)});
            else pg8::gemm_phase<pg8::EpiSwiGLU, SchedUp, true>(F.lds, tokbuf, D, S, pg8::EpiSwiGLU{});
        } SEAM(s5);
#endif
#ifndef NO_P6
        if (RUN(s6)) {
            const int nfull = h8 ? min(nblk, cblk) : nblk;
            constexpr bool y8 = Y8_MOE && f8;
            typedef SchedDownT<h8, y8> SchedDown; SchedDown S{(const char*)(F.ws + WS_HFF), moe ? (const char*)(F.ws + WS_WDM) : (const char*)(F.ws + WS_WD0), (bf16*)(F.ws + WS_Y), blk, F.G, F.bid, cstart, nfull, F_, h8 ? 1 : 2, (h8 ? 1.0f / W8_DN : 1.0f) * (y8 ? YS : 1.0f), (const int*)(F.ws + WS_LISTID), 0, 1};
            if constexpr (h8) {
                const int npass = (f8 && nblk > nfull) ? 2 : 1;
                if constexpr (y8) {
                    pg8::gemm_phase<pg8::EpiY8, SchedDown, true, 1>(F.lds, tokbuf, F_ / 2, S, pg8::EpiY8{}, F_ / 2, 64, HFF_TILE);
                    if (npass > 1) { const SchedDown S2{(const char*)(F.ws + WS_HFF), (const char*)(F.ws + WS_WDM), (bf16*)(F.ws + WS_Y), blk, F.G, F.bid, cstart + nfull, nblk - nfull, F_, 1, 1.0f / W8_DN, (const int*)(F.ws + WS_LISTID), nfull, TAILSPLIT};
                        int ksplit = F_ / 2 / TAILSPLIT; asm volatile("" : "+s"(ksplit));
                        pg8::gemm_phase<pg8::EpiBf16, SchedDown, true, 1>(F.lds, tokbuf, ksplit, S2, pg8::EpiBf16{}, F_ / 2, 64, HFF_TILE); }
                } else {
#pragma clang loop unroll(disable)
                for (int pass = 0; pass < npass; ++pass) {
                    if (pass == 1) { S.cstart = cstart + nfull; S.nblk = nblk - nfull; S.pm0 = nfull; S.split = TAILSPLIT; }
                    pg8::gemm_phase<pg8::EpiBf16, SchedDown, true, 1>(F.lds, tokbuf, pass == 0 ? F_ / 2 : F_ / 2 / TAILSPLIT, S, pg8::EpiBf16{}, F_ / 2, 64, HFF_TILE);
                }
                }
            }
            else pg8::gemm_phase<pg8::EpiBf16, SchedDown, false>(F.lds, tokbuf, F_, S, pg8::EpiBf16{});
        } SEAM(s6);
#endif
    }
#ifndef NO_P7
    if (RUN(base + 14)) { if constexpr (f8) { if (tail_reduce(F)) xcd_barrier(bar); } norm_phase<true>(F, l); }
#endif
    if (l + 1 < DEPTH) { if (RUN(base + 14) && RUN(base + 16)) xcd_barrier(bar); }
}
__global__ void __launch_bounds__(512, 2) mk_fwd(Args args) {
    extern __shared__ __attribute__((aligned(16))) unsigned char lds_raw[];
    Frame F;
    F.lds = (LAS unsigned char*)lds_raw; F.MISC = (volatile LAS unsigned*)(F.lds + MISC_OFF);
    F.tid = threadIdx.x; F.lane = F.tid & 63; F.wave = __builtin_amdgcn_readfirstlane(F.tid >> 6); F.G = gridDim.x; F.bid = blockIdx.x;
    F.ws = args.ws; F.ctl = (unsigned*)(args.ws + WS_CTL); F.out = args.out;
    F.x = args.in[0]; F.g_mpre = args.in[1]; F.g_mpost = args.in[2]; F.g_fpre = args.in[3]; F.g_fpost = args.in[4]; F.w_in = args.in[5]; F.pool_w = args.in[6]; F.pool_scale = args.in[7];
    F.rpb = args.in[8]; F.w_out = args.in[9]; F.dwg = args.in[10]; F.dwu = args.in[11]; F.dwd = args.in[12]; F.router = args.in[13]; F.mwg = args.in[14]; F.mwu = args.in[15]; F.mwd = args.in[16];
    if (F.tid < 16) F.MISC[F.tid] = 0u;
    __syncthreads();
    const int lo = args.lo, hi = args.hi;
    XcdBarrier bar; bar.bar = F.ctl + CW_BAR + args.breg * XCD_BAR_WORDS; bar.x = 0; bar.st = F.MISC;
    if (hi - lo > 1) bar = xcd_barrier_post(F.ctl + CW_BAR + args.breg * XCD_BAR_WORDS, F.MISC);
#ifndef NO_P0
#ifndef REP_P0
#define REP_P0 1
#endif
    if (RUN(0)) { for (int r_ = 0; r_ < REP_P0; ++r_) p0_prologue(F); } SEAM(0);
#endif
    run_layer<0>(F, bar, lo, hi);
    run_layer<1>(F, bar, lo, hi);
}
#undef RUN
#undef SEAM

__global__ void __launch_bounds__(64) nk_gemm(const bf16* A, int lda, const bf16* Bt, int ldb, int K, bf16* O, int ldo, float scale, int sc_lo, int sc_hi, int vt) {
    const int m0 = 32 * blockIdx.y, n0 = 32 * blockIdx.x, lane = threadIdx.x, fr = lane & 15, fq = lane >> 4;
    f32x4 acc[2][2];
#pragma unroll
    for (int a = 0; a < 2; ++a)
#pragma unroll
        for (int b = 0; b < 2; ++b) acc[a][b] = (f32x4){0.f, 0.f, 0.f, 0.f};
    for (int k0 = 0; k0 < K; k0 += 32) {
        bf16x8 a[2], b[2];
#pragma unroll
        for (int i = 0; i < 2; ++i) { a[i] = *(const bf16x8*)(A + (size_t)(m0 + 16 * i + fr) * lda + k0 + 8 * fq); b[i] = *(const bf16x8*)(Bt + (size_t)(n0 + 16 * i + fr) * ldb + k0 + 8 * fq); }
#pragma unroll
        for (int mt = 0; mt < 2; ++mt)
#pragma unroll
            for (int nt = 0; nt < 2; ++nt) acc[mt][nt] = __builtin_amdgcn_mfma_f32_16x16x32_bf16(a[mt], b[nt], acc[mt][nt], 0, 0, 0);
    }
#pragma unroll
    for (int mt = 0; mt < 2; ++mt)
#pragma unroll
        for (int nt = 0; nt < 2; ++nt)
#pragma unroll
            for (int q = 0; q < 4; ++q) { const int m = m0 + 16 * mt + 4 * fq + q, n = n0 + 16 * nt + fr; const float sc = (n >= sc_lo && n < sc_hi) ? scale : 1.0f;
                O[vt ? vt_index(m, n) : (size_t)m * ldo + n] = (bf16)f2bf(acc[mt][nt][q] * sc); }
}
__global__ void nk_blocktab(const unsigned* ctl, int* btab, int moe) {
    if (threadIdx.x != 0 || blockIdx.x != 0) return;
    int b = 0;
    for (int e = 0; e < NE; ++e) { const int nb = moe ? (int)((ctl[CW_CNT + 64 * e] + 255u) >> 8) : (e == 0 ? T / 256 : 0); for (int k = 0; k < nb; ++k) btab[b++] = e | (k << 8); }
    btab[MAXBLK] = b;
}
__global__ void __launch_bounds__(64) nk_ffn_up(const bf16* hn, const bf16* wgu, const int* lists, const int* btab, bf16* hff, int cstart, int F_, int moe) {
    const int m0 = 32 * blockIdx.y, f0 = 32 * blockIdx.x, lane = threadIdx.x, fr = lane & 15, fq = lane >> 4;
    const int b = cstart + m0 / 256; if (b >= btab[MAXBLK]) return;
    const int e = btab[b] & 0xff, lb = btab[b] >> 8;
    const int* list = lists + (moe ? (size_t)e * T + 256 * lb : (size_t)256 * b) + (m0 % 256);
    const bf16* W = wgu + (size_t)e * 2 * F_ * D; const int rg = (f0 / 128) * 256 + (f0 % 128);
    const bf16* arow[2]; arow[0] = hn + (size_t)list[fr] * D; arow[1] = hn + (size_t)list[16 + fr] * D;
    f32x4 ag[2][2], au[2][2];
#pragma unroll
    for (int a = 0; a < 2; ++a)
#pragma unroll
        for (int c = 0; c < 2; ++c) { ag[a][c] = (f32x4){0.f, 0.f, 0.f, 0.f}; au[a][c] = (f32x4){0.f, 0.f, 0.f, 0.f}; }
    for (int k0 = 0; k0 < D; k0 += 32) {
        bf16x8 a[2], bg[2], bu[2];
#pragma unroll
        for (int i = 0; i < 2; ++i) { a[i] = *(const bf16x8*)(arow[i] + k0 + 8 * fq); bg[i] = *(const bf16x8*)(W + (size_t)(rg + 16 * i + fr) * D + k0 + 8 * fq); bu[i] = *(const bf16x8*)(W + (size_t)(rg + 128 + 16 * i + fr) * D + k0 + 8 * fq); }
#pragma unroll
        for (int mt = 0; mt < 2; ++mt)
#pragma unroll
            for (int nt = 0; nt < 2; ++nt) { ag[mt][nt] = __builtin_amdgcn_mfma_f32_16x16x32_bf16(a[mt], bg[nt], ag[mt][nt], 0, 0, 0); au[mt][nt] = __builtin_amdgcn_mfma_f32_16x16x32_bf16(a[mt], bu[nt], au[mt][nt], 0, 0, 0); }
    }
#pragma unroll
    for (int mt = 0; mt < 2; ++mt)
#pragma unroll
        for (int nt = 0; nt < 2; ++nt)
#pragma unroll
            for (int q = 0; q < 4; ++q) { const float g = ag[mt][nt][q], u = au[mt][nt][q]; const float v = g * u / (1.0f + __expf(-g));
                hff[(size_t)(m0 + 16 * mt + 4 * fq + q) * F_ + f0 + 16 * nt + fr] = (bf16)f2bf(v); }
}
__global__ void __launch_bounds__(64) nk_ffn_down(const bf16* hff, const bf16* wd, const int* btab, bf16* y, int cstart, int F_) {
    const int m0 = 32 * blockIdx.y, n0 = 32 * blockIdx.x, lane = threadIdx.x, fr = lane & 15, fq = lane >> 4;
    const int b = cstart + m0 / 256; if (b >= btab[MAXBLK]) return;
    const int e = btab[b] & 0xff; const bf16* W = wd + (size_t)e * D * F_;
    f32x4 acc[2][2];
#pragma unroll
    for (int a = 0; a < 2; ++a)
#pragma unroll
        for (int c = 0; c < 2; ++c) acc[a][c] = (f32x4){0.f, 0.f, 0.f, 0.f};
    for (int k0 = 0; k0 < F_; k0 += 32) {
        bf16x8 a[2], bb[2];
#pragma unroll
        for (int i = 0; i < 2; ++i) { a[i] = *(const bf16x8*)(hff + (size_t)(m0 + 16 * i + fr) * F_ + k0 + 8 * fq); bb[i] = *(const bf16x8*)(W + (size_t)(n0 + 16 * i + fr) * F_ + k0 + 8 * fq); }
#pragma unroll
        for (int mt = 0; mt < 2; ++mt)
#pragma unroll
            for (int nt = 0; nt < 2; ++nt) acc[mt][nt] = __builtin_amdgcn_mfma_f32_16x16x32_bf16(a[mt], bb[nt], acc[mt][nt], 0, 0, 0);
    }
#pragma unroll
    for (int mt = 0; mt < 2; ++mt)
#pragma unroll
        for (int nt = 0; nt < 2; ++nt)
#pragma unroll
            for (int q = 0; q < 4; ++q) y[(size_t)(256 * cstart + m0 + 16 * mt + 4 * fq + q) * D + n0 + 16 * nt + fr] = (bf16)f2bf(acc[mt][nt][q]);
}
__global__ void nk_pool_delta(const bf16* proj, bf16* delta) {
    const int idx = blockIdx.x * 256 + threadIdx.x, tok = idx / DPOOL, ch = idx % DPOOL, b = tok / SEQ, t = tok % SEQ, g = ch / 128, hw = 1 << g;
    const int lo = max(t - hw, 0), hi = min(t + hw, SEQ); float s = 0.f;
    for (int tt = lo; tt < hi; ++tt) s += bf2f(proj[(size_t)(b * SEQ + tt) * NPROJ + ch]);
    delta[(size_t)tok * DPOOL + ch] = (bf16)f2bf(s / (float)(hi - lo) - bf2f(proj[(size_t)tok * NPROJ + ch]));
}
__global__ void nk_pool_mm(const bf16* delta, const bf16* Wp, const float* pscale, bf16* mixo) {
    const int idx = blockIdx.x * 256 + threadIdx.x, tok = idx / DPOOL, dd = idx % DPOOL, g = dd / 128, d = dd % 128; float s = 0.f;
    for (int c = 0; c < 128; ++c) s += bf2f(delta[(size_t)tok * DPOOL + 128 * g + c]) * bf2f(Wp[(size_t)(g * 128 + d) * 128 + c]);
    mixo[(size_t)tok * D + dd] = (bf16)f2bf(s * pscale[dd]);
}
__global__ void nk_na(const bf16* proj, const bf16* Vt, const float* rpb, bf16* mixo) {
    const int idx = blockIdx.x * 256 + threadIdx.x, tok = idx / NH, h = idx % NH, b = tok / SEQ, t = tok % SEQ, r = t / GRIDW, c = t % GRIDW;
    const int r0 = min(max(r - KH / 2, 0), GROWS - KH), c0 = min(max(c - KW / 2, 0), GRIDW - KW);
    float q[HD];
#pragma unroll
    for (int d = 0; d < HD; ++d) q[d] = bf2f(proj[(size_t)tok * NPROJ + 512 + HD * h + d]);
    float mx = -INFINITY;
    for (int i = 0; i < KH; ++i) for (int j = 0; j < KW; ++j) {
        const size_t kt = (size_t)(b * SEQ + (r0 + i) * GRIDW + c0 + j); float s = 0.f;
#pragma unroll
        for (int d = 0; d < HD; ++d) s += q[d] * bf2f(proj[kt * NPROJ + 1024 + HD * h + d]);
        s += rpb[(h * 15 + (r0 + i - r + KH - 1)) * 31 + (c0 + j - c + KW - 1)] * LOG2E; mx = fmaxf(mx, s);
    }
    float o[HD], sum = 0.f;
#pragma unroll
    for (int d = 0; d < HD; ++d) o[d] = 0.f;
    for (int i = 0; i < KH; ++i) for (int j = 0; j < KW; ++j) {
        const size_t kt = (size_t)(b * SEQ + (r0 + i) * GRIDW + c0 + j); float s = 0.f;
#pragma unroll
        for (int d = 0; d < HD; ++d) s += q[d] * bf2f(proj[kt * NPROJ + 1024 + HD * h + d]);
        s += rpb[(h * 15 + (r0 + i - r + KH - 1)) * 31 + (c0 + j - c + KW - 1)] * LOG2E;
        const float p = exp2f(s - mx); sum += p; const float pb = __builtin_bit_cast(float, f2bf(p) << 16);
#pragma unroll
        for (int d = 0; d < HD; ++d) o[d] += pb * bf2f(Vt[vt_index(HD * h + d, (int)kt)]);
    }
#pragma unroll
    for (int d = 0; d < HD; ++d) mixo[(size_t)tok * D + DPOOL + HD * h + d] = (bf16)f2bf(o[d] / sum);
}

static void launch_mk(const Args& a0, int lo, int hi, int grid, hipStream_t stream, int breg = 0) {
    Args a = a0; a.lo = lo; a.hi = hi; a.breg = breg; a.pad = 0;
    hipLaunchKernelGGL(mk_fwd, dim3(grid), dim3(512), LDS_BYTES, stream, a);
}
extern "C" void kernel_launch(void* const* d_in, const int* in_sizes, int n_in, void* d_out, int out_size, void* d_ws, size_t ws_size, hipStream_t stream) {
    static int grid = 0;
    if (grid == 0) {
        if (n_in != 17 || out_size != T * D || ws_size < WS_END) { fprintf(stderr, "kernel_launch: unexpected problem (n_in %d, out %d, ws %zu)\n", n_in, out_size, ws_size); grid = -1; return; }
        int dev = 0, cus = 0;
        if (hipGetDevice(&dev) != hipSuccess || hipDeviceGetAttribute(&cus, hipDeviceAttributeMultiprocessorCount, dev) != hipSuccess) { grid = -1; return; }
        if (hipFuncSetAttribute((const void*)mk_fwd, hipFuncAttributeMaxDynamicSharedMemorySize, LDS_BYTES) != hipSuccess) { grid = -1; return; }
        int per_cu = 0;
        if (hipOccupancyMaxActiveBlocksPerMultiprocessor(&per_cu, (const void*)mk_fwd, 512, LDS_BYTES) != hipSuccess || per_cu < 1) { fprintf(stderr, "kernel_launch: occupancy query says %d\n", per_cu); }
        (void)hipGetLastError();
        grid = cus;
    }
    if (grid < 0) return;
    hipMemsetAsync((char*)d_ws + WS_CTL, 0, CTL_ZERO_BYTES, stream);
    Args a{};
    for (int i = 0; i < 17; ++i) a.in[i] = (const float*)d_in[i];
    a.out = (float*)d_out; a.ws = (unsigned char*)d_ws; a.lo = 0; a.hi = 0;
    unsigned char* ws = (unsigned char*)d_ws;
#if MODE == 3
#if defined(REPSTEP)
    launch_mk(a, 0, REPSTEP + 1, grid, stream, 0); launch_mk(a, REPSTEP, REPSTEP + 1, grid, stream, 1); launch_mk(a, REPSTEP + 1, NSTEPS, grid, stream, 2);
#else
    launch_mk(a, 0, NSTEPS, grid, stream);
#endif
#else
    launch_mk(a, 0, 1, grid, stream);
    const bf16* HN = (const bf16*)(ws + WS_HN);
    for (int l = 0; l < DEPTH; ++l) {
        const int base = 1 + STEPS_PER_LAYER * l; const int moe = l & 1;
        const bf16* win = (const bf16*)(ws + WS_WIN) + (size_t)l * DIN * D;
        if (NAIVE & 1) {
            hipLaunchKernelGGL(nk_gemm, dim3(NPROJ / 32, T / 32), dim3(64), 0, stream, HN, D, win, D, D, (bf16*)(ws + WS_PROJ), NPROJ, QSCALE, 512, 1024, 0);
            hipLaunchKernelGGL(nk_gemm, dim3(T / 32, DATT / 32), dim3(64), 0, stream, win + (size_t)NPROJ * D, D, HN, D, D, (bf16*)(ws + WS_VT), T, 1.0f, 0, 0, 1);
        } else launch_mk(a, base + 0, base + 1, grid, stream);
        if (NAIVE & 2) {
            hipLaunchKernelGGL(nk_pool_delta, dim3(T * DPOOL / 256), dim3(256), 0, stream, (const bf16*)(ws + WS_PROJ), (bf16*)(ws + WS_MIX));
            hipLaunchKernelGGL(nk_pool_mm, dim3(T * DPOOL / 256), dim3(256), 0, stream, (const bf16*)(ws + WS_MIX), (const bf16*)(ws + WS_WP) + (size_t)l * 4 * 128 * 128, (const float*)d_in[7] + l * DPOOL, (bf16*)(ws + WS_MIXO));
            hipLaunchKernelGGL(nk_na, dim3(T * NH / 256), dim3(256), 0, stream, (const bf16*)(ws + WS_PROJ), (const bf16*)(ws + WS_VT), (const float*)d_in[8] + (size_t)l * NH * 15 * 31, (bf16*)(ws + WS_MIXO));
        } else launch_mk(a, base + 1, base + 2, grid, stream);
        if (NAIVE & 4) hipLaunchKernelGGL(nk_gemm, dim3(D / 32, T / 32), dim3(64), 0, stream, (const bf16*)(ws + WS_MIXO), D, (const bf16*)(ws + WS_WOUT) + (size_t)l * D * D, D, D, (bf16*)(ws + WS_MIX), D, 1.0f, 0, 0, 0);
        else launch_mk(a, base + 2, base + 3, grid, stream);
        launch_mk(a, base + 3, base + 4, grid, stream);
        if (NAIVE & 24) hipLaunchKernelGGL(nk_blocktab, dim3(1), dim3(64), 0, stream, (const unsigned*)(ws + WS_CTL), (int*)(ws + WS_BTAB), moe);
        const int F_ = moe ? DFFE : DFF, nchunk = moe ? MAXCHUNK : 2;
        for (int c = 0; c < nchunk; ++c) {
            if (NAIVE & 8) hipLaunchKernelGGL(nk_ffn_up, dim3(F_ / 32, CHUNK_BLK * 256 / 32), dim3(64), 0, stream, HN, moe ? (const bf16*)(ws + WS_WGUM) : (const bf16*)(ws + WS_WGU0), moe ? (const int*)(ws + WS_LIST) : (const int*)(ws + WS_LISTID), (const int*)(ws + WS_BTAB), (bf16*)(ws + WS_HFF), c * CHUNK_BLK, F_, moe);
            else launch_mk(a, base + 4 + 2 * c, base + 5 + 2 * c, grid, stream);
            if (NAIVE & 16) hipLaunchKernelGGL(nk_ffn_down, dim3(D / 32, CHUNK_BLK * 256 / 32), dim3(64), 0, stream, (const bf16*)(ws + WS_HFF), moe ? (const bf16*)(ws + WS_WDM) : (const bf16*)(ws + WS_WD0), (const int*)(ws + WS_BTAB), (bf16*)(ws + WS_Y), c * CHUNK_BLK, F_);
            else launch_mk(a, base + 5 + 2 * c, base + 6 + 2 * c, grid, stream);
        }
        launch_mk(a, base + 14, base + 15, grid, stream);
    }
#endif
}
```
